# Optimizing an MI355X kernel written in HIP

```python
import jax, jax.numpy as jnp
from jax import lax
import numpy as np

D_MODEL = 2048
BATCH = 2
SEQ = 16384
DEPTH = 2
DEC_BATCH = 8
DEC_SEQ = 4096
PAST_LEN = 128

GRID_W = 64

POOL_WIDTH = D_MODEL // 4
POOL_WINDOWS = (2, 4, 8, 16)
POOL_GROUPS = len(POOL_WINDOWS)
POOL_GC = POOL_WIDTH // POOL_GROUPS

HEAD_DIM = 128
N_Q_HEADS = (D_MODEL // 2) // HEAD_DIM
N_KV_HEADS = 2
GQA_GROUP = N_Q_HEADS // N_KV_HEADS
ATTN_WIDTH = N_Q_HEADS * HEAD_DIM
KV_WIDTH = N_KV_HEADS * HEAD_DIM
Q_BLOCK = 128
ROPE_THETA = 10000.0
ROPE_HALF = HEAD_DIM // 2
ROPE_FREQS_PER_AXIS = HEAD_DIM // 4

FOURIER_WIDTH = D_MODEL - POOL_WIDTH - ATTN_WIDTH
FOURIER_GROUPS = 4
FOURIER_GC = FOURIER_WIDTH // FOURIER_GROUPS

IN_WIDTH = POOL_WIDTH + ATTN_WIDTH + 2 * KV_WIDTH + FOURIER_WIDTH
IN_SPLITS = (POOL_WIDTH,
             POOL_WIDTH + ATTN_WIDTH,
             POOL_WIDTH + ATTN_WIDTH + KV_WIDTH,
             POOL_WIDTH + ATTN_WIDTH + 2 * KV_WIDTH)
MIX_WIDTH = POOL_WIDTH + ATTN_WIDTH + FOURIER_WIDTH

D_FF = 11 * D_MODEL // 4
CONV_WIDTH = 3

NORM_EPS = 1e-6

kernel_name = 'hybrid_pool_attn_fourier_encoder'


def rms_norm(x, g):
    xf = x.astype(jnp.float32)
    y = xf * lax.rsqrt(jnp.mean(xf * xf, axis=-1, keepdims=True) + NORM_EPS)
    return (y * g.astype(jnp.float32)).astype(x.dtype)


def axial_rope_tables(seq_len):
    rows = seq_len // GRID_W
    row_idx = jnp.repeat(jnp.arange(rows, dtype=jnp.float32), GRID_W)
    col_idx = jnp.tile(jnp.arange(GRID_W, dtype=jnp.float32), rows)
    inv_freq = 1.0 / (ROPE_THETA ** (jnp.arange(ROPE_FREQS_PER_AXIS, dtype=jnp.float32) / ROPE_FREQS_PER_AXIS))
    ang = jnp.concatenate([row_idx[:, None] * inv_freq[None, :],
                           col_idx[:, None] * inv_freq[None, :]], axis=-1)
    return jnp.cos(ang), jnp.sin(ang)


def apply_rope(x, cos, sin):
    extra = x.ndim - 3
    shape = (1, cos.shape[0]) + (1,) * extra + (cos.shape[1],)
    c = cos.reshape(shape)
    s = sin.reshape(shape)
    xf = x.astype(jnp.float32)
    x1, x2 = xf[..., :ROPE_HALF], xf[..., ROPE_HALF:]
    return jnp.concatenate([x1 * c - x2 * s, x2 * c + x1 * s], axis=-1).astype(x.dtype)


def multiscale_pool(u, pool_w, pool_scale):
    B, L, _ = u.shape
    uf = u.astype(jnp.float32)
    csum = jnp.concatenate([jnp.zeros((B, 1, POOL_WIDTH), jnp.float32),
                            jnp.cumsum(uf, axis=1)], axis=1)
    t = np.arange(L)
    outs = []
    for g, w in enumerate(POOL_WINDOWS):
        lo = np.clip(t - w // 2, 0, L - 1)
        hi = np.clip(t + w - 1 - w // 2, 0, L - 1)
        cnt = jnp.asarray((hi - lo + 1).astype(np.float32))[None, :, None]
        sl = slice(g * POOL_GC, (g + 1) * POOL_GC)
        cg = csum[..., sl]
        win_sum = jnp.take(cg, jnp.asarray(hi + 1), axis=1) - jnp.take(cg, jnp.asarray(lo), axis=1)
        outs.append(win_sum / cnt - uf[..., sl])
    d = jnp.stack(outs, axis=2).astype(u.dtype)
    y = jnp.einsum('blgc,gce->blge', d, pool_w).reshape(B, L, POOL_WIDTH)
    return y * pool_scale


def gqa_attention(q, k, v):
    B, L = q.shape[0], q.shape[1]
    n_blk = L // Q_BLOCK
    scale = HEAD_DIM ** -0.5
    qb = q.reshape(B, n_blk, Q_BLOCK, N_KV_HEADS, GQA_GROUP, HEAD_DIM).transpose(1, 0, 2, 3, 4, 5)

    def block(q_blk):
        s = jnp.einsum('bqkgd,bskd->bkgqs', q_blk, k,
                       preferred_element_type=jnp.float32) * scale
        p = jax.nn.softmax(s, axis=-1)
        return jnp.einsum('bkgqs,bskd->bqkgd', p.astype(v.dtype), v)

    o = lax.map(block, qb)
    return o.transpose(1, 0, 2, 3, 4, 5).reshape(B, L, ATTN_WIDTH)


def fourier_mix(u, fourier_w):
    B, L, _ = u.shape
    ug = u.astype(jnp.float32).reshape(B, L, FOURIER_GROUPS, FOURIER_GC)
    f = jnp.fft.fft2(ug, axes=(1, 3), norm='ortho').real.astype(u.dtype)
    return jnp.einsum('blgc,gce->blge', f, fourier_w).reshape(B, L, FOURIER_WIDTH)


def token_mixer(h, w_in, pool_w, pool_scale, q_norm, k_norm, fourier_w, w_out):
    B, L, _ = h.shape
    z = h @ w_in
    u_pool, q, k, v, u_four = jnp.split(z, IN_SPLITS, axis=-1)
    cos, sin = axial_rope_tables(L)
    q = apply_rope(rms_norm(q.reshape(B, L, N_KV_HEADS, GQA_GROUP, HEAD_DIM), q_norm), cos, sin)
    k = apply_rope(rms_norm(k.reshape(B, L, N_KV_HEADS, HEAD_DIM), k_norm), cos, sin)
    v = v.reshape(B, L, N_KV_HEADS, HEAD_DIM)
    heads = jnp.concatenate([multiscale_pool(u_pool, pool_w, pool_scale),
                             gqa_attention(q, k, v),
                             fourier_mix(u_four, fourier_w)], axis=-1)
    return heads @ w_out


def conv_gated_mlp(h, w_up, conv_w, conv_b, w_down):
    u = h @ w_up
    up = jnp.pad(u, ((0, 0), (1, 1), (0, 0)))
    c = up[:, :-2] * conv_w[0] + up[:, 1:-1] * conv_w[1] + up[:, 2:] * conv_w[2] + conv_b
    gate, val = jnp.split(c, 2, axis=-1)
    return (jax.nn.gelu(gate, approximate=True) * val) @ w_down


def run_trunk(x, g_pre_mix, g_post_mix, w_in, pool_w, pool_scale, q_norm, k_norm,
              fourier_w, w_out, g_pre_ffn, g_post_ffn, w_up, conv_w, conv_b, w_down):
    for l in range(DEPTH):
        m = token_mixer(rms_norm(x, g_pre_mix[l]), w_in[l], pool_w[l], pool_scale[l],
                        q_norm[l], k_norm[l], fourier_w[l], w_out[l])
        x = x + rms_norm(m, g_post_mix[l])
        f = conv_gated_mlp(rms_norm(x, g_pre_ffn[l]), w_up[l], conv_w[l], conv_b[l], w_down[l])
        x = x + rms_norm(f, g_post_ffn[l])
    return x


def setup_inputs(seed: int = 0) -> dict:
    key = jax.random.key(seed)
    ks = jax.random.split(key, 20)
    f32 = jnp.float32

    def nrm(k, shape, scale):
        return jax.random.normal(k, shape, f32) * scale

    def gain(k, shape):
        return 1.0 + 0.05 * jax.random.normal(k, shape, f32)

    return {
        'x_prompt': nrm(ks[0], (BATCH, SEQ, D_MODEL), 1.0),
        'x_sample': nrm(ks[1], (DEC_BATCH, DEC_SEQ, D_MODEL), 1.0),
        'g_pre_mix': gain(ks[2], (DEPTH, D_MODEL)),
        'g_post_mix': gain(ks[3], (DEPTH, D_MODEL)),
        'w_in': nrm(ks[4], (DEPTH, D_MODEL, IN_WIDTH), D_MODEL ** -0.5),
        'pool_w': nrm(ks[5], (DEPTH, POOL_GROUPS, POOL_GC, POOL_GC), POOL_GC ** -0.5),
        'pool_scale': gain(ks[6], (DEPTH, POOL_WIDTH)),
        'q_norm': gain(ks[7], (DEPTH, HEAD_DIM)),
        'k_norm': gain(ks[8], (DEPTH, HEAD_DIM)),
        'fourier_w': nrm(ks[9], (DEPTH, FOURIER_GROUPS, FOURIER_GC, FOURIER_GC), FOURIER_GC ** -0.5),
        'w_out': nrm(ks[10], (DEPTH, MIX_WIDTH, D_MODEL), MIX_WIDTH ** -0.5),
        'g_pre_ffn': gain(ks[11], (DEPTH, D_MODEL)),
        'g_post_ffn': gain(ks[12], (DEPTH, D_MODEL)),
        'w_up': nrm(ks[13], (DEPTH, D_MODEL, 2 * D_FF), D_MODEL ** -0.5),
        'conv_w': nrm(ks[14], (DEPTH, CONV_WIDTH, 2 * D_FF), CONV_WIDTH ** -0.5),
        'conv_b': nrm(ks[15], (DEPTH, 2 * D_FF), 0.02),
        'w_down': nrm(ks[16], (DEPTH, D_FF, D_MODEL), D_FF ** -0.5),
    }


def reference(x_prompt, x_sample, g_pre_mix, g_post_mix, w_in, pool_w, pool_scale, q_norm,
              k_norm, fourier_w, w_out, g_pre_ffn, g_post_ffn, w_up, conv_w, conv_b, w_down):
    y_prompt = run_trunk(x_prompt, g_pre_mix, g_post_mix, w_in, pool_w, pool_scale, q_norm,
                         k_norm, fourier_w, w_out, g_pre_ffn, g_post_ffn, w_up, conv_w,
                         conv_b, w_down)
    y_sample = run_trunk(x_sample, g_pre_mix, g_post_mix, w_in, pool_w, pool_scale, q_norm,
                         k_norm, fourier_w, w_out, g_pre_ffn, g_post_ffn, w_up, conv_w,
                         conv_b, w_down)
    return (y_prompt, y_sample)
```

```cpp
#include <hip/hip_runtime.h>
#include <hip/hip_bf16.h>
#include <hip/hip_cooperative_groups.h>
#include <cstdio>
#include <cstdint>
#ifndef MK_MULTI
#define MK_MULTI 0
#endif
__device__ __forceinline__ int ltid() { int t = threadIdx.x; asm volatile("" : "+v"(t)); return t; }
#ifndef REP_UP
#define REP_UP 1
#endif
#ifndef REP_ATTN
#define REP_ATTN 1
#endif
#ifndef REP_PLAIN
#define REP_PLAIN 1
#endif
#ifndef REP_WIN
#define REP_WIN 1
#endif
#ifndef REP_P0
#define REP_P0 1
#endif
#ifndef REP_LIGHT
#define REP_LIGHT 1
#endif
#ifndef REP_SYNC
#define REP_SYNC 1
#endif
namespace pg8 {
#define PG8_LAS __attribute__((address_space(3)))
typedef unsigned short bf16_t;
typedef short bf16x8 __attribute__((ext_vector_type(8)));
typedef float f32x4 __attribute__((ext_vector_type(4)));
typedef unsigned u32x4 __attribute__((ext_vector_type(4)));
constexpr int BM = 256, BK = 64, HALF = 128, HTB = HALF * BK * 2  , STAGE_BYTES = 8 * HTB, NXCD = 8, WGM = 8;

__host__ __device__ __forceinline__ int lds_byte(int r, int c) { const int st = (r >> 4) * 2 + (c >> 5), rr = r & 15, cc = c & 31, ob = rr * 64 + cc * 2; return st * 1024 + (ob ^ (((ob >> 9) & 1) << 5)); }
__host__ __device__ __forceinline__ void stage_rc(int b, int& R, int& C) { const int st = b / 1024, sb = b % 1024, swz = sb ^ (((sb >> 9) & 1) << 5); R = (st >> 1) * 16 + swz / 64; C = (st & 1) * 32 + (swz % 64) / 2; }
__host__ __device__ __forceinline__ int perm32(int rho) { const int n = rho >> 4, i = rho & 15; return 8 * (i >> 2) + 4 * n + (i & 3); }

struct Unit { int pm, pn; };
struct Gemm { const bf16_t* A; const bf16_t* Bt; int M, N, K; };

struct StaticOrder {
    int nM, nN, nwg, G, c;
    __host__ __device__ void init(int M, int N, int G_, int c_) { nM = M / BM; nN = N / BM; nwg = nM * nN; G = G_; c = c_; }
    __host__ __device__ bool next(int i, Unit& u) const {
        const long L = (long)i * G + c; if (L >= nwg) return false;
        int wgid = (int)L; { const int q = nwg / NXCD, r = nwg % NXCD, xcd = wgid % NXCD, off = wgid / NXCD; wgid = (xcd < r ? xcd * (q + 1) : r * (q + 1) + (xcd - r) * q) + off; }
        const int nig = WGM * nN, gid = wgid / nig, fm = gid * WGM, gsz = (nM - fm) < WGM ? (nM - fm) : WGM;
        u.pm = fm + ((wgid % nig) % gsz); u.pn = (wgid % nig) / gsz; return true;
    }
    __device__ __forceinline__ void a_ready(const Unit&) const {}
    __device__ __forceinline__ void done(const Unit&) const {}
};

__device__ __forceinline__ unsigned cvt_pk_bf16(float lo, float hi) { unsigned r; asm volatile("v_cvt_pk_bf16_f32 %0, %1, %2" : "=v"(r) : "v"(lo), "v"(hi)); return r; }
typedef float f32x2 __attribute__((ext_vector_type(2)));
__device__ __forceinline__ f32x2 gelu_pk(f32x2 v) {
    const f32x2 av = __builtin_elementwise_abs(v), d = av * 0.2316418882f + 1.0f;
    f32x2 t; t.x = __builtin_amdgcn_rcpf(d.x); t.y = __builtin_amdgcn_rcpf(d.y);
    f32x2 q = t * 0.5307027145f + (-0.7265760135f); q = q * t + 0.7107068705f; q = q * t + (-0.142248368f); q = q * t + 0.127414796f; q = q * t;
    const f32x2 s = (v * v) * (-0.72134752044f);
    f32x2 e; e.x = __builtin_amdgcn_exp2f(s.x); e.y = __builtin_amdgcn_exp2f(s.y);
    const f32x2 m = v * (q * e), r = v - m;
    f32x2 o; o.x = v.x < 0.f ? m.x : r.x; o.y = v.y < 0.f ? m.y : r.y; return o;
}

template <int ACT  > struct EpiBf16 {
    static constexpr bool PERM = true, AFTER_DRAIN = false; static_assert(ACT == 0 || ACT == 1, "EpiBf16: ACT is 0 (none) or 1 (gelu_pk)");
    bf16_t* O; int ldc; const float* bias; int split_cols; size_t split_stride; float scale0;
    __device__ __forceinline__ void operator()(const f32x4 (&acc)[2][2][4][2], const Unit& u, int wr, int wc, int fr, int fq) const {
        const int row0 = u.pm * BM + wr * 64 + fr; int colt = u.pn * BM; bf16_t* base = O;
        float sc = 1.f; if (split_cols) { const int t = colt / split_cols; base += (size_t)t * split_stride; colt -= t * split_cols; if (t == 0) sc = scale0; }
        const int col0 = colt + wc * 32 + 8 * fq, bcol0 = u.pn * BM + wc * 32 + 8 * fq;
        f32x4 bv[2][2];
#pragma unroll
        for (int bj = 0; bj < 2; ++bj)
#pragma unroll
            for (int n = 0; n < 2; ++n) bv[bj][n] = bias ? *(const f32x4*)(bias + bcol0 + bj * HALF + 4 * n) : (f32x4){0.f, 0.f, 0.f, 0.f};
#pragma unroll
        for (int ai = 0; ai < 2; ++ai)
#pragma unroll
            for (int m = 0; m < 4; ++m) { bf16_t* rowp = base + (size_t)(row0 + ai * HALF + m * 16) * ldc + col0;
#pragma unroll
                for (int bj = 0; bj < 2; ++bj) { f32x4 v0 = acc[ai][bj][m][0] + bv[bj][0], v1 = acc[ai][bj][m][1] + bv[bj][1];
                    if (ACT == 1) { f32x2 a = gelu_pk((f32x2){v0[0], v0[1]}), b = gelu_pk((f32x2){v0[2], v0[3]}), c = gelu_pk((f32x2){v1[0], v1[1]}), d = gelu_pk((f32x2){v1[2], v1[3]});
                        v0 = (f32x4){a.x, a.y, b.x, b.y}; v1 = (f32x4){c.x, c.y, d.x, d.y}; }
                    v0 = v0 * sc; v1 = v1 * sc; u32x4 w; w.x = cvt_pk_bf16(v0[0], v0[1]); w.y = cvt_pk_bf16(v0[2], v0[3]); w.z = cvt_pk_bf16(v1[0], v1[1]); w.w = cvt_pk_bf16(v1[2], v1[3]);
                    *(u32x4*)(rowp + bj * HALF) = w; } }
    }
};
template <class Epi, class Sched, bool ALIGN_EPI = false, bool SP2 = false>
__device__ __forceinline__ void gemm_phase(PG8_LAS unsigned char* lds, const Gemm g, const Sched& S, const Epi& E) {
    const int tid = ltid(), wid = __builtin_amdgcn_readfirstlane(tid >> 6), lane = tid & 63, wr = wid >> 2, wc = wid & 3, fr = lane & 15, fq = lane >> 4;
    const int K = g.K, nt = K / BK;
    unsigned voffA[2], voffB[2];
#pragma unroll
    for (int i = 0; i < 2; ++i) { int R, C; stage_rc(tid * 16 + i * 8192, R, C); const int Rb = Epi::PERM ? ((R & ~31) + perm32(R & 31)) : R;
        voffA[i] = (unsigned)(R * K + C) * 2u; voffB[i] = (unsigned)(Rb * K + C) * 2u; }
    const size_t kstep = (size_t)(BK * 2);
    const size_t hstep = (size_t)HALF * K * 2;
    const size_t tstep = 2 * hstep;
    const unsigned ldsw = (unsigned)wid * 1024u;
    const int aoff = lds_byte(wr * 64 + fr, fq * 8), boff = lds_byte(wc * 32 + fr, fq * 8);
#define PG8_SA(b, h) (((b) * 2 + (h)) * HTB)
#define PG8_SB(b, h) ((4 + (b) * 2 + (h)) * HTB)
#define PG8_STAGE(bufoff, gbase, voff) do { _Pragma("unroll") for (int _i = 0; _i < 2; ++_i) \
        __builtin_amdgcn_global_load_lds((const unsigned*)((const char*)(gbase) + (voff)[_i]), (PG8_LAS unsigned*)(lds + (bufoff) + ldsw + _i * 8192), 16, 0, 0); } while (0)
#define PG8_LDA(dst, b, h) do { _Pragma("unroll") for (int m = 0; m < 4; ++m) _Pragma("unroll") for (int k = 0; k < 2; ++k) dst[m][k] = *(const PG8_LAS bf16x8*)(lds + PG8_SA(b, h) + aoff + m * 2048 + k * 1024); } while (0)
#define PG8_LDB(dst, b, h) do { _Pragma("unroll") for (int n = 0; n < 2; ++n) _Pragma("unroll") for (int k = 0; k < 2; ++k) dst[n][k] = *(const PG8_LAS bf16x8*)(lds + PG8_SB(b, h) + boff + n * 2048 + k * 1024); } while (0)
#define PG8_MMA(ai, bj, At, Bt) do { __builtin_amdgcn_s_setprio(1); _Pragma("unroll") for (int m = 0; m < 4; ++m) _Pragma("unroll") for (int n = 0; n < 2; ++n) _Pragma("unroll") for (int k = 0; k < 2; ++k) \
        acc[ai][bj][m][n] = __builtin_amdgcn_mfma_f32_16x16x32_bf16(Bt[n][k], At[m][k], acc[ai][bj][m][n], 0, 0, 0); __builtin_amdgcn_s_setprio(0); } while (0)
#define PG8_WAIT_V(n) asm volatile("s_waitcnt vmcnt(" #n ")" ::: "memory")
#define PG8_WAIT_L(n) asm volatile("s_waitcnt lgkmcnt(" #n ")" ::: "memory")
#define PG8_BAR __builtin_amdgcn_s_barrier()
#define PG8_SCHED __builtin_amdgcn_sched_barrier(0)
    Unit cur, nxt; int ui = 0;
    if (!S.next(0, cur)) return;
    f32x4 acc[2][2][4][2];
#pragma unroll
    for (int a = 0; a < 2; ++a)
#pragma unroll
        for (int b = 0; b < 2; ++b)
#pragma unroll
            for (int m = 0; m < 4; ++m)
#pragma unroll
                for (int n = 0; n < 2; ++n) acc[a][b][m][n] = (f32x4){0.f, 0.f, 0.f, 0.f};
    bf16x8 At[4][2], B0[2][2], B1[2][2];
    const char* cA = (const char*)g.A + (size_t)cur.pm * tstep; const char* cB = (const char*)g.Bt + (size_t)cur.pn * tstep;
    S.a_ready(cur);
    if constexpr (SP2) {
        PG8_STAGE(PG8_SB(0, 0), cB, voffB); PG8_STAGE(PG8_SB(0, 1), cB + hstep, voffB); PG8_STAGE(PG8_SA(0, 0), cA, voffA); PG8_STAGE(PG8_SA(0, 1), cA + hstep, voffA);
        if (wr == 1) PG8_BAR;
        PG8_WAIT_V(2); PG8_BAR;
        PG8_STAGE(PG8_SB(1, 0), cB + kstep, voffB); PG8_STAGE(PG8_SA(1, 0), cA + kstep, voffA); PG8_STAGE(PG8_SB(1, 1), cB + hstep + kstep, voffB);
        PG8_WAIT_V(6); PG8_BAR;
    } else {
        PG8_STAGE(PG8_SB(0, 0), cB, voffB); PG8_STAGE(PG8_SA(0, 0), cA, voffA); PG8_STAGE(PG8_SB(0, 1), cB + hstep, voffB); PG8_STAGE(PG8_SA(0, 1), cA + hstep, voffA);
        if (wr == 1) PG8_BAR;
        PG8_WAIT_V(4); PG8_BAR;
        PG8_STAGE(PG8_SB(1, 0), cB + kstep, voffB); PG8_STAGE(PG8_SA(1, 0), cA + kstep, voffA); PG8_STAGE(PG8_SB(1, 1), cB + hstep + kstep, voffB);
        PG8_WAIT_V(6); PG8_BAR;
    }
    for (;;) {
        const bool has_next = S.next(ui + 1, nxt);
        const char* nA = has_next ? (const char*)g.A + (size_t)nxt.pm * tstep : cA; const char* nB = has_next ? (const char*)g.Bt + (size_t)nxt.pn * tstep : cB;
        for (int t = 0; t < nt; t += 2) {
            const bool last = (t == nt - 2);
            const char* a1 = cA + (size_t)(t + 1) * kstep;
            const char* a2 = last ? nA : cA + (size_t)(t + 2) * kstep; const char* b2 = last ? nB : cB + (size_t)(t + 2) * kstep;
            const char* a3 = a2 + kstep; const char* b3 = b2 + kstep;
            if (last && has_next) S.a_ready(nxt);
            if constexpr (SP2) {
            PG8_LDB(B0, 0, 0); PG8_LDB(B1, 0, 1); PG8_SCHED; PG8_LDA(At, 0, 0); PG8_STAGE(PG8_SA(1, 1), a1 + hstep, voffA);
            PG8_WAIT_V(8); PG8_WAIT_L(0); PG8_BAR; PG8_MMA(0, 0, At, B0); PG8_MMA(0, 1, At, B1); PG8_BAR; PG8_SCHED;
            PG8_LDA(At, 0, 1); PG8_STAGE(PG8_SB(0, 0), b2, voffB); PG8_STAGE(PG8_SB(0, 1), b2 + hstep, voffB); PG8_STAGE(PG8_SA(0, 0), a2, voffA);
            PG8_WAIT_V(8); PG8_WAIT_L(0); PG8_BAR; PG8_MMA(1, 0, At, B0); PG8_MMA(1, 1, At, B1); PG8_BAR; PG8_SCHED;
            PG8_LDB(B0, 1, 0); PG8_LDB(B1, 1, 1); PG8_SCHED; PG8_LDA(At, 1, 0); PG8_STAGE(PG8_SA(0, 1), a2 + hstep, voffA);
            PG8_WAIT_V(8); PG8_WAIT_L(0); PG8_BAR; PG8_MMA(0, 0, At, B0); PG8_MMA(0, 1, At, B1); PG8_BAR; PG8_SCHED;
            PG8_LDA(At, 1, 1); PG8_STAGE(PG8_SB(1, 0), b3, voffB); PG8_STAGE(PG8_SB(1, 1), b3 + hstep, voffB); PG8_STAGE(PG8_SA(1, 0), a3, voffA);
            PG8_WAIT_V(8); PG8_WAIT_L(0); PG8_BAR; PG8_MMA(1, 0, At, B0); PG8_MMA(1, 1, At, B1); PG8_BAR; PG8_SCHED;
            } else {
            PG8_LDB(B0, 0, 0); PG8_SCHED; PG8_LDA(At, 0, 0); PG8_STAGE(PG8_SA(1, 1), a1 + hstep, voffA);
            PG8_WAIT_L(8); PG8_BAR; PG8_WAIT_L(0); PG8_MMA(0, 0, At, B0); PG8_BAR; PG8_SCHED;
            PG8_LDB(B1, 0, 1); PG8_STAGE(PG8_SB(0, 0), b2, voffB);
            PG8_BAR; PG8_WAIT_L(0); PG8_MMA(0, 1, At, B1); PG8_BAR;
            PG8_LDA(At, 0, 1); PG8_STAGE(PG8_SA(0, 0), a2, voffA);
            PG8_BAR; PG8_WAIT_L(0); PG8_MMA(1, 0, At, B0); PG8_BAR; PG8_SCHED;
            PG8_STAGE(PG8_SB(0, 1), b2 + hstep, voffB);
            PG8_WAIT_V(6); PG8_BAR; PG8_MMA(1, 1, At, B1); PG8_BAR;
            PG8_LDB(B0, 1, 0); PG8_SCHED; PG8_LDA(At, 1, 0); PG8_STAGE(PG8_SA(0, 1), a2 + hstep, voffA);
            PG8_WAIT_L(8); PG8_BAR; PG8_WAIT_L(0); PG8_MMA(0, 0, At, B0); PG8_BAR; PG8_SCHED;
            PG8_LDB(B1, 1, 1); PG8_STAGE(PG8_SB(1, 0), b3, voffB);
            PG8_BAR; PG8_WAIT_L(0); PG8_MMA(0, 1, At, B1); PG8_BAR;
            PG8_LDA(At, 1, 1); PG8_STAGE(PG8_SA(1, 0), a3, voffA);
            PG8_BAR; PG8_WAIT_L(0); PG8_MMA(1, 0, At, B0); PG8_BAR; PG8_SCHED;
            PG8_STAGE(PG8_SB(1, 1), b3 + hstep, voffB);
            PG8_WAIT_V(6); PG8_BAR; PG8_MMA(1, 1, At, B1); PG8_BAR;
            }
        }
        if constexpr (ALIGN_EPI) { if (wr == 0) PG8_BAR; }
        if constexpr (!Epi::AFTER_DRAIN) { E(acc, cur, wr, wc, fr, fq); S.done(cur); }
        if (!has_next) break;
#pragma unroll
        for (int a = 0; a < 2; ++a)
#pragma unroll
            for (int b = 0; b < 2; ++b)
#pragma unroll
                for (int m = 0; m < 4; ++m)
#pragma unroll
                    for (int n = 0; n < 2; ++n) acc[a][b][m][n] = (f32x4){0.f, 0.f, 0.f, 0.f};
        cur = nxt; cA = nA; cB = nB; ++ui;
        if constexpr (ALIGN_EPI) { if (wr == 1) PG8_BAR; }
    }
    PG8_WAIT_V(0);
    if constexpr (!ALIGN_EPI) { if (wr == 0) PG8_BAR; }
    PG8_BAR;
    if constexpr (Epi::AFTER_DRAIN) { E.fused(acc, cur, wr, wc, fr, fq, lds, wid, lane); S.done(cur); }
#undef PG8_SA
#undef PG8_SB
#undef PG8_STAGE
#undef PG8_LDA
#undef PG8_LDB
#undef PG8_MMA
#undef PG8_WAIT_V
#undef PG8_WAIT_L
#undef PG8_BAR
#undef PG8_SCHED
}
}
#define PG8_SP2 true
#define PG8_ALIGN true
namespace att {
using bf16 = __hip_bfloat16;
constexpr int   D = 128, NW = 8, QBLK = 32, KVBLK = 64;
constexpr float SCALE = 0.088388347648318440f;
constexpr float THR = 8.f;
constexpr int SDEPTH = 2;
constexpr bool STATIC_MAX = true;
constexpr int LDQ = 2048, LDK = 2048, LDO = 2048;
constexpr size_t SHM_V = KVBLK * D * 2, SHM_K = KVBLK * D * 2, SHM_ATTN = 2 * SHM_V + 2 * SHM_K + NW * 64 * 4;
using bf16x8 = __attribute__((ext_vector_type(8))) short;
using s16x4  = __attribute__((ext_vector_type(4))) short;
using f32x16 = __attribute__((ext_vector_type(16))) float;
using f32x8  = __attribute__((ext_vector_type(8))) float;
using u32x4  = __attribute__((ext_vector_type(4))) unsigned;
#define KSWZ(row, colB) ((row) * 256 + ((colB) ^ (((row) & 7) << 4)))
#define SBAR() __builtin_amdgcn_sched_barrier(0)
__device__ __forceinline__ int crow(int r, int hi) { return (r & 3) + 8 * (r >> 2) + 4 * hi; }
__device__ __forceinline__ unsigned cvtpk(float lo, float hi) {
  unsigned r; asm volatile("v_cvt_pk_bf16_f32 %0, %1, %2" : "=v"(r) : "v"(lo), "v"(hi)); return r;
}
template <typename TIn> struct Stage;
template <> struct Stage<bf16>  { using T = bf16x8;
  __device__ static __forceinline__ T ld8(const bf16* p) { return *reinterpret_cast<const bf16x8*>(p); }
  __device__ static __forceinline__ bf16x8 tobf(T x) { return x; } };
template <> struct Stage<float> { using T = f32x8;
  __device__ static __forceinline__ T ld8(const float* p) { return *reinterpret_cast<const f32x8*>(p); }
  __device__ static __forceinline__ bf16x8 tobf(T x) {
    u32x4 w = {cvtpk(x[0], x[1]), cvtpk(x[2], x[3]), cvtpk(x[4], x[5]), cvtpk(x[6], x[7])}; return *reinterpret_cast<bf16x8*>(&w); } };

__device__ __forceinline__ void partialSM(f32x16& p0, f32x16& p1, float& m_reg, float& mn, float& alpha) {
  constexpr float C = SCALE * 1.4426950408889634f;
  if constexpr (STATIC_MAX) { mn = m_reg; alpha = 1.f; }
  else {
  float pmax = p0[0]; for (int r = 1; r < 16; ++r) pmax = fmaxf(pmax, p0[r]); for (int r = 0; r < 16; ++r) pmax = fmaxf(pmax, p1[r]);
  { auto rr = __builtin_amdgcn_permlane32_swap(__float_as_uint(pmax), __float_as_uint(pmax), false, false);
    pmax = fmaxf(__uint_as_float(rr[0]), __uint_as_float(rr[1])); }
  if (__builtin_expect(__all(pmax - m_reg <= THR / SCALE), 1)) { mn = m_reg; alpha = 1.f; }
  else { mn = fmaxf(m_reg, pmax); alpha = __builtin_amdgcn_exp2f((m_reg - mn) * C); m_reg = mn; }
  }
  float mnC = -mn * C;
  for (int r = 0; r < 16; ++r) p0[r] = fmaf(p0[r], C, mnC); for (int r = 0; r < 16; ++r) p1[r] = fmaf(p1[r], C, mnC);
  for (int r = 0; r < 16; ++r) p0[r] = __builtin_amdgcn_exp2f(p0[r]);
}
__device__ __forceinline__ void finishSM(f32x16& p0, f32x16& p1, float alpha, float& l_reg, bf16x8& pa0, bf16x8& pa1, bf16x8& pa2, bf16x8& pa3) {
  for (int r = 0; r < 16; ++r) p1[r] = __builtin_amdgcn_exp2f(p1[r]);
  float ps = 0; for (int r = 0; r < 16; ++r) ps += p0[r]; for (int r = 0; r < 16; ++r) ps += p1[r];
  { auto rr = __builtin_amdgcn_permlane32_swap(__float_as_uint(ps), __float_as_uint(ps), false, false);
    ps = __uint_as_float(rr[0]) + __uint_as_float(rr[1]); }
  l_reg = l_reg * alpha + ps;
#define PK4(P, BASE, OUT) do { unsigned a0 = cvtpk(P[BASE + 0], P[BASE + 1]), a1 = cvtpk(P[BASE + 2], P[BASE + 3]);   \
    unsigned b0 = cvtpk(P[BASE + 4], P[BASE + 5]), b1 = cvtpk(P[BASE + 6], P[BASE + 7]);                              \
    auto r0 = __builtin_amdgcn_permlane32_swap(a0, b0, false, false); auto r1 = __builtin_amdgcn_permlane32_swap(a1, b1, false, false); \
    u32x4 w = {r0[0], r1[0], r0[1], r1[1]}; OUT = *reinterpret_cast<bf16x8*>(&w); } while (0)
  PK4(p0, 0, pa0); PK4(p0, 8, pa1); PK4(p1, 0, pa2); PK4(p1, 8, pa3);
#undef PK4
}
__device__ __forceinline__ void qkt(f32x16& p0, f32x16& p1, const bf16* Ks, const bf16x8* qr, int r32, int hi) {
  p0 = f32x16{}; p1 = f32x16{};
  for (int d0 = 0; d0 < 8; ++d0) { int cb = (d0 * 16 + hi * 8) * 2;
    bf16x8 b0 = *reinterpret_cast<const bf16x8*>((const char*)Ks + KSWZ(r32, cb));
    bf16x8 b1 = *reinterpret_cast<const bf16x8*>((const char*)Ks + KSWZ(32 + r32, cb));
    p0 = __builtin_amdgcn_mfma_f32_32x32x16_bf16(b0, qr[d0], p0, 0, 0, 0);
    p1 = __builtin_amdgcn_mfma_f32_32x32x16_bf16(b1, qr[d0], p1, 0, 0, 0); }
}
__device__ __forceinline__ int v_st(int k, int c) { const int kk = (k & ~0xC) | ((k & 4) << 1) | ((k & 8) >> 1); return ((kk >> 3) * 4 + (c >> 5)) * 512 + ((kk & 7) * 32 + (c & 31)) * 2; }
__device__ __forceinline__ int v_rd_base(int lane) { return ((lane & 3) << 3) | (((lane >> 2) & 3) << 6) | (((lane >> 4) & 1) << 5) | (((lane >> 5) & 1) << 8); }
constexpr int v_rd_off(int d0, int ks, int half) { return d0 * 512 + ks * 4096 + half * 2048; }
template <int OFF> __device__ __forceinline__ s16x4 tr_read(int vb) {
  s16x4 r; asm volatile("ds_read_b64_tr_b16 %0, %1 offset:%2" : "=&v"(r) : "v"(vb), "i"(OFF) : "memory"); return r;
}
template <int D0> __device__ __forceinline__ void pv_one(f32x16& od, int vb, bf16x8 pa0, bf16x8 pa1, bf16x8 pa2, bf16x8 pa3) {
  const s16x4 l0 = tr_read<v_rd_off(D0, 0, 0)>(vb), h0 = tr_read<v_rd_off(D0, 0, 1)>(vb), l1 = tr_read<v_rd_off(D0, 1, 0)>(vb), h1 = tr_read<v_rd_off(D0, 1, 1)>(vb);
  const s16x4 l2 = tr_read<v_rd_off(D0, 2, 0)>(vb), h2 = tr_read<v_rd_off(D0, 2, 1)>(vb), l3 = tr_read<v_rd_off(D0, 3, 0)>(vb), h3 = tr_read<v_rd_off(D0, 3, 1)>(vb);
  asm volatile("s_waitcnt lgkmcnt(0)" ::: "memory"); SBAR();
#define PK(L, H) (bf16x8){L[0], L[1], L[2], L[3], H[0], H[1], H[2], H[3]}
  od = __builtin_amdgcn_mfma_f32_32x32x16_bf16(pa0, PK(l0, h0), od, 0, 0, 0);
  od = __builtin_amdgcn_mfma_f32_32x32x16_bf16(pa1, PK(l1, h1), od, 0, 0, 0);
  od = __builtin_amdgcn_mfma_f32_32x32x16_bf16(pa2, PK(l2, h2), od, 0, 0, 0);
  od = __builtin_amdgcn_mfma_f32_32x32x16_bf16(pa3, PK(l3, h3), od, 0, 0, 0);
#undef PK
}
__device__ __forceinline__ void pv_d0(f32x16* o, int vb, bf16x8 pa0, bf16x8 pa1, bf16x8 pa2, bf16x8 pa3) {
  pv_one<0>(o[0], vb, pa0, pa1, pa2, pa3); pv_one<1>(o[1], vb, pa0, pa1, pa2, pa3); pv_one<2>(o[2], vb, pa0, pa1, pa2, pa3); pv_one<3>(o[3], vb, pa0, pa1, pa2, pa3);
}
template <typename TQ>
__device__ __forceinline__ void attn_dense_body(const TQ* __restrict__ Qb, const bf16* __restrict__ Kh, const bf16* __restrict__ Vh,
                                                bf16* __restrict__ Ob, int seq, char* lds, float bound) {
  using St = Stage<bf16>; using SQ = Stage<TQ>;
  const int tid = ltid(), wid = tid >> 6, lane = tid & 63, r32 = lane & 31, hi = lane >> 5;
  bf16* V_lds = (bf16*)lds; bf16* K_lds = (bf16*)(lds + 2 * SHM_V);
  float* ws = (float*)(lds + 2 * SHM_V + 2 * SHM_K) + wid * 64; float* li_l = ws; float* al_l = ws + 32;
  float m_reg = STATIC_MAX ? bound : -1e30f, l_reg = 0; f32x16 o[4] = {}; bf16x8 qr[8];
  const TQ* Qw = Qb + (long)(wid * QBLK + r32) * LDQ + hi * 8;
#pragma unroll
  for (int d0 = 0; d0 < 8; ++d0) qr[d0] = SQ::tobf(SQ::ld8(Qw + d0 * 16));
  const int sr = tid >> 4, sc = (tid & 15) * 8, vst0 = v_st(sr, sc), vst1 = v_st(32 + sr, sc);
  const int vb0 = (int)(uintptr_t)V_lds + v_rd_base(lane);
  struct { typename St::T vs0, vs1, ks0, ks1; } sr_[SDEPTH];
#define SLOAD(i, k0) do { sr_[i].vs0 = St::ld8(&Vh[(long)((k0) + sr) * LDK + sc]); sr_[i].vs1 = St::ld8(&Vh[(long)((k0) + 32 + sr) * LDK + sc]); \
    sr_[i].ks0 = St::ld8(&Kh[(long)((k0) + sr) * LDK + sc]); sr_[i].ks1 = St::ld8(&Kh[(long)((k0) + 32 + sr) * LDK + sc]); } while (0)
#define SWRITE(b, i) do { *(bf16x8*)((char*)V_lds + (b) * SHM_V + vst0) = St::tobf(sr_[i].vs0);          \
    *(bf16x8*)((char*)V_lds + (b) * SHM_V + vst1) = St::tobf(sr_[i].vs1); int kc = sc * 2;               \
    *(bf16x8*)((char*)K_lds + (b) * SHM_K + KSWZ(sr, kc)) = St::tobf(sr_[i].ks0);                       \
    *(bf16x8*)((char*)K_lds + (b) * SHM_K + KSWZ(32 + sr, kc)) = St::tobf(sr_[i].ks1); } while (0)
#define SWAIT() do { if constexpr (SDEPTH == 2) asm volatile("s_waitcnt vmcnt(4)" ::: "memory"); else asm volatile("s_waitcnt vmcnt(0)" ::: "memory"); } while (0)
#define RESC(a) do { if (!STATIC_MAX && __any((a) < 1.f)) { if (hi == 0) al_l[r32] = (a); asm volatile("s_waitcnt lgkmcnt(0)" ::: "memory"); \
    for (int d = 0; d < 4; ++d) for (int r = 0; r < 16; ++r) o[d][r] *= al_l[crow(r, hi)]; } } while (0)
  f32x16 pA0, pA1, pB0, pB1; float mnA, mnB, alA, alB; bf16x8 pa0, pa1, pa2, pa3; const int NT = seq / KVBLK;
  constexpr int SE = 0, SO = SDEPTH - 1;
  SLOAD(SE, 0); asm volatile("s_waitcnt vmcnt(0)" ::: "memory"); SWRITE(0, SE); __syncthreads();
  qkt(pA0, pA1, K_lds, qr, r32, hi); partialSM(pA0, pA1, m_reg, mnA, alA);
  SLOAD(SO, KVBLK); if constexpr (SDEPTH == 2) { if (2 < NT) SLOAD(SE, 2 * KVBLK); }
  SWAIT(); SWRITE(1, SO); __syncthreads();
  for (int j = 1; j + 1 < NT; j += 2) {
    SBAR(); qkt(pB0, pB1, (bf16*)((char*)K_lds + SHM_K), qr, r32, hi);
    finishSM(pA0, pA1, alA, l_reg, pa0, pa1, pa2, pa3); SBAR();
    SLOAD(SO, (j + SDEPTH) * KVBLK); SBAR();
    pv_d0(o, vb0, pa0, pa1, pa2, pa3); partialSM(pB0, pB1, m_reg, mnB, alB);
    __syncthreads(); SWAIT(); SWRITE(0, SE);
    RESC(alB); __syncthreads();
    SBAR(); qkt(pA0, pA1, K_lds, qr, r32, hi);
    finishSM(pB0, pB1, alB, l_reg, pa0, pa1, pa2, pa3); SBAR();
    if (SDEPTH == 1 || j + 3 < NT) SLOAD(SE, (j + 1 + SDEPTH) * KVBLK); SBAR();
    pv_d0(o, vb0 + (int)SHM_V, pa0, pa1, pa2, pa3); partialSM(pA0, pA1, m_reg, mnA, alA);
    __syncthreads(); SWAIT(); SWRITE(1, SO);
    RESC(alA); __syncthreads();
  }
  SBAR(); qkt(pB0, pB1, (bf16*)((char*)K_lds + SHM_K), qr, r32, hi);
  finishSM(pA0, pA1, alA, l_reg, pa0, pa1, pa2, pa3); SBAR();
  pv_d0(o, vb0, pa0, pa1, pa2, pa3); partialSM(pB0, pB1, m_reg, mnB, alB);
  __syncthreads(); RESC(alB);
  finishSM(pB0, pB1, alB, l_reg, pa0, pa1, pa2, pa3); SBAR();
  pv_d0(o, vb0 + (int)SHM_V, pa0, pa1, pa2, pa3);
  if (hi == 0) li_l[r32] = l_reg; asm volatile("s_waitcnt lgkmcnt(0)" ::: "memory");
  float rli[16];
#pragma unroll
  for (int r = 0; r < 16; ++r) rli[r] = __builtin_amdgcn_rcpf(li_l[crow(r, hi)]);
  bf16* Ow = Ob + (long)(wid * QBLK) * LDO;
#pragma unroll
  for (int r = 0; r < 16; ++r) { int orow = crow(r, hi);
    for (int d0 = 0; d0 < 4; ++d0) Ow[(long)orow * LDO + d0 * 32 + r32] = __float2bfloat16(o[d0][r] * rli[r]); }
#undef SLOAD
#undef SWRITE
#undef SWAIT
#undef RESC
}

template <int NC> __device__ __forceinline__ void pv_n(f32x16* o, int vb, bf16x8 pa0, bf16x8 pa1, bf16x8 pa2, bf16x8 pa3) {
  pv_one<0>(o[0], vb, pa0, pa1, pa2, pa3);
  if constexpr (NC > 1) pv_one<1>(o[1], vb, pa0, pa1, pa2, pa3);
  if constexpr (NC > 2) { pv_one<2>(o[2], vb, pa0, pa1, pa2, pa3); pv_one<3>(o[3], vb, pa0, pa1, pa2, pa3); }
}
template <int MB, class BR, class ST>
__device__ __forceinline__ void dft_unit(const bf16* __restrict__ A, int lda, int K, const BR& br, const ST& st, char* lds) {
  constexpr int NBW = 8 / MB, NC = 4 / NBW;
  const int tid = ltid(), wid = tid >> 6, lane = tid & 63, r32 = lane & 31, hi = lane >> 5;
  const int mb = wid % MB, cgp = wid / MB;
  const int sr = tid >> 4, sc = (tid & 15) * 8, vst0 = v_st(sr, sc), vst1 = v_st(32 + sr, sc);
  const int nkt = K / 64;
  __syncthreads();
  for (int kt = 0; kt < nkt; ++kt) {
    bf16x8 a = *reinterpret_cast<const bf16x8*>(br.row(kt * 64 + sr) + sc);
    bf16x8 b = *reinterpret_cast<const bf16x8*>(br.row(kt * 64 + 32 + sr) + sc);
    *(bf16x8*)(lds + kt * 16384 + vst0) = a;
    *(bf16x8*)(lds + kt * 16384 + vst1) = b;
  }
  __syncthreads();
  f32x16 o[NC];
#pragma unroll
  for (int d = 0; d < NC; ++d) o[d] = f32x16{};
  const int vb = (int)(uintptr_t)lds + v_rd_base(lane) + cgp * NC * 512;
  const bf16* Aw = A + (long)(mb * 32 + r32) * lda + hi * 8;
  for (int kt = 0; kt < nkt; ++kt) {
    bf16x8 pa0 = *reinterpret_cast<const bf16x8*>(Aw + kt * 64);
    bf16x8 pa1 = *reinterpret_cast<const bf16x8*>(Aw + kt * 64 + 16);
    bf16x8 pa2 = *reinterpret_cast<const bf16x8*>(Aw + kt * 64 + 32);
    bf16x8 pa3 = *reinterpret_cast<const bf16x8*>(Aw + kt * 64 + 48);
    pv_n<NC>(o, vb + kt * 16384, pa0, pa1, pa2, pa3);
  }
#pragma unroll
  for (int r = 0; r < 16; ++r) {
#pragma unroll
    for (int d = 0; d < NC; ++d) st(mb * 32 + crow(r, hi), (cgp * NC + d) * 32 + r32, o[d][r]);
  }
}
#undef SBAR
#undef KSWZ
}

namespace cg = cooperative_groups;
#define LAS __attribute__((address_space(3)))
typedef unsigned short bf16_t;
typedef unsigned v4u __attribute__((ext_vector_type(4)));
typedef unsigned v2u __attribute__((ext_vector_type(2)));
typedef float f4 __attribute__((ext_vector_type(4)));

#define XB_TMO      128
#define XB_XCNT(j)  (256  + 64 * (j))
#define XB_XSUB(j)  (1280 + 64 * (j))
#define XB_XGEN(j)  (2304 + 64 * (j))
#define XB_TOP      3328
#define XB_TOPGEN   3392
#define XCD_BAR_WORDS 3456
#define XB_SPIN_CAP (1u << 18)

__device__ __forceinline__ unsigned xb_ld(unsigned* p)              { return __hip_atomic_load(p, __ATOMIC_RELAXED, __HIP_MEMORY_SCOPE_AGENT); }
__device__ __forceinline__ unsigned xb_add(unsigned* p, unsigned v) { return __hip_atomic_fetch_add(p, v, __ATOMIC_RELAXED, __HIP_MEMORY_SCOPE_AGENT); }
__device__ __forceinline__ unsigned xb_xcc_id() { return (unsigned)__builtin_amdgcn_s_getreg((3 << 11) | 20) & 0xFu; }
#define XB_SPIN(cond, bar) do { unsigned _sp = 0; while (cond) { __builtin_amdgcn_s_sleep(1); \
    if ((++_sp & 255u) == 0u) { if (xb_ld(&(bar)[XB_TMO])) break; if (_sp > XB_SPIN_CAP) { atomicAdd(&(bar)[XB_TMO], 1u); break; } } } } while (0)

struct XcdBarrier {
    unsigned* bar; unsigned x;
    volatile LAS unsigned* st;
};

__device__ __forceinline__ XcdBarrier xcd_barrier_post(unsigned* bar, volatile LAS unsigned* st) {
    XcdBarrier b; b.bar = bar; b.x = xb_xcc_id(); b.st = st;
    if (threadIdx.x == 0) (void)xb_add(&bar[XB_XCNT(b.x)], 1u);
    return b;
}
__device__ __forceinline__ void xcd_barrier_complete(unsigned* bar, unsigned x, unsigned& nloc, unsigned& nx) {
    const unsigned G = gridDim.x * gridDim.y * gridDim.z;
    unsigned sum, cnt, mine, sp = 0u;
    for (;;) {
        sum = 0u; cnt = 0u; mine = 0u;
#pragma unroll
        for (unsigned j = 0; j < 16; ++j) { const unsigned c = xb_ld(&bar[XB_XCNT(j)]); sum += c; cnt += (c > 0u) ? 1u : 0u; mine = (j == x) ? c : mine; }
        if (sum == G) break;
        __builtin_amdgcn_s_sleep(1);
        if ((++sp & 255u) == 0u) { if (xb_ld(&bar[XB_TMO])) break; if (sp > XB_SPIN_CAP) { atomicAdd(&bar[XB_TMO], 1u); break; } }
    }
    nloc = mine > 0u ? mine : 1u; nx = cnt > 0u ? cnt : 1u;
}

__device__ __forceinline__ void xcd_barrier(const XcdBarrier& b) {
    asm volatile("s_waitcnt vmcnt(0)" ::: "memory");
    __syncthreads();
    if (threadIdx.x == 0) {
        unsigned* bar = b.bar;
        __builtin_amdgcn_s_waitcnt(0);
        unsigned nloc = b.st[0], nx = b.st[1];
        if (nloc == 0u) { xcd_barrier_complete(bar, b.x, nloc, nx); b.st[0] = nloc; b.st[1] = nx; }
        const unsigned old = xb_add(&bar[XB_XSUB(b.x)], 1u);
        const unsigned gen = old / nloc;
        if (old + 1u == (gen + 1u) * nloc) {
            __builtin_amdgcn_fence(__ATOMIC_RELEASE, "agent");
            asm volatile("s_waitcnt vmcnt(0)" ::: "memory");
            const unsigned og = xb_add(&bar[XB_TOP], 1u);
            const unsigned tg = og / nx;
            if (og + 1u == (tg + 1u) * nx) xb_add(&bar[XB_TOPGEN], 1u);
            else XB_SPIN(xb_ld(&bar[XB_TOPGEN]) == tg, bar);
            __builtin_amdgcn_fence(__ATOMIC_ACQUIRE, "agent");
            xb_add(&bar[XB_XGEN(b.x)], 1u);
            asm volatile("s_waitcnt vmcnt(0)" ::: "memory");
        } else {
            XB_SPIN(xb_ld(&bar[XB_XGEN(b.x)]) == gen, bar);
            __builtin_amdgcn_fence(__ATOMIC_ACQUIRE, "agent");
            asm volatile("s_waitcnt vmcnt(0)" ::: "memory");
        }
    }
    __syncthreads();
}

constexpr int DM = 2048, MTOK = 65536, NIN = 3072, DFF = 5632, NUP = 11264, WINW = 2560;
constexpr int NPROMPT = 32768;
constexpr int CHUNK = 65536, NCHUNK = 1;
constexpr float EPS = 1e-6f;
constexpr size_t MiB = (size_t)1 << 20;
constexpr size_t WS_M2F = 0;
constexpr size_t WS_COS = 1 * MiB, WS_SIN = 5 * MiB;
constexpr size_t WS_A1P = 9 * MiB, WS_A1S = 9 * MiB + 128 * 1024;
constexpr size_t WS_A3P = 10 * MiB, WS_A3S = 18 * MiB;
constexpr size_t WS_BAR = 19 * MiB, BAR_BYTES = 16384;
constexpr size_t WS_W = 20 * MiB;
constexpr size_t W_LAYER = 86 * MiB, W_OUT_OFF = 12 * MiB, W_UP_OFF = 20 * MiB, W_DOWN_OFF = 64 * MiB;
constexpr size_t WS_XH = 192 * MiB;
constexpr size_t WS_Z = 448 * MiB;
constexpr size_t WS_G = 704 * MiB;
constexpr size_t WS_Y = 832 * MiB;
constexpr size_t WS_ACT = 448 * MiB;
constexpr size_t WS_HB = 1152 * MiB;
constexpr size_t WS_XB = 1240 * MiB;
constexpr size_t WS_END = 1496 * MiB;
constexpr int LDS_BYTES = 135168;

__device__ __forceinline__ float bf2f(unsigned short b) { return __uint_as_float((unsigned)b << 16); }
__device__ __forceinline__ float bflo(unsigned w) { return __uint_as_float(w << 16); }
__device__ __forceinline__ float bfhi(unsigned w) { return __uint_as_float(w & 0xffff0000u); }
__device__ __forceinline__ unsigned pk2(float lo, float hi) { return pg8::cvt_pk_bf16(lo, hi); }
__device__ __forceinline__ float wave_sum(float v) {
#pragma unroll
    for (int o = 1; o < 64; o <<= 1) v += __shfl_xor(v, o);
    return v;
}

struct EpiWin {
    static constexpr bool PERM = true, AFTER_DRAIN = false;
    bf16_t* Z; bf16_t* Gp;
    __device__ __forceinline__ void operator()(const pg8::f32x4 (&acc)[2][2][4][2], const pg8::Unit& u, int wr, int wc, int fr, int fq) const {
        const int row0 = u.pm * pg8::BM + wr * 64 + fr;
        bf16_t* base; size_t rstride, bjstride;
        if (u.pn < 8) { base = Z + (size_t)row0 * 2048 + u.pn * 256 + wc * 32 + 8 * fq; rstride = 2048; bjstride = 128; }
        else {
            const int g = u.pn - 8, r0 = u.pm * pg8::BM; size_t sb; int L, t0;
            if (r0 < NPROMPT) { const int s = r0 >> 14; sb = (size_t)s * (2u * 16384u * 512u); L = 16384; t0 = row0 - s * 16384; }
            else { const int s = (r0 - NPROMPT) >> 12; sb = (size_t)NPROMPT * 1024 + (size_t)s * (2u * 4096u * 512u); L = 4096; t0 = row0 - NPROMPT - s * 4096; }
            base = Gp + sb + (size_t)t0 * 512 + g * 128 + wc * 32 + 8 * fq; rstride = 512; bjstride = (size_t)L * 512;
        }
#pragma unroll
        for (int ai = 0; ai < 2; ++ai)
#pragma unroll
            for (int m = 0; m < 4; ++m) { bf16_t* rowp = base + (size_t)(ai * pg8::HALF + m * 16) * rstride;
#pragma unroll
                for (int bj = 0; bj < 2; ++bj) { const pg8::f32x4 v0 = acc[ai][bj][m][0], v1 = acc[ai][bj][m][1];
                    pg8::u32x4 w; w.x = pk2(v0[0], v0[1]); w.y = pk2(v0[2], v0[3]); w.z = pk2(v1[0], v1[1]); w.w = pk2(v1[2], v1[3]);
                    *(pg8::u32x4*)(rowp + bj * bjstride) = w; } }
    }
};

__device__ __forceinline__ void p0a_tables(const float* fourier_w, unsigned char* ws, LAS float* tab, int gtid, int NT) {
    float* M2F = (float*)(ws + WS_M2F);
    { const int t = ltid(); if (t < 128) { float sn, cs; sincospif((float)t * (2.f / 128.f), &sn, &cs); tab[t] = cs; tab[128 + t] = -sn; } }
    __syncthreads();
    for (int i = gtid; i < 2 * 4 * 128 * 256; i += NT) {
        const int lg = i >> 15, c = (i >> 8) & 127, n = i & 255, part = n >> 7, e2 = n & 127;
        const float* fw = fourier_w + (size_t)lg * 16384 + e2;
        float acc = 0.f;
#pragma unroll 8
        for (int e = 0; e < 128; ++e) { const int r = (c * e) & 127; acc += tab[part * 128 + r] * fw[e * 128]; }
        M2F[i] = acc;
    }
    __syncthreads();
    float* COS = (float*)(ws + WS_COS); float* SIN = (float*)(ws + WS_SIN);
    for (int i = gtid; i < 16384 * 64; i += NT) {
        const int t = i >> 6, j = i & 63; const float pos = (float)(j < 32 ? (t >> 6) : (t & 63));
        const float inv = 1.0f / powf(10000.0f, (float)(j & 31) / 32.0f); const float ang = pos * inv;
        COS[i] = cosf(ang); SIN[i] = sinf(ang);
    }
    bf16_t* A1P = (bf16_t*)(ws + WS_A1P);
    for (int i = gtid; i < 256 * 256; i += NT) { const int m = i >> 8, k = i & 255, pm = m >> 7, k1 = m & 127, pk = k >> 7, t1 = k & 127; const int r = (t1 * k1) & 127;
        float sn, cs; sincospif((float)r * (2.f / 128.f), &sn, &cs); const float v = (pm == pk) ? cs : (pm == 0 ? sn : -sn); A1P[i] = (bf16_t)(pk2(v, 0.f) & 0xffff); }
    bf16_t* A1S = (bf16_t*)(ws + WS_A1S);
    for (int i = gtid; i < 128 * 128; i += NT) { const int m = i >> 7, k = i & 127, pm = m >> 6, k1 = m & 63, pk = k >> 6, t1 = k & 63; const int r = (t1 * k1) & 63;
        float sn, cs; sincospif((float)r * (2.f / 64.f), &sn, &cs); const float v = (pm == pk) ? cs : (pm == 0 ? sn : -sn); A1S[i] = (bf16_t)(pk2(v, 0.f) & 0xffff); }
    bf16_t* A3P = (bf16_t*)(ws + WS_A3P);
    for (int i = gtid; i < 128 * 128 * 256; i += NT) { const int k1 = i >> 15, k2 = (i >> 8) & 127, kk = i & 255, part = kk >> 7, t2 = kk & 127; const int k = k1 + 128 * k2; const int r = (t2 * k) & 16383;
        float sn, cs; sincospif((float)r * (1.f / 8192.f), &sn, &cs); A3P[i] = (bf16_t)(pk2(part ? sn : cs, 0.f) & 0xffff); }
    bf16_t* A3S = (bf16_t*)(ws + WS_A3S);
    for (int i = gtid; i < 64 * 64 * 128; i += NT) { const int k1 = i >> 13, k2 = (i >> 7) & 63, kk = i & 127, part = kk >> 6, t2 = kk & 63; const int k = k1 + 64 * k2; const int r = (t2 * k) & 4095;
        float sn, cs; sincospif((float)r * (1.f / 2048.f), &sn, &cs); A3S[i] = (bf16_t)(pk2(part ? sn : cs, 0.f) & 0xffff); }
}

struct ValUp { const float* W; __device__ __forceinline__ const float* ptr(int k, int n) const { const int src = ((n >> 7) & 1) * DFF + (n >> 8) * 128 + (n & 127); return W + (size_t)k * NUP + src; }
    __device__ __forceinline__ float operator()(int k, int n) const { return *ptr(k, n); } };
struct ValDirect { const float* W; int ldw; __device__ __forceinline__ const float* ptr(int k, int n) const { return W + (size_t)k * ldw + n; }
    __device__ __forceinline__ float operator()(int k, int n) const { return W[(size_t)k * ldw + n]; } };
struct ValWin { const float* win; const float* poolw; const float* pscale; const float* m2f;
    __device__ __forceinline__ const float* ptr(int k, int n) const { return win + (size_t)k * WINW + n; }
    __device__ __forceinline__ float operator()(int k, int n) const {
        if (n >= 512 && n < 2048) return win[(size_t)k * WINW + n];
        if (n < 512) { const int g = n >> 7, e = n & 127; const float* wr = win + (size_t)k * WINW + g * 128; const float* pw = poolw + g * 16384 + e; float acc = 0.f;
            for (int c = 0; c < 128; ++c) acc += wr[c] * pw[c * 128]; return acc * pscale[n]; }
        const int n2 = n - 2048, g = n2 >> 8, np = n2 & 255; const float* wr = win + (size_t)k * WINW + 2048 + g * 128; const float* mf = m2f + g * 32768 + np; float acc = 0.f;
        for (int c = 0; c < 128; ++c) acc += wr[c] * mf[c * 256]; return acc; } };
template <class F> __device__ __forceinline__ void transpose_item(const F& val, int K, bf16_t* WT, int k0, int n0, LAS float* scr, int lane) {
    for (int i = 0; i < 32; ++i) { const int kk = 2 * i + (lane >> 5); scr[kk * 33 + (lane & 31)] = val(k0 + kk, n0 + (lane & 31)); }
    asm volatile("s_waitcnt lgkmcnt(0)" ::: "memory");
    const int c = lane & 7;
#pragma unroll
    for (int j = 0; j < 4; ++j) { const int n = (lane >> 3) + 8 * j; const LAS float* s = scr + (8 * c) * 33 + n;
        v4u o; o.x = pk2(s[0 * 33], s[1 * 33]); o.y = pk2(s[2 * 33], s[3 * 33]); o.z = pk2(s[4 * 33], s[5 * 33]); o.w = pk2(s[6 * 33], s[7 * 33]);
        *(v4u*)(WT + (size_t)(n0 + n) * K + k0 + 8 * c) = o; }
    asm volatile("s_waitcnt lgkmcnt(0)" ::: "memory");
}
template <class F> __device__ __forceinline__ void tr_load(const F& f, int k0, int n0, int lane, f4 (&v)[8]) {
#pragma unroll
    for (int i = 0; i < 8; ++i) v[i] = __builtin_nontemporal_load((const f4*)f.ptr(k0 + 8 * i + (lane >> 3), n0 + 4 * (lane & 7)));
}
__device__ __forceinline__ void tr_store(const f4 (&v)[8], int K, bf16_t* WT, int k0, int n0, LAS float* scr, int lane) {
#pragma unroll
    for (int i = 0; i < 8; ++i) { LAS float* d = scr + (8 * i + (lane >> 3)) * 33 + 4 * (lane & 7); d[0] = v[i].x; d[1] = v[i].y; d[2] = v[i].z; d[3] = v[i].w; }
    asm volatile("s_waitcnt lgkmcnt(0)" ::: "memory");
    const int c = lane & 7;
#pragma unroll
    for (int j = 0; j < 4; ++j) { const int n = (lane >> 3) + 8 * j; const LAS float* s = scr + (8 * c) * 33 + n;
        v4u o; o.x = pk2(s[0 * 33], s[1 * 33]); o.y = pk2(s[2 * 33], s[3 * 33]); o.z = pk2(s[4 * 33], s[5 * 33]); o.w = pk2(s[6 * 33], s[7 * 33]);
        *(v4u*)(WT + (size_t)(n0 + n) * K + k0 + 8 * c) = o; }
    asm volatile("s_waitcnt lgkmcnt(0)" ::: "memory");
}
template <class F> __device__ __forceinline__ void transpose_matrix(const F& val, int K, int N, bf16_t* WT, LAS float* scr, int gw, int NGW, int lane, int nlo, int nhi) {
    const int nblk = (nhi - nlo) / 32, nitems = (K / 64) * nblk;
    int it = gw; if (it >= nitems) return;
    f4 cur[8], nxt[8];
    tr_load(val, 64 * (it / nblk), nlo + 32 * (it % nblk), lane, cur);
    for (; it < nitems; it += NGW) {
        const int k0 = 64 * (it / nblk), n0 = nlo + 32 * (it % nblk); const int it2 = it + NGW; const bool more = it2 < nitems;
        if (more) tr_load(val, 64 * (it2 / nblk), nlo + 32 * (it2 % nblk), lane, nxt);
        tr_store(cur, K, WT, k0, n0, scr, lane);
        if (more) {
#pragma unroll
            for (int i = 0; i < 8; ++i) cur[i] = nxt[i]; }
    }
}

typedef float __attribute__((address_space(4))) cf32;
__device__ __forceinline__ void fold_items(const float* win, const float* poolw, const float* pscale, const float* m2f, bf16_t* WT, int gw, int NGW, int lane) {
    for (int it = gw; it < 32 * 24; it += NGW) {
        const int kb = it / 24, nb = it - kb * 24, k0 = 64 * kb;
        float m2[128]; int base, nout;
        if (nb < 8) { const int n = nb * 64 + lane, g = nb >> 1, e = n & 127; base = g * 128; nout = n; const float sc = pscale[n]; const float* pw = poolw + g * 16384 + e;
#pragma unroll
            for (int c = 0; c < 128; ++c) m2[c] = pw[c * 128] * sc;
        } else { const int n2 = (nb - 8) * 64 + lane, g = (nb - 8) >> 2, np = n2 & 255; base = 2048 + g * 128; nout = 2048 + n2; const float* mf = m2f + g * 32768 + np;
#pragma unroll
            for (int c = 0; c < 128; ++c) m2[c] = mf[c * 256];
        }
        bf16_t* wrow = WT + (size_t)nout * DM + k0;
        for (int kg = 0; kg < 8; ++kg) {
            float acc[8];
#pragma unroll
            for (int kk = 0; kk < 8; ++kk) { const cf32* wr = (const cf32*)(unsigned long long)(win + (size_t)(k0 + 8 * kg + kk) * WINW + base); float a = 0.f;
#pragma unroll
                for (int c = 0; c < 128; ++c) a += wr[c] * m2[c];
                acc[kk] = a; }
            v4u o; o.x = pk2(acc[0], acc[1]); o.y = pk2(acc[2], acc[3]); o.z = pk2(acc[4], acc[5]); o.w = pk2(acc[6], acc[7]);
            *(v4u*)(wrow + 8 * kg) = o;
        }
    }
}

__device__ __forceinline__ const float* xrow_ptr(const float* xa, const float* xb, int row) { return (row < NPROMPT) ? xa + (size_t)row * DM : xb + (size_t)(row - NPROMPT) * DM; }
template <bool XBF, bool OBF, int RR>
__device__ __forceinline__ void resid_rows(const float* xa, const float* xb, const bf16_t* xbf, const bf16_t* m, const float* g1, float* xout, bf16_t* xbout, bf16_t* xh, const float* g2, int gw, int NGW, int lane) {
    for (int row0 = gw; row0 < MTOK; row0 += RR * NGW) {
        f4 xf[XBF ? 1 : RR][8]; v2u xp[XBF ? RR : 1][8]; v2u mw[RR][8];
#pragma unroll
        for (int u = 0; u < RR; ++u) { const int row = row0 + u * NGW;
            if constexpr (XBF) { const bf16_t* xr = xbf + (size_t)row * DM;
#pragma unroll
                for (int j = 0; j < 8; ++j) xp[u][j] = *(const v2u*)(xr + 4 * lane + 256 * j);
            } else { const float* xr = xrow_ptr(xa, xb, row);
#pragma unroll
                for (int j = 0; j < 8; ++j) xf[u][j] = __builtin_nontemporal_load((const f4*)(xr + 4 * lane + 256 * j)); } }
        if (m) {
#pragma unroll
            for (int u = 0; u < RR; ++u) { const bf16_t* mr = m + (size_t)(row0 + u * NGW) * DM;
#pragma unroll
                for (int j = 0; j < 8; ++j) mw[u][j] = *(const v2u*)(mr + 4 * lane + 256 * j); }
        }
#pragma unroll
        for (int u = 0; u < RR; ++u) { const int row = row0 + u * NGW;
            f4 xv[8];
#pragma unroll
            for (int j = 0; j < 8; ++j) { if constexpr (XBF) { const v2u w = xp[u][j]; xv[j] = (f4){bflo(w.x), bfhi(w.x), bflo(w.y), bfhi(w.y)}; } else xv[j] = xf[u][j]; }
            if (m) { float ss = 0.f;
#pragma unroll
                for (int j = 0; j < 8; ++j) { const v2u w = mw[u][j]; const f4 mv = (f4){bflo(w.x), bfhi(w.x), bflo(w.y), bfhi(w.y)}; ss += (mv.x * mv.x + mv.y * mv.y) + (mv.z * mv.z + mv.w * mv.w); }
                const float r = 1.0f / sqrtf(wave_sum(ss) * (1.f / DM) + EPS);
#pragma unroll
                for (int j = 0; j < 8; ++j) { const v2u w = mw[u][j]; const f4 mv = (f4){bflo(w.x), bfhi(w.x), bflo(w.y), bfhi(w.y)}; const f4 gv = *(const f4*)(g1 + 4 * lane + 256 * j); xv[j] += mv * r * gv; } }
            if constexpr (OBF) { if (xbout) {
#pragma unroll
                for (int j = 0; j < 8; ++j) { v2u w; w.x = pk2(xv[j].x, xv[j].y); w.y = pk2(xv[j].z, xv[j].w); *(v2u*)(xbout + (size_t)row * DM + 4 * lane + 256 * j) = w; } }
            } else { if (xout) {
#pragma unroll
                for (int j = 0; j < 8; ++j) __builtin_nontemporal_store(xv[j], (f4*)(xout + (size_t)row * DM + 4 * lane + 256 * j)); } }
            if (xh) { float ss = 0.f;
#pragma unroll
                for (int j = 0; j < 8; ++j) ss += (xv[j].x * xv[j].x + xv[j].y * xv[j].y) + (xv[j].z * xv[j].z + xv[j].w * xv[j].w);
                const float r = 1.0f / sqrtf(wave_sum(ss) * (1.f / DM) + EPS);
#pragma unroll
                for (int j = 0; j < 8; ++j) { const f4 gv = *(const f4*)(g2 + 4 * lane + 256 * j); const f4 y = xv[j] * r * gv;
                    v2u w; w.x = pk2(y.x, y.y); w.y = pk2(y.z, y.w); *(v2u*)(xh + (size_t)row * DM + 4 * lane + 256 * j) = w; } }
        }
    }
}

__device__ __forceinline__ void rope_pass(bf16_t* Z, const float* qn, const float* kn, const float* COS, const float* SIN, int gtid, int NT) {
    const int hw = gtid >> 5, NHW = NT >> 5, j = gtid & 31;
    const float qa0 = qn[2 * j], qa1 = qn[2 * j + 1], qb0 = qn[64 + 2 * j], qb1 = qn[65 + 2 * j];
    const float ka0 = kn[2 * j], ka1 = kn[2 * j + 1], kb0 = kn[64 + 2 * j], kb1 = kn[65 + 2 * j];
    for (int row = hw; row < MTOK; row += NHW) {
        const int t = row < NPROMPT ? (row & 16383) : (row & 4095);
        bf16_t* p = Z + (size_t)row * DM + 512 + 2 * j;
        unsigned a[10], b[10];
#pragma unroll
        for (int hh = 0; hh < 10; ++hh) { a[hh] = *(const unsigned*)(p + hh * 128); b[hh] = *(const unsigned*)(p + hh * 128 + 64); }
        const float c0 = COS[t * 64 + 2 * j], c1 = COS[t * 64 + 2 * j + 1], s0 = SIN[t * 64 + 2 * j], s1 = SIN[t * 64 + 2 * j + 1];
#pragma unroll
        for (int hh = 0; hh < 10; ++hh) {
            float x0 = bflo(a[hh]), x1 = bfhi(a[hh]), y0 = bflo(b[hh]), y1 = bfhi(b[hh]);
            float ss = (x0 * x0 + x1 * x1) + (y0 * y0 + y1 * y1);
#pragma unroll
            for (int o = 1; o < 32; o <<= 1) ss += __shfl_xor(ss, o);
            const float r = 1.0f / sqrtf(ss * (1.f / 128.f) + EPS);
            x0 *= r * (hh < 8 ? qa0 : ka0); x1 *= r * (hh < 8 ? qa1 : ka1); y0 *= r * (hh < 8 ? qb0 : kb0); y1 *= r * (hh < 8 ? qb1 : kb1);
            const float ox0 = x0 * c0 - y0 * s0, oy0 = y0 * c0 + x0 * s0, ox1 = x1 * c1 - y1 * s1, oy1 = y1 * c1 + x1 * s1;
            *(unsigned*)(p + hh * 128) = pk2(ox0, ox1); *(unsigned*)(p + hh * 128 + 64) = pk2(oy0, oy1);
        }
    }
}

__device__ __forceinline__ void pool_pass(const bf16_t* Z, bf16_t* H, int gtid, int NT) {
    for (int it = gtid; it < MTOK * 64; it += NT) {
        const int row = it >> 6, ch = it & 63, c0 = ch * 8, g = ch >> 4, w = 2 << g;
        int t, L; if (row < NPROMPT) { t = row & 16383; L = 16384; } else { t = row & 4095; L = 4096; }
        const int rb = row - t; int lo = t - (w >> 1); if (lo < 0) lo = 0; int hi = t + w - 1 - (w >> 1); if (hi > L - 1) hi = L - 1;
        float s[8] = {0.f, 0.f, 0.f, 0.f, 0.f, 0.f, 0.f, 0.f};
        for (int tt = lo; tt <= hi; ++tt) { const v4u v = *(const v4u*)(Z + (size_t)(rb + tt) * DM + c0);
            s[0] += bflo(v.x); s[1] += bfhi(v.x); s[2] += bflo(v.y); s[3] += bfhi(v.y); s[4] += bflo(v.z); s[5] += bfhi(v.z); s[6] += bflo(v.w); s[7] += bfhi(v.w); }
        const float ic = 1.0f / (float)(hi - lo + 1);
        const v4u v = *(const v4u*)(Z + (size_t)row * DM + c0);
        v4u o; o.x = pk2(s[0] * ic - bflo(v.x), s[1] * ic - bfhi(v.x)); o.y = pk2(s[2] * ic - bflo(v.y), s[3] * ic - bfhi(v.y));
        o.z = pk2(s[4] * ic - bflo(v.z), s[5] * ic - bfhi(v.z)); o.w = pk2(s[6] * ic - bflo(v.w), s[7] * ic - bfhi(v.w));
        *(v4u*)(H + (size_t)row * DM + c0) = o;
    }
}

__device__ __forceinline__ float gelu_tanh(float x) { const float y = 0.7978845608028654f * (x + 0.044715f * x * x * x); return x * __builtin_amdgcn_rcpf(1.0f + __expf(-2.0f * y)); }
__device__ __forceinline__ void ld8f(const bf16_t* p, float* o) { const v4u v = *(const v4u*)p; o[0] = bflo(v.x); o[1] = bfhi(v.x); o[2] = bflo(v.y); o[3] = bfhi(v.y); o[4] = bflo(v.z); o[5] = bfhi(v.z); o[6] = bflo(v.w); o[7] = bfhi(v.w); }
__device__ __forceinline__ float dpp_ror1(float v) { return __int_as_float(__builtin_amdgcn_update_dpp(0, __float_as_int(v), 0x121, 0xf, 0xf, false)); }
__device__ __forceinline__ float dpp_ror15(float v) { return __int_as_float(__builtin_amdgcn_update_dpp(0, __float_as_int(v), 0x12F, 0xf, 0xf, false)); }
struct EpiGlu {
    static constexpr bool PERM = true, AFTER_DRAIN = false;
    bf16_t* ACT; bf16_t* HB; const float* cw; const float* cb;
    __device__ __forceinline__ void operator()(const pg8::f32x4 (&acc)[2][2][4][2], const pg8::Unit& u, int wr, int wc, int fr, int fq) const {
        const int jc = u.pn * 128 + wc * 32 + 8 * fq;
        const bool first = (fr == 0), last = (fr == 15);
#pragma unroll
        for (int n = 0; n < 2; ++n) {
            const f4 w0g = *(const f4*)(cw + jc + 4 * n), w1g = *(const f4*)(cw + NUP + jc + 4 * n), w2g = *(const f4*)(cw + 2 * NUP + jc + 4 * n), bg = *(const f4*)(cb + jc + 4 * n);
            const f4 w0v = *(const f4*)(cw + DFF + jc + 4 * n), w1v = *(const f4*)(cw + NUP + DFF + jc + 4 * n), w2v = *(const f4*)(cw + 2 * NUP + DFF + jc + 4 * n), bv = *(const f4*)(cb + DFF + jc + 4 * n);
#pragma unroll
            for (int ai = 0; ai < 2; ++ai) {
                float g1p[4], v1p[4], g15c[4], v15c[4];
#pragma unroll
                for (int i = 0; i < 4; ++i) { g1p[i] = 0.f; v1p[i] = 0.f; g15c[i] = dpp_ror15(acc[ai][0][0][n][i]); v15c[i] = dpp_ror15(acc[ai][1][0][n][i]); }
#pragma unroll
                for (int m = 0; m < 4; ++m) {
                    const int mn = m < 3 ? m + 1 : 3;
                    float o[4];
#pragma unroll
                    for (int i = 0; i < 4; ++i) {
                        const float g = acc[ai][0][m][n][i], v = acc[ai][1][m][n][i];
                        const float g1c = dpp_ror1(g), v1c = dpp_ror1(v), g15n = dpp_ror15(acc[ai][0][mn][n][i]), v15n = dpp_ror15(acc[ai][1][mn][n][i]);
                        const float gp = first ? g1p[i] : g1c, gn = last ? g15n : g15c[i], vp = first ? v1p[i] : v1c, vn = last ? v15n : v15c[i];
                        g1p[i] = g1c; v1p[i] = v1c; g15c[i] = g15n; v15c[i] = v15n;
                        const float a = gp * w0g[i] + g * w1g[i] + gn * w2g[i] + bg[i];
                        const float b = vp * w0v[i] + v * w1v[i] + vn * w2v[i] + bv[i];
                        const float e = __builtin_amdgcn_exp2f(a * (-2.3022082f + -0.10294324f * (a * a)));
                        o[i] = a * __builtin_amdgcn_rcpf(1.0f + e) * b;
                    }
                    const int row = u.pm * pg8::BM + ai * pg8::HALF + wr * 64 + m * 16 + fr;
                    v2u w; w.x = pk2(o[0], o[1]); w.y = pk2(o[2], o[3]);
                    *(v2u*)(ACT + (size_t)row * DFF + jc + 4 * n) = w;
                }
            }
            asm volatile("" ::: "memory");
        }
#pragma unroll
        for (int ai = 0; ai < 2; ++ai) {
            const int grp = u.pm * 4 + ai * 2 + wr;
            if (fr < 2 || fr >= 14) {
                const int m = fr < 2 ? 0 : 3, slot = fr < 2 ? fr : fr - 12;
                bf16_t* hp = HB + ((size_t)grp * 4 + slot) * NUP + u.pn * 256 + wc * 32 + 8 * fq;
#pragma unroll
                for (int bj = 0; bj < 2; ++bj) {
                    const pg8::f32x4 v0 = fr < 2 ? acc[ai][bj][0][0] : acc[ai][bj][3][0], v1 = fr < 2 ? acc[ai][bj][0][1] : acc[ai][bj][3][1];
                    v4u w; w.x = pk2(v0[0], v0[1]); w.y = pk2(v0[2], v0[3]); w.z = pk2(v1[0], v1[1]); w.w = pk2(v1[2], v1[3]);
                    *(v4u*)(hp + bj * 128) = w;
                }
                (void)m;
            }
        }
    }
};
__device__ __forceinline__ void glu_fix(const bf16_t* HB, bf16_t* ACT, const float* cw, const float* cb, int gtid, int NT) {
    constexpr int NCC = DFF / 8, NG = CHUNK / 64;
    for (int it = gtid; it < NG * 2 * NCC; it += NT) {
        const int cc = it % NCC, rest = it / NCC, which = rest & 1, g = rest >> 1, j0 = cc * 8, colp = (j0 >> 7) * 256 + (j0 & 127);
        const int row = g * 64 + (which ? 63 : 0); const int Lc = row < NPROMPT ? 16384 : 4096;
        const bf16_t *P, *C, *N;
        if (!which) { C = HB + ((size_t)g * 4 + 0) * NUP; N = HB + ((size_t)g * 4 + 1) * NUP; P = ((row & (Lc - 1)) == 0) ? nullptr : HB + ((size_t)(g - 1) * 4 + 3) * NUP; }
        else { P = HB + ((size_t)g * 4 + 2) * NUP; C = HB + ((size_t)g * 4 + 3) * NUP; N = (((row + 1) & (Lc - 1)) == 0) ? nullptr : HB + ((size_t)(g + 1) * 4 + 0) * NUP; }
        float pg[8], pv[8], cg_[8], cv[8], ng[8], nv[8];
        if (P) { ld8f(P + colp, pg); ld8f(P + colp + 128, pv); } else {
#pragma unroll
            for (int i = 0; i < 8; ++i) { pg[i] = 0.f; pv[i] = 0.f; } }
        if (N) { ld8f(N + colp, ng); ld8f(N + colp + 128, nv); } else {
#pragma unroll
            for (int i = 0; i < 8; ++i) { ng[i] = 0.f; nv[i] = 0.f; } }
        ld8f(C + colp, cg_); ld8f(C + colp + 128, cv);
        float o[8];
#pragma unroll
        for (int h = 0; h < 2; ++h) {
            const f4 w0g = *(const f4*)(cw + j0 + 4 * h), w1g = *(const f4*)(cw + NUP + j0 + 4 * h), w2g = *(const f4*)(cw + 2 * NUP + j0 + 4 * h), bg = *(const f4*)(cb + j0 + 4 * h);
            const f4 w0v = *(const f4*)(cw + DFF + j0 + 4 * h), w1v = *(const f4*)(cw + NUP + DFF + j0 + 4 * h), w2v = *(const f4*)(cw + 2 * NUP + DFF + j0 + 4 * h), bv = *(const f4*)(cb + DFF + j0 + 4 * h);
#pragma unroll
            for (int q = 0; q < 4; ++q) { const int i = 4 * h + q;
                const float a = pg[i] * w0g[q] + cg_[i] * w1g[q] + ng[i] * w2g[q] + bg[q];
                const float b = pv[i] * w0v[q] + cv[i] * w1v[q] + nv[i] * w2v[q] + bv[q];
                o[i] = gelu_tanh(a) * b; } }
        v4u w; w.x = pk2(o[0], o[1]); w.y = pk2(o[2], o[3]); w.z = pk2(o[4], o[5]); w.w = pk2(o[6], o[7]);
        *(v4u*)(ACT + (size_t)row * DFF + j0) = w;
    }
}

struct BRow1 { const att::bf16* base; size_t ldb; __device__ __forceinline__ const att::bf16* row(int kk) const { return base + (size_t)kk * ldb; } };
struct St1 { att::bf16* base; size_t ldb; __device__ __forceinline__ void operator()(int m, int c, float v) const { base[(size_t)m * ldb + c] = __float2bfloat16(v); } };
struct BRow3 { const att::bf16* base; int R, lgR, k1; __device__ __forceinline__ const att::bf16* row(int kk) const { const int part = kk >> lgR, t2 = kk & (R - 1); return base + (size_t)(((part << lgR) + k1) * R + t2) * 512; } };
struct St3 { att::bf16* base; int R; float scale; __device__ __forceinline__ void operator()(int m, int c, float v) const { base[(size_t)(m * R) * DM + c] = __float2bfloat16(v * scale); } };

__device__ __forceinline__ void dft_stage1(const bf16_t* Gp, bf16_t* Yp, const unsigned char* ws, char* lds, int vcu, int G) {
    for (int it = 0;; ++it) { const int uid = it * G + vcu; if (uid >= 3072) break;
        if (uid < 1024) { const int s = uid >> 9, nt = uid & 511; const size_t off = (size_t)s * (2u * 16384u * 512u) + (size_t)nt * 128;
            BRow1 br{(const att::bf16*)Gp + off, 65536}; St1 st{(att::bf16*)Yp + off, 65536};
            att::dft_unit<8>((const att::bf16*)(ws + WS_A1P), 256, 256, br, st, lds);
        } else { const int u2 = uid - 1024, s = u2 >> 8, nt = u2 & 255; const size_t off = (size_t)NPROMPT * 1024 + (size_t)s * (2u * 4096u * 512u) + (size_t)nt * 128;
            BRow1 br{(const att::bf16*)Gp + off, 32768}; St1 st{(att::bf16*)Yp + off, 32768};
            att::dft_unit<4>((const att::bf16*)(ws + WS_A1S), 128, 128, br, st, lds);
        }
    }
}
__device__ __forceinline__ void dft_stage3(const bf16_t* Yp, bf16_t* H, const unsigned char* ws, char* lds, int vcu, int G) {
    for (int it = 0;; ++it) { const int uid = it * G + vcu; if (uid >= 3072) break;
        if (uid < 1024) { const int s = uid >> 9, k1 = (uid >> 2) & 127, nt = uid & 3;
            BRow3 br{(const att::bf16*)Yp + (size_t)s * (2u * 16384u * 512u) + nt * 128, 128, 7, k1};
            St3 st{(att::bf16*)H + (size_t)(s * 16384 + k1) * DM + 1536 + nt * 128, 128, 1.0f / sqrtf(16384.f * 128.f)};
            att::dft_unit<4>((const att::bf16*)(ws + WS_A3P) + (size_t)k1 * (128 * 256), 256, 256, br, st, lds);
        } else { const int u2 = uid - 1024, s = u2 >> 8, k1 = (u2 >> 2) & 63, nt = u2 & 3;
            BRow3 br{(const att::bf16*)Yp + (size_t)NPROMPT * 1024 + (size_t)s * (2u * 4096u * 512u) + nt * 128, 64, 6, k1};
            St3 st{(att::bf16*)H + (size_t)(NPROMPT + s * 4096 + k1) * DM + 1536 + nt * 128, 64, 1.0f / sqrtf(4096.f * 128.f)};
            att::dft_unit<2>((const att::bf16*)(ws + WS_A3S) + (size_t)k1 * (64 * 128), 128, 128, br, st, lds);
        }
    }
}

__device__ __forceinline__ void attn_phase(const bf16_t* Z, bf16_t* H, const float* qn, const float* kn, char* lds, int vcu, int G) {
    float mq = 0.f, mk = 0.f;
    for (int i = 0; i < 128; ++i) { mq = fmaxf(mq, fabsf(qn[i])); mk = fmaxf(mk, fabsf(kn[i])); }
    const float bound = 128.f * mq * mk * 1.02f;
    for (int it = 0;; ++it) { const int uid = it * G + vcu; if (uid >= 2048) break;
        int rowbase, h, qb, seq;
        if (uid < 1024) { const int s = uid >> 9; h = (uid >> 6) & 7; qb = uid & 63; rowbase = s * 16384; seq = 16384; }
        else { const int u2 = uid - 1024, s = u2 >> 7; h = (u2 >> 4) & 7; qb = u2 & 15; rowbase = NPROMPT + s * 4096; seq = 4096; }
        const att::bf16* Q = (const att::bf16*)Z + (size_t)(rowbase + qb * 256) * DM + 512 + h * 128;
        const att::bf16* K = (const att::bf16*)Z + (size_t)rowbase * DM + 1536 + (h >> 2) * 128;
        att::bf16* O = (att::bf16*)H + (size_t)(rowbase + qb * 256) * DM + 512 + h * 128;
        att::attn_dense_body<att::bf16>(Q, K, K + 256, O, seq, lds, bound);
        __syncthreads();
    }
}

struct Params { const float* in[17]; float* out; unsigned char* ws; int ph_lo, ph_hi; };
constexpr int NPL = 9;
constexpr int NPHASE = 2 + 2 * NPL;

__global__ void __launch_bounds__(512, 2) mega_fwd(Params p) {
    extern __shared__ __attribute__((aligned(16))) unsigned char lds[];
    cg::grid_group grid = cg::this_grid();
    const int G = gridDim.x, bx = blockIdx.x;
    const int vcu = (G % 8 == 0) ? (bx % 8) * (G / 8) + bx / 8 : bx;
    const int NGW = G * 8, NT = G * 512;
    unsigned char* ws = p.ws;
    const float *x_prompt = p.in[0], *x_sample = p.in[1], *g_pre_mix = p.in[2], *g_post_mix = p.in[3], *w_in = p.in[4], *pool_w = p.in[5], *pool_scale = p.in[6],
                *q_norm = p.in[7], *k_norm = p.in[8], *fourier_w = p.in[9], *w_out = p.in[10], *g_pre_ffn = p.in[11], *g_post_ffn = p.in[12], *w_up = p.in[13],
                *conv_w = p.in[14], *conv_b = p.in[15], *w_down = p.in[16];
    bf16_t* XH = (bf16_t*)(ws + WS_XH); bf16_t* Z = (bf16_t*)(ws + WS_Z); bf16_t* Gp = (bf16_t*)(ws + WS_G); bf16_t* Yp = (bf16_t*)(ws + WS_Y);
    bf16_t* HB = (bf16_t*)(ws + WS_HB); bf16_t* ACT = (bf16_t*)(ws + WS_ACT); bf16_t* XB = (bf16_t*)(ws + WS_XB);
    LAS unsigned char* ring = (LAS unsigned char*)lds;
    volatile LAS unsigned* bst = (volatile LAS unsigned*)(ring + 131072 + 64);
    if (threadIdx.x < 2) bst[threadIdx.x] = 0u;
    __syncthreads();
    XcdBarrier xbar = xcd_barrier_post((unsigned*)(ws + WS_BAR), bst);

    for (int ph = p.ph_lo; ph < p.ph_hi; ++ph) {
        const int tid = ltid(), lane = tid & 63, wave = __builtin_amdgcn_readfirstlane(tid >> 6);
        const int gw = vcu * 8 + wave, gtid = bx * 512 + tid;
        if (ph == 0) {
#if !defined(ONLY) || ONLY==0
            for (int rep = 0; rep < REP_P0; ++rep) p0a_tables(fourier_w, ws, (LAS float*)ring, gtid, NT);
#endif
        } else if (ph == 1) {
#if !defined(ONLY) || ONLY==1
            LAS float* scr = (LAS float*)(ring + wave * 16384);
            for (int l = 0; l < 2 * REP_P0; ++l) {
                bf16_t* Wl = (bf16_t*)(ws + WS_W + (l & 1) * W_LAYER);
                ValWin vw{w_in + (size_t)(l & 1) * DM * WINW, pool_w + (size_t)(l & 1) * 4 * 16384, pool_scale + (l & 1) * 512, (const float*)(ws + WS_M2F) + (size_t)(l & 1) * 4 * 32768};
                transpose_matrix(vw, DM, NIN, Wl, scr, gw, NGW, lane, 512, 2048);
                fold_items(vw.win, vw.poolw, vw.pscale, vw.m2f, Wl, gw, NGW, lane);
                ValDirect vo{w_out + (size_t)(l & 1) * DM * DM, DM};
                transpose_matrix(vo, DM, DM, (bf16_t*)((unsigned char*)Wl + W_OUT_OFF), scr, gw, NGW, lane, 0, DM);
                ValUp vu{w_up + (size_t)(l & 1) * DM * NUP};
                transpose_matrix(vu, DM, NUP, (bf16_t*)((unsigned char*)Wl + W_UP_OFF), scr, gw, NGW, lane, 0, NUP);
                ValDirect vd{w_down + (size_t)(l & 1) * DFF * DM, DM};
                transpose_matrix(vd, DFF, DM, (bf16_t*)((unsigned char*)Wl + W_DOWN_OFF), scr, gw, NGW, lane, 0, DM);
            }
            for (int rep = 0; rep < REP_P0; ++rep) resid_rows<false, false, 2>(x_prompt, x_sample, nullptr, nullptr, nullptr, nullptr, nullptr, XH, g_pre_mix, gw, NGW, lane);
#endif
        } else {
            const int l = (ph - 2) / NPL, q = (ph - 2) % NPL;
            const bf16_t* Wl = (const bf16_t*)(ws + WS_W + l * W_LAYER);
            if (q == 0) {
#if !defined(ONLY) || ONLY==2
                pg8::Gemm g{XH, Wl, MTOK, NIN, DM}; pg8::StaticOrder S; S.init(MTOK, NIN, G, bx);
                EpiWin E{Z, Gp};
                for (int rep = 0; rep < REP_WIN; ++rep) pg8::gemm_phase<EpiWin, pg8::StaticOrder, PG8_ALIGN, PG8_SP2>(ring, g, S, E);
#endif
            } else if (q == 1) {
#if !defined(ONLY) || ONLY==3
                rope_pass(Z, q_norm + l * 128, k_norm + l * 128, (const float*)(ws + WS_COS), (const float*)(ws + WS_SIN), gtid, NT);
                for (int rep = 0; rep < REP_LIGHT; ++rep) { pool_pass(Z, XH, gtid, NT);
                dft_stage1(Gp, Yp, ws, (char*)lds, vcu, G); }
#endif
            } else if (q == 2) {
#if !defined(ONLY) || ONLY==4
                for (int rep = 0; rep < REP_ATTN; ++rep) attn_phase(Z, XH, q_norm + l * 128, k_norm + l * 128, (char*)lds, vcu, G);
#endif
#if !defined(ONLY) || ONLY==5
                for (int rep = 0; rep < REP_LIGHT; ++rep) dft_stage3(Yp, XH, ws, (char*)lds, vcu, G);
#endif
            } else if (q == 4) {
#if !defined(ONLY) || ONLY==6
                if (l == 0) resid_rows<false, true, 2>(x_prompt, x_sample, nullptr, Z, g_post_mix, nullptr, XB, XH, g_pre_ffn, gw, NGW, lane);
                else resid_rows<true, true, 4>(nullptr, nullptr, XB, Z, g_post_mix + DM, nullptr, XB, XH, g_pre_ffn + DM, gw, NGW, lane);
#endif
            } else if (q == 8) {
#if !defined(ONLY) || ONLY==6
                if (l == 0) resid_rows<true, true, 4>(nullptr, nullptr, XB, XH, g_post_ffn, nullptr, XB, XH, g_pre_mix + DM, gw, NGW, lane);
                else resid_rows<true, false, 4>(nullptr, nullptr, XB, XH, g_post_ffn + DM, p.out, nullptr, nullptr, nullptr, gw, NGW, lane);
#endif
            } else {
                const int c = 0, step = (q >= 5) ? (q - 5) : -1;
                const float* cwl = conv_w + (size_t)l * 3 * NUP; const float* cbl = conv_b + (size_t)l * NUP;
                if (step == 1) {
#if !defined(ONLY) || ONLY==7
                    for (int rep = 0; rep < REP_LIGHT; ++rep) glu_fix(HB, ACT, cwl, cbl, gtid, NT);
#endif
                } else if (step == 0) {
#if !defined(ONLY) || ONLY==9
                    pg8::Gemm g{XH + (size_t)c * CHUNK * DM, (const bf16_t*)((const unsigned char*)Wl + W_UP_OFF), CHUNK, NUP, DM};
                    pg8::StaticOrder S; S.init(g.M, g.N, G, bx);
                    EpiGlu E{ACT, HB, cwl, cbl};
                    for (int rep = 0; rep < REP_UP; ++rep) pg8::gemm_phase<EpiGlu, pg8::StaticOrder, PG8_ALIGN, PG8_SP2>(ring, g, S, E);
#endif
                } else {
#if !defined(ONLY) || ONLY==8
                    pg8::Gemm g; bf16_t* O;
                    if (q == 3) { g = pg8::Gemm{XH, (const bf16_t*)((const unsigned char*)Wl + W_OUT_OFF), MTOK, DM, DM}; O = Z; }
                    else { g = pg8::Gemm{ACT, (const bf16_t*)((const unsigned char*)Wl + W_DOWN_OFF), CHUNK, DM, DFF}; O = XH + (size_t)c * CHUNK * DM; }
                    pg8::StaticOrder S; S.init(g.M, g.N, G, bx);
                    pg8::EpiBf16<0> E{O, DM, nullptr, 0, 0, 1.f};
                    for (int rep = 0; rep < REP_PLAIN; ++rep) pg8::gemm_phase<pg8::EpiBf16<0>, pg8::StaticOrder, PG8_ALIGN, PG8_SP2>(ring, g, S, E);
#endif
                }
            }
        }
        if (ph + 1 < p.ph_hi) { for (int rep = 0; rep < REP_SYNC; ++rep) { if (MK_MULTI == 0 && ph != 0) xcd_barrier(xbar); else grid.sync(); } }
    }
}

extern "C" void kernel_launch(void* const* d_in, const int* in_sizes, int n_in, void* d_out, int out_size, void* d_ws, size_t ws_size, hipStream_t stream) {
    static int grid = 0;
    if (grid == 0) {
        if (n_in != 17 || out_size != MTOK * DM || ws_size < WS_END) { fprintf(stderr, "kernel_launch: unexpected shapes: n_in %d out %d ws %zu (need %zu)\n", n_in, out_size, ws_size, (size_t)WS_END); grid = -1; return; }
        int dev = 0, cus = 0, per_cu = 0;
        if (hipGetDevice(&dev) != hipSuccess || hipDeviceGetAttribute(&cus, hipDeviceAttributeMultiprocessorCount, dev) != hipSuccess) { grid = -1; return; }
        if (hipFuncSetAttribute((const void*)mega_fwd, hipFuncAttributeMaxDynamicSharedMemorySize, LDS_BYTES) != hipSuccess) { fprintf(stderr, "kernel_launch: hipFuncSetAttribute failed\n"); grid = -1; return; }
        if (hipOccupancyMaxActiveBlocksPerMultiprocessor(&per_cu, (const void*)mega_fwd, 512, LDS_BYTES) != hipSuccess || per_cu < 1) { fprintf(stderr, "kernel_launch: occupancy query says %d\n", per_cu); per_cu = 1; }
        (void)hipGetLastError();
        grid = cus * 1;
    }
    if (grid < 0) return;
    if (hipMemsetAsync((char*)d_ws + WS_BAR, 0, BAR_BYTES, stream) != hipSuccess) { fprintf(stderr, "kernel_launch: memset failed\n"); return; }
    Params p{};
    for (int i = 0; i < 17; ++i) p.in[i] = (const float*)d_in[i];
    p.out = (float*)d_out; p.ws = (unsigned char*)d_ws;
#if MK_MULTI
    for (int ph = 0; ph < NPHASE; ++ph) { p.ph_lo = ph; p.ph_hi = ph + 1; hipLaunchKernelGGL(mega_fwd, dim3(grid), dim3(512), LDS_BYTES, stream, p); }
#else
    p.ph_lo = 0; p.ph_hi = NPHASE;
    void* args[] = {&p};
    hipError_t e = hipLaunchCooperativeKernel((const void*)mega_fwd, dim3(grid), dim3(512), args, LDS_BYTES, stream);
    if (e != hipSuccess) fprintf(stderr, "cooperative launch failed: %s (grid %d)\n", hipGetErrorString(e), grid);
#endif
}
```

```cpp
#include <hip/hip_runtime.h>
#include <hip/hip_bf16.h>
#include <hip/hip_cooperative_groups.h>
#include <cstdio>
#include <cstdint>
#ifndef MK_MULTI
#define MK_MULTI 0
#endif
__device__ __forceinline__ int ltid() { int t = threadIdx.x; asm volatile("" : "+v"(t)); return t; }
#ifndef REP_UP
#define REP_UP 1
#endif
#ifndef REP_ATTN
#define REP_ATTN 1
#endif
#ifndef REP_PLAIN
#define REP_PLAIN 1
#endif
#ifndef REP_WIN
#define REP_WIN 1
#endif
#ifndef REP_P0
#define REP_P0 1
#endif
#ifndef REP_LIGHT
#define REP_LIGHT 1
#endif
#ifndef REP_SYNC
#define REP_SYNC 1
#endif
namespace pg8 {
#define PG8_LAS __attribute__((address_space(3)))
typedef unsigned short bf16_t;
typedef short bf16x8 __attribute__((ext_vector_type(8)));
typedef float f32x4 __attribute__((ext_vector_type(4)));
typedef unsigned u32x4 __attribute__((ext_vector_type(4)));
constexpr int BM = 256, BK = 64, HALF = 128, HTB = HALF * BK * 2  , STAGE_BYTES = 8 * HTB, NXCD = 8, WGM = 8;

__host__ __device__ __forceinline__ int lds_byte(int r, int c) { const int st = (r >> 4) * 2 + (c >> 5), rr = r & 15, cc = c & 31, ob = rr * 64 + cc * 2; return st * 1024 + (ob ^ (((ob >> 9) & 1) << 5)); }
__host__ __device__ __forceinline__ void stage_rc(int b, int& R, int& C) { const int st = b / 1024, sb = b % 1024, swz = sb ^ (((sb >> 9) & 1) << 5); R = (st >> 1) * 16 + swz / 64; C = (st & 1) * 32 + (swz % 64) / 2; }
__host__ __device__ __forceinline__ int perm32(int rho) { const int n = rho >> 4, i = rho & 15; return 8 * (i >> 2) + 4 * n + (i & 3); }

struct Unit { int pm, pn; };
struct Gemm { const bf16_t* A; const bf16_t* Bt; int M, N, K; };

struct StaticOrder {
    int nM, nN, nwg, G, c;
    __host__ __device__ void init(int M, int N, int G_, int c_) { nM = M / BM; nN = N / BM; nwg = nM * nN; G = G_; c = c_; }
    __host__ __device__ bool next(int i, Unit& u) const {
        const long L = (long)i * G + c; if (L >= nwg) return false;
        int wgid = (int)L; { const int q = nwg / NXCD, r = nwg % NXCD, xcd = wgid % NXCD, off = wgid / NXCD; wgid = (xcd < r ? xcd * (q + 1) : r * (q + 1) + (xcd - r) * q) + off; }
        const int nig = WGM * nN, gid = wgid / nig, fm = gid * WGM, gsz = (nM - fm) < WGM ? (nM - fm) : WGM;
        u.pm = fm + ((wgid % nig) % gsz); u.pn = (wgid % nig) / gsz; return true;
    }
    __device__ __forceinline__ void a_ready(const Unit&) const {}
    __device__ __forceinline__ void done(const Unit&) const {}
};

__device__ __forceinline__ unsigned cvt_pk_bf16(float lo, float hi) { unsigned r; asm volatile("v_cvt_pk_bf16_f32 %0, %1, %2" : "=v"(r) : "v"(lo), "v"(hi)); return r; }
typedef float f32x2 __attribute__((ext_vector_type(2)));
__device__ __forceinline__ f32x2 gelu_pk(f32x2 v) {
    const f32x2 av = __builtin_elementwise_abs(v), d = av * 0.2316418882f + 1.0f;
    f32x2 t; t.x = __builtin_amdgcn_rcpf(d.x); t.y = __builtin_amdgcn_rcpf(d.y);
    f32x2 q = t * 0.5307027145f + (-0.7265760135f); q = q * t + 0.7107068705f; q = q * t + (-0.142248368f); q = q * t + 0.127414796f; q = q * t;
    const f32x2 s = (v * v) * (-0.72134752044f);
    f32x2 e; e.x = __builtin_amdgcn_exp2f(s.x); e.y = __builtin_amdgcn_exp2f(s.y);
    const f32x2 m = v * (q * e), r = v - m;
    f32x2 o; o.x = v.x < 0.f ? m.x : r.x; o.y = v.y < 0.f ? m.y : r.y; return o;
}

template <int ACT  > struct EpiBf16 {
    static constexpr bool PERM = true, AFTER_DRAIN = false; static_assert(ACT == 0 || ACT == 1, "EpiBf16: ACT is 0 (none) or 1 (gelu_pk)");
    bf16_t* O; int ldc; const float* bias; int split_cols; size_t split_stride; float scale0;
    __device__ __forceinline__ void operator()(const f32x4 (&acc)[2][2][4][2], const Unit& u, int wr, int wc, int fr, int fq) const {
        const int row0 = u.pm * BM + wr * 64 + fr; int colt = u.pn * BM; bf16_t* base = O;
        float sc = 1.f; if (split_cols) { const int t = colt / split_cols; base += (size_t)t * split_stride; colt -= t * split_cols; if (t == 0) sc = scale0; }
        const int col0 = colt + wc * 32 + 8 * fq, bcol0 = u.pn * BM + wc * 32 + 8 * fq;
        f32x4 bv[2][2];
#pragma unroll
        for (int bj = 0; bj < 2; ++bj)
#pragma unroll
            for (int n = 0; n < 2; ++n) bv[bj][n] = bias ? *(const f32x4*)(bias + bcol0 + bj * HALF + 4 * n) : (f32x4){0.f, 0.f, 0.f, 0.f};
#pragma unroll
        for (int ai = 0; ai < 2; ++ai)
#pragma unroll
            for (int m = 0; m < 4; ++m) { bf16_t* rowp = base + (size_t)(row0 + ai * HALF + m * 16) * ldc + col0;
#pragma unroll
                for (int bj = 0; bj < 2; ++bj) { f32x4 v0 = acc[ai][bj][m][0] + bv[bj][0], v1 = acc[ai][bj][m][1] + bv[bj][1];
                    if (ACT == 1) { f32x2 a = gelu_pk((f32x2){v0[0], v0[1]}), b = gelu_pk((f32x2){v0[2], v0[3]}), c = gelu_pk((f32x2){v1[0], v1[1]}), d = gelu_pk((f32x2){v1[2], v1[3]});
                        v0 = (f32x4){a.x, a.y, b.x, b.y}; v1 = (f32x4){c.x, c.y, d.x, d.y}; }
                    v0 = v0 * sc; v1 = v1 * sc; u32x4 w; w.x = cvt_pk_bf16(v0[0], v0[1]); w.y = cvt_pk_bf16(v0[2], v0[3]); w.z = cvt_pk_bf16(v1[0], v1[1]); w.w = cvt_pk_bf16(v1[2], v1[3]);
                    *(u32x4*)(rowp + bj * HALF) = w; } }
    }
};
template <class Epi, class Sched, bool ALIGN_EPI = false, bool SP2 = false>
__device__ __forceinline__ void gemm_phase(PG8_LAS unsigned char* lds, const Gemm g, const Sched& S, const Epi& E) {
    const int tid = ltid(), wid = __builtin_amdgcn_readfirstlane(tid >> 6), lane = tid & 63, wr = wid >> 2, wc = wid & 3, fr = lane & 15, fq = lane >> 4;
    const int K = g.K, nt = K / BK;
    unsigned voffA[2], voffB[2];
#pragma unroll
    for (int i = 0; i < 2; ++i) { int R, C; stage_rc(tid * 16 + i * 8192, R, C); const int Rb = Epi::PERM ? ((R & ~31) + perm32(R & 31)) : R;
        voffA[i] = (unsigned)(R * K + C) * 2u; voffB[i] = (unsigned)(Rb * K + C) * 2u; }
    const size_t kstep = (size_t)(BK * 2);
    const size_t hstep = (size_t)HALF * K * 2;
    const size_t tstep = 2 * hstep;
    const unsigned ldsw = (unsigned)wid * 1024u;
    const int aoff = lds_byte(wr * 64 + fr, fq * 8), boff = lds_byte(wc * 32 + fr, fq * 8);
#define PG8_SA(b, h) (((b) * 2 + (h)) * HTB)
#define PG8_SB(b, h) ((4 + (b) * 2 + (h)) * HTB)
#define PG8_STAGE(bufoff, gbase, voff) do { _Pragma("unroll") for (int _i = 0; _i < 2; ++_i) \
        __builtin_amdgcn_global_load_lds((const unsigned*)((const char*)(gbase) + (voff)[_i]), (PG8_LAS unsigned*)(lds + (bufoff) + ldsw + _i * 8192), 16, 0, 0); } while (0)
#define PG8_LDA(dst, b, h) do { _Pragma("unroll") for (int m = 0; m < 4; ++m) _Pragma("unroll") for (int k = 0; k < 2; ++k) dst[m][k] = *(const PG8_LAS bf16x8*)(lds + PG8_SA(b, h) + aoff + m * 2048 + k * 1024); } while (0)
#define PG8_LDB(dst, b, h) do { _Pragma("unroll") for (int n = 0; n < 2; ++n) _Pragma("unroll") for (int k = 0; k < 2; ++k) dst[n][k] = *(const PG8_LAS bf16x8*)(lds + PG8_SB(b, h) + boff + n * 2048 + k * 1024); } while (0)
#define PG8_MMA(ai, bj, At, Bt) do { __builtin_amdgcn_s_setprio(1); _Pragma("unroll") for (int m = 0; m < 4; ++m) _Pragma("unroll") for (int n = 0; n < 2; ++n) _Pragma("unroll") for (int k = 0; k < 2; ++k) \
        acc[ai][bj][m][n] = __builtin_amdgcn_mfma_f32_16x16x32_bf16(Bt[n][k], At[m][k], acc[ai][bj][m][n], 0, 0, 0); __builtin_amdgcn_s_setprio(0); } while (0)
#define PG8_WAIT_V(n) asm volatile("s_waitcnt vmcnt(" #n ")" ::: "memory")
#define PG8_WAIT_L(n) asm volatile("s_waitcnt lgkmcnt(" #n ")" ::: "memory")
#define PG8_BAR __builtin_amdgcn_s_barrier()
#define PG8_SCHED __builtin_amdgcn_sched_barrier(0)
    Unit cur, nxt; int ui = 0;
    if (!S.next(0, cur)) return;
    f32x4 acc[2][2][4][2];
#pragma unroll
    for (int a = 0; a < 2; ++a)
#pragma unroll
        for (int b = 0; b < 2; ++b)
#pragma unroll
            for (int m = 0; m < 4; ++m)
#pragma unroll
                for (int n = 0; n < 2; ++n) acc[a][b][m][n] = (f32x4){0.f, 0.f, 0.f, 0.f};
    bf16x8 At[4][2], B0[2][2], B1[2][2];
    const char* cA = (const char*)g.A + (size_t)cur.pm * tstep; const char* cB = (const char*)g.Bt + (size_t)cur.pn * tstep;
    S.a_ready(cur);
    if constexpr (SP2) {
        PG8_STAGE(PG8_SB(0, 0), cB, voffB); PG8_STAGE(PG8_SB(0, 1), cB + hstep, voffB); PG8_STAGE(PG8_SA(0, 0), cA, voffA); PG8_STAGE(PG8_SA(0, 1), cA + hstep, voffA);
        if (wr == 1) PG8_BAR;
        PG8_WAIT_V(2); PG8_BAR;
        PG8_STAGE(PG8_SB(1, 0), cB + kstep, voffB); PG8_STAGE(PG8_SA(1, 0), cA + kstep, voffA); PG8_STAGE(PG8_SB(1, 1), cB + hstep + kstep, voffB);
        PG8_WAIT_V(6); PG8_BAR;
    } else {
        PG8_STAGE(PG8_SB(0, 0), cB, voffB); PG8_STAGE(PG8_SA(0, 0), cA, voffA); PG8_STAGE(PG8_SB(0, 1), cB + hstep, voffB); PG8_STAGE(PG8_SA(0, 1), cA + hstep, voffA);
        if (wr == 1) PG8_BAR;
        PG8_WAIT_V(4); PG8_BAR;
        PG8_STAGE(PG8_SB(1, 0), cB + kstep, voffB); PG8_STAGE(PG8_SA(1, 0), cA + kstep, voffA); PG8_STAGE(PG8_SB(1, 1), cB + hstep + kstep, voffB);
        PG8_WAIT_V(6); PG8_BAR;
    }
    for (;;) {
        const bool has_next = S.next(ui + 1, nxt);
        const char* nA = has_next ? (const char*)g.A + (size_t)nxt.pm * tstep : cA; const char* nB = has_next ? (const char*)g.Bt + (size_t)nxt.pn * tstep : cB;
        for (int t = 0; t < nt; t += 2) {
            const bool last = (t == nt - 2);
            const char* a1 = cA + (size_t)(t + 1) * kstep;
            const char* a2 = last ? nA : cA + (size_t)(t + 2) * kstep; const char* b2 = last ? nB : cB + (size_t)(t + 2) * kstep;
            const char* a3 = a2 + kstep; const char* b3 = b2 + kstep;
            if (last && has_next) S.a_ready(nxt);
            if constexpr (SP2) {
            PG8_LDB(B0, 0, 0); PG8_LDB(B1, 0, 1); PG8_SCHED; PG8_LDA(At, 0, 0); PG8_STAGE(PG8_SA(1, 1), a1 + hstep, voffA);
            PG8_WAIT_V(8); PG8_WAIT_L(0); PG8_BAR; PG8_MMA(0, 0, At, B0); PG8_MMA(0, 1, At, B1); PG8_BAR; PG8_SCHED;
            PG8_LDA(At, 0, 1); PG8_STAGE(PG8_SB(0, 0), b2, voffB); PG8_STAGE(PG8_SB(0, 1), b2 + hstep, voffB); PG8_STAGE(PG8_SA(0, 0), a2, voffA);
            PG8_WAIT_V(8); PG8_WAIT_L(0); PG8_BAR; PG8_MMA(1, 0, At, B0); PG8_MMA(1, 1, At, B1); PG8_BAR; PG8_SCHED;
            PG8_LDB(B0, 1, 0); PG8_LDB(B1, 1, 1); PG8_SCHED; PG8_LDA(At, 1, 0); PG8_STAGE(PG8_SA(0, 1), a2 + hstep, voffA);
            PG8_WAIT_V(8); PG8_WAIT_L(0); PG8_BAR; PG8_MMA(0, 0, At, B0); PG8_MMA(0, 1, At, B1); PG8_BAR; PG8_SCHED;
            PG8_LDA(At, 1, 1); PG8_STAGE(PG8_SB(1, 0), b3, voffB); PG8_STAGE(PG8_SB(1, 1), b3 + hstep, voffB); PG8_STAGE(PG8_SA(1, 0), a3, voffA);
            PG8_WAIT_V(8); PG8_WAIT_L(0); PG8_BAR; PG8_MMA(1, 0, At, B0); PG8_MMA(1, 1, At, B1); PG8_BAR; PG8_SCHED;
            } else {
            PG8_LDB(B0, 0, 0); PG8_SCHED; PG8_LDA(At, 0, 0); PG8_STAGE(PG8_SA(1, 1), a1 + hstep, voffA);
            PG8_WAIT_L(8); PG8_BAR; PG8_WAIT_L(0); PG8_MMA(0, 0, At, B0); PG8_BAR; PG8_SCHED;
            PG8_LDB(B1, 0, 1); PG8_STAGE(PG8_SB(0, 0), b2, voffB);
            PG8_BAR; PG8_WAIT_L(0); PG8_MMA(0, 1, At, B1); PG8_BAR;
            PG8_LDA(At, 0, 1); PG8_STAGE(PG8_SA(0, 0), a2, voffA);
            PG8_BAR; PG8_WAIT_L(0); PG8_MMA(1, 0, At, B0); PG8_BAR; PG8_SCHED;
            PG8_STAGE(PG8_SB(0, 1), b2 + hstep, voffB);
            PG8_WAIT_V(6); PG8_BAR; PG8_MMA(1, 1, At, B1); PG8_BAR;
            PG8_LDB(B0, 1, 0); PG8_SCHED; PG8_LDA(At, 1, 0); PG8_STAGE(PG8_SA(0, 1), a2 + hstep, voffA);
            PG8_WAIT_L(8); PG8_BAR; PG8_WAIT_L(0); PG8_MMA(0, 0, At, B0); PG8_BAR; PG8_SCHED;
            PG8_LDB(B1, 1, 1); PG8_STAGE(PG8_SB(1, 0), b3, voffB);
            PG8_BAR; PG8_WAIT_L(0); PG8_MMA(0, 1, At, B1); PG8_BAR;
            PG8_LDA(At, 1, 1); PG8_STAGE(PG8_SA(1, 0), a3, voffA);
            PG8_BAR; PG8_WAIT_L(0); PG8_MMA(1, 0, At, B0); PG8_BAR; PG8_SCHED;
            PG8_STAGE(PG8_SB(1, 1), b3 + hstep, voffB);
            PG8_WAIT_V(6); PG8_BAR; PG8_MMA(1, 1, At, B1); PG8_BAR;
            }
        }
        if constexpr (ALIGN_EPI) { if (wr == 0) PG8_BAR; }
        if constexpr (!Epi::AFTER_DRAIN) { E(acc, cur, wr, wc, fr, fq); S.done(cur); }
        if (!has_next) break;
#pragma unroll
        for (int a = 0; a < 2; ++a)
#pragma unroll
            for (int b = 0; b < 2; ++b)
#pragma unroll
                for (int m = 0; m < 4; ++m)
#pragma unroll
                    for (int n = 0; n < 2; ++n) acc[a][b][m][n] = (f32x4){0.f, 0.f, 0.f, 0.f};
        cur = nxt; cA = nA; cB = nB; ++ui;
        if constexpr (ALIGN_EPI) { if (wr == 1) PG8_BAR; }
    }
    PG8_WAIT_V(0);
    if constexpr (!ALIGN_EPI) { if (wr == 0) PG8_BAR; }
    PG8_BAR;
    if constexpr (Epi::AFTER_DRAIN) { E.fused(acc, cur, wr, wc, fr, fq, lds, wid, lane); S.done(cur); }
#undef PG8_SA
#undef PG8_SB
#undef PG8_STAGE
#undef PG8_LDA
#undef PG8_LDB
#undef PG8_MMA
#undef PG8_WAIT_V
#undef PG8_WAIT_L
#undef PG8_BAR
#undef PG8_SCHED
}
}
#define PG8_SP2 true
#define PG8_ALIGN true
namespace att {
using bf16 = __hip_bfloat16;
constexpr int   D = 128, NW = 8, QBLK = 32, KVBLK = 64;
constexpr float SCALE = 0.088388347648318440f;
constexpr float THR = 8.f;
constexpr int SDEPTH = 2;
constexpr bool STATIC_MAX = true;
constexpr int LDQ = 2048, LDK = 2048, LDO = 2048;
constexpr size_t SHM_V = KVBLK * D * 2, SHM_K = KVBLK * D * 2, SHM_ATTN = 2 * SHM_V + 2 * SHM_K + NW * 64 * 4;
using bf16x8 = __attribute__((ext_vector_type(8))) short;
using s16x4  = __attribute__((ext_vector_type(4))) short;
using f32x16 = __attribute__((ext_vector_type(16))) float;
using f32x8  = __attribute__((ext_vector_type(8))) float;
using u32x4  = __attribute__((ext_vector_type(4))) unsigned;
#define KSWZ(row, colB) ((row) * 256 + ((colB) ^ (((row) & 7) << 4)))
#define SBAR() __builtin_amdgcn_sched_barrier(0)
__device__ __forceinline__ int crow(int r, int hi) { return (r & 3) + 8 * (r >> 2) + 4 * hi; }
__device__ __forceinline__ unsigned cvtpk(float lo, float hi) {
  unsigned r; asm volatile("v_cvt_pk_bf16_f32 %0, %1, %2" : "=v"(r) : "v"(lo), "v"(hi)); return r;
}
template <typename TIn> struct Stage;
template <> struct Stage<bf16>  { using T = bf16x8;
  __device__ static __forceinline__ T ld8(const bf16* p) { return *reinterpret_cast<const bf16x8*>(p); }
  __device__ static __forceinline__ bf16x8 tobf(T x) { return x; } };
template <> struct Stage<float> { using T = f32x8;
  __device__ static __forceinline__ T ld8(const float* p) { return *reinterpret_cast<const f32x8*>(p); }
  __device__ static __forceinline__ bf16x8 tobf(T x) {
    u32x4 w = {cvtpk(x[0], x[1]), cvtpk(x[2], x[3]), cvtpk(x[4], x[5]), cvtpk(x[6], x[7])}; return *reinterpret_cast<bf16x8*>(&w); } };

__device__ __forceinline__ void partialSM(f32x16& p0, f32x16& p1, float& m_reg, float& mn, float& alpha) {
  constexpr float C = SCALE * 1.4426950408889634f;
  if constexpr (STATIC_MAX) { mn = m_reg; alpha = 1.f; }
  else {
  float pmax = p0[0]; for (int r = 1; r < 16; ++r) pmax = fmaxf(pmax, p0[r]); for (int r = 0; r < 16; ++r) pmax = fmaxf(pmax, p1[r]);
  { auto rr = __builtin_amdgcn_permlane32_swap(__float_as_uint(pmax), __float_as_uint(pmax), false, false);
    pmax = fmaxf(__uint_as_float(rr[0]), __uint_as_float(rr[1])); }
  if (__builtin_expect(__all(pmax - m_reg <= THR / SCALE), 1)) { mn = m_reg; alpha = 1.f; }
  else { mn = fmaxf(m_reg, pmax); alpha = __builtin_amdgcn_exp2f((m_reg - mn) * C); m_reg = mn; }
  }
  float mnC = -mn * C;
  for (int r = 0; r < 16; ++r) p0[r] = fmaf(p0[r], C, mnC); for (int r = 0; r < 16; ++r) p1[r] = fmaf(p1[r], C, mnC);
  for (int r = 0; r < 16; ++r) p0[r] = __builtin_amdgcn_exp2f(p0[r]);
}
__device__ __forceinline__ void finishSM(f32x16& p0, f32x16& p1, float alpha, float& l_reg, bf16x8& pa0, bf16x8& pa1, bf16x8& pa2, bf16x8& pa3) {
  for (int r = 0; r < 16; ++r) p1[r] = __builtin_amdgcn_exp2f(p1[r]);
  float ps = 0; for (int r = 0; r < 16; ++r) ps += p0[r]; for (int r = 0; r < 16; ++r) ps += p1[r];
  { auto rr = __builtin_amdgcn_permlane32_swap(__float_as_uint(ps), __float_as_uint(ps), false, false);
    ps = __uint_as_float(rr[0]) + __uint_as_float(rr[1]); }
  l_reg = l_reg * alpha + ps;
#define PK4(P, BASE, OUT) do { unsigned a0 = cvtpk(P[BASE + 0], P[BASE + 1]), a1 = cvtpk(P[BASE + 2], P[BASE + 3]);   \
    unsigned b0 = cvtpk(P[BASE + 4], P[BASE + 5]), b1 = cvtpk(P[BASE + 6], P[BASE + 7]);                              \
    auto r0 = __builtin_amdgcn_permlane32_swap(a0, b0, false, false); auto r1 = __builtin_amdgcn_permlane32_swap(a1, b1, false, false); \
    u32x4 w = {r0[0], r1[0], r0[1], r1[1]}; OUT = *reinterpret_cast<bf16x8*>(&w); } while (0)
  PK4(p0, 0, pa0); PK4(p0, 8, pa1); PK4(p1, 0, pa2); PK4(p1, 8, pa3);
#undef PK4
}
__device__ __forceinline__ void qkt(f32x16& p0, f32x16& p1, const bf16* Ks, const bf16x8* qr, int r32, int hi) {
  p0 = f32x16{}; p1 = f32x16{};
  for (int d0 = 0; d0 < 8; ++d0) { int cb = (d0 * 16 + hi * 8) * 2;
    bf16x8 b0 = *reinterpret_cast<const bf16x8*>((const char*)Ks + KSWZ(r32, cb));
    bf16x8 b1 = *reinterpret_cast<const bf16x8*>((const char*)Ks + KSWZ(32 + r32, cb));
    p0 = __builtin_amdgcn_mfma_f32_32x32x16_bf16(b0, qr[d0], p0, 0, 0, 0);
    p1 = __builtin_amdgcn_mfma_f32_32x32x16_bf16(b1, qr[d0], p1, 0, 0, 0); }
}
__device__ __forceinline__ int v_st(int k, int c) { const int kk = (k & ~0xC) | ((k & 4) << 1) | ((k & 8) >> 1); return ((kk >> 3) * 4 + (c >> 5)) * 512 + ((kk & 7) * 32 + (c & 31)) * 2; }
__device__ __forceinline__ int v_rd_base(int lane) { return ((lane & 3) << 3) | (((lane >> 2) & 3) << 6) | (((lane >> 4) & 1) << 5) | (((lane >> 5) & 1) << 8); }
constexpr int v_rd_off(int d0, int ks, int half) { return d0 * 512 + ks * 4096 + half * 2048; }
template <int OFF> __device__ __forceinline__ s16x4 tr_read(int vb) {
  s16x4 r; asm volatile("ds_read_b64_tr_b16 %0, %1 offset:%2" : "=&v"(r) : "v"(vb), "i"(OFF) : "memory"); return r;
}
template <int D0> __device__ __forceinline__ void pv_one(f32x16& od, int vb, bf16x8 pa0, bf16x8 pa1, bf16x8 pa2, bf16x8 pa3) {
  const s16x4 l0 = tr_read<v_rd_off(D0, 0, 0)>(vb), h0 = tr_read<v_rd_off(D0, 0, 1)>(vb), l1 = tr_read<v_rd_off(D0, 1, 0)>(vb), h1 = tr_read<v_rd_off(D0, 1, 1)>(vb);
  const s16x4 l2 = tr_read<v_rd_off(D0, 2, 0)>(vb), h2 = tr_read<v_rd_off(D0, 2, 1)>(vb), l3 = tr_read<v_rd_off(D0, 3, 0)>(vb), h3 = tr_read<v_rd_off(D0, 3, 1)>(vb);
  asm volatile("s_waitcnt lgkmcnt(0)" ::: "memory"); SBAR();
#define PK(L, H) (bf16x8){L[0], L[1], L[2], L[3], H[0], H[1], H[2], H[3]}
  od = __builtin_amdgcn_mfma_f32_32x32x16_bf16(pa0, PK(l0, h0), od, 0, 0, 0);
  od = __builtin_amdgcn_mfma_f32_32x32x16_bf16(pa1, PK(l1, h1), od, 0, 0, 0);
  od = __builtin_amdgcn_mfma_f32_32x32x16_bf16(pa2, PK(l2, h2), od, 0, 0, 0);
  od = __builtin_amdgcn_mfma_f32_32x32x16_bf16(pa3, PK(l3, h3), od, 0, 0, 0);
#undef PK
}
__device__ __forceinline__ void pv_d0(f32x16* o, int vb, bf16x8 pa0, bf16x8 pa1, bf16x8 pa2, bf16x8 pa3) {
  pv_one<0>(o[0], vb, pa0, pa1, pa2, pa3); pv_one<1>(o[1], vb, pa0, pa1, pa2, pa3); pv_one<2>(o[2], vb, pa0, pa1, pa2, pa3); pv_one<3>(o[3], vb, pa0, pa1, pa2, pa3);
}
template <typename TQ>
__device__ __forceinline__ void attn_dense_body(const TQ* __restrict__ Qb, const bf16* __restrict__ Kh, const bf16* __restrict__ Vh,
                                                bf16* __restrict__ Ob, int seq, char* lds, float bound) {
  using St = Stage<bf16>; using SQ = Stage<TQ>;
  const int tid = ltid(), wid = tid >> 6, lane = tid & 63, r32 = lane & 31, hi = lane >> 5;
  bf16* V_lds = (bf16*)lds; bf16* K_lds = (bf16*)(lds + 2 * SHM_V);
  float* ws = (float*)(lds + 2 * SHM_V + 2 * SHM_K) + wid * 64; float* li_l = ws; float* al_l = ws + 32;
  float m_reg = STATIC_MAX ? bound : -1e30f, l_reg = 0; f32x16 o[4] = {}; bf16x8 qr[8];
  const TQ* Qw = Qb + (long)(wid * QBLK + r32) * LDQ + hi * 8;
#pragma unroll
  for (int d0 = 0; d0 < 8; ++d0) qr[d0] = SQ::tobf(SQ::ld8(Qw + d0 * 16));
  const int sr = tid >> 4, sc = (tid & 15) * 8, vst0 = v_st(sr, sc), vst1 = v_st(32 + sr, sc);
  const int vb0 = (int)(uintptr_t)V_lds + v_rd_base(lane);
  struct { typename St::T vs0, vs1, ks0, ks1; } sr_[SDEPTH];
#define SLOAD(i, k0) do { sr_[i].vs0 = St::ld8(&Vh[(long)((k0) + sr) * LDK + sc]); sr_[i].vs1 = St::ld8(&Vh[(long)((k0) + 32 + sr) * LDK + sc]); \
    sr_[i].ks0 = St::ld8(&Kh[(long)((k0) + sr) * LDK + sc]); sr_[i].ks1 = St::ld8(&Kh[(long)((k0) + 32 + sr) * LDK + sc]); } while (0)
#define SWRITE(b, i) do { *(bf16x8*)((char*)V_lds + (b) * SHM_V + vst0) = St::tobf(sr_[i].vs0);          \
    *(bf16x8*)((char*)V_lds + (b) * SHM_V + vst1) = St::tobf(sr_[i].vs1); int kc = sc * 2;               \
    *(bf16x8*)((char*)K_lds + (b) * SHM_K + KSWZ(sr, kc)) = St::tobf(sr_[i].ks0);                       \
    *(bf16x8*)((char*)K_lds + (b) * SHM_K + KSWZ(32 + sr, kc)) = St::tobf(sr_[i].ks1); } while (0)
#define SWAIT() do { if constexpr (SDEPTH == 2) asm volatile("s_waitcnt vmcnt(4)" ::: "memory"); else asm volatile("s_waitcnt vmcnt(0)" ::: "memory"); } while (0)
#define RESC(a) do { if (!STATIC_MAX && __any((a) < 1.f)) { if (hi == 0) al_l[r32] = (a); asm volatile("s_waitcnt lgkmcnt(0)" ::: "memory"); \
    for (int d = 0; d < 4; ++d) for (int r = 0; r < 16; ++r) o[d][r] *= al_l[crow(r, hi)]; } } while (0)
  f32x16 pA0, pA1, pB0, pB1; float mnA, mnB, alA, alB; bf16x8 pa0, pa1, pa2, pa3; const int NT = seq / KVBLK;
  constexpr int SE = 0, SO = SDEPTH - 1;
  SLOAD(SE, 0); asm volatile("s_waitcnt vmcnt(0)" ::: "memory"); SWRITE(0, SE); __syncthreads();
  qkt(pA0, pA1, K_lds, qr, r32, hi); partialSM(pA0, pA1, m_reg, mnA, alA);
  SLOAD(SO, KVBLK); if constexpr (SDEPTH == 2) { if (2 < NT) SLOAD(SE, 2 * KVBLK); }
  SWAIT(); SWRITE(1, SO); __syncthreads();
  for (int j = 1; j + 1 < NT; j += 2) {
    SBAR(); qkt(pB0, pB1, (bf16*)((char*)K_lds + SHM_K), qr, r32, hi);
    finishSM(pA0, pA1, alA, l_reg, pa0, pa1, pa2, pa3); SBAR();
    SLOAD(SO, (j + SDEPTH) * KVBLK); SBAR();
    pv_d0(o, vb0, pa0, pa1, pa2, pa3); partialSM(pB0, pB1, m_reg, mnB, alB);
    __syncthreads(); SWAIT(); SWRITE(0, SE);
    RESC(alB); __syncthreads();
    SBAR(); qkt(pA0, pA1, K_lds, qr, r32, hi);
    finishSM(pB0, pB1, alB, l_reg, pa0, pa1, pa2, pa3); SBAR();
    if (SDEPTH == 1 || j + 3 < NT) SLOAD(SE, (j + 1 + SDEPTH) * KVBLK); SBAR();
    pv_d0(o, vb0 + (int)SHM_V, pa0, pa1, pa2, pa3); partialSM(pA0, pA1, m_reg, mnA, alA);
    __syncthreads(); SWAIT(); SWRITE(1, SO);
    RESC(alA); __syncthreads();
  }
  SBAR(); qkt(pB0, pB1, (bf16*)((char*)K_lds + SHM_K), qr, r32, hi);
  finishSM(pA0, pA1, alA, l_reg, pa0, pa1, pa2, pa3); SBAR();
  pv_d0(o, vb0, pa0, pa1, pa2, pa3); partialSM(pB0, pB1, m_reg, mnB, alB);
  __syncthreads(); RESC(alB);
  finishSM(pB0, pB1, alB, l_reg, pa0, pa1, pa2, pa3); SBAR();
  pv_d0(o, vb0 + (int)SHM_V, pa0, pa1, pa2, pa3);
  if (hi == 0) li_l[r32] = l_reg; asm volatile("s_waitcnt lgkmcnt(0)" ::: "memory");
  float rli[16];
#pragma unroll
  for (int r = 0; r < 16; ++r) rli[r] = __builtin_amdgcn_rcpf(li_l[crow(r, hi)]);
  bf16* Ow = Ob + (long)(wid * QBLK) * LDO;
#pragma unroll
  for (int r = 0; r < 16; ++r) { int orow = crow(r, hi);
    for (int d0 = 0; d0 < 4; ++d0) Ow[(long)orow * LDO + d0 * 32 + r32] = __float2bfloat16(o[d0][r] * rli[r]); }
#undef SLOAD
#undef SWRITE
#undef SWAIT
#undef RESC
}

template <int NC> __device__ __forceinline__ void pv_n(f32x16* o, int vb, bf16x8 pa0, bf16x8 pa1, bf16x8 pa2, bf16x8 pa3) {
  pv_one<0>(o[0], vb, pa0, pa1, pa2, pa3);
  if constexpr (NC > 1) pv_one<1>(o[1], vb, pa0, pa1, pa2, pa3);
  if constexpr (NC > 2) { pv_one<2>(o[2], vb, pa0, pa1, pa2, pa3); pv_one<3>(o[3], vb, pa0, pa1, pa2, pa3); }
}
template <int MB, int NKT, class BR, class ST>
__device__ __forceinline__ void dft_unit(const bf16* __restrict__ A, int lda, const BR& br, const ST& st, char* lds) {
  constexpr int NBW = 8 / MB, NC = 4 / NBW;
  const int tid = ltid(), wid = tid >> 6, lane = tid & 63, r32 = lane & 31, hi = lane >> 5;
  const int mb = wid % MB, cgp = wid / MB;
  const int sr = tid >> 4, sc = (tid & 15) * 8, vst0 = v_st(sr, sc), vst1 = v_st(32 + sr, sc);
  bf16x8 bq[NKT][2], af[NKT][4];
#pragma unroll
  for (int kt = 0; kt < NKT; ++kt) {
    bq[kt][0] = *reinterpret_cast<const bf16x8*>(br.row(kt * 64 + sr) + sc);
    bq[kt][1] = *reinterpret_cast<const bf16x8*>(br.row(kt * 64 + 32 + sr) + sc);
  }
  const bf16* Aw = A + (long)(mb * 32 + r32) * lda + hi * 8;
#pragma unroll
  for (int kt = 0; kt < NKT; ++kt)
#pragma unroll
    for (int ks = 0; ks < 4; ++ks) af[kt][ks] = *reinterpret_cast<const bf16x8*>(Aw + kt * 64 + ks * 16);
  __syncthreads();
#pragma unroll
  for (int kt = 0; kt < NKT; ++kt) {
    *(bf16x8*)(lds + kt * 16384 + vst0) = bq[kt][0];
    *(bf16x8*)(lds + kt * 16384 + vst1) = bq[kt][1];
  }
  __syncthreads();
  f32x16 o[NC];
#pragma unroll
  for (int d = 0; d < NC; ++d) o[d] = f32x16{};
  const int vb = (int)(uintptr_t)lds + v_rd_base(lane) + cgp * NC * 512;
#pragma unroll
  for (int kt = 0; kt < NKT; ++kt) pv_n<NC>(o, vb + kt * 16384, af[kt][0], af[kt][1], af[kt][2], af[kt][3]);
#pragma unroll
  for (int r = 0; r < 16; ++r) {
#pragma unroll
    for (int d = 0; d < NC; ++d) st(mb * 32 + crow(r, hi), (cgp * NC + d) * 32 + r32, o[d][r]);
  }
}
#undef SBAR
#undef KSWZ
}

namespace cg = cooperative_groups;
#define LAS __attribute__((address_space(3)))
typedef unsigned short bf16_t;
typedef unsigned v4u __attribute__((ext_vector_type(4)));
typedef unsigned v2u __attribute__((ext_vector_type(2)));
typedef float f4 __attribute__((ext_vector_type(4)));

#define XB_TMO      128
#define XB_XCNT(j)  (256  + 64 * (j))
#define XB_XSUB(j)  (1280 + 64 * (j))
#define XB_XGEN(j)  (2304 + 64 * (j))
#define XB_TOP      3328
#define XB_TOPGEN   3392
#define XCD_BAR_WORDS 3456
#define XB_SPIN_CAP (1u << 18)

__device__ __forceinline__ unsigned xb_ld(unsigned* p)              { return __hip_atomic_load(p, __ATOMIC_RELAXED, __HIP_MEMORY_SCOPE_AGENT); }
__device__ __forceinline__ unsigned xb_add(unsigned* p, unsigned v) { return __hip_atomic_fetch_add(p, v, __ATOMIC_RELAXED, __HIP_MEMORY_SCOPE_AGENT); }
__device__ __forceinline__ unsigned xb_xcc_id() { return (unsigned)__builtin_amdgcn_s_getreg((3 << 11) | 20) & 0xFu; }
#define XB_SPIN(cond, bar) do { unsigned _sp = 0; while (cond) { __builtin_amdgcn_s_sleep(1); \
    if ((++_sp & 255u) == 0u) { if (xb_ld(&(bar)[XB_TMO])) break; if (_sp > XB_SPIN_CAP) { atomicAdd(&(bar)[XB_TMO], 1u); break; } } } } while (0)

struct XcdBarrier {
    unsigned* bar; unsigned x;
    volatile LAS unsigned* st;
};

__device__ __forceinline__ XcdBarrier xcd_barrier_post(unsigned* bar, volatile LAS unsigned* st) {
    XcdBarrier b; b.bar = bar; b.x = xb_xcc_id(); b.st = st;
    if (threadIdx.x == 0) (void)xb_add(&bar[XB_XCNT(b.x)], 1u);
    return b;
}
__device__ __forceinline__ void xcd_barrier_complete(unsigned* bar, unsigned x, unsigned& nloc, unsigned& nx) {
    const unsigned G = gridDim.x * gridDim.y * gridDim.z;
    unsigned sum, cnt, mine, sp = 0u;
    for (;;) {
        sum = 0u; cnt = 0u; mine = 0u;
#pragma unroll
        for (unsigned j = 0; j < 16; ++j) { const unsigned c = xb_ld(&bar[XB_XCNT(j)]); sum += c; cnt += (c > 0u) ? 1u : 0u; mine = (j == x) ? c : mine; }
        if (sum == G) break;
        __builtin_amdgcn_s_sleep(1);
        if ((++sp & 255u) == 0u) { if (xb_ld(&bar[XB_TMO])) break; if (sp > XB_SPIN_CAP) { atomicAdd(&bar[XB_TMO], 1u); break; } }
    }
    nloc = mine > 0u ? mine : 1u; nx = cnt > 0u ? cnt : 1u;
}

__device__ __forceinline__ void xcd_barrier(const XcdBarrier& b) {
    asm volatile("s_waitcnt vmcnt(0)" ::: "memory");
    __syncthreads();
    if (threadIdx.x == 0) {
        unsigned* bar = b.bar;
        __builtin_amdgcn_s_waitcnt(0);
        unsigned nloc = b.st[0], nx = b.st[1];
        if (nloc == 0u) { xcd_barrier_complete(bar, b.x, nloc, nx); b.st[0] = nloc; b.st[1] = nx; }
        const unsigned old = xb_add(&bar[XB_XSUB(b.x)], 1u);
        const unsigned gen = old / nloc;
        if (old + 1u == (gen + 1u) * nloc) {
            __builtin_amdgcn_fence(__ATOMIC_RELEASE, "agent");
            asm volatile("s_waitcnt vmcnt(0)" ::: "memory");
            const unsigned og = xb_add(&bar[XB_TOP], 1u);
            const unsigned tg = og / nx;
            if (og + 1u == (tg + 1u) * nx) xb_add(&bar[XB_TOPGEN], 1u);
            else XB_SPIN(xb_ld(&bar[XB_TOPGEN]) == tg, bar);
            __builtin_amdgcn_fence(__ATOMIC_ACQUIRE, "agent");
            xb_add(&bar[XB_XGEN(b.x)], 1u);
            asm volatile("s_waitcnt vmcnt(0)" ::: "memory");
        } else {
            XB_SPIN(xb_ld(&bar[XB_XGEN(b.x)]) == gen, bar);
            __builtin_amdgcn_fence(__ATOMIC_ACQUIRE, "agent");
            asm volatile("s_waitcnt vmcnt(0)" ::: "memory");
        }
    }
    __syncthreads();
}

constexpr int DM = 2048, MTOK = 65536, NIN = 3072, DFF = 5632, NUP = 11264, WINW = 2560;
constexpr int NPROMPT = 32768;
constexpr int CHUNK = 65536, NCHUNK = 1;
constexpr float EPS = 1e-6f;
constexpr size_t MiB = (size_t)1 << 20;
constexpr size_t WS_M2F = 0;
constexpr size_t WS_COS = 1 * MiB, WS_SIN = 5 * MiB;
constexpr size_t WS_A1P = 9 * MiB, WS_A1S = 9 * MiB + 128 * 1024;
constexpr size_t WS_A3P = 10 * MiB, WS_A3S = 18 * MiB;
constexpr size_t WS_BAR = 19 * MiB, BAR_BYTES = 16384;
constexpr size_t WS_W = 20 * MiB;
constexpr size_t W_LAYER = 86 * MiB, W_OUT_OFF = 12 * MiB, W_UP_OFF = 20 * MiB, W_DOWN_OFF = 64 * MiB;
constexpr size_t WS_XH = 192 * MiB;
constexpr size_t WS_Z = 448 * MiB;
constexpr size_t WS_G = 704 * MiB;
constexpr size_t WS_Y = 832 * MiB;
constexpr size_t WS_ACT = 448 * MiB;
constexpr size_t WS_HB = 1152 * MiB;
constexpr size_t WS_XB = 1240 * MiB;
constexpr size_t WS_END = 1496 * MiB;
constexpr int LDS_BYTES = 135168;

__device__ __forceinline__ float bf2f(unsigned short b) { return __uint_as_float((unsigned)b << 16); }
__device__ __forceinline__ float bflo(unsigned w) { return __uint_as_float(w << 16); }
__device__ __forceinline__ float bfhi(unsigned w) { return __uint_as_float(w & 0xffff0000u); }
__device__ __forceinline__ unsigned pk2(float lo, float hi) { return pg8::cvt_pk_bf16(lo, hi); }
__device__ __forceinline__ float wave_sum(float v) {
#pragma unroll
    for (int o = 1; o < 64; o <<= 1) v += __shfl_xor(v, o);
    return v;
}

struct EpiWin {
    static constexpr bool PERM = true, AFTER_DRAIN = false;
    bf16_t* Z; bf16_t* Gp;
    __device__ __forceinline__ void operator()(const pg8::f32x4 (&acc)[2][2][4][2], const pg8::Unit& u, int wr, int wc, int fr, int fq) const {
        const int row0 = u.pm * pg8::BM + wr * 64 + fr;
        bf16_t* base; size_t rstride, bjstride;
        if (u.pn < 8) { base = Z + (size_t)row0 * 2048 + u.pn * 256 + wc * 32 + 8 * fq; rstride = 2048; bjstride = 128; }
        else {
            const int g = u.pn - 8, r0 = u.pm * pg8::BM; size_t sb; int L, t0;
            if (r0 < NPROMPT) { const int s = r0 >> 14; sb = (size_t)s * (2u * 16384u * 512u); L = 16384; t0 = row0 - s * 16384; }
            else { const int s = (r0 - NPROMPT) >> 12; sb = (size_t)NPROMPT * 1024 + (size_t)s * (2u * 4096u * 512u); L = 4096; t0 = row0 - NPROMPT - s * 4096; }
            base = Gp + sb + (size_t)t0 * 512 + g * 128 + wc * 32 + 8 * fq; rstride = 512; bjstride = (size_t)L * 512;
        }
#pragma unroll
        for (int ai = 0; ai < 2; ++ai)
#pragma unroll
            for (int m = 0; m < 4; ++m) { bf16_t* rowp = base + (size_t)(ai * pg8::HALF + m * 16) * rstride;
#pragma unroll
                for (int bj = 0; bj < 2; ++bj) { const pg8::f32x4 v0 = acc[ai][bj][m][0], v1 = acc[ai][bj][m][1];
                    pg8::u32x4 w; w.x = pk2(v0[0], v0[1]); w.y = pk2(v0[2], v0[3]); w.z = pk2(v1[0], v1[1]); w.w = pk2(v1[2], v1[3]);
                    *(pg8::u32x4*)(rowp + bj * bjstride) = w; } }
    }
};

__device__ __forceinline__ void p0a_tables(const float* fourier_w, unsigned char* ws, LAS float* tab, int gtid, int NT) {
    float* M2F = (float*)(ws + WS_M2F);
    { const int t = ltid(); if (t < 128) { float sn, cs; sincospif((float)t * (2.f / 128.f), &sn, &cs); tab[t] = cs; tab[128 + t] = -sn; } }
    __syncthreads();
    for (int i = gtid; i < 2 * 4 * 128 * 256; i += NT) {
        const int lg = i >> 15, c = (i >> 8) & 127, n = i & 255, part = n >> 7, e2 = n & 127;
        const float* fw = fourier_w + (size_t)lg * 16384 + e2;
        float acc = 0.f;
#pragma unroll 8
        for (int e = 0; e < 128; ++e) { const int r = (c * e) & 127; acc += tab[part * 128 + r] * fw[e * 128]; }
        M2F[i] = acc;
    }
    __syncthreads();
    float* COS = (float*)(ws + WS_COS); float* SIN = (float*)(ws + WS_SIN);
    for (int i = gtid; i < 16384 * 64; i += NT) {
        const int t = i >> 6, j = i & 63; const float pos = (float)(j < 32 ? (t >> 6) : (t & 63));
        const float inv = 1.0f / powf(10000.0f, (float)(j & 31) / 32.0f); const float ang = pos * inv;
        COS[i] = cosf(ang); SIN[i] = sinf(ang);
    }
    bf16_t* A1P = (bf16_t*)(ws + WS_A1P);
    for (int i = gtid; i < 256 * 256; i += NT) { const int m = i >> 8, k = i & 255, pm = m >> 7, k1 = m & 127, pk = k >> 7, t1 = k & 127; const int r = (t1 * k1) & 127;
        float sn, cs; sincospif((float)r * (2.f / 128.f), &sn, &cs); const float v = (pm == pk) ? cs : (pm == 0 ? sn : -sn); A1P[i] = (bf16_t)(pk2(v, 0.f) & 0xffff); }
    bf16_t* A1S = (bf16_t*)(ws + WS_A1S);
    for (int i = gtid; i < 128 * 128; i += NT) { const int m = i >> 7, k = i & 127, pm = m >> 6, k1 = m & 63, pk = k >> 6, t1 = k & 63; const int r = (t1 * k1) & 63;
        float sn, cs; sincospif((float)r * (2.f / 64.f), &sn, &cs); const float v = (pm == pk) ? cs : (pm == 0 ? sn : -sn); A1S[i] = (bf16_t)(pk2(v, 0.f) & 0xffff); }
    bf16_t* A3P = (bf16_t*)(ws + WS_A3P);
    for (int i = gtid; i < 128 * 128 * 256; i += NT) { const int k1 = i >> 15, k2 = (i >> 8) & 127, kk = i & 255, part = kk >> 7, t2 = kk & 127; const int k = k1 + 128 * k2; const int r = (t2 * k) & 16383;
        float sn, cs; sincospif((float)r * (1.f / 8192.f), &sn, &cs); A3P[i] = (bf16_t)(pk2(part ? sn : cs, 0.f) & 0xffff); }
    bf16_t* A3S = (bf16_t*)(ws + WS_A3S);
    for (int i = gtid; i < 64 * 64 * 128; i += NT) { const int k1 = i >> 13, k2 = (i >> 7) & 63, kk = i & 127, part = kk >> 6, t2 = kk & 63; const int k = k1 + 64 * k2; const int r = (t2 * k) & 4095;
        float sn, cs; sincospif((float)r * (1.f / 2048.f), &sn, &cs); A3S[i] = (bf16_t)(pk2(part ? sn : cs, 0.f) & 0xffff); }
}

struct ValUp { const float* W; __device__ __forceinline__ const float* ptr(int k, int n) const { const int src = ((n >> 7) & 1) * DFF + (n >> 8) * 128 + (n & 127); return W + (size_t)k * NUP + src; }
    __device__ __forceinline__ float operator()(int k, int n) const { return *ptr(k, n); } };
struct ValDirect { const float* W; int ldw; __device__ __forceinline__ const float* ptr(int k, int n) const { return W + (size_t)k * ldw + n; }
    __device__ __forceinline__ float operator()(int k, int n) const { return W[(size_t)k * ldw + n]; } };
struct ValWin { const float* win; const float* poolw; const float* pscale; const float* m2f;
    __device__ __forceinline__ const float* ptr(int k, int n) const { return win + (size_t)k * WINW + n; }
    __device__ __forceinline__ float operator()(int k, int n) const {
        if (n >= 512 && n < 2048) return win[(size_t)k * WINW + n];
        if (n < 512) { const int g = n >> 7, e = n & 127; const float* wr = win + (size_t)k * WINW + g * 128; const float* pw = poolw + g * 16384 + e; float acc = 0.f;
            for (int c = 0; c < 128; ++c) acc += wr[c] * pw[c * 128]; return acc * pscale[n]; }
        const int n2 = n - 2048, g = n2 >> 8, np = n2 & 255; const float* wr = win + (size_t)k * WINW + 2048 + g * 128; const float* mf = m2f + g * 32768 + np; float acc = 0.f;
        for (int c = 0; c < 128; ++c) acc += wr[c] * mf[c * 256]; return acc; } };
template <class F> __device__ __forceinline__ void transpose_item(const F& val, int K, bf16_t* WT, int k0, int n0, LAS float* scr, int lane) {
    for (int i = 0; i < 32; ++i) { const int kk = 2 * i + (lane >> 5); scr[kk * 33 + (lane & 31)] = val(k0 + kk, n0 + (lane & 31)); }
    asm volatile("s_waitcnt lgkmcnt(0)" ::: "memory");
    const int c = lane & 7;
#pragma unroll
    for (int j = 0; j < 4; ++j) { const int n = (lane >> 3) + 8 * j; const LAS float* s = scr + (8 * c) * 33 + n;
        v4u o; o.x = pk2(s[0 * 33], s[1 * 33]); o.y = pk2(s[2 * 33], s[3 * 33]); o.z = pk2(s[4 * 33], s[5 * 33]); o.w = pk2(s[6 * 33], s[7 * 33]);
        *(v4u*)(WT + (size_t)(n0 + n) * K + k0 + 8 * c) = o; }
    asm volatile("s_waitcnt lgkmcnt(0)" ::: "memory");
}
template <class F> __device__ __forceinline__ void tr_load(const F& f, int k0, int n0, int lane, f4 (&v)[8]) {
#pragma unroll
    for (int i = 0; i < 8; ++i) v[i] = __builtin_nontemporal_load((const f4*)f.ptr(k0 + 8 * i + (lane >> 3), n0 + 4 * (lane & 7)));
}
__device__ __forceinline__ void tr_store(const f4 (&v)[8], int K, bf16_t* WT, int k0, int n0, LAS float* scr, int lane) {
#pragma unroll
    for (int i = 0; i < 8; ++i) { LAS float* d = scr + (8 * i + (lane >> 3)) * 33 + 4 * (lane & 7); d[0] = v[i].x; d[1] = v[i].y; d[2] = v[i].z; d[3] = v[i].w; }
    asm volatile("s_waitcnt lgkmcnt(0)" ::: "memory");
    const int c = lane & 7;
#pragma unroll
    for (int j = 0; j < 4; ++j) { const int n = (lane >> 3) + 8 * j; const LAS float* s = scr + (8 * c) * 33 + n;
        v4u o; o.x = pk2(s[0 * 33], s[1 * 33]); o.y = pk2(s[2 * 33], s[3 * 33]); o.z = pk2(s[4 * 33], s[5 * 33]); o.w = pk2(s[6 * 33], s[7 * 33]);
        *(v4u*)(WT + (size_t)(n0 + n) * K + k0 + 8 * c) = o; }
    asm volatile("s_waitcnt lgkmcnt(0)" ::: "memory");
}
template <class F> __device__ __forceinline__ void transpose_matrix(const F& val, int K, int N, bf16_t* WT, LAS float* scr, int gw, int NGW, int lane, int nlo, int nhi) {
    const int nblk = (nhi - nlo) / 32, nitems = (K / 64) * nblk;
    int it = gw; if (it >= nitems) return;
    f4 cur[8], nxt[8];
    tr_load(val, 64 * (it / nblk), nlo + 32 * (it % nblk), lane, cur);
    for (; it < nitems; it += NGW) {
        const int k0 = 64 * (it / nblk), n0 = nlo + 32 * (it % nblk); const int it2 = it + NGW; const bool more = it2 < nitems;
        if (more) tr_load(val, 64 * (it2 / nblk), nlo + 32 * (it2 % nblk), lane, nxt);
        tr_store(cur, K, WT, k0, n0, scr, lane);
        if (more) {
#pragma unroll
            for (int i = 0; i < 8; ++i) cur[i] = nxt[i]; }
    }
}

typedef float __attribute__((address_space(4))) cf32;
__device__ __forceinline__ void fold_items(const float* win, const float* poolw, const float* pscale, const float* m2f, bf16_t* WT, int gw, int NGW, int lane) {
    for (int it = gw; it < 32 * 24; it += NGW) {
        const int kb = it / 24, nb = it - kb * 24, k0 = 64 * kb;
        float m2[128]; int base, nout;
        if (nb < 8) { const int n = nb * 64 + lane, g = nb >> 1, e = n & 127; base = g * 128; nout = n; const float sc = pscale[n]; const float* pw = poolw + g * 16384 + e;
#pragma unroll
            for (int c = 0; c < 128; ++c) m2[c] = pw[c * 128] * sc;
        } else { const int n2 = (nb - 8) * 64 + lane, g = (nb - 8) >> 2, np = n2 & 255; base = 2048 + g * 128; nout = 2048 + n2; const float* mf = m2f + g * 32768 + np;
#pragma unroll
            for (int c = 0; c < 128; ++c) m2[c] = mf[c * 256];
        }
        bf16_t* wrow = WT + (size_t)nout * DM + k0;
        for (int kg = 0; kg < 8; ++kg) {
            float acc[8];
#pragma unroll
            for (int kk = 0; kk < 8; ++kk) { const cf32* wr = (const cf32*)(unsigned long long)(win + (size_t)(k0 + 8 * kg + kk) * WINW + base); float a = 0.f;
#pragma unroll
                for (int c = 0; c < 128; ++c) a += wr[c] * m2[c];
                acc[kk] = a; }
            v4u o; o.x = pk2(acc[0], acc[1]); o.y = pk2(acc[2], acc[3]); o.z = pk2(acc[4], acc[5]); o.w = pk2(acc[6], acc[7]);
            *(v4u*)(wrow + 8 * kg) = o;
        }
    }
}

__device__ __forceinline__ const float* xrow_ptr(const float* xa, const float* xb, int row) { return (row < NPROMPT) ? xa + (size_t)row * DM : xb + (size_t)(row - NPROMPT) * DM; }
template <bool XBF, bool OBF, int RR>
__device__ __forceinline__ void resid_rows(const float* xa, const float* xb, const bf16_t* xbf, const bf16_t* m, const float* g1, float* xout, bf16_t* xbout, bf16_t* xh, const float* g2, int gw, int NGW, int lane) {
    for (int row0 = gw; row0 < MTOK; row0 += RR * NGW) {
        f4 xf[XBF ? 1 : RR][8]; v2u xp[XBF ? RR : 1][8]; v2u mw[RR][8];
#pragma unroll
        for (int u = 0; u < RR; ++u) { const int row = row0 + u * NGW;
            if constexpr (XBF) { const bf16_t* xr = xbf + (size_t)row * DM;
#pragma unroll
                for (int j = 0; j < 8; ++j) xp[u][j] = *(const v2u*)(xr + 4 * lane + 256 * j);
            } else { const float* xr = xrow_ptr(xa, xb, row);
#pragma unroll
                for (int j = 0; j < 8; ++j) xf[u][j] = __builtin_nontemporal_load((const f4*)(xr + 4 * lane + 256 * j)); } }
        if (m) {
#pragma unroll
            for (int u = 0; u < RR; ++u) { const bf16_t* mr = m + (size_t)(row0 + u * NGW) * DM;
#pragma unroll
                for (int j = 0; j < 8; ++j) mw[u][j] = *(const v2u*)(mr + 4 * lane + 256 * j); }
        }
#pragma unroll
        for (int u = 0; u < RR; ++u) { const int row = row0 + u * NGW;
            f4 xv[8];
#pragma unroll
            for (int j = 0; j < 8; ++j) { if constexpr (XBF) { const v2u w = xp[u][j]; xv[j] = (f4){bflo(w.x), bfhi(w.x), bflo(w.y), bfhi(w.y)}; } else xv[j] = xf[u][j]; }
            if (m) { float ss = 0.f;
#pragma unroll
                for (int j = 0; j < 8; ++j) { const v2u w = mw[u][j]; const f4 mv = (f4){bflo(w.x), bfhi(w.x), bflo(w.y), bfhi(w.y)}; ss += (mv.x * mv.x + mv.y * mv.y) + (mv.z * mv.z + mv.w * mv.w); }
                const float r = 1.0f / sqrtf(wave_sum(ss) * (1.f / DM) + EPS);
#pragma unroll
                for (int j = 0; j < 8; ++j) { const v2u w = mw[u][j]; const f4 mv = (f4){bflo(w.x), bfhi(w.x), bflo(w.y), bfhi(w.y)}; const f4 gv = *(const f4*)(g1 + 4 * lane + 256 * j); xv[j] += mv * r * gv; } }
            if constexpr (OBF) { if (xbout) {
#pragma unroll
                for (int j = 0; j < 8; ++j) { v2u w; w.x = pk2(xv[j].x, xv[j].y); w.y = pk2(xv[j].z, xv[j].w); *(v2u*)(xbout + (size_t)row * DM + 4 * lane + 256 * j) = w; } }
            } else { if (xout) {
#pragma unroll
                for (int j = 0; j < 8; ++j) __builtin_nontemporal_store(xv[j], (f4*)(xout + (size_t)row * DM + 4 * lane + 256 * j)); } }
            if (xh) { float ss = 0.f;
#pragma unroll
                for (int j = 0; j < 8; ++j) ss += (xv[j].x * xv[j].x + xv[j].y * xv[j].y) + (xv[j].z * xv[j].z + xv[j].w * xv[j].w);
                const float r = 1.0f / sqrtf(wave_sum(ss) * (1.f / DM) + EPS);
#pragma unroll
                for (int j = 0; j < 8; ++j) { const f4 gv = *(const f4*)(g2 + 4 * lane + 256 * j); const f4 y = xv[j] * r * gv;
                    v2u w; w.x = pk2(y.x, y.y); w.y = pk2(y.z, y.w); *(v2u*)(xh + (size_t)row * DM + 4 * lane + 256 * j) = w; } }
        }
    }
}

__device__ __forceinline__ void rope_pass(bf16_t* Z, const float* qn, const float* kn, const float* COS, const float* SIN, int gtid, int NT) {
    const int hw = gtid >> 5, NHW = NT >> 5, j = gtid & 31;
    const float qa0 = qn[2 * j], qa1 = qn[2 * j + 1], qb0 = qn[64 + 2 * j], qb1 = qn[65 + 2 * j];
    const float ka0 = kn[2 * j], ka1 = kn[2 * j + 1], kb0 = kn[64 + 2 * j], kb1 = kn[65 + 2 * j];
    for (int row = hw; row < MTOK; row += NHW) {
        const int t = row < NPROMPT ? (row & 16383) : (row & 4095);
        bf16_t* p = Z + (size_t)row * DM + 512 + 2 * j;
        unsigned a[10], b[10];
#pragma unroll
        for (int hh = 0; hh < 10; ++hh) { a[hh] = *(const unsigned*)(p + hh * 128); b[hh] = *(const unsigned*)(p + hh * 128 + 64); }
        const float c0 = COS[t * 64 + 2 * j], c1 = COS[t * 64 + 2 * j + 1], s0 = SIN[t * 64 + 2 * j], s1 = SIN[t * 64 + 2 * j + 1];
#pragma unroll
        for (int hh = 0; hh < 10; ++hh) {
            float x0 = bflo(a[hh]), x1 = bfhi(a[hh]), y0 = bflo(b[hh]), y1 = bfhi(b[hh]);
            float ss = (x0 * x0 + x1 * x1) + (y0 * y0 + y1 * y1);
#pragma unroll
            for (int o = 1; o < 32; o <<= 1) ss += __shfl_xor(ss, o);
            const float r = 1.0f / sqrtf(ss * (1.f / 128.f) + EPS);
            x0 *= r * (hh < 8 ? qa0 : ka0); x1 *= r * (hh < 8 ? qa1 : ka1); y0 *= r * (hh < 8 ? qb0 : kb0); y1 *= r * (hh < 8 ? qb1 : kb1);
            const float ox0 = x0 * c0 - y0 * s0, oy0 = y0 * c0 + x0 * s0, ox1 = x1 * c1 - y1 * s1, oy1 = y1 * c1 + x1 * s1;
            *(unsigned*)(p + hh * 128) = pk2(ox0, ox1); *(unsigned*)(p + hh * 128 + 64) = pk2(oy0, oy1);
        }
    }
}

__device__ __forceinline__ void pool_pass(const bf16_t* Z, bf16_t* H, int gtid, int NT) {
    for (int it = gtid; it < MTOK * 64; it += NT) {
        const int row = it >> 6, ch = it & 63, c0 = ch * 8, g = ch >> 4, w = 2 << g;
        int t, L; if (row < NPROMPT) { t = row & 16383; L = 16384; } else { t = row & 4095; L = 4096; }
        const int rb = row - t; int lo = t - (w >> 1); if (lo < 0) lo = 0; int hi = t + w - 1 - (w >> 1); if (hi > L - 1) hi = L - 1;
        float s[8] = {0.f, 0.f, 0.f, 0.f, 0.f, 0.f, 0.f, 0.f};
        for (int tt = lo; tt <= hi; ++tt) { const v4u v = *(const v4u*)(Z + (size_t)(rb + tt) * DM + c0);
            s[0] += bflo(v.x); s[1] += bfhi(v.x); s[2] += bflo(v.y); s[3] += bfhi(v.y); s[4] += bflo(v.z); s[5] += bfhi(v.z); s[6] += bflo(v.w); s[7] += bfhi(v.w); }
        const float ic = 1.0f / (float)(hi - lo + 1);
        const v4u v = *(const v4u*)(Z + (size_t)row * DM + c0);
        v4u o; o.x = pk2(s[0] * ic - bflo(v.x), s[1] * ic - bfhi(v.x)); o.y = pk2(s[2] * ic - bflo(v.y), s[3] * ic - bfhi(v.y));
        o.z = pk2(s[4] * ic - bflo(v.z), s[5] * ic - bfhi(v.z)); o.w = pk2(s[6] * ic - bflo(v.w), s[7] * ic - bfhi(v.w));
        *(v4u*)(H + (size_t)row * DM + c0) = o;
    }
}

__device__ __forceinline__ float gelu_tanh(float x) { const float y = 0.7978845608028654f * (x + 0.044715f * x * x * x); return x * __builtin_amdgcn_rcpf(1.0f + __expf(-2.0f * y)); }
__device__ __forceinline__ void ld8f(const bf16_t* p, float* o) { const v4u v = *(const v4u*)p; o[0] = bflo(v.x); o[1] = bfhi(v.x); o[2] = bflo(v.y); o[3] = bfhi(v.y); o[4] = bflo(v.z); o[5] = bfhi(v.z); o[6] = bflo(v.w); o[7] = bfhi(v.w); }
__device__ __forceinline__ float dpp_ror1(float v) { return __int_as_float(__builtin_amdgcn_update_dpp(0, __float_as_int(v), 0x121, 0xf, 0xf, false)); }
__device__ __forceinline__ float dpp_ror15(float v) { return __int_as_float(__builtin_amdgcn_update_dpp(0, __float_as_int(v), 0x12F, 0xf, 0xf, false)); }
struct EpiGlu {
    static constexpr bool PERM = true, AFTER_DRAIN = false;
    bf16_t* ACT; bf16_t* HB; const float* cw; const float* cb;
    __device__ __forceinline__ void operator()(const pg8::f32x4 (&acc)[2][2][4][2], const pg8::Unit& u, int wr, int wc, int fr, int fq) const {
        const int jc = u.pn * 128 + wc * 32 + 8 * fq;
        const bool first = (fr == 0), last = (fr == 15);
        v2u stash[2][4];
#pragma unroll
        for (int n = 0; n < 2; ++n) {
            const f4 w0g = *(const f4*)(cw + jc + 4 * n), w1g = *(const f4*)(cw + NUP + jc + 4 * n), w2g = *(const f4*)(cw + 2 * NUP + jc + 4 * n), bg = *(const f4*)(cb + jc + 4 * n);
            const f4 w0v = *(const f4*)(cw + DFF + jc + 4 * n), w1v = *(const f4*)(cw + NUP + DFF + jc + 4 * n), w2v = *(const f4*)(cw + 2 * NUP + DFF + jc + 4 * n), bv = *(const f4*)(cb + DFF + jc + 4 * n);
#pragma unroll
            for (int ai = 0; ai < 2; ++ai) {
                float g1p[4], v1p[4], g15c[4], v15c[4];
#pragma unroll
                for (int i = 0; i < 4; ++i) { g1p[i] = 0.f; v1p[i] = 0.f; g15c[i] = dpp_ror15(acc[ai][0][0][n][i]); v15c[i] = dpp_ror15(acc[ai][1][0][n][i]); }
#pragma unroll
                for (int m = 0; m < 4; ++m) {
                    const int mn = m < 3 ? m + 1 : 3;
                    float o[4];
#pragma unroll
                    for (int i = 0; i < 4; ++i) {
                        const float g = acc[ai][0][m][n][i], v = acc[ai][1][m][n][i];
                        const float g1c = dpp_ror1(g), v1c = dpp_ror1(v), g15n = dpp_ror15(acc[ai][0][mn][n][i]), v15n = dpp_ror15(acc[ai][1][mn][n][i]);
                        const float gp = first ? g1p[i] : g1c, gn = last ? g15n : g15c[i], vp = first ? v1p[i] : v1c, vn = last ? v15n : v15c[i];
                        g1p[i] = g1c; v1p[i] = v1c; g15c[i] = g15n; v15c[i] = v15n;
                        const float a = gp * w0g[i] + g * w1g[i] + gn * w2g[i] + bg[i];
                        const float b = vp * w0v[i] + v * w1v[i] + vn * w2v[i] + bv[i];
                        const float e = __builtin_amdgcn_exp2f(a * (-2.3022082f + -0.10294324f * (a * a)));
                        o[i] = a * __builtin_amdgcn_rcpf(1.0f + e) * b;
                    }
                    const int row = u.pm * pg8::BM + ai * pg8::HALF + wr * 64 + m * 16 + fr;
                    v2u w; w.x = pk2(o[0], o[1]); w.y = pk2(o[2], o[3]);
                    if (n == 0) stash[ai][m] = w;
                    else { v4u ww; ww.x = stash[ai][m].x; ww.y = stash[ai][m].y; ww.z = w.x; ww.w = w.y; *(v4u*)(ACT + (size_t)row * DFF + jc) = ww; }
                }
            }
        }
#pragma unroll
        for (int ai = 0; ai < 2; ++ai) {
            const int grp = u.pm * 4 + ai * 2 + wr;
            if (fr < 2 || fr >= 14) {
                const int m = fr < 2 ? 0 : 3, slot = fr < 2 ? fr : fr - 12;
                bf16_t* hp = HB + ((size_t)grp * 4 + slot) * NUP + u.pn * 256 + wc * 32 + 8 * fq;
#pragma unroll
                for (int bj = 0; bj < 2; ++bj) {
                    const pg8::f32x4 v0 = fr < 2 ? acc[ai][bj][0][0] : acc[ai][bj][3][0], v1 = fr < 2 ? acc[ai][bj][0][1] : acc[ai][bj][3][1];
                    v4u w; w.x = pk2(v0[0], v0[1]); w.y = pk2(v0[2], v0[3]); w.z = pk2(v1[0], v1[1]); w.w = pk2(v1[2], v1[3]);
                    *(v4u*)(hp + bj * 128) = w;
                }
                (void)m;
            }
        }
    }
};
__device__ __forceinline__ void glu_fix(const bf16_t* HB, bf16_t* ACT, const float* cw, const float* cb, int gtid, int NT) {
    constexpr int NCC = DFF / 8, NG = CHUNK / 64;
    for (int it = gtid; it < NG * 2 * NCC; it += NT) {
        const int cc = it % NCC, rest = it / NCC, which = rest & 1, g = rest >> 1, j0 = cc * 8, colp = (j0 >> 7) * 256 + (j0 & 127);
        const int row = g * 64 + (which ? 63 : 0); const int Lc = row < NPROMPT ? 16384 : 4096;
        const bf16_t *P, *C, *N;
        if (!which) { C = HB + ((size_t)g * 4 + 0) * NUP; N = HB + ((size_t)g * 4 + 1) * NUP; P = ((row & (Lc - 1)) == 0) ? nullptr : HB + ((size_t)(g - 1) * 4 + 3) * NUP; }
        else { P = HB + ((size_t)g * 4 + 2) * NUP; C = HB + ((size_t)g * 4 + 3) * NUP; N = (((row + 1) & (Lc - 1)) == 0) ? nullptr : HB + ((size_t)(g + 1) * 4 + 0) * NUP; }
        float pg[8], pv[8], cg_[8], cv[8], ng[8], nv[8];
        if (P) { ld8f(P + colp, pg); ld8f(P + colp + 128, pv); } else {
#pragma unroll
            for (int i = 0; i < 8; ++i) { pg[i] = 0.f; pv[i] = 0.f; } }
        if (N) { ld8f(N + colp, ng); ld8f(N + colp + 128, nv); } else {
#pragma unroll
            for (int i = 0; i < 8; ++i) { ng[i] = 0.f; nv[i] = 0.f; } }
        ld8f(C + colp, cg_); ld8f(C + colp + 128, cv);
        float o[8];
#pragma unroll
        for (int h = 0; h < 2; ++h) {
            const f4 w0g = *(const f4*)(cw + j0 + 4 * h), w1g = *(const f4*)(cw + NUP + j0 + 4 * h), w2g = *(const f4*)(cw + 2 * NUP + j0 + 4 * h), bg = *(const f4*)(cb + j0 + 4 * h);
            const f4 w0v = *(const f4*)(cw + DFF + j0 + 4 * h), w1v = *(const f4*)(cw + NUP + DFF + j0 + 4 * h), w2v = *(const f4*)(cw + 2 * NUP + DFF + j0 + 4 * h), bv = *(const f4*)(cb + DFF + j0 + 4 * h);
#pragma unroll
            for (int q = 0; q < 4; ++q) { const int i = 4 * h + q;
                const float a = pg[i] * w0g[q] + cg_[i] * w1g[q] + ng[i] * w2g[q] + bg[q];
                const float b = pv[i] * w0v[q] + cv[i] * w1v[q] + nv[i] * w2v[q] + bv[q];
                o[i] = gelu_tanh(a) * b; } }
        v4u w; w.x = pk2(o[0], o[1]); w.y = pk2(o[2], o[3]); w.z = pk2(o[4], o[5]); w.w = pk2(o[6], o[7]);
        *(v4u*)(ACT + (size_t)row * DFF + j0) = w;
    }
}

struct BRow1 { const att::bf16* base; size_t ldb; __device__ __forceinline__ const att::bf16* row(int kk) const { return base + (size_t)kk * ldb; } };
struct St1 { att::bf16* base; size_t ldb; __device__ __forceinline__ void operator()(int m, int c, float v) const { base[(size_t)m * ldb + c] = __float2bfloat16(v); } };
struct BRow3 { const att::bf16* base; int R, lgR, k1; __device__ __forceinline__ const att::bf16* row(int kk) const { const int part = kk >> lgR, t2 = kk & (R - 1); return base + (size_t)(((part << lgR) + k1) * R + t2) * 512; } };
struct St3 { att::bf16* base; int R; float scale; __device__ __forceinline__ void operator()(int m, int c, float v) const { base[(size_t)(m * R) * DM + c] = __float2bfloat16(v * scale); } };

__device__ __forceinline__ void dft_stage1(const bf16_t* Gp, bf16_t* Yp, const unsigned char* ws, char* lds, int vcu, int G) {
    for (int it = 0;; ++it) { const int uid = it * G + vcu; if (uid >= 3072) break;
        if (uid < 1024) { const int s = uid >> 9, nt = uid & 511; const size_t off = (size_t)s * (2u * 16384u * 512u) + (size_t)nt * 128;
            BRow1 br{(const att::bf16*)Gp + off, 65536}; St1 st{(att::bf16*)Yp + off, 65536};
            att::dft_unit<8, 4>((const att::bf16*)(ws + WS_A1P), 256, br, st, lds);
        } else { const int u2 = uid - 1024, s = u2 >> 8, nt = u2 & 255; const size_t off = (size_t)NPROMPT * 1024 + (size_t)s * (2u * 4096u * 512u) + (size_t)nt * 128;
            BRow1 br{(const att::bf16*)Gp + off, 32768}; St1 st{(att::bf16*)Yp + off, 32768};
            att::dft_unit<4, 2>((const att::bf16*)(ws + WS_A1S), 128, br, st, lds);
        }
    }
}
__device__ __forceinline__ void dft_stage3(const bf16_t* Yp, bf16_t* H, const unsigned char* ws, char* lds, int vcu, int G) {
    for (int it = 0;; ++it) { const int uid = it * G + vcu; if (uid >= 3072) break;
        if (uid < 1024) { const int s = uid >> 9, k1 = (uid >> 2) & 127, nt = uid & 3;
            BRow3 br{(const att::bf16*)Yp + (size_t)s * (2u * 16384u * 512u) + nt * 128, 128, 7, k1};
            St3 st{(att::bf16*)H + (size_t)(s * 16384 + k1) * DM + 1536 + nt * 128, 128, 1.0f / sqrtf(16384.f * 128.f)};
            att::dft_unit<4, 4>((const att::bf16*)(ws + WS_A3P) + (size_t)k1 * (128 * 256), 256, br, st, lds);
        } else { const int u2 = uid - 1024, s = u2 >> 8, k1 = (u2 >> 2) & 63, nt = u2 & 3;
            BRow3 br{(const att::bf16*)Yp + (size_t)NPROMPT * 1024 + (size_t)s * (2u * 4096u * 512u) + nt * 128, 64, 6, k1};
            St3 st{(att::bf16*)H + (size_t)(NPROMPT + s * 4096 + k1) * DM + 1536 + nt * 128, 64, 1.0f / sqrtf(4096.f * 128.f)};
            att::dft_unit<2, 2>((const att::bf16*)(ws + WS_A3S) + (size_t)k1 * (64 * 128), 128, br, st, lds);
        }
    }
}

__device__ __forceinline__ void attn_phase(const bf16_t* Z, bf16_t* H, const float* qn, const float* kn, char* lds, int vcu, int G) {
    float mq = 0.f, mk = 0.f;
    for (int i = 0; i < 128; ++i) { mq = fmaxf(mq, fabsf(qn[i])); mk = fmaxf(mk, fabsf(kn[i])); }
    const float bound = 128.f * mq * mk * 1.02f;
    for (int it = 0;; ++it) { const int uid = it * G + vcu; if (uid >= 2048) break;
        int rowbase, h, qb, seq;
        if (uid < 1024) { const int s = uid >> 9; h = (uid >> 6) & 7; qb = uid & 63; rowbase = s * 16384; seq = 16384; }
        else { const int u2 = uid - 1024, s = u2 >> 7; h = (u2 >> 4) & 7; qb = u2 & 15; rowbase = NPROMPT + s * 4096; seq = 4096; }
        const att::bf16* Q = (const att::bf16*)Z + (size_t)(rowbase + qb * 256) * DM + 512 + h * 128;
        const att::bf16* K = (const att::bf16*)Z + (size_t)rowbase * DM + 1536 + (h >> 2) * 128;
        att::bf16* O = (att::bf16*)H + (size_t)(rowbase + qb * 256) * DM + 512 + h * 128;
        att::attn_dense_body<att::bf16>(Q, K, K + 256, O, seq, lds, bound);
        __syncthreads();
    }
}

struct Params { const float* in[17]; float* out; unsigned char* ws; int ph_lo, ph_hi; };
constexpr int NPL = 9;
constexpr int NPHASE = 2 + 2 * NPL;

__global__ void __launch_bounds__(512, 2) mega_fwd(Params p) {
    extern __shared__ __attribute__((aligned(16))) unsigned char lds[];
    cg::grid_group grid = cg::this_grid();
    const int G = gridDim.x, bx = blockIdx.x;
    const int vcu = (G % 8 == 0) ? (bx % 8) * (G / 8) + bx / 8 : bx;
    const int NGW = G * 8, NT = G * 512;
    unsigned char* ws = p.ws;
    const float *x_prompt = p.in[0], *x_sample = p.in[1], *g_pre_mix = p.in[2], *g_post_mix = p.in[3], *w_in = p.in[4], *pool_w = p.in[5], *pool_scale = p.in[6],
                *q_norm = p.in[7], *k_norm = p.in[8], *fourier_w = p.in[9], *w_out = p.in[10], *g_pre_ffn = p.in[11], *g_post_ffn = p.in[12], *w_up = p.in[13],
                *conv_w = p.in[14], *conv_b = p.in[15], *w_down = p.in[16];
    bf16_t* XH = (bf16_t*)(ws + WS_XH); bf16_t* Z = (bf16_t*)(ws + WS_Z); bf16_t* Gp = (bf16_t*)(ws + WS_G); bf16_t* Yp = (bf16_t*)(ws + WS_Y);
    bf16_t* HB = (bf16_t*)(ws + WS_HB); bf16_t* ACT = (bf16_t*)(ws + WS_ACT); bf16_t* XB = (bf16_t*)(ws + WS_XB);
    LAS unsigned char* ring = (LAS unsigned char*)lds;
    volatile LAS unsigned* bst = (volatile LAS unsigned*)(ring + 131072 + 64);
    if (threadIdx.x < 2) bst[threadIdx.x] = 0u;
    __syncthreads();
    XcdBarrier xbar = xcd_barrier_post((unsigned*)(ws + WS_BAR), bst);

    for (int ph = p.ph_lo; ph < p.ph_hi; ++ph) {
        const int tid = ltid(), lane = tid & 63, wave = __builtin_amdgcn_readfirstlane(tid >> 6);
        const int gw = vcu * 8 + wave, gtid = bx * 512 + tid;
        if (ph == 0) {
#if !defined(ONLY) || ONLY==0
            for (int rep = 0; rep < REP_P0; ++rep) p0a_tables(fourier_w, ws, (LAS float*)ring, gtid, NT);
#endif
        } else if (ph == 1) {
#if !defined(ONLY) || ONLY==1
            LAS float* scr = (LAS float*)(ring + wave * 16384);
            for (int l = 0; l < 2 * REP_P0; ++l) {
                bf16_t* Wl = (bf16_t*)(ws + WS_W + (l & 1) * W_LAYER);
                ValWin vw{w_in + (size_t)(l & 1) * DM * WINW, pool_w + (size_t)(l & 1) * 4 * 16384, pool_scale + (l & 1) * 512, (const float*)(ws + WS_M2F) + (size_t)(l & 1) * 4 * 32768};
                transpose_matrix(vw, DM, NIN, Wl, scr, gw, NGW, lane, 512, 2048);
                fold_items(vw.win, vw.poolw, vw.pscale, vw.m2f, Wl, gw, NGW, lane);
                ValDirect vo{w_out + (size_t)(l & 1) * DM * DM, DM};
                transpose_matrix(vo, DM, DM, (bf16_t*)((unsigned char*)Wl + W_OUT_OFF), scr, gw, NGW, lane, 0, DM);
                ValUp vu{w_up + (size_t)(l & 1) * DM * NUP};
                transpose_matrix(vu, DM, NUP, (bf16_t*)((unsigned char*)Wl + W_UP_OFF), scr, gw, NGW, lane, 0, NUP);
                ValDirect vd{w_down + (size_t)(l & 1) * DFF * DM, DM};
                transpose_matrix(vd, DFF, DM, (bf16_t*)((unsigned char*)Wl + W_DOWN_OFF), scr, gw, NGW, lane, 0, DM);
            }
            for (int rep = 0; rep < REP_P0; ++rep) resid_rows<false, false, 2>(x_prompt, x_sample, nullptr, nullptr, nullptr, nullptr, nullptr, XH, g_pre_mix, gw, NGW, lane);
#endif
        } else {
            const int l = (ph - 2) / NPL, q = (ph - 2) % NPL;
            const bf16_t* Wl = (const bf16_t*)(ws + WS_W + l * W_LAYER);
            if (q == 0) {
#if !defined(ONLY) || ONLY==2
                pg8::Gemm g{XH, Wl, MTOK, NIN, DM}; pg8::StaticOrder S; S.init(MTOK, NIN, G, bx);
                EpiWin E{Z, Gp};
                for (int rep = 0; rep < REP_WIN; ++rep) pg8::gemm_phase<EpiWin, pg8::StaticOrder, PG8_ALIGN, PG8_SP2>(ring, g, S, E);
#endif
            } else if (q == 1) {
#if !defined(ONLY) || ONLY==3
                rope_pass(Z, q_norm + l * 128, k_norm + l * 128, (const float*)(ws + WS_COS), (const float*)(ws + WS_SIN), gtid, NT);
                for (int rep = 0; rep < REP_LIGHT; ++rep) { pool_pass(Z, XH, gtid, NT);
                dft_stage1(Gp, Yp, ws, (char*)lds, vcu, G); }
#endif
            } else if (q == 2) {
#if !defined(ONLY) || ONLY==4
                for (int rep = 0; rep < REP_ATTN; ++rep) attn_phase(Z, XH, q_norm + l * 128, k_norm + l * 128, (char*)lds, vcu, G);
#endif
#if !defined(ONLY) || ONLY==5
                for (int rep = 0; rep < REP_LIGHT; ++rep) dft_stage3(Yp, XH, ws, (char*)lds, vcu, G);
#endif
            } else if (q == 4) {
#if !defined(ONLY) || ONLY==6
                if (l == 0) resid_rows<false, true, 2>(x_prompt, x_sample, nullptr, Z, g_post_mix, nullptr, XB, XH, g_pre_ffn, gw, NGW, lane);
                else resid_rows<true, true, 4>(nullptr, nullptr, XB, Z, g_post_mix + DM, nullptr, XB, XH, g_pre_ffn + DM, gw, NGW, lane);
#endif
            } else if (q == 8) {
#if !defined(ONLY) || ONLY==6
                if (l == 0) resid_rows<true, true, 4>(nullptr, nullptr, XB, XH, g_post_ffn, nullptr, XB, XH, g_pre_mix + DM, gw, NGW, lane);
                else resid_rows<true, false, 4>(nullptr, nullptr, XB, XH, g_post_ffn + DM, p.out, nullptr, nullptr, nullptr, gw, NGW, lane);
#endif
            } else {
                const int c = 0, step = (q >= 5) ? (q - 5) : -1;
                const float* cwl = conv_w + (size_t)l * 3 * NUP; const float* cbl = conv_b + (size_t)l * NUP;
                if (step == 1) {
#if !defined(ONLY) || ONLY==7
                    for (int rep = 0; rep < REP_LIGHT; ++rep) glu_fix(HB, ACT, cwl, cbl, gtid, NT);
#endif
                } else if (step == 0) {
#if !defined(ONLY) || ONLY==9
                    pg8::Gemm g{XH + (size_t)c * CHUNK * DM, (const bf16_t*)((const unsigned char*)Wl + W_UP_OFF), CHUNK, NUP, DM};
                    pg8::StaticOrder S; S.init(g.M, g.N, G, bx);
                    EpiGlu E{ACT, HB, cwl, cbl};
                    for (int rep = 0; rep < REP_UP; ++rep) pg8::gemm_phase<EpiGlu, pg8::StaticOrder, PG8_ALIGN, PG8_SP2>(ring, g, S, E);
#endif
                } else {
#if !defined(ONLY) || ONLY==8
                    pg8::Gemm g; bf16_t* O;
                    if (q == 3) { g = pg8::Gemm{XH, (const bf16_t*)((const unsigned char*)Wl + W_OUT_OFF), MTOK, DM, DM}; O = Z; }
                    else { g = pg8::Gemm{ACT, (const bf16_t*)((const unsigned char*)Wl + W_DOWN_OFF), CHUNK, DM, DFF}; O = XH + (size_t)c * CHUNK * DM; }
                    pg8::StaticOrder S; S.init(g.M, g.N, G, bx);
                    pg8::EpiBf16<0> E{O, DM, nullptr, 0, 0, 1.f};
                    for (int rep = 0; rep < REP_PLAIN; ++rep) pg8::gemm_phase<pg8::EpiBf16<0>, pg8::StaticOrder, PG8_ALIGN, PG8_SP2>(ring, g, S, E);
#endif
                }
            }
        }
        if (ph + 1 < p.ph_hi) { for (int rep = 0; rep < REP_SYNC; ++rep) { if (MK_MULTI == 0 && ph != 0) xcd_barrier(xbar); else grid.sync(); } }
    }
}

extern "C" void kernel_launch(void* const* d_in, const int* in_sizes, int n_in, void* d_out, int out_size, void* d_ws, size_t ws_size, hipStream_t stream) {
    static int grid = 0;
    if (grid == 0) {
        if (n_in != 17 || out_size != MTOK * DM || ws_size < WS_END) { fprintf(stderr, "kernel_launch: unexpected shapes: n_in %d out %d ws %zu (need %zu)\n", n_in, out_size, ws_size, (size_t)WS_END); grid = -1; return; }
        int dev = 0, cus = 0, per_cu = 0;
        if (hipGetDevice(&dev) != hipSuccess || hipDeviceGetAttribute(&cus, hipDeviceAttributeMultiprocessorCount, dev) != hipSuccess) { grid = -1; return; }
        if (hipFuncSetAttribute((const void*)mega_fwd, hipFuncAttributeMaxDynamicSharedMemorySize, LDS_BYTES) != hipSuccess) { fprintf(stderr, "kernel_launch: hipFuncSetAttribute failed\n"); grid = -1; return; }
        if (hipOccupancyMaxActiveBlocksPerMultiprocessor(&per_cu, (const void*)mega_fwd, 512, LDS_BYTES) != hipSuccess || per_cu < 1) { fprintf(stderr, "kernel_launch: occupancy query says %d\n", per_cu); per_cu = 1; }
        (void)hipGetLastError();
        grid = cus * 1;
    }
    if (grid < 0) return;
    if (hipMemsetAsync((char*)d_ws + WS_BAR, 0, BAR_BYTES, stream) != hipSuccess) { fprintf(stderr, "kernel_launch: memset failed\n"); return; }
    Params p{};
    for (int i = 0; i < 17; ++i) p.in[i] = (const float*)d_in[i];
    p.out = (float*)d_out; p.ws = (unsigned char*)d_ws;
#if MK_MULTI
    for (int ph = 0; ph < NPHASE; ++ph) { p.ph_lo = ph; p.ph_hi = ph + 1; hipLaunchKernelGGL(mega_fwd, dim3(grid), dim3(512), LDS_BYTES, stream, p); }
#else
    p.ph_lo = 0; p.ph_hi = NPHASE;
    void* args[] = {&p};
    hipError_t e = hipLaunchCooperativeKernel((const void*)mega_fwd, dim3(grid), dim3(512), args, LDS_BYTES, stream);
    if (e != hipSuccess) fprintf(stderr, "cooperative launch failed: %s (grid %d)\n", hipGetErrorString(e), grid);
#endif
}
```

```cpp
#include <hip/hip_runtime.h>
#include <hip/hip_bf16.h>
#include <hip/hip_cooperative_groups.h>
#include <cstdio>
#include <cstdint>
#ifndef MK_MULTI
#define MK_MULTI 0
#endif
__device__ __forceinline__ int ltid() { int t = threadIdx.x; asm volatile("" : "+v"(t)); return t; }
#ifndef REP_UP
#define REP_UP 1
#endif
#ifndef REP_ATTN
#define REP_ATTN 1
#endif
#ifndef REP_PLAIN
#define REP_PLAIN 1
#endif
#ifndef REP_WIN
#define REP_WIN 1
#endif
#ifndef REP_P0
#define REP_P0 1
#endif
#ifndef REP_LIGHT
#define REP_LIGHT 1
#endif
#ifndef REP_SYNC
#define REP_SYNC 1
#endif
#ifndef REP_ROPE
#define REP_ROPE 1
#endif
#ifndef REP_RES
#define REP_RES 1
#endif
namespace pg8 {
#define PG8_LAS __attribute__((address_space(3)))
typedef unsigned short bf16_t;
typedef short bf16x8 __attribute__((ext_vector_type(8)));
typedef float f32x4 __attribute__((ext_vector_type(4)));
typedef unsigned u32x4 __attribute__((ext_vector_type(4)));
constexpr int BM = 256, BK = 64, HALF = 128, HTB = HALF * BK * 2  , STAGE_BYTES = 8 * HTB, NXCD = 8, WGM = 8;

__host__ __device__ __forceinline__ int lds_byte(int r, int c) { const int st = (r >> 4) * 2 + (c >> 5), rr = r & 15, cc = c & 31, ob = rr * 64 + cc * 2; return st * 1024 + (ob ^ (((ob >> 9) & 1) << 5)); }
__host__ __device__ __forceinline__ void stage_rc(int b, int& R, int& C) { const int st = b / 1024, sb = b % 1024, swz = sb ^ (((sb >> 9) & 1) << 5); R = (st >> 1) * 16 + swz / 64; C = (st & 1) * 32 + (swz % 64) / 2; }
__host__ __device__ __forceinline__ int perm32(int rho) { const int n = rho >> 4, i = rho & 15; return 8 * (i >> 2) + 4 * n + (i & 3); }

struct Unit { int pm, pn; };
struct Gemm { const bf16_t* A; const bf16_t* Bt; int M, N, K; };

struct StaticOrder {
    int nM, nN, nwg, G, c;
    __host__ __device__ void init(int M, int N, int G_, int c_) { nM = M / BM; nN = N / BM; nwg = nM * nN; G = G_; c = c_; }
    __host__ __device__ bool next(int i, Unit& u) const {
        const long L = (long)i * G + c; if (L >= nwg) return false;
        int wgid = (int)L; { const int q = nwg / NXCD, r = nwg % NXCD, xcd = wgid % NXCD, off = wgid / NXCD; wgid = (xcd < r ? xcd * (q + 1) : r * (q + 1) + (xcd - r) * q) + off; }
        const int nig = WGM * nN, gid = wgid / nig, fm = gid * WGM, gsz = (nM - fm) < WGM ? (nM - fm) : WGM;
        u.pm = fm + ((wgid % nig) % gsz); u.pn = (wgid % nig) / gsz; return true;
    }
    __device__ __forceinline__ void a_ready(const Unit&) const {}
    __device__ __forceinline__ void done(const Unit&) const {}
};

__device__ __forceinline__ unsigned cvt_pk_bf16(float lo, float hi) { unsigned r; asm volatile("v_cvt_pk_bf16_f32 %0, %1, %2" : "=v"(r) : "v"(lo), "v"(hi)); return r; }
typedef float f32x2 __attribute__((ext_vector_type(2)));
__device__ __forceinline__ f32x2 gelu_pk(f32x2 v) {
    const f32x2 av = __builtin_elementwise_abs(v), d = av * 0.2316418882f + 1.0f;
    f32x2 t; t.x = __builtin_amdgcn_rcpf(d.x); t.y = __builtin_amdgcn_rcpf(d.y);
    f32x2 q = t * 0.5307027145f + (-0.7265760135f); q = q * t + 0.7107068705f; q = q * t + (-0.142248368f); q = q * t + 0.127414796f; q = q * t;
    const f32x2 s = (v * v) * (-0.72134752044f);
    f32x2 e; e.x = __builtin_amdgcn_exp2f(s.x); e.y = __builtin_amdgcn_exp2f(s.y);
    const f32x2 m = v * (q * e), r = v - m;
    f32x2 o; o.x = v.x < 0.f ? m.x : r.x; o.y = v.y < 0.f ? m.y : r.y; return o;
}

template <int ACT  > struct EpiBf16 {
    static constexpr bool PERM = true, AFTER_DRAIN = false; static_assert(ACT == 0 || ACT == 1, "EpiBf16: ACT is 0 (none) or 1 (gelu_pk)");
    bf16_t* O; int ldc; const float* bias; int split_cols; size_t split_stride; float scale0;
    __device__ __forceinline__ void operator()(const f32x4 (&acc)[2][2][4][2], const Unit& u, int wr, int wc, int fr, int fq) const {
        const int row0 = u.pm * BM + wr * 64 + fr; int colt = u.pn * BM; bf16_t* base = O;
        float sc = 1.f; if (split_cols) { const int t = colt / split_cols; base += (size_t)t * split_stride; colt -= t * split_cols; if (t == 0) sc = scale0; }
        const int col0 = colt + wc * 32 + 8 * fq, bcol0 = u.pn * BM + wc * 32 + 8 * fq;
        f32x4 bv[2][2];
#pragma unroll
        for (int bj = 0; bj < 2; ++bj)
#pragma unroll
            for (int n = 0; n < 2; ++n) bv[bj][n] = bias ? *(const f32x4*)(bias + bcol0 + bj * HALF + 4 * n) : (f32x4){0.f, 0.f, 0.f, 0.f};
#pragma unroll
        for (int ai = 0; ai < 2; ++ai)
#pragma unroll
            for (int m = 0; m < 4; ++m) { bf16_t* rowp = base + (size_t)(row0 + ai * HALF + m * 16) * ldc + col0;
#pragma unroll
                for (int bj = 0; bj < 2; ++bj) { f32x4 v0 = acc[ai][bj][m][0] + bv[bj][0], v1 = acc[ai][bj][m][1] + bv[bj][1];
                    if (ACT == 1) { f32x2 a = gelu_pk((f32x2){v0[0], v0[1]}), b = gelu_pk((f32x2){v0[2], v0[3]}), c = gelu_pk((f32x2){v1[0], v1[1]}), d = gelu_pk((f32x2){v1[2], v1[3]});
                        v0 = (f32x4){a.x, a.y, b.x, b.y}; v1 = (f32x4){c.x, c.y, d.x, d.y}; }
                    v0 = v0 * sc; v1 = v1 * sc; u32x4 w; w.x = cvt_pk_bf16(v0[0], v0[1]); w.y = cvt_pk_bf16(v0[2], v0[3]); w.z = cvt_pk_bf16(v1[0], v1[1]); w.w = cvt_pk_bf16(v1[2], v1[3]);
                    *(u32x4*)(rowp + bj * HALF) = w; } }
    }
};
template <class Epi, class Sched, bool ALIGN_EPI = false, bool SP2 = false>
__device__ __forceinline__ void gemm_phase(PG8_LAS unsigned char* lds, const Gemm g, const Sched& S, const Epi& E) {
    const int tid = ltid(), wid = __builtin_amdgcn_readfirstlane(tid >> 6), lane = tid & 63, wr = wid >> 2, wc = wid & 3, fr = lane & 15, fq = lane >> 4;
    const int K = g.K, nt = K / BK;
    unsigned voffA[2], voffB[2];
#pragma unroll
    for (int i = 0; i < 2; ++i) { int R, C; stage_rc(tid * 16 + i * 8192, R, C); const int Rb = Epi::PERM ? ((R & ~31) + perm32(R & 31)) : R;
        voffA[i] = (unsigned)(R * K + C) * 2u; voffB[i] = (unsigned)(Rb * K + C) * 2u; }
    const size_t kstep = (size_t)(BK * 2);
    const size_t hstep = (size_t)HALF * K * 2;
    const size_t tstep = 2 * hstep;
    const unsigned ldsw = (unsigned)wid * 1024u;
    const int aoff = lds_byte(wr * 64 + fr, fq * 8), boff = lds_byte(wc * 32 + fr, fq * 8);
#define PG8_SA(b, h) (((b) * 2 + (h)) * HTB)
#define PG8_SB(b, h) ((4 + (b) * 2 + (h)) * HTB)
#define PG8_STAGE(bufoff, gbase, voff) do { _Pragma("unroll") for (int _i = 0; _i < 2; ++_i) \
        __builtin_amdgcn_global_load_lds((const unsigned*)((const char*)(gbase) + (voff)[_i]), (PG8_LAS unsigned*)(lds + (bufoff) + ldsw + _i * 8192), 16, 0, 0); } while (0)
#define PG8_LDA(dst, b, h) do { _Pragma("unroll") for (int m = 0; m < 4; ++m) _Pragma("unroll") for (int k = 0; k < 2; ++k) dst[m][k] = *(const PG8_LAS bf16x8*)(lds + PG8_SA(b, h) + aoff + m * 2048 + k * 1024); } while (0)
#define PG8_LDB(dst, b, h) do { _Pragma("unroll") for (int n = 0; n < 2; ++n) _Pragma("unroll") for (int k = 0; k < 2; ++k) dst[n][k] = *(const PG8_LAS bf16x8*)(lds + PG8_SB(b, h) + boff + n * 2048 + k * 1024); } while (0)
#define PG8_MMA(ai, bj, At, Bt) do { __builtin_amdgcn_s_setprio(1); _Pragma("unroll") for (int m = 0; m < 4; ++m) _Pragma("unroll") for (int n = 0; n < 2; ++n) _Pragma("unroll") for (int k = 0; k < 2; ++k) \
        acc[ai][bj][m][n] = __builtin_amdgcn_mfma_f32_16x16x32_bf16(Bt[n][k], At[m][k], acc[ai][bj][m][n], 0, 0, 0); __builtin_amdgcn_s_setprio(0); } while (0)
#define PG8_WAIT_V(n) asm volatile("s_waitcnt vmcnt(" #n ")" ::: "memory")
#define PG8_WAIT_L(n) asm volatile("s_waitcnt lgkmcnt(" #n ")" ::: "memory")
#define PG8_BAR __builtin_amdgcn_s_barrier()
#define PG8_SCHED __builtin_amdgcn_sched_barrier(0)
    Unit cur, nxt; int ui = 0;
    if (!S.next(0, cur)) return;
    f32x4 acc[2][2][4][2];
#pragma unroll
    for (int a = 0; a < 2; ++a)
#pragma unroll
        for (int b = 0; b < 2; ++b)
#pragma unroll
            for (int m = 0; m < 4; ++m)
#pragma unroll
                for (int n = 0; n < 2; ++n) acc[a][b][m][n] = (f32x4){0.f, 0.f, 0.f, 0.f};
    bf16x8 At[4][2], B0[2][2], B1[2][2];
    const char* cA = (const char*)g.A + (size_t)cur.pm * tstep; const char* cB = (const char*)g.Bt + (size_t)cur.pn * tstep;
    S.a_ready(cur);
    if constexpr (SP2) {
        PG8_STAGE(PG8_SB(0, 0), cB, voffB); PG8_STAGE(PG8_SB(0, 1), cB + hstep, voffB); PG8_STAGE(PG8_SA(0, 0), cA, voffA); PG8_STAGE(PG8_SA(0, 1), cA + hstep, voffA);
        if (wr == 1) PG8_BAR;
        PG8_WAIT_V(2); PG8_BAR;
        PG8_STAGE(PG8_SB(1, 0), cB + kstep, voffB); PG8_STAGE(PG8_SA(1, 0), cA + kstep, voffA); PG8_STAGE(PG8_SB(1, 1), cB + hstep + kstep, voffB);
        PG8_WAIT_V(6); PG8_BAR;
    } else {
        PG8_STAGE(PG8_SB(0, 0), cB, voffB); PG8_STAGE(PG8_SA(0, 0), cA, voffA); PG8_STAGE(PG8_SB(0, 1), cB + hstep, voffB); PG8_STAGE(PG8_SA(0, 1), cA + hstep, voffA);
        if (wr == 1) PG8_BAR;
        PG8_WAIT_V(4); PG8_BAR;
        PG8_STAGE(PG8_SB(1, 0), cB + kstep, voffB); PG8_STAGE(PG8_SA(1, 0), cA + kstep, voffA); PG8_STAGE(PG8_SB(1, 1), cB + hstep + kstep, voffB);
        PG8_WAIT_V(6); PG8_BAR;
    }
    for (;;) {
        const bool has_next = S.next(ui + 1, nxt);
        const char* nA = has_next ? (const char*)g.A + (size_t)nxt.pm * tstep : cA; const char* nB = has_next ? (const char*)g.Bt + (size_t)nxt.pn * tstep : cB;
        for (int t = 0; t < nt; t += 2) {
            const bool last = (t == nt - 2);
            const char* a1 = cA + (size_t)(t + 1) * kstep;
            const char* a2 = last ? nA : cA + (size_t)(t + 2) * kstep; const char* b2 = last ? nB : cB + (size_t)(t + 2) * kstep;
            const char* a3 = a2 + kstep; const char* b3 = b2 + kstep;
            if (last && has_next) S.a_ready(nxt);
            if constexpr (SP2) {
            PG8_LDB(B0, 0, 0); PG8_LDB(B1, 0, 1); PG8_SCHED; PG8_LDA(At, 0, 0); PG8_STAGE(PG8_SA(1, 1), a1 + hstep, voffA);
            PG8_WAIT_V(8); PG8_WAIT_L(0); PG8_BAR; PG8_MMA(0, 0, At, B0); PG8_MMA(0, 1, At, B1); PG8_BAR; PG8_SCHED;
            PG8_LDA(At, 0, 1); PG8_STAGE(PG8_SB(0, 0), b2, voffB); PG8_STAGE(PG8_SB(0, 1), b2 + hstep, voffB); PG8_STAGE(PG8_SA(0, 0), a2, voffA);
            PG8_WAIT_V(8); PG8_WAIT_L(0); PG8_BAR; PG8_MMA(1, 0, At, B0); PG8_MMA(1, 1, At, B1); PG8_BAR; PG8_SCHED;
            PG8_LDB(B0, 1, 0); PG8_LDB(B1, 1, 1); PG8_SCHED; PG8_LDA(At, 1, 0); PG8_STAGE(PG8_SA(0, 1), a2 + hstep, voffA);
            PG8_WAIT_V(8); PG8_WAIT_L(0); PG8_BAR; PG8_MMA(0, 0, At, B0); PG8_MMA(0, 1, At, B1); PG8_BAR; PG8_SCHED;
            PG8_LDA(At, 1, 1); PG8_STAGE(PG8_SB(1, 0), b3, voffB); PG8_STAGE(PG8_SB(1, 1), b3 + hstep, voffB); PG8_STAGE(PG8_SA(1, 0), a3, voffA);
            PG8_WAIT_V(8); PG8_WAIT_L(0); PG8_BAR; PG8_MMA(1, 0, At, B0); PG8_MMA(1, 1, At, B1); PG8_BAR; PG8_SCHED;
            } else {
            PG8_LDB(B0, 0, 0); PG8_SCHED; PG8_LDA(At, 0, 0); PG8_STAGE(PG8_SA(1, 1), a1 + hstep, voffA);
            PG8_WAIT_L(8); PG8_BAR; PG8_WAIT_L(0); PG8_MMA(0, 0, At, B0); PG8_BAR; PG8_SCHED;
            PG8_LDB(B1, 0, 1); PG8_STAGE(PG8_SB(0, 0), b2, voffB);
            PG8_BAR; PG8_WAIT_L(0); PG8_MMA(0, 1, At, B1); PG8_BAR;
            PG8_LDA(At, 0, 1); PG8_STAGE(PG8_SA(0, 0), a2, voffA);
            PG8_BAR; PG8_WAIT_L(0); PG8_MMA(1, 0, At, B0); PG8_BAR; PG8_SCHED;
            PG8_STAGE(PG8_SB(0, 1), b2 + hstep, voffB);
            PG8_WAIT_V(6); PG8_BAR; PG8_MMA(1, 1, At, B1); PG8_BAR;
            PG8_LDB(B0, 1, 0); PG8_SCHED; PG8_LDA(At, 1, 0); PG8_STAGE(PG8_SA(0, 1), a2 + hstep, voffA);
            PG8_WAIT_L(8); PG8_BAR; PG8_WAIT_L(0); PG8_MMA(0, 0, At, B0); PG8_BAR; PG8_SCHED;
            PG8_LDB(B1, 1, 1); PG8_STAGE(PG8_SB(1, 0), b3, voffB);
            PG8_BAR; PG8_WAIT_L(0); PG8_MMA(0, 1, At, B1); PG8_BAR;
            PG8_LDA(At, 1, 1); PG8_STAGE(PG8_SA(1, 0), a3, voffA);
            PG8_BAR; PG8_WAIT_L(0); PG8_MMA(1, 0, At, B0); PG8_BAR; PG8_SCHED;
            PG8_STAGE(PG8_SB(1, 1), b3 + hstep, voffB);
            PG8_WAIT_V(6); PG8_BAR; PG8_MMA(1, 1, At, B1); PG8_BAR;
            }
        }
        if constexpr (ALIGN_EPI) { if (wr == 0) PG8_BAR; }
        if constexpr (!Epi::AFTER_DRAIN) { E(acc, cur, wr, wc, fr, fq); S.done(cur); }
        if (!has_next) break;
#pragma unroll
        for (int a = 0; a < 2; ++a)
#pragma unroll
            for (int b = 0; b < 2; ++b)
#pragma unroll
                for (int m = 0; m < 4; ++m)
#pragma unroll
                    for (int n = 0; n < 2; ++n) acc[a][b][m][n] = (f32x4){0.f, 0.f, 0.f, 0.f};
        cur = nxt; cA = nA; cB = nB; ++ui;
        if constexpr (ALIGN_EPI) { if (wr == 1) PG8_BAR; }
    }
    PG8_WAIT_V(0);
    if constexpr (!ALIGN_EPI) { if (wr == 0) PG8_BAR; }
    PG8_BAR;
    if constexpr (Epi::AFTER_DRAIN) { E.fused(acc, cur, wr, wc, fr, fq, lds, wid, lane); S.done(cur); }
#undef PG8_SA
#undef PG8_SB
#undef PG8_STAGE
#undef PG8_LDA
#undef PG8_LDB
#undef PG8_MMA
#undef PG8_WAIT_V
#undef PG8_WAIT_L
#undef PG8_BAR
#undef PG8_SCHED
}
}
#define PG8_SP2 true
#define PG8_ALIGN true
namespace att {
using bf16 = __hip_bfloat16;
constexpr int   D = 128, NW = 8, QBLK = 32, KVBLK = 64;
constexpr float SCALE = 0.088388347648318440f;
constexpr float THR = 8.f;
constexpr int SDEPTH = 2;
constexpr bool STATIC_MAX = true;
constexpr int LDQ = 2048, LDK = 2048, LDO = 2048;
constexpr size_t SHM_V = KVBLK * D * 2, SHM_K = KVBLK * D * 2, SHM_ATTN = 2 * SHM_V + 2 * SHM_K + NW * 64 * 4;
using bf16x8 = __attribute__((ext_vector_type(8))) short;
using s16x4  = __attribute__((ext_vector_type(4))) short;
using f32x16 = __attribute__((ext_vector_type(16))) float;
using f32x8  = __attribute__((ext_vector_type(8))) float;
using u32x4  = __attribute__((ext_vector_type(4))) unsigned;
#define KSWZ(row, colB) ((row) * 256 + ((colB) ^ (((row) & 7) << 4)))
#define SBAR() __builtin_amdgcn_sched_barrier(0)
__device__ __forceinline__ int crow(int r, int hi) { return (r & 3) + 8 * (r >> 2) + 4 * hi; }
__device__ __forceinline__ unsigned cvtpk(float lo, float hi) {
  unsigned r; asm volatile("v_cvt_pk_bf16_f32 %0, %1, %2" : "=v"(r) : "v"(lo), "v"(hi)); return r;
}
template <typename TIn> struct Stage;
template <> struct Stage<bf16>  { using T = bf16x8;
  __device__ static __forceinline__ T ld8(const bf16* p) { return *reinterpret_cast<const bf16x8*>(p); }
  __device__ static __forceinline__ bf16x8 tobf(T x) { return x; } };
template <> struct Stage<float> { using T = f32x8;
  __device__ static __forceinline__ T ld8(const float* p) { return *reinterpret_cast<const f32x8*>(p); }
  __device__ static __forceinline__ bf16x8 tobf(T x) {
    u32x4 w = {cvtpk(x[0], x[1]), cvtpk(x[2], x[3]), cvtpk(x[4], x[5]), cvtpk(x[6], x[7])}; return *reinterpret_cast<bf16x8*>(&w); } };

__device__ __forceinline__ void partialSM(f32x16& p0, f32x16& p1, float& m_reg, float& mn, float& alpha) {
  constexpr float C = SCALE * 1.4426950408889634f;
  if constexpr (STATIC_MAX) { mn = m_reg; alpha = 1.f; }
  else {
  float pmax = p0[0]; for (int r = 1; r < 16; ++r) pmax = fmaxf(pmax, p0[r]); for (int r = 0; r < 16; ++r) pmax = fmaxf(pmax, p1[r]);
  { auto rr = __builtin_amdgcn_permlane32_swap(__float_as_uint(pmax), __float_as_uint(pmax), false, false);
    pmax = fmaxf(__uint_as_float(rr[0]), __uint_as_float(rr[1])); }
  if (__builtin_expect(__all(pmax - m_reg <= THR / SCALE), 1)) { mn = m_reg; alpha = 1.f; }
  else { mn = fmaxf(m_reg, pmax); alpha = __builtin_amdgcn_exp2f((m_reg - mn) * C); m_reg = mn; }
  }
  float mnC = -mn * C;
  for (int r = 0; r < 16; ++r) p0[r] = fmaf(p0[r], C, mnC); for (int r = 0; r < 16; ++r) p1[r] = fmaf(p1[r], C, mnC);
  for (int r = 0; r < 16; ++r) p0[r] = __builtin_amdgcn_exp2f(p0[r]);
}
__device__ __forceinline__ void finishSM(f32x16& p0, f32x16& p1, float alpha, float& l_reg, bf16x8& pa0, bf16x8& pa1, bf16x8& pa2, bf16x8& pa3) {
  for (int r = 0; r < 16; ++r) p1[r] = __builtin_amdgcn_exp2f(p1[r]);
  float ps = 0; for (int r = 0; r < 16; ++r) ps += p0[r]; for (int r = 0; r < 16; ++r) ps += p1[r];
  { auto rr = __builtin_amdgcn_permlane32_swap(__float_as_uint(ps), __float_as_uint(ps), false, false);
    ps = __uint_as_float(rr[0]) + __uint_as_float(rr[1]); }
  l_reg = l_reg * alpha + ps;
#define PK4(P, BASE, OUT) do { unsigned a0 = cvtpk(P[BASE + 0], P[BASE + 1]), a1 = cvtpk(P[BASE + 2], P[BASE + 3]);   \
    unsigned b0 = cvtpk(P[BASE + 4], P[BASE + 5]), b1 = cvtpk(P[BASE + 6], P[BASE + 7]);                              \
    auto r0 = __builtin_amdgcn_permlane32_swap(a0, b0, false, false); auto r1 = __builtin_amdgcn_permlane32_swap(a1, b1, false, false); \
    u32x4 w = {r0[0], r1[0], r0[1], r1[1]}; OUT = *reinterpret_cast<bf16x8*>(&w); } while (0)
  PK4(p0, 0, pa0); PK4(p0, 8, pa1); PK4(p1, 0, pa2); PK4(p1, 8, pa3);
#undef PK4
}
__device__ __forceinline__ void qkt(f32x16& p0, f32x16& p1, const bf16* Ks, const bf16x8* qr, int r32, int hi) {
  p0 = f32x16{}; p1 = f32x16{};
  for (int d0 = 0; d0 < 8; ++d0) { int cb = (d0 * 16 + hi * 8) * 2;
    bf16x8 b0 = *reinterpret_cast<const bf16x8*>((const char*)Ks + KSWZ(r32, cb));
    bf16x8 b1 = *reinterpret_cast<const bf16x8*>((const char*)Ks + KSWZ(32 + r32, cb));
    p0 = __builtin_amdgcn_mfma_f32_32x32x16_bf16(b0, qr[d0], p0, 0, 0, 0);
    p1 = __builtin_amdgcn_mfma_f32_32x32x16_bf16(b1, qr[d0], p1, 0, 0, 0); }
}
__device__ __forceinline__ int v_st(int k, int c) { const int kk = (k & ~0xC) | ((k & 4) << 1) | ((k & 8) >> 1); return ((kk >> 3) * 4 + (c >> 5)) * 512 + ((kk & 7) * 32 + (c & 31)) * 2; }
__device__ __forceinline__ int v_rd_base(int lane) { return ((lane & 3) << 3) | (((lane >> 2) & 3) << 6) | (((lane >> 4) & 1) << 5) | (((lane >> 5) & 1) << 8); }
constexpr int v_rd_off(int d0, int ks, int half) { return d0 * 512 + ks * 4096 + half * 2048; }
template <int OFF> __device__ __forceinline__ s16x4 tr_read(int vb) {
  s16x4 r; asm volatile("ds_read_b64_tr_b16 %0, %1 offset:%2" : "=&v"(r) : "v"(vb), "i"(OFF) : "memory"); return r;
}
template <int D0> __device__ __forceinline__ void pv_one(f32x16& od, int vb, bf16x8 pa0, bf16x8 pa1, bf16x8 pa2, bf16x8 pa3) {
  const s16x4 l0 = tr_read<v_rd_off(D0, 0, 0)>(vb), h0 = tr_read<v_rd_off(D0, 0, 1)>(vb), l1 = tr_read<v_rd_off(D0, 1, 0)>(vb), h1 = tr_read<v_rd_off(D0, 1, 1)>(vb);
  const s16x4 l2 = tr_read<v_rd_off(D0, 2, 0)>(vb), h2 = tr_read<v_rd_off(D0, 2, 1)>(vb), l3 = tr_read<v_rd_off(D0, 3, 0)>(vb), h3 = tr_read<v_rd_off(D0, 3, 1)>(vb);
  asm volatile("s_waitcnt lgkmcnt(0)" ::: "memory"); SBAR();
#define PK(L, H) (bf16x8){L[0], L[1], L[2], L[3], H[0], H[1], H[2], H[3]}
  od = __builtin_amdgcn_mfma_f32_32x32x16_bf16(pa0, PK(l0, h0), od, 0, 0, 0);
  od = __builtin_amdgcn_mfma_f32_32x32x16_bf16(pa1, PK(l1, h1), od, 0, 0, 0);
  od = __builtin_amdgcn_mfma_f32_32x32x16_bf16(pa2, PK(l2, h2), od, 0, 0, 0);
  od = __builtin_amdgcn_mfma_f32_32x32x16_bf16(pa3, PK(l3, h3), od, 0, 0, 0);
#undef PK
}
__device__ __forceinline__ void pv_d0(f32x16* o, int vb, bf16x8 pa0, bf16x8 pa1, bf16x8 pa2, bf16x8 pa3) {
  pv_one<0>(o[0], vb, pa0, pa1, pa2, pa3); pv_one<1>(o[1], vb, pa0, pa1, pa2, pa3); pv_one<2>(o[2], vb, pa0, pa1, pa2, pa3); pv_one<3>(o[3], vb, pa0, pa1, pa2, pa3);
}
template <typename TQ>
__device__ __forceinline__ void attn_dense_body(const TQ* __restrict__ Qb, const bf16* __restrict__ Kh, const bf16* __restrict__ Vh,
                                                bf16* __restrict__ Ob, int seq, char* lds, float bound) {
  using St = Stage<bf16>; using SQ = Stage<TQ>;
  const int tid = ltid(), wid = tid >> 6, lane = tid & 63, r32 = lane & 31, hi = lane >> 5;
  bf16* V_lds = (bf16*)lds; bf16* K_lds = (bf16*)(lds + 2 * SHM_V);
  float* ws = (float*)(lds + 2 * SHM_V + 2 * SHM_K) + wid * 64; float* li_l = ws; float* al_l = ws + 32;
  float m_reg = STATIC_MAX ? bound : -1e30f, l_reg = 0; f32x16 o[4] = {}; bf16x8 qr[8];
  const TQ* Qw = Qb + (long)(wid * QBLK + r32) * LDQ + hi * 8;
#pragma unroll
  for (int d0 = 0; d0 < 8; ++d0) qr[d0] = SQ::tobf(SQ::ld8(Qw + d0 * 16));
  const int sr = tid >> 4, sc = (tid & 15) * 8, vst0 = v_st(sr, sc), vst1 = v_st(32 + sr, sc);
  const int vb0 = (int)(uintptr_t)V_lds + v_rd_base(lane);
  struct { typename St::T vs0, vs1, ks0, ks1; } sr_[SDEPTH];
#define SLOAD(i, k0) do { sr_[i].vs0 = St::ld8(&Vh[(long)((k0) + sr) * LDK + sc]); sr_[i].vs1 = St::ld8(&Vh[(long)((k0) + 32 + sr) * LDK + sc]); \
    sr_[i].ks0 = St::ld8(&Kh[(long)((k0) + sr) * LDK + sc]); sr_[i].ks1 = St::ld8(&Kh[(long)((k0) + 32 + sr) * LDK + sc]); } while (0)
#define SWRITE(b, i) do { *(bf16x8*)((char*)V_lds + (b) * SHM_V + vst0) = St::tobf(sr_[i].vs0);          \
    *(bf16x8*)((char*)V_lds + (b) * SHM_V + vst1) = St::tobf(sr_[i].vs1); int kc = sc * 2;               \
    *(bf16x8*)((char*)K_lds + (b) * SHM_K + KSWZ(sr, kc)) = St::tobf(sr_[i].ks0);                       \
    *(bf16x8*)((char*)K_lds + (b) * SHM_K + KSWZ(32 + sr, kc)) = St::tobf(sr_[i].ks1); } while (0)
#define SWAIT() do { if constexpr (SDEPTH == 2) asm volatile("s_waitcnt vmcnt(4)" ::: "memory"); else asm volatile("s_waitcnt vmcnt(0)" ::: "memory"); } while (0)
#define RESC(a) do { if (!STATIC_MAX && __any((a) < 1.f)) { if (hi == 0) al_l[r32] = (a); asm volatile("s_waitcnt lgkmcnt(0)" ::: "memory"); \
    for (int d = 0; d < 4; ++d) for (int r = 0; r < 16; ++r) o[d][r] *= al_l[crow(r, hi)]; } } while (0)
  f32x16 pA0, pA1, pB0, pB1; float mnA, mnB, alA, alB; bf16x8 pa0, pa1, pa2, pa3; const int NT = seq / KVBLK;
  constexpr int SE = 0, SO = SDEPTH - 1;
  SLOAD(SE, 0); asm volatile("s_waitcnt vmcnt(0)" ::: "memory"); SWRITE(0, SE); __syncthreads();
  qkt(pA0, pA1, K_lds, qr, r32, hi); partialSM(pA0, pA1, m_reg, mnA, alA);
  SLOAD(SO, KVBLK); if constexpr (SDEPTH == 2) { if (2 < NT) SLOAD(SE, 2 * KVBLK); }
  SWAIT(); SWRITE(1, SO); __syncthreads();
  for (int j = 1; j + 1 < NT; j += 2) {
    SBAR(); qkt(pB0, pB1, (bf16*)((char*)K_lds + SHM_K), qr, r32, hi);
    finishSM(pA0, pA1, alA, l_reg, pa0, pa1, pa2, pa3); SBAR();
    SLOAD(SO, (j + SDEPTH) * KVBLK); SBAR();
    pv_d0(o, vb0, pa0, pa1, pa2, pa3); partialSM(pB0, pB1, m_reg, mnB, alB);
    __syncthreads(); SWAIT(); SWRITE(0, SE);
    RESC(alB); __syncthreads();
    SBAR(); qkt(pA0, pA1, K_lds, qr, r32, hi);
    finishSM(pB0, pB1, alB, l_reg, pa0, pa1, pa2, pa3); SBAR();
    if (SDEPTH == 1 || j + 3 < NT) SLOAD(SE, (j + 1 + SDEPTH) * KVBLK); SBAR();
    pv_d0(o, vb0 + (int)SHM_V, pa0, pa1, pa2, pa3); partialSM(pA0, pA1, m_reg, mnA, alA);
    __syncthreads(); SWAIT(); SWRITE(1, SO);
    RESC(alA); __syncthreads();
  }
  SBAR(); qkt(pB0, pB1, (bf16*)((char*)K_lds + SHM_K), qr, r32, hi);
  finishSM(pA0, pA1, alA, l_reg, pa0, pa1, pa2, pa3); SBAR();
  pv_d0(o, vb0, pa0, pa1, pa2, pa3); partialSM(pB0, pB1, m_reg, mnB, alB);
  __syncthreads(); RESC(alB);
  finishSM(pB0, pB1, alB, l_reg, pa0, pa1, pa2, pa3); SBAR();
  pv_d0(o, vb0 + (int)SHM_V, pa0, pa1, pa2, pa3);
  if (hi == 0) li_l[r32] = l_reg; asm volatile("s_waitcnt lgkmcnt(0)" ::: "memory");
  float rli[16];
#pragma unroll
  for (int r = 0; r < 16; ++r) rli[r] = __builtin_amdgcn_rcpf(li_l[crow(r, hi)]);
  bf16* Ow = Ob + (long)(wid * QBLK) * LDO;
#pragma unroll
  for (int r = 0; r < 16; ++r) { int orow = crow(r, hi);
    for (int d0 = 0; d0 < 4; ++d0) Ow[(long)orow * LDO + d0 * 32 + r32] = __float2bfloat16(o[d0][r] * rli[r]); }
#undef SLOAD
#undef SWRITE
#undef SWAIT
#undef RESC
}

template <int NC> __device__ __forceinline__ void pv_n(f32x16* o, int vb, bf16x8 pa0, bf16x8 pa1, bf16x8 pa2, bf16x8 pa3) {
  pv_one<0>(o[0], vb, pa0, pa1, pa2, pa3);
  if constexpr (NC > 1) pv_one<1>(o[1], vb, pa0, pa1, pa2, pa3);
  if constexpr (NC > 2) { pv_one<2>(o[2], vb, pa0, pa1, pa2, pa3); pv_one<3>(o[3], vb, pa0, pa1, pa2, pa3); }
}
template <int MB, int NKT, class BR, class ST>
__device__ __forceinline__ void dft_unit(const bf16* __restrict__ A, int lda, const BR& br, const ST& st, char* lds) {
  constexpr int NBW = 8 / MB, NC = 4 / NBW;
  const int tid = ltid(), wid = tid >> 6, lane = tid & 63, r32 = lane & 31, hi = lane >> 5;
  const int mb = wid % MB, cgp = wid / MB;
  const int sr = tid >> 4, sc = (tid & 15) * 8, vst0 = v_st(sr, sc), vst1 = v_st(32 + sr, sc);
  bf16x8 bq[NKT][2], af[NKT][4];
#pragma unroll
  for (int kt = 0; kt < NKT; ++kt) {
    bq[kt][0] = *reinterpret_cast<const bf16x8*>(br.row(kt * 64 + sr) + sc);
    bq[kt][1] = *reinterpret_cast<const bf16x8*>(br.row(kt * 64 + 32 + sr) + sc);
  }
  const bf16* Aw = A + (long)(mb * 32 + r32) * lda + hi * 8;
#pragma unroll
  for (int kt = 0; kt < NKT; ++kt)
#pragma unroll
    for (int ks = 0; ks < 4; ++ks) af[kt][ks] = *reinterpret_cast<const bf16x8*>(Aw + kt * 64 + ks * 16);
  __syncthreads();
#pragma unroll
  for (int kt = 0; kt < NKT; ++kt) {
    *(bf16x8*)(lds + kt * 16384 + vst0) = bq[kt][0];
    *(bf16x8*)(lds + kt * 16384 + vst1) = bq[kt][1];
  }
  __syncthreads();
  f32x16 o[NC];
#pragma unroll
  for (int d = 0; d < NC; ++d) o[d] = f32x16{};
  const int vb = (int)(uintptr_t)lds + v_rd_base(lane) + cgp * NC * 512;
#pragma unroll
  for (int kt = 0; kt < NKT; ++kt) pv_n<NC>(o, vb + kt * 16384, af[kt][0], af[kt][1], af[kt][2], af[kt][3]);
#pragma unroll
  for (int r = 0; r < 16; ++r) {
#pragma unroll
    for (int d = 0; d < NC; ++d) st(mb * 32 + crow(r, hi), (cgp * NC + d) * 32 + r32, o[d][r]);
  }
}
#undef SBAR
#undef KSWZ
}

namespace cg = cooperative_groups;
#define LAS __attribute__((address_space(3)))
typedef unsigned short bf16_t;
typedef unsigned v4u __attribute__((ext_vector_type(4)));
typedef unsigned v2u __attribute__((ext_vector_type(2)));
typedef float f4 __attribute__((ext_vector_type(4)));

#define XB_TMO      128
#define XB_XCNT(j)  (256  + 64 * (j))
#define XB_XSUB(j)  (1280 + 64 * (j))
#define XB_XGEN(j)  (2304 + 64 * (j))
#define XB_TOP      3328
#define XB_TOPGEN   3392
#define XCD_BAR_WORDS 3456
#define XB_SPIN_CAP (1u << 18)

__device__ __forceinline__ unsigned xb_ld(unsigned* p)              { return __hip_atomic_load(p, __ATOMIC_RELAXED, __HIP_MEMORY_SCOPE_AGENT); }
__device__ __forceinline__ unsigned xb_add(unsigned* p, unsigned v) { return __hip_atomic_fetch_add(p, v, __ATOMIC_RELAXED, __HIP_MEMORY_SCOPE_AGENT); }
__device__ __forceinline__ unsigned xb_xcc_id() { return (unsigned)__builtin_amdgcn_s_getreg((3 << 11) | 20) & 0xFu; }
#define XB_SPIN(cond, bar) do { unsigned _sp = 0; while (cond) { __builtin_amdgcn_s_sleep(1); \
    if ((++_sp & 255u) == 0u) { if (xb_ld(&(bar)[XB_TMO])) break; if (_sp > XB_SPIN_CAP) { atomicAdd(&(bar)[XB_TMO], 1u); break; } } } } while (0)

struct XcdBarrier {
    unsigned* bar; unsigned x;
    volatile LAS unsigned* st;
};

__device__ __forceinline__ XcdBarrier xcd_barrier_post(unsigned* bar, volatile LAS unsigned* st) {
    XcdBarrier b; b.bar = bar; b.x = xb_xcc_id(); b.st = st;
    if (threadIdx.x == 0) (void)xb_add(&bar[XB_XCNT(b.x)], 1u);
    return b;
}
__device__ __forceinline__ void xcd_barrier_complete(unsigned* bar, unsigned x, unsigned& nloc, unsigned& nx) {
    const unsigned G = gridDim.x * gridDim.y * gridDim.z;
    unsigned sum, cnt, mine, sp = 0u;
    for (;;) {
        sum = 0u; cnt = 0u; mine = 0u;
#pragma unroll
        for (unsigned j = 0; j < 16; ++j) { const unsigned c = xb_ld(&bar[XB_XCNT(j)]); sum += c; cnt += (c > 0u) ? 1u : 0u; mine = (j == x) ? c : mine; }
        if (sum == G) break;
        __builtin_amdgcn_s_sleep(1);
        if ((++sp & 255u) == 0u) { if (xb_ld(&bar[XB_TMO])) break; if (sp > XB_SPIN_CAP) { atomicAdd(&bar[XB_TMO], 1u); break; } }
    }
    nloc = mine > 0u ? mine : 1u; nx = cnt > 0u ? cnt : 1u;
}

__device__ __forceinline__ void xcd_barrier(const XcdBarrier& b) {
    asm volatile("s_waitcnt vmcnt(0)" ::: "memory");
    __syncthreads();
    if (threadIdx.x == 0) {
        unsigned* bar = b.bar;
        __builtin_amdgcn_s_waitcnt(0);
        unsigned nloc = b.st[0], nx = b.st[1];
        if (nloc == 0u) { xcd_barrier_complete(bar, b.x, nloc, nx); b.st[0] = nloc; b.st[1] = nx; }
        const unsigned old = xb_add(&bar[XB_XSUB(b.x)], 1u);
        const unsigned gen = old / nloc;
        if (old + 1u == (gen + 1u) * nloc) {
            __builtin_amdgcn_fence(__ATOMIC_RELEASE, "agent");
            asm volatile("s_waitcnt vmcnt(0)" ::: "memory");
            const unsigned og = xb_add(&bar[XB_TOP], 1u);
            const unsigned tg = og / nx;
            if (og + 1u == (tg + 1u) * nx) xb_add(&bar[XB_TOPGEN], 1u);
            else XB_SPIN(xb_ld(&bar[XB_TOPGEN]) == tg, bar);
            __builtin_amdgcn_fence(__ATOMIC_ACQUIRE, "agent");
            xb_add(&bar[XB_XGEN(b.x)], 1u);
            asm volatile("s_waitcnt vmcnt(0)" ::: "memory");
        } else {
            XB_SPIN(xb_ld(&bar[XB_XGEN(b.x)]) == gen, bar);
            __builtin_amdgcn_fence(__ATOMIC_ACQUIRE, "agent");
            asm volatile("s_waitcnt vmcnt(0)" ::: "memory");
        }
    }
    __syncthreads();
}

constexpr int DM = 2048, MTOK = 65536, NIN = 3072, DFF = 5632, NUP = 11264, WINW = 2560;
constexpr int NPROMPT = 32768;
constexpr int CHUNK = 65536, NCHUNK = 1;
constexpr float EPS = 1e-6f;
constexpr size_t MiB = (size_t)1 << 20;
constexpr size_t WS_M2F = 0;
constexpr size_t WS_COS = 1 * MiB, WS_SIN = 5 * MiB;
constexpr size_t WS_A1P = 9 * MiB, WS_A1S = 9 * MiB + 128 * 1024;
constexpr size_t WS_A3P = 10 * MiB, WS_A3S = 18 * MiB;
constexpr size_t WS_BAR = 19 * MiB, BAR_BYTES = 16384;
constexpr size_t WS_W = 20 * MiB;
constexpr size_t W_LAYER = 86 * MiB, W_OUT_OFF = 12 * MiB, W_UP_OFF = 20 * MiB, W_DOWN_OFF = 64 * MiB;
constexpr size_t WS_XH = 192 * MiB;
constexpr size_t WS_Z = 448 * MiB;
constexpr size_t WS_G = 704 * MiB;
constexpr size_t WS_Y = 832 * MiB;
constexpr size_t WS_ACT = 448 * MiB;
constexpr size_t WS_HB = 1152 * MiB;
constexpr size_t WS_XB = 1240 * MiB;
constexpr size_t WS_END = 1496 * MiB;
constexpr int LDS_BYTES = 135168;

__device__ __forceinline__ float bf2f(unsigned short b) { return __uint_as_float((unsigned)b << 16); }
__device__ __forceinline__ float bflo(unsigned w) { return __uint_as_float(w << 16); }
__device__ __forceinline__ float bfhi(unsigned w) { return __uint_as_float(w & 0xffff0000u); }
__device__ __forceinline__ unsigned pk2(float lo, float hi) { return pg8::cvt_pk_bf16(lo, hi); }
__device__ __forceinline__ float wave_sum(float v) {
#pragma unroll
    for (int o = 1; o < 64; o <<= 1) v += __shfl_xor(v, o);
    return v;
}

struct EpiWin {
    static constexpr bool PERM = true, AFTER_DRAIN = false;
    bf16_t* Z; bf16_t* Gp;
    __device__ __forceinline__ void operator()(const pg8::f32x4 (&acc)[2][2][4][2], const pg8::Unit& u, int wr, int wc, int fr, int fq) const {
        const int row0 = u.pm * pg8::BM + wr * 64 + fr;
        bf16_t* base; size_t rstride, bjstride;
        if (u.pn < 8) { base = Z + (size_t)row0 * 2048 + u.pn * 256 + wc * 32 + 8 * fq; rstride = 2048; bjstride = 128; }
        else {
            const int g = u.pn - 8, r0 = u.pm * pg8::BM; size_t sb; int L, t0;
            if (r0 < NPROMPT) { const int s = r0 >> 14; sb = (size_t)s * (2u * 16384u * 512u); L = 16384; t0 = row0 - s * 16384; }
            else { const int s = (r0 - NPROMPT) >> 12; sb = (size_t)NPROMPT * 1024 + (size_t)s * (2u * 4096u * 512u); L = 4096; t0 = row0 - NPROMPT - s * 4096; }
            base = Gp + sb + (size_t)t0 * 512 + g * 128 + wc * 32 + 8 * fq; rstride = 512; bjstride = (size_t)L * 512;
        }
#pragma unroll
        for (int ai = 0; ai < 2; ++ai)
#pragma unroll
            for (int m = 0; m < 4; ++m) { bf16_t* rowp = base + (size_t)(ai * pg8::HALF + m * 16) * rstride;
#pragma unroll
                for (int bj = 0; bj < 2; ++bj) { const pg8::f32x4 v0 = acc[ai][bj][m][0], v1 = acc[ai][bj][m][1];
                    pg8::u32x4 w; w.x = pk2(v0[0], v0[1]); w.y = pk2(v0[2], v0[3]); w.z = pk2(v1[0], v1[1]); w.w = pk2(v1[2], v1[3]);
                    *(pg8::u32x4*)(rowp + bj * bjstride) = w; } }
    }
};

__device__ __forceinline__ void p0a_tables(const float* fourier_w, unsigned char* ws, LAS float* tab, int gtid, int NT) {
    float* M2F = (float*)(ws + WS_M2F);
    { const int t = ltid(); if (t < 128) { float sn, cs; sincospif((float)t * (2.f / 128.f), &sn, &cs); tab[t] = cs; tab[128 + t] = -sn; } }
    __syncthreads();
    for (int i = gtid; i < 2 * 4 * 128 * 256; i += NT) {
        const int lg = i >> 15, c = (i >> 8) & 127, n = i & 255, part = n >> 7, e2 = n & 127;
        const float* fw = fourier_w + (size_t)lg * 16384 + e2;
        float acc = 0.f;
#pragma unroll 8
        for (int e = 0; e < 128; ++e) { const int r = (c * e) & 127; acc += tab[part * 128 + r] * fw[e * 128]; }
        M2F[i] = acc;
    }
    __syncthreads();
    float* COS = (float*)(ws + WS_COS); float* SIN = (float*)(ws + WS_SIN);
    for (int i = gtid; i < 16384 * 64; i += NT) {
        const int t = i >> 6, j = i & 63; const float pos = (float)(j < 32 ? (t >> 6) : (t & 63));
        const float inv = 1.0f / powf(10000.0f, (float)(j & 31) / 32.0f); const float ang = pos * inv;
        COS[i] = cosf(ang); SIN[i] = sinf(ang);
    }
    bf16_t* A1P = (bf16_t*)(ws + WS_A1P);
    for (int i = gtid; i < 256 * 256; i += NT) { const int m = i >> 8, k = i & 255, pm = m >> 7, k1 = m & 127, pk = k >> 7, t1 = k & 127; const int r = (t1 * k1) & 127;
        float sn, cs; sincospif((float)r * (2.f / 128.f), &sn, &cs); const float v = (pm == pk) ? cs : (pm == 0 ? sn : -sn); A1P[i] = (bf16_t)(pk2(v, 0.f) & 0xffff); }
    bf16_t* A1S = (bf16_t*)(ws + WS_A1S);
    for (int i = gtid; i < 128 * 128; i += NT) { const int m = i >> 7, k = i & 127, pm = m >> 6, k1 = m & 63, pk = k >> 6, t1 = k & 63; const int r = (t1 * k1) & 63;
        float sn, cs; sincospif((float)r * (2.f / 64.f), &sn, &cs); const float v = (pm == pk) ? cs : (pm == 0 ? sn : -sn); A1S[i] = (bf16_t)(pk2(v, 0.f) & 0xffff); }
    bf16_t* A3P = (bf16_t*)(ws + WS_A3P);
    for (int i = gtid; i < 128 * 128 * 256; i += NT) { const int k1 = i >> 15, k2 = (i >> 8) & 127, kk = i & 255, part = kk >> 7, t2 = kk & 127; const int k = k1 + 128 * k2; const int r = (t2 * k) & 16383;
        float sn, cs; sincospif((float)r * (1.f / 8192.f), &sn, &cs); A3P[i] = (bf16_t)(pk2(part ? sn : cs, 0.f) & 0xffff); }
    bf16_t* A3S = (bf16_t*)(ws + WS_A3S);
    for (int i = gtid; i < 64 * 64 * 128; i += NT) { const int k1 = i >> 13, k2 = (i >> 7) & 63, kk = i & 127, part = kk >> 6, t2 = kk & 63; const int k = k1 + 64 * k2; const int r = (t2 * k) & 4095;
        float sn, cs; sincospif((float)r * (1.f / 2048.f), &sn, &cs); A3S[i] = (bf16_t)(pk2(part ? sn : cs, 0.f) & 0xffff); }
}

struct ValUp { const float* W; __device__ __forceinline__ const float* ptr(int k, int n) const { const int src = ((n >> 7) & 1) * DFF + (n >> 8) * 128 + (n & 127); return W + (size_t)k * NUP + src; }
    __device__ __forceinline__ float operator()(int k, int n) const { return *ptr(k, n); } };
struct ValDirect { const float* W; int ldw; __device__ __forceinline__ const float* ptr(int k, int n) const { return W + (size_t)k * ldw + n; }
    __device__ __forceinline__ float operator()(int k, int n) const { return W[(size_t)k * ldw + n]; } };
struct ValWin { const float* win; const float* poolw; const float* pscale; const float* m2f;
    __device__ __forceinline__ const float* ptr(int k, int n) const { return win + (size_t)k * WINW + n; }
    __device__ __forceinline__ float operator()(int k, int n) const {
        if (n >= 512 && n < 2048) return win[(size_t)k * WINW + n];
        if (n < 512) { const int g = n >> 7, e = n & 127; const float* wr = win + (size_t)k * WINW + g * 128; const float* pw = poolw + g * 16384 + e; float acc = 0.f;
            for (int c = 0; c < 128; ++c) acc += wr[c] * pw[c * 128]; return acc * pscale[n]; }
        const int n2 = n - 2048, g = n2 >> 8, np = n2 & 255; const float* wr = win + (size_t)k * WINW + 2048 + g * 128; const float* mf = m2f + g * 32768 + np; float acc = 0.f;
        for (int c = 0; c < 128; ++c) acc += wr[c] * mf[c * 256]; return acc; } };
template <class F> __device__ __forceinline__ void transpose_item(const F& val, int K, bf16_t* WT, int k0, int n0, LAS float* scr, int lane) {
    for (int i = 0; i < 32; ++i) { const int kk = 2 * i + (lane >> 5); scr[kk * 33 + (lane & 31)] = val(k0 + kk, n0 + (lane & 31)); }
    asm volatile("s_waitcnt lgkmcnt(0)" ::: "memory");
    const int c = lane & 7;
#pragma unroll
    for (int j = 0; j < 4; ++j) { const int n = (lane >> 3) + 8 * j; const LAS float* s = scr + (8 * c) * 33 + n;
        v4u o; o.x = pk2(s[0 * 33], s[1 * 33]); o.y = pk2(s[2 * 33], s[3 * 33]); o.z = pk2(s[4 * 33], s[5 * 33]); o.w = pk2(s[6 * 33], s[7 * 33]);
        *(v4u*)(WT + (size_t)(n0 + n) * K + k0 + 8 * c) = o; }
    asm volatile("s_waitcnt lgkmcnt(0)" ::: "memory");
}
template <class F> __device__ __forceinline__ void tr_load(const F& f, int k0, int n0, int lane, f4 (&v)[8]) {
#pragma unroll
    for (int i = 0; i < 8; ++i) v[i] = __builtin_nontemporal_load((const f4*)f.ptr(k0 + 8 * i + (lane >> 3), n0 + 4 * (lane & 7)));
}
__device__ __forceinline__ void tr_store(const f4 (&v)[8], int K, bf16_t* WT, int k0, int n0, LAS float* scr, int lane) {
#pragma unroll
    for (int i = 0; i < 8; ++i) { LAS float* d = scr + (8 * i + (lane >> 3)) * 33 + 4 * (lane & 7); d[0] = v[i].x; d[1] = v[i].y; d[2] = v[i].z; d[3] = v[i].w; }
    asm volatile("s_waitcnt lgkmcnt(0)" ::: "memory");
    const int c = lane & 7;
#pragma unroll
    for (int j = 0; j < 4; ++j) { const int n = (lane >> 3) + 8 * j; const LAS float* s = scr + (8 * c) * 33 + n;
        v4u o; o.x = pk2(s[0 * 33], s[1 * 33]); o.y = pk2(s[2 * 33], s[3 * 33]); o.z = pk2(s[4 * 33], s[5 * 33]); o.w = pk2(s[6 * 33], s[7 * 33]);
        *(v4u*)(WT + (size_t)(n0 + n) * K + k0 + 8 * c) = o; }
    asm volatile("s_waitcnt lgkmcnt(0)" ::: "memory");
}
template <class F> __device__ __forceinline__ void transpose_matrix(const F& val, int K, int N, bf16_t* WT, LAS float* scr, int gw, int NGW, int lane, int nlo, int nhi) {
    const int nblk = (nhi - nlo) / 32, nitems = (K / 64) * nblk;
    int it = gw; if (it >= nitems) return;
    f4 cur[8], nxt[8];
    tr_load(val, 64 * (it / nblk), nlo + 32 * (it % nblk), lane, cur);
    for (; it < nitems; it += NGW) {
        const int k0 = 64 * (it / nblk), n0 = nlo + 32 * (it % nblk); const int it2 = it + NGW; const bool more = it2 < nitems;
        if (more) tr_load(val, 64 * (it2 / nblk), nlo + 32 * (it2 % nblk), lane, nxt);
        tr_store(cur, K, WT, k0, n0, scr, lane);
        if (more) {
#pragma unroll
            for (int i = 0; i < 8; ++i) cur[i] = nxt[i]; }
    }
}

typedef float __attribute__((address_space(4))) cf32;
__device__ __forceinline__ void fold_items(const float* win, const float* poolw, const float* pscale, const float* m2f, bf16_t* WT, int gw, int NGW, int lane) {
    for (int it = gw; it < 64 * 24; it += NGW) {
        const int kb = it / 24, nb = it - kb * 24, k0 = 32 * kb;
        float m2[128]; int base, nout;
        if (nb < 8) { const int n = nb * 64 + lane, g = nb >> 1, e = n & 127; base = g * 128; nout = n; const float sc = pscale[n]; const float* pw = poolw + g * 16384 + e;
#pragma unroll
            for (int c = 0; c < 128; ++c) m2[c] = pw[c * 128] * sc;
        } else { const int n2 = (nb - 8) * 64 + lane, g = (nb - 8) >> 2, np = n2 & 255; base = 2048 + g * 128; nout = 2048 + n2; const float* mf = m2f + g * 32768 + np;
#pragma unroll
            for (int c = 0; c < 128; ++c) m2[c] = mf[c * 256];
        }
        bf16_t* wrow = WT + (size_t)nout * DM + k0;
        for (int kg = 0; kg < 4; ++kg) {
            float acc[8];
#pragma unroll
            for (int kk = 0; kk < 8; ++kk) { const cf32* wr = (const cf32*)(unsigned long long)(win + (size_t)(k0 + 8 * kg + kk) * WINW + base); float a = 0.f;
#pragma unroll
                for (int c = 0; c < 128; ++c) a += wr[c] * m2[c];
                acc[kk] = a; }
            v4u o; o.x = pk2(acc[0], acc[1]); o.y = pk2(acc[2], acc[3]); o.z = pk2(acc[4], acc[5]); o.w = pk2(acc[6], acc[7]);
            *(v4u*)(wrow + 8 * kg) = o;
        }
    }
}

__device__ __forceinline__ const float* xrow_ptr(const float* xa, const float* xb, int row) { return (row < NPROMPT) ? xa + (size_t)row * DM : xb + (size_t)(row - NPROMPT) * DM; }
template <bool XBF, bool OBF, int RR>
__device__ __forceinline__ void resid_rows(const float* xa, const float* xb, const bf16_t* xbf, const bf16_t* m, const float* g1, float* xout, bf16_t* xbout, bf16_t* xh, const float* g2, int gw, int NGW, int lane) {
    for (int row0 = gw; row0 < MTOK; row0 += RR * NGW) {
        f4 xf[XBF ? 1 : RR][8]; v2u xp[XBF ? RR : 1][8]; v2u mw[RR][8];
#pragma unroll
        for (int u = 0; u < RR; ++u) { const int row = row0 + u * NGW;
            if constexpr (XBF) { const bf16_t* xr = xbf + (size_t)row * DM;
#pragma unroll
                for (int j = 0; j < 8; ++j) xp[u][j] = *(const v2u*)(xr + 4 * lane + 256 * j);
            } else { const float* xr = xrow_ptr(xa, xb, row);
#pragma unroll
                for (int j = 0; j < 8; ++j) xf[u][j] = __builtin_nontemporal_load((const f4*)(xr + 4 * lane + 256 * j)); } }
        if (m) {
#pragma unroll
            for (int u = 0; u < RR; ++u) { const bf16_t* mr = m + (size_t)(row0 + u * NGW) * DM;
#pragma unroll
                for (int j = 0; j < 8; ++j) mw[u][j] = *(const v2u*)(mr + 4 * lane + 256 * j); }
        }
#pragma unroll
        for (int u = 0; u < RR; ++u) { const int row = row0 + u * NGW;
            f4 xv[8];
#pragma unroll
            for (int j = 0; j < 8; ++j) { if constexpr (XBF) { const v2u w = xp[u][j]; xv[j] = (f4){bflo(w.x), bfhi(w.x), bflo(w.y), bfhi(w.y)}; } else xv[j] = xf[u][j]; }
            if (m) { float ss = 0.f;
#pragma unroll
                for (int j = 0; j < 8; ++j) { const v2u w = mw[u][j]; const f4 mv = (f4){bflo(w.x), bfhi(w.x), bflo(w.y), bfhi(w.y)}; ss += (mv.x * mv.x + mv.y * mv.y) + (mv.z * mv.z + mv.w * mv.w); }
                const float r = 1.0f / sqrtf(wave_sum(ss) * (1.f / DM) + EPS);
#pragma unroll
                for (int j = 0; j < 8; ++j) { const v2u w = mw[u][j]; const f4 mv = (f4){bflo(w.x), bfhi(w.x), bflo(w.y), bfhi(w.y)}; const f4 gv = *(const f4*)(g1 + 4 * lane + 256 * j); xv[j] += mv * r * gv; } }
            if constexpr (OBF) { if (xbout) {
#pragma unroll
                for (int j = 0; j < 8; ++j) { v2u w; w.x = pk2(xv[j].x, xv[j].y); w.y = pk2(xv[j].z, xv[j].w); *(v2u*)(xbout + (size_t)row * DM + 4 * lane + 256 * j) = w; } }
            } else { if (xout) {
#pragma unroll
                for (int j = 0; j < 8; ++j) __builtin_nontemporal_store(xv[j], (f4*)(xout + (size_t)row * DM + 4 * lane + 256 * j)); } }
            if (xh) { float ss = 0.f;
#pragma unroll
                for (int j = 0; j < 8; ++j) ss += (xv[j].x * xv[j].x + xv[j].y * xv[j].y) + (xv[j].z * xv[j].z + xv[j].w * xv[j].w);
                const float r = 1.0f / sqrtf(wave_sum(ss) * (1.f / DM) + EPS);
#pragma unroll
                for (int j = 0; j < 8; ++j) { const f4 gv = *(const f4*)(g2 + 4 * lane + 256 * j); const f4 y = xv[j] * r * gv;
                    v2u w; w.x = pk2(y.x, y.y); w.y = pk2(y.z, y.w); *(v2u*)(xh + (size_t)row * DM + 4 * lane + 256 * j) = w; } }
        }
    }
}

__device__ __forceinline__ void rope_pass(bf16_t* Z, bf16_t* Zout, const float* qn, const float* kn, const float* COS, const float* SIN, int gtid, int NT) {
    const int hw = gtid >> 5, NHW = NT >> 5, j = gtid & 31;
    const float qa0 = qn[2 * j], qa1 = qn[2 * j + 1], qb0 = qn[64 + 2 * j], qb1 = qn[65 + 2 * j];
    const float ka0 = kn[2 * j], ka1 = kn[2 * j + 1], kb0 = kn[64 + 2 * j], kb1 = kn[65 + 2 * j];
    for (int row = hw; row < MTOK; row += NHW) {
        const int t = row < NPROMPT ? (row & 16383) : (row & 4095);
        bf16_t* p = Z + (size_t)row * DM + 512 + 2 * j;
        unsigned a[10], b[10];
#pragma unroll
        for (int hh = 0; hh < 10; ++hh) { a[hh] = *(const unsigned*)(p + hh * 128); b[hh] = *(const unsigned*)(p + hh * 128 + 64); }
        const float c0 = COS[t * 64 + 2 * j], c1 = COS[t * 64 + 2 * j + 1], s0 = SIN[t * 64 + 2 * j], s1 = SIN[t * 64 + 2 * j + 1];
#pragma unroll
        for (int hh = 0; hh < 10; ++hh) {
            float x0 = bflo(a[hh]), x1 = bfhi(a[hh]), y0 = bflo(b[hh]), y1 = bfhi(b[hh]);
            float ss = (x0 * x0 + x1 * x1) + (y0 * y0 + y1 * y1);
#pragma unroll
            for (int o = 1; o < 32; o <<= 1) ss += __shfl_xor(ss, o);
            const float r = 1.0f / sqrtf(ss * (1.f / 128.f) + EPS);
            x0 *= r * (hh < 8 ? qa0 : ka0); x1 *= r * (hh < 8 ? qa1 : ka1); y0 *= r * (hh < 8 ? qb0 : kb0); y1 *= r * (hh < 8 ? qb1 : kb1);
            const float ox0 = x0 * c0 - y0 * s0, oy0 = y0 * c0 + x0 * s0, ox1 = x1 * c1 - y1 * s1, oy1 = y1 * c1 + x1 * s1;
            bf16_t* po = Zout + (size_t)row * DM + 512 + 2 * j;
            *(unsigned*)(po + hh * 128) = pk2(ox0, ox1); *(unsigned*)(po + hh * 128 + 64) = pk2(oy0, oy1);
        }
    }
}

__device__ __forceinline__ void pool_pass(const bf16_t* Z, bf16_t* H, int gtid, int NT) {
    for (int it = gtid; it < MTOK * 64; it += NT) {
        const int row = it >> 6, ch = it & 63, c0 = ch * 8, g = ch >> 4, w = 2 << g;
        int t, L; if (row < NPROMPT) { t = row & 16383; L = 16384; } else { t = row & 4095; L = 4096; }
        const int rb = row - t; int lo = t - (w >> 1); if (lo < 0) lo = 0; int hi = t + w - 1 - (w >> 1); if (hi > L - 1) hi = L - 1;
        float s[8] = {0.f, 0.f, 0.f, 0.f, 0.f, 0.f, 0.f, 0.f};
        for (int tt = lo; tt <= hi; ++tt) { const v4u v = *(const v4u*)(Z + (size_t)(rb + tt) * DM + c0);
            s[0] += bflo(v.x); s[1] += bfhi(v.x); s[2] += bflo(v.y); s[3] += bfhi(v.y); s[4] += bflo(v.z); s[5] += bfhi(v.z); s[6] += bflo(v.w); s[7] += bfhi(v.w); }
        const float ic = 1.0f / (float)(hi - lo + 1);
        const v4u v = *(const v4u*)(Z + (size_t)row * DM + c0);
        v4u o; o.x = pk2(s[0] * ic - bflo(v.x), s[1] * ic - bfhi(v.x)); o.y = pk2(s[2] * ic - bflo(v.y), s[3] * ic - bfhi(v.y));
        o.z = pk2(s[4] * ic - bflo(v.z), s[5] * ic - bfhi(v.z)); o.w = pk2(s[6] * ic - bflo(v.w), s[7] * ic - bfhi(v.w));
        *(v4u*)(H + (size_t)row * DM + c0) = o;
    }
}

__device__ __forceinline__ float gelu_tanh(float x) { const float y = 0.7978845608028654f * (x + 0.044715f * x * x * x); return x * __builtin_amdgcn_rcpf(1.0f + __expf(-2.0f * y)); }
__device__ __forceinline__ void ld8f(const bf16_t* p, float* o) { const v4u v = *(const v4u*)p; o[0] = bflo(v.x); o[1] = bfhi(v.x); o[2] = bflo(v.y); o[3] = bfhi(v.y); o[4] = bflo(v.z); o[5] = bfhi(v.z); o[6] = bflo(v.w); o[7] = bfhi(v.w); }
__device__ __forceinline__ float dpp_ror1(float v) { return __int_as_float(__builtin_amdgcn_update_dpp(0, __float_as_int(v), 0x121, 0xf, 0xf, false)); }
__device__ __forceinline__ float dpp_ror15(float v) { return __int_as_float(__builtin_amdgcn_update_dpp(0, __float_as_int(v), 0x12F, 0xf, 0xf, false)); }
struct EpiGlu {
    static constexpr bool PERM = true, AFTER_DRAIN = false;
    bf16_t* ACT; bf16_t* HB; const float* cw; const float* cb;
    __device__ __forceinline__ void operator()(const pg8::f32x4 (&acc)[2][2][4][2], const pg8::Unit& u, int wr, int wc, int fr, int fq) const {
        const int jc = u.pn * 128 + wc * 32 + 8 * fq;
        const bool first = (fr == 0), last = (fr == 15);
        v2u stash[2][4];
#pragma unroll
        for (int n = 0; n < 2; ++n) {
            const f4 w0g = *(const f4*)(cw + jc + 4 * n), w1g = *(const f4*)(cw + NUP + jc + 4 * n), w2g = *(const f4*)(cw + 2 * NUP + jc + 4 * n), bg = *(const f4*)(cb + jc + 4 * n);
            const f4 w0v = *(const f4*)(cw + DFF + jc + 4 * n), w1v = *(const f4*)(cw + NUP + DFF + jc + 4 * n), w2v = *(const f4*)(cw + 2 * NUP + DFF + jc + 4 * n), bv = *(const f4*)(cb + DFF + jc + 4 * n);
#pragma unroll
            for (int ai = 0; ai < 2; ++ai) {
                float g1p[4], v1p[4], g15c[4], v15c[4];
#pragma unroll
                for (int i = 0; i < 4; ++i) { g1p[i] = 0.f; v1p[i] = 0.f; g15c[i] = dpp_ror15(acc[ai][0][0][n][i]); v15c[i] = dpp_ror15(acc[ai][1][0][n][i]); }
#pragma unroll
                for (int m = 0; m < 4; ++m) {
                    const int mn = m < 3 ? m + 1 : 3;
                    float o[4];
#pragma unroll
                    for (int i = 0; i < 4; ++i) {
                        const float g = acc[ai][0][m][n][i], v = acc[ai][1][m][n][i];
                        const float g1c = dpp_ror1(g), v1c = dpp_ror1(v), g15n = dpp_ror15(acc[ai][0][mn][n][i]), v15n = dpp_ror15(acc[ai][1][mn][n][i]);
                        const float gp = first ? g1p[i] : g1c, gn = last ? g15n : g15c[i], vp = first ? v1p[i] : v1c, vn = last ? v15n : v15c[i];
                        g1p[i] = g1c; v1p[i] = v1c; g15c[i] = g15n; v15c[i] = v15n;
                        const float a = gp * w0g[i] + g * w1g[i] + gn * w2g[i] + bg[i];
                        const float b = vp * w0v[i] + v * w1v[i] + vn * w2v[i] + bv[i];
                        const float e = __builtin_amdgcn_exp2f(a * (-2.3022082f + -0.10294324f * (a * a)));
                        o[i] = a * __builtin_amdgcn_rcpf(1.0f + e) * b;
                    }
                    const int row = u.pm * pg8::BM + ai * pg8::HALF + wr * 64 + m * 16 + fr;
                    v2u w; w.x = pk2(o[0], o[1]); w.y = pk2(o[2], o[3]);
                    if (n == 0) stash[ai][m] = w;
                    else { v4u ww; ww.x = stash[ai][m].x; ww.y = stash[ai][m].y; ww.z = w.x; ww.w = w.y; *(v4u*)(ACT + (size_t)row * DFF + jc) = ww; }
                }
            }
        }
#pragma unroll
        for (int ai = 0; ai < 2; ++ai) {
            const int grp = u.pm * 4 + ai * 2 + wr;
            if (fr < 2 || fr >= 14) {
                const int m = fr < 2 ? 0 : 3, slot = fr < 2 ? fr : fr - 12;
                bf16_t* hp = HB + ((size_t)grp * 4 + slot) * NUP + u.pn * 256 + wc * 32 + 8 * fq;
#pragma unroll
                for (int bj = 0; bj < 2; ++bj) {
                    const pg8::f32x4 v0 = fr < 2 ? acc[ai][bj][0][0] : acc[ai][bj][3][0], v1 = fr < 2 ? acc[ai][bj][0][1] : acc[ai][bj][3][1];
                    v4u w; w.x = pk2(v0[0], v0[1]); w.y = pk2(v0[2], v0[3]); w.z = pk2(v1[0], v1[1]); w.w = pk2(v1[2], v1[3]);
                    *(v4u*)(hp + bj * 128) = w;
                }
                (void)m;
            }
        }
    }
};
__device__ __forceinline__ void glu_fix(const bf16_t* HB, bf16_t* ACT, const float* cw, const float* cb, int gtid, int NT) {
    constexpr int NCC = DFF / 8, NG = CHUNK / 64;
    for (int it = gtid; it < NG * 2 * NCC; it += NT) {
        const int cc = it % NCC, rest = it / NCC, which = rest & 1, g = rest >> 1, j0 = cc * 8, colp = (j0 >> 7) * 256 + (j0 & 127);
        const int row = g * 64 + (which ? 63 : 0); const int Lc = row < NPROMPT ? 16384 : 4096;
        const bf16_t *P, *C, *N;
        if (!which) { C = HB + ((size_t)g * 4 + 0) * NUP; N = HB + ((size_t)g * 4 + 1) * NUP; P = ((row & (Lc - 1)) == 0) ? nullptr : HB + ((size_t)(g - 1) * 4 + 3) * NUP; }
        else { P = HB + ((size_t)g * 4 + 2) * NUP; C = HB + ((size_t)g * 4 + 3) * NUP; N = (((row + 1) & (Lc - 1)) == 0) ? nullptr : HB + ((size_t)(g + 1) * 4 + 0) * NUP; }
        float pg[8], pv[8], cg_[8], cv[8], ng[8], nv[8];
        if (P) { ld8f(P + colp, pg); ld8f(P + colp + 128, pv); } else {
#pragma unroll
            for (int i = 0; i < 8; ++i) { pg[i] = 0.f; pv[i] = 0.f; } }
        if (N) { ld8f(N + colp, ng); ld8f(N + colp + 128, nv); } else {
#pragma unroll
            for (int i = 0; i < 8; ++i) { ng[i] = 0.f; nv[i] = 0.f; } }
        ld8f(C + colp, cg_); ld8f(C + colp + 128, cv);
        float o[8];
#pragma unroll
        for (int h = 0; h < 2; ++h) {
            const f4 w0g = *(const f4*)(cw + j0 + 4 * h), w1g = *(const f4*)(cw + NUP + j0 + 4 * h), w2g = *(const f4*)(cw + 2 * NUP + j0 + 4 * h), bg = *(const f4*)(cb + j0 + 4 * h);
            const f4 w0v = *(const f4*)(cw + DFF + j0 + 4 * h), w1v = *(const f4*)(cw + NUP + DFF + j0 + 4 * h), w2v = *(const f4*)(cw + 2 * NUP + DFF + j0 + 4 * h), bv = *(const f4*)(cb + DFF + j0 + 4 * h);
#pragma unroll
            for (int q = 0; q < 4; ++q) { const int i = 4 * h + q;
                const float a = pg[i] * w0g[q] + cg_[i] * w1g[q] + ng[i] * w2g[q] + bg[q];
                const float b = pv[i] * w0v[q] + cv[i] * w1v[q] + nv[i] * w2v[q] + bv[q];
                o[i] = gelu_tanh(a) * b; } }
        v4u w; w.x = pk2(o[0], o[1]); w.y = pk2(o[2], o[3]); w.z = pk2(o[4], o[5]); w.w = pk2(o[6], o[7]);
        *(v4u*)(ACT + (size_t)row * DFF + j0) = w;
    }
}

struct BRow1 { const att::bf16* base; size_t ldb; __device__ __forceinline__ const att::bf16* row(int kk) const { return base + (size_t)kk * ldb; } };
struct St1 { att::bf16* base; size_t ldb; __device__ __forceinline__ void operator()(int m, int c, float v) const { base[(size_t)m * ldb + c] = __float2bfloat16(v); } };
struct BRow3 { const att::bf16* base; int R, lgR, k1; __device__ __forceinline__ const att::bf16* row(int kk) const { const int part = kk >> lgR, t2 = kk & (R - 1); return base + (size_t)(((part << lgR) + k1) * R + t2) * 512; } };
struct St3 { att::bf16* base; int R; float scale; __device__ __forceinline__ void operator()(int m, int c, float v) const { base[(size_t)(m * R) * DM + c] = __float2bfloat16(v * scale); } };

__device__ __forceinline__ void dft_stage1(const bf16_t* Gp, bf16_t* Yp, const unsigned char* ws, char* lds, int vcu, int G) {
    for (int it = 0;; ++it) { const int uid = it * G + vcu; if (uid >= 3072) break;
        if (uid < 1024) { const int s = uid >> 9, nt = uid & 511; const size_t off = (size_t)s * (2u * 16384u * 512u) + (size_t)nt * 128;
            BRow1 br{(const att::bf16*)Gp + off, 65536}; St1 st{(att::bf16*)Yp + off, 65536};
            att::dft_unit<8, 4>((const att::bf16*)(ws + WS_A1P), 256, br, st, lds);
        } else { const int u2 = uid - 1024, s = u2 >> 8, nt = u2 & 255; const size_t off = (size_t)NPROMPT * 1024 + (size_t)s * (2u * 4096u * 512u) + (size_t)nt * 128;
            BRow1 br{(const att::bf16*)Gp + off, 32768}; St1 st{(att::bf16*)Yp + off, 32768};
            att::dft_unit<4, 2>((const att::bf16*)(ws + WS_A1S), 128, br, st, lds);
        }
    }
}
__device__ __forceinline__ void dft_stage3(const bf16_t* Yp, bf16_t* H, const unsigned char* ws, char* lds, int vcu, int G) {
    for (int it = 0;; ++it) { const int uid = it * G + vcu; if (uid >= 3072) break;
        if (uid < 1024) { const int s = uid >> 9, k1 = (uid >> 2) & 127, nt = uid & 3;
            BRow3 br{(const att::bf16*)Yp + (size_t)s * (2u * 16384u * 512u) + nt * 128, 128, 7, k1};
            St3 st{(att::bf16*)H + (size_t)(s * 16384 + k1) * DM + 1536 + nt * 128, 128, 1.0f / sqrtf(16384.f * 128.f)};
            att::dft_unit<4, 4>((const att::bf16*)(ws + WS_A3P) + (size_t)k1 * (128 * 256), 256, br, st, lds);
        } else { const int u2 = uid - 1024, s = u2 >> 8, k1 = (u2 >> 2) & 63, nt = u2 & 3;
            BRow3 br{(const att::bf16*)Yp + (size_t)NPROMPT * 1024 + (size_t)s * (2u * 4096u * 512u) + nt * 128, 64, 6, k1};
            St3 st{(att::bf16*)H + (size_t)(NPROMPT + s * 4096 + k1) * DM + 1536 + nt * 128, 64, 1.0f / sqrtf(4096.f * 128.f)};
            att::dft_unit<2, 2>((const att::bf16*)(ws + WS_A3S) + (size_t)k1 * (64 * 128), 128, br, st, lds);
        }
    }
}

__device__ __forceinline__ void attn_phase(const bf16_t* Z, bf16_t* H, const float* qn, const float* kn, char* lds, int vcu, int G) {
    float mq = 0.f, mk = 0.f;
    for (int i = 0; i < 128; ++i) { mq = fmaxf(mq, fabsf(qn[i])); mk = fmaxf(mk, fabsf(kn[i])); }
    const float bound = 128.f * mq * mk * 1.02f;
    for (int it = 0;; ++it) { const int uid = it * G + vcu; if (uid >= 2048) break;
        int rowbase, h, qb, seq;
        if (uid < 1024) { const int s = uid >> 9; h = (uid >> 6) & 7; qb = uid & 63; rowbase = s * 16384; seq = 16384; }
        else { const int u2 = uid - 1024, s = u2 >> 7; h = (u2 >> 4) & 7; qb = u2 & 15; rowbase = NPROMPT + s * 4096; seq = 4096; }
        const att::bf16* Q = (const att::bf16*)Z + (size_t)(rowbase + qb * 256) * DM + 512 + h * 128;
        const att::bf16* K = (const att::bf16*)Z + (size_t)rowbase * DM + 1536 + (h >> 2) * 128;
        att::bf16* O = (att::bf16*)H + (size_t)(rowbase + qb * 256) * DM + 512 + h * 128;
        att::attn_dense_body<att::bf16>(Q, K, K + 256, O, seq, lds, bound);
        __syncthreads();
    }
}

struct Params { const float* in[17]; float* out; unsigned char* ws; int ph_lo, ph_hi; };
constexpr int NPL = 9;
constexpr int NPHASE = 2 + 2 * NPL;

__global__ void __launch_bounds__(512, 2) mega_fwd(Params p) {
    extern __shared__ __attribute__((aligned(16))) unsigned char lds[];
    cg::grid_group grid = cg::this_grid();
    const int G = gridDim.x, bx = blockIdx.x;
    const int vcu = (G % 8 == 0) ? (bx % 8) * (G / 8) + bx / 8 : bx;
    const int NGW = G * 8, NT = G * 512;
    unsigned char* ws = p.ws;
    const float *x_prompt = p.in[0], *x_sample = p.in[1], *g_pre_mix = p.in[2], *g_post_mix = p.in[3], *w_in = p.in[4], *pool_w = p.in[5], *pool_scale = p.in[6],
                *q_norm = p.in[7], *k_norm = p.in[8], *fourier_w = p.in[9], *w_out = p.in[10], *g_pre_ffn = p.in[11], *g_post_ffn = p.in[12], *w_up = p.in[13],
                *conv_w = p.in[14], *conv_b = p.in[15], *w_down = p.in[16];
    bf16_t* XH = (bf16_t*)(ws + WS_XH); bf16_t* Z = (bf16_t*)(ws + WS_Z); bf16_t* Gp = (bf16_t*)(ws + WS_G); bf16_t* Yp = (bf16_t*)(ws + WS_Y);
    bf16_t* HB = (bf16_t*)(ws + WS_HB); bf16_t* ACT = (bf16_t*)(ws + WS_ACT); bf16_t* XB = (bf16_t*)(ws + WS_XB);
    LAS unsigned char* ring = (LAS unsigned char*)lds;
    volatile LAS unsigned* bst = (volatile LAS unsigned*)(ring + 131072 + 64);
    if (threadIdx.x < 2) bst[threadIdx.x] = 0u;
    __syncthreads();
    XcdBarrier xbar = xcd_barrier_post((unsigned*)(ws + WS_BAR), bst);

    for (int ph = p.ph_lo; ph < p.ph_hi; ++ph) {
        const int tid = ltid(), lane = tid & 63, wave = __builtin_amdgcn_readfirstlane(tid >> 6);
        const int gw = vcu * 8 + wave, gtid = bx * 512 + tid;
        if (ph == 0) {
#if !defined(ONLY) || ONLY==0
            for (int rep = 0; rep < REP_P0; ++rep) p0a_tables(fourier_w, ws, (LAS float*)ring, gtid, NT);
#endif
        } else if (ph == 1) {
#if !defined(ONLY) || ONLY==1
            LAS float* scr = (LAS float*)(ring + wave * 16384);
            for (int l = 0; l < 2 * REP_P0; ++l) {
                bf16_t* Wl = (bf16_t*)(ws + WS_W + (l & 1) * W_LAYER);
                ValWin vw{w_in + (size_t)(l & 1) * DM * WINW, pool_w + (size_t)(l & 1) * 4 * 16384, pool_scale + (l & 1) * 512, (const float*)(ws + WS_M2F) + (size_t)(l & 1) * 4 * 32768};
                transpose_matrix(vw, DM, NIN, Wl, scr, gw, NGW, lane, 512, 2048);
                fold_items(vw.win, vw.poolw, vw.pscale, vw.m2f, Wl, gw, NGW, lane);
                ValDirect vo{w_out + (size_t)(l & 1) * DM * DM, DM};
                transpose_matrix(vo, DM, DM, (bf16_t*)((unsigned char*)Wl + W_OUT_OFF), scr, gw, NGW, lane, 0, DM);
                ValUp vu{w_up + (size_t)(l & 1) * DM * NUP};
                transpose_matrix(vu, DM, NUP, (bf16_t*)((unsigned char*)Wl + W_UP_OFF), scr, gw, NGW, lane, 0, NUP);
                ValDirect vd{w_down + (size_t)(l & 1) * DFF * DM, DM};
                transpose_matrix(vd, DFF, DM, (bf16_t*)((unsigned char*)Wl + W_DOWN_OFF), scr, gw, NGW, lane, 0, DM);
            }
            for (int rep = 0; rep < REP_P0; ++rep) resid_rows<false, false, 2>(x_prompt, x_sample, nullptr, nullptr, nullptr, nullptr, nullptr, XH, g_pre_mix, gw, NGW, lane);
#endif
        } else {
            const int l = (ph - 2) / NPL, q = (ph - 2) % NPL;
            const bf16_t* Wl = (const bf16_t*)(ws + WS_W + l * W_LAYER);
            if (q == 0) {
#if !defined(ONLY) || ONLY==2
                pg8::Gemm g{XH, Wl, MTOK, NIN, DM}; pg8::StaticOrder S; S.init(MTOK, NIN, G, bx);
                EpiWin E{Z, Gp};
                for (int rep = 0; rep < REP_WIN; ++rep) pg8::gemm_phase<EpiWin, pg8::StaticOrder, PG8_ALIGN, PG8_SP2>(ring, g, S, E);
#endif
            } else if (q == 1) {
#if !defined(ONLY) || ONLY==3
                for (int rep = 1; rep < REP_ROPE; ++rep) rope_pass(Z, (bf16_t*)(ws + WS_END), q_norm + l * 128, k_norm + l * 128, (const float*)(ws + WS_COS), (const float*)(ws + WS_SIN), gtid, NT);
                rope_pass(Z, Z, q_norm + l * 128, k_norm + l * 128, (const float*)(ws + WS_COS), (const float*)(ws + WS_SIN), gtid, NT);
                for (int rep = 0; rep < REP_LIGHT; ++rep) { pool_pass(Z, XH, gtid, NT);
                dft_stage1(Gp, Yp, ws, (char*)lds, vcu, G); }
#endif
            } else if (q == 2) {
#if !defined(ONLY) || ONLY==4
                for (int rep = 0; rep < REP_ATTN; ++rep) attn_phase(Z, XH, q_norm + l * 128, k_norm + l * 128, (char*)lds, vcu, G);
#endif
#if !defined(ONLY) || ONLY==5
                for (int rep = 0; rep < REP_LIGHT; ++rep) dft_stage3(Yp, XH, ws, (char*)lds, vcu, G);
#endif
            } else if (q == 4) {
#if !defined(ONLY) || ONLY==6
                for (int rep = 1; rep < REP_RES; ++rep) resid_rows<true, true, 4>(nullptr, nullptr, XB, Z, g_post_mix + DM, nullptr, nullptr, (bf16_t*)(ws + WS_END), g_pre_ffn + DM, gw, NGW, lane);
                if (l == 0) resid_rows<false, true, 2>(x_prompt, x_sample, nullptr, Z, g_post_mix, nullptr, XB, XH, g_pre_ffn, gw, NGW, lane);
                else resid_rows<true, true, 4>(nullptr, nullptr, XB, Z, g_post_mix + DM, nullptr, XB, XH, g_pre_ffn + DM, gw, NGW, lane);
#endif
            } else if (q == 8) {
#if !defined(ONLY) || ONLY==6
                if (l == 0) resid_rows<true, true, 4>(nullptr, nullptr, XB, XH, g_post_ffn, nullptr, XB, XH, g_pre_mix + DM, gw, NGW, lane);
                else resid_rows<true, false, 4>(nullptr, nullptr, XB, XH, g_post_ffn + DM, p.out, nullptr, nullptr, nullptr, gw, NGW, lane);
#endif
            } else {
                const int c = 0, step = (q >= 5) ? (q - 5) : -1;
                const float* cwl = conv_w + (size_t)l * 3 * NUP; const float* cbl = conv_b + (size_t)l * NUP;
                if (step == 1) {
#if !defined(ONLY) || ONLY==7
                    for (int rep = 0; rep < REP_LIGHT; ++rep) glu_fix(HB, ACT, cwl, cbl, gtid, NT);
#endif
                } else if (step == 0) {
#if !defined(ONLY) || ONLY==9
                    pg8::Gemm g{XH + (size_t)c * CHUNK * DM, (const bf16_t*)((const unsigned char*)Wl + W_UP_OFF), CHUNK, NUP, DM};
                    pg8::StaticOrder S; S.init(g.M, g.N, G, bx);
                    EpiGlu E{ACT, HB, cwl, cbl};
                    for (int rep = 0; rep < REP_UP; ++rep) pg8::gemm_phase<EpiGlu, pg8::StaticOrder, PG8_ALIGN, PG8_SP2>(ring, g, S, E);
#endif
                } else {
#if !defined(ONLY) || ONLY==8
                    pg8::Gemm g; bf16_t* O;
                    if (q == 3) { g = pg8::Gemm{XH, (const bf16_t*)((const unsigned char*)Wl + W_OUT_OFF), MTOK, DM, DM}; O = Z; }
                    else { g = pg8::Gemm{ACT, (const bf16_t*)((const unsigned char*)Wl + W_DOWN_OFF), CHUNK, DM, DFF}; O = XH + (size_t)c * CHUNK * DM; }
                    pg8::StaticOrder S; S.init(g.M, g.N, G, bx);
                    pg8::EpiBf16<0> E{O, DM, nullptr, 0, 0, 1.f};
                    for (int rep = 0; rep < REP_PLAIN; ++rep) pg8::gemm_phase<pg8::EpiBf16<0>, pg8::StaticOrder, PG8_ALIGN, PG8_SP2>(ring, g, S, E);
#endif
                }
            }
        }
        if (ph + 1 < p.ph_hi) { for (int rep = 0; rep < REP_SYNC; ++rep) { if (MK_MULTI == 0 && ph != 0) xcd_barrier(xbar); else grid.sync(); } }
    }
}

extern "C" void kernel_launch(void* const* d_in, const int* in_sizes, int n_in, void* d_out, int out_size, void* d_ws, size_t ws_size, hipStream_t stream) {
    static int grid = 0;
    if (grid == 0) {
        if (n_in != 17 || out_size != MTOK * DM || ws_size < WS_END) { fprintf(stderr, "kernel_launch: unexpected shapes: n_in %d out %d ws %zu (need %zu)\n", n_in, out_size, ws_size, (size_t)WS_END); grid = -1; return; }
        int dev = 0, cus = 0, per_cu = 0;
        if (hipGetDevice(&dev) != hipSuccess || hipDeviceGetAttribute(&cus, hipDeviceAttributeMultiprocessorCount, dev) != hipSuccess) { grid = -1; return; }
        if (hipFuncSetAttribute((const void*)mega_fwd, hipFuncAttributeMaxDynamicSharedMemorySize, LDS_BYTES) != hipSuccess) { fprintf(stderr, "kernel_launch: hipFuncSetAttribute failed\n"); grid = -1; return; }
        if (hipOccupancyMaxActiveBlocksPerMultiprocessor(&per_cu, (const void*)mega_fwd, 512, LDS_BYTES) != hipSuccess || per_cu < 1) { fprintf(stderr, "kernel_launch: occupancy query says %d\n", per_cu); per_cu = 1; }
        (void)hipGetLastError();
        grid = cus * 1;
    }
    if (grid < 0) return;
    if (hipMemsetAsync((char*)d_ws + WS_BAR, 0, BAR_BYTES, stream) != hipSuccess) { fprintf(stderr, "kernel_launch: memset failed\n"); return; }
    Params p{};
    for (int i = 0; i < 17; ++i) p.in[i] = (const float*)d_in[i];
    p.out = (float*)d_out; p.ws = (unsigned char*)d_ws;
#if MK_MULTI
    for (int ph = 0; ph < NPHASE; ++ph) { p.ph_lo = ph; p.ph_hi = ph + 1; hipLaunchKernelGGL(mega_fwd, dim3(grid), dim3(512), LDS_BYTES, stream, p); }
#else
    p.ph_lo = 0; p.ph_hi = NPHASE;
    void* args[] = {&p};
    hipError_t e = hipLaunchCooperativeKernel((const void*)mega_fwd, dim3(grid), dim3(512), args, LDS_BYTES, stream);
    if (e != hipSuccess) fprintf(stderr, "cooperative launch failed: %s (grid %d)\n", hipGetErrorString(e), grid);
#endif
}
```

```cpp
#include <hip/hip_runtime.h>
#include <hip/hip_bf16.h>
#include <hip/hip_cooperative_groups.h>
#include <cstdio>
#include <cstdint>
#ifndef MK_MULTI
#define MK_MULTI 0
#endif
__device__ __forceinline__ int ltid() { int t = threadIdx.x; asm volatile("" : "+v"(t)); return t; }
#ifndef REP_UP
#define REP_UP 1
#endif
#ifndef REP_ATTN
#define REP_ATTN 1
#endif
#ifndef REP_PLAIN
#define REP_PLAIN 1
#endif
#ifndef REP_WIN
#define REP_WIN 1
#endif
#ifndef REP_P0
#define REP_P0 1
#endif
#ifndef REP_LIGHT
#define REP_LIGHT 1
#endif
#ifndef REP_SYNC
#define REP_SYNC 1
#endif
#ifndef REP_ROPE
#define REP_ROPE 1
#endif
#ifndef REP_RES
#define REP_RES 1
#endif
#ifndef REP_POOL
#define REP_POOL 1
#endif
namespace pg8 {
#define PG8_LAS __attribute__((address_space(3)))
typedef unsigned short bf16_t;
typedef short bf16x8 __attribute__((ext_vector_type(8)));
typedef float f32x4 __attribute__((ext_vector_type(4)));
typedef unsigned u32x4 __attribute__((ext_vector_type(4)));
constexpr int BM = 256, BK = 64, HALF = 128, HTB = HALF * BK * 2  , STAGE_BYTES = 8 * HTB, NXCD = 8, WGM = 8;

__host__ __device__ __forceinline__ int lds_byte(int r, int c) { const int st = (r >> 4) * 2 + (c >> 5), rr = r & 15, cc = c & 31, ob = rr * 64 + cc * 2; return st * 1024 + (ob ^ (((ob >> 9) & 1) << 5)); }
__host__ __device__ __forceinline__ void stage_rc(int b, int& R, int& C) { const int st = b / 1024, sb = b % 1024, swz = sb ^ (((sb >> 9) & 1) << 5); R = (st >> 1) * 16 + swz / 64; C = (st & 1) * 32 + (swz % 64) / 2; }
__host__ __device__ __forceinline__ int perm32(int rho) { const int n = rho >> 4, i = rho & 15; return 8 * (i >> 2) + 4 * n + (i & 3); }

struct Unit { int pm, pn; };
struct Gemm { const bf16_t* A; const bf16_t* Bt; int M, N, K; };

struct StaticOrder {
    int nM, nN, nwg, G, c;
    __host__ __device__ void init(int M, int N, int G_, int c_) { nM = M / BM; nN = N / BM; nwg = nM * nN; G = G_; c = c_; }
    __host__ __device__ bool next(int i, Unit& u) const {
        const long L = (long)i * G + c; if (L >= nwg) return false;
        int wgid = (int)L; { const int q = nwg / NXCD, r = nwg % NXCD, xcd = wgid % NXCD, off = wgid / NXCD; wgid = (xcd < r ? xcd * (q + 1) : r * (q + 1) + (xcd - r) * q) + off; }
        const int nig = WGM * nN, gid = wgid / nig, fm = gid * WGM, gsz = (nM - fm) < WGM ? (nM - fm) : WGM;
        u.pm = fm + ((wgid % nig) % gsz); u.pn = (wgid % nig) / gsz; return true;
    }
    __device__ __forceinline__ void a_ready(const Unit&) const {}
    __device__ __forceinline__ void done(const Unit&) const {}
};

__device__ __forceinline__ unsigned cvt_pk_bf16(float lo, float hi) { unsigned r; asm volatile("v_cvt_pk_bf16_f32 %0, %1, %2" : "=v"(r) : "v"(lo), "v"(hi)); return r; }
typedef float f32x2 __attribute__((ext_vector_type(2)));
__device__ __forceinline__ f32x2 gelu_pk(f32x2 v) {
    const f32x2 av = __builtin_elementwise_abs(v), d = av * 0.2316418882f + 1.0f;
    f32x2 t; t.x = __builtin_amdgcn_rcpf(d.x); t.y = __builtin_amdgcn_rcpf(d.y);
    f32x2 q = t * 0.5307027145f + (-0.7265760135f); q = q * t + 0.7107068705f; q = q * t + (-0.142248368f); q = q * t + 0.127414796f; q = q * t;
    const f32x2 s = (v * v) * (-0.72134752044f);
    f32x2 e; e.x = __builtin_amdgcn_exp2f(s.x); e.y = __builtin_amdgcn_exp2f(s.y);
    const f32x2 m = v * (q * e), r = v - m;
    f32x2 o; o.x = v.x < 0.f ? m.x : r.x; o.y = v.y < 0.f ? m.y : r.y; return o;
}

template <int ACT  > struct EpiBf16 {
    static constexpr bool PERM = true, AFTER_DRAIN = false; static_assert(ACT == 0 || ACT == 1, "EpiBf16: ACT is 0 (none) or 1 (gelu_pk)");
    bf16_t* O; int ldc; const float* bias; int split_cols; size_t split_stride; float scale0;
    __device__ __forceinline__ void operator()(const f32x4 (&acc)[2][2][4][2], const Unit& u, int wr, int wc, int fr, int fq) const {
        const int row0 = u.pm * BM + wr * 64 + fr; int colt = u.pn * BM; bf16_t* base = O;
        float sc = 1.f; if (split_cols) { const int t = colt / split_cols; base += (size_t)t * split_stride; colt -= t * split_cols; if (t == 0) sc = scale0; }
        const int col0 = colt + wc * 32 + 8 * fq, bcol0 = u.pn * BM + wc * 32 + 8 * fq;
        f32x4 bv[2][2];
#pragma unroll
        for (int bj = 0; bj < 2; ++bj)
#pragma unroll
            for (int n = 0; n < 2; ++n) bv[bj][n] = bias ? *(const f32x4*)(bias + bcol0 + bj * HALF + 4 * n) : (f32x4){0.f, 0.f, 0.f, 0.f};
#pragma unroll
        for (int ai = 0; ai < 2; ++ai)
#pragma unroll
            for (int m = 0; m < 4; ++m) { bf16_t* rowp = base + (size_t)(row0 + ai * HALF + m * 16) * ldc + col0;
#pragma unroll
                for (int bj = 0; bj < 2; ++bj) { f32x4 v0 = acc[ai][bj][m][0] + bv[bj][0], v1 = acc[ai][bj][m][1] + bv[bj][1];
                    if (ACT == 1) { f32x2 a = gelu_pk((f32x2){v0[0], v0[1]}), b = gelu_pk((f32x2){v0[2], v0[3]}), c = gelu_pk((f32x2){v1[0], v1[1]}), d = gelu_pk((f32x2){v1[2], v1[3]});
                        v0 = (f32x4){a.x, a.y, b.x, b.y}; v1 = (f32x4){c.x, c.y, d.x, d.y}; }
                    v0 = v0 * sc; v1 = v1 * sc; u32x4 w; w.x = cvt_pk_bf16(v0[0], v0[1]); w.y = cvt_pk_bf16(v0[2], v0[3]); w.z = cvt_pk_bf16(v1[0], v1[1]); w.w = cvt_pk_bf16(v1[2], v1[3]);
                    *(u32x4*)(rowp + bj * HALF) = w; } }
    }
};
template <class Epi, class Sched, bool ALIGN_EPI = false, bool SP2 = false>
__device__ __forceinline__ void gemm_phase(PG8_LAS unsigned char* lds, const Gemm g, const Sched& S, const Epi& E) {
    const int tid = ltid(), wid = __builtin_amdgcn_readfirstlane(tid >> 6), lane = tid & 63, wr = wid >> 2, wc = wid & 3, fr = lane & 15, fq = lane >> 4;
    const int K = g.K, nt = K / BK;
    unsigned voffA[2], voffB[2];
#pragma unroll
    for (int i = 0; i < 2; ++i) { int R, C; stage_rc(tid * 16 + i * 8192, R, C); const int Rb = Epi::PERM ? ((R & ~31) + perm32(R & 31)) : R;
        voffA[i] = (unsigned)(R * K + C) * 2u; voffB[i] = (unsigned)(Rb * K + C) * 2u; }
    const size_t kstep = (size_t)(BK * 2);
    const size_t hstep = (size_t)HALF * K * 2;
    const size_t tstep = 2 * hstep;
    const unsigned ldsw = (unsigned)wid * 1024u;
    const int aoff = lds_byte(wr * 64 + fr, fq * 8), boff = lds_byte(wc * 32 + fr, fq * 8);
#define PG8_SA(b, h) (((b) * 2 + (h)) * HTB)
#define PG8_SB(b, h) ((4 + (b) * 2 + (h)) * HTB)
#define PG8_STAGE(bufoff, gbase, voff) do { _Pragma("unroll") for (int _i = 0; _i < 2; ++_i) \
        __builtin_amdgcn_global_load_lds((const unsigned*)((const char*)(gbase) + (voff)[_i]), (PG8_LAS unsigned*)(lds + (bufoff) + ldsw + _i * 8192), 16, 0, 0); } while (0)
#define PG8_LDA(dst, b, h) do { _Pragma("unroll") for (int m = 0; m < 4; ++m) _Pragma("unroll") for (int k = 0; k < 2; ++k) dst[m][k] = *(const PG8_LAS bf16x8*)(lds + PG8_SA(b, h) + aoff + m * 2048 + k * 1024); } while (0)
#define PG8_LDB(dst, b, h) do { _Pragma("unroll") for (int n = 0; n < 2; ++n) _Pragma("unroll") for (int k = 0; k < 2; ++k) dst[n][k] = *(const PG8_LAS bf16x8*)(lds + PG8_SB(b, h) + boff + n * 2048 + k * 1024); } while (0)
#define PG8_MMA(ai, bj, At, Bt) do { __builtin_amdgcn_s_setprio(1); _Pragma("unroll") for (int m = 0; m < 4; ++m) _Pragma("unroll") for (int n = 0; n < 2; ++n) _Pragma("unroll") for (int k = 0; k < 2; ++k) \
        acc[ai][bj][m][n] = __builtin_amdgcn_mfma_f32_16x16x32_bf16(Bt[n][k], At[m][k], acc[ai][bj][m][n], 0, 0, 0); __builtin_amdgcn_s_setprio(0); } while (0)
#define PG8_WAIT_V(n) asm volatile("s_waitcnt vmcnt(" #n ")" ::: "memory")
#define PG8_WAIT_L(n) asm volatile("s_waitcnt lgkmcnt(" #n ")" ::: "memory")
#define PG8_BAR __builtin_amdgcn_s_barrier()
#define PG8_SCHED __builtin_amdgcn_sched_barrier(0)
    Unit cur, nxt; int ui = 0;
    if (!S.next(0, cur)) return;
    f32x4 acc[2][2][4][2];
#pragma unroll
    for (int a = 0; a < 2; ++a)
#pragma unroll
        for (int b = 0; b < 2; ++b)
#pragma unroll
            for (int m = 0; m < 4; ++m)
#pragma unroll
                for (int n = 0; n < 2; ++n) acc[a][b][m][n] = (f32x4){0.f, 0.f, 0.f, 0.f};
    bf16x8 At[4][2], B0[2][2], B1[2][2];
    const char* cA = (const char*)g.A + (size_t)cur.pm * tstep; const char* cB = (const char*)g.Bt + (size_t)cur.pn * tstep;
    S.a_ready(cur);
    if constexpr (SP2) {
        PG8_STAGE(PG8_SB(0, 0), cB, voffB); PG8_STAGE(PG8_SB(0, 1), cB + hstep, voffB); PG8_STAGE(PG8_SA(0, 0), cA, voffA); PG8_STAGE(PG8_SA(0, 1), cA + hstep, voffA);
        if (wr == 1) PG8_BAR;
        PG8_WAIT_V(2); PG8_BAR;
        PG8_STAGE(PG8_SB(1, 0), cB + kstep, voffB); PG8_STAGE(PG8_SA(1, 0), cA + kstep, voffA); PG8_STAGE(PG8_SB(1, 1), cB + hstep + kstep, voffB);
        PG8_WAIT_V(6); PG8_BAR;
    } else {
        PG8_STAGE(PG8_SB(0, 0), cB, voffB); PG8_STAGE(PG8_SA(0, 0), cA, voffA); PG8_STAGE(PG8_SB(0, 1), cB + hstep, voffB); PG8_STAGE(PG8_SA(0, 1), cA + hstep, voffA);
        if (wr == 1) PG8_BAR;
        PG8_WAIT_V(4); PG8_BAR;
        PG8_STAGE(PG8_SB(1, 0), cB + kstep, voffB); PG8_STAGE(PG8_SA(1, 0), cA + kstep, voffA); PG8_STAGE(PG8_SB(1, 1), cB + hstep + kstep, voffB);
        PG8_WAIT_V(6); PG8_BAR;
    }
    for (;;) {
        const bool has_next = S.next(ui + 1, nxt);
        const char* nA = has_next ? (const char*)g.A + (size_t)nxt.pm * tstep : cA; const char* nB = has_next ? (const char*)g.Bt + (size_t)nxt.pn * tstep : cB;
        for (int t = 0; t < nt; t += 2) {
            const bool last = (t == nt - 2);
            const char* a1 = cA + (size_t)(t + 1) * kstep;
            const char* a2 = last ? nA : cA + (size_t)(t + 2) * kstep; const char* b2 = last ? nB : cB + (size_t)(t + 2) * kstep;
            const char* a3 = a2 + kstep; const char* b3 = b2 + kstep;
            if (last && has_next) S.a_ready(nxt);
            if constexpr (SP2) {
            PG8_LDB(B0, 0, 0); PG8_LDB(B1, 0, 1); PG8_SCHED; PG8_LDA(At, 0, 0); PG8_STAGE(PG8_SA(1, 1), a1 + hstep, voffA);
            PG8_WAIT_V(8); PG8_WAIT_L(0); PG8_BAR; PG8_MMA(0, 0, At, B0); PG8_MMA(0, 1, At, B1); PG8_BAR; PG8_SCHED;
            PG8_LDA(At, 0, 1); PG8_STAGE(PG8_SB(0, 0), b2, voffB); PG8_STAGE(PG8_SB(0, 1), b2 + hstep, voffB); PG8_STAGE(PG8_SA(0, 0), a2, voffA);
            PG8_WAIT_V(8); PG8_WAIT_L(0); PG8_BAR; PG8_MMA(1, 0, At, B0); PG8_MMA(1, 1, At, B1); PG8_BAR; PG8_SCHED;
            PG8_LDB(B0, 1, 0); PG8_LDB(B1, 1, 1); PG8_SCHED; PG8_LDA(At, 1, 0); PG8_STAGE(PG8_SA(0, 1), a2 + hstep, voffA);
            PG8_WAIT_V(8); PG8_WAIT_L(0); PG8_BAR; PG8_MMA(0, 0, At, B0); PG8_MMA(0, 1, At, B1); PG8_BAR; PG8_SCHED;
            PG8_LDA(At, 1, 1); PG8_STAGE(PG8_SB(1, 0), b3, voffB); PG8_STAGE(PG8_SB(1, 1), b3 + hstep, voffB); PG8_STAGE(PG8_SA(1, 0), a3, voffA);
            PG8_WAIT_V(8); PG8_WAIT_L(0); PG8_BAR; PG8_MMA(1, 0, At, B0); PG8_MMA(1, 1, At, B1); PG8_BAR; PG8_SCHED;
            } else {
            PG8_LDB(B0, 0, 0); PG8_SCHED; PG8_LDA(At, 0, 0); PG8_STAGE(PG8_SA(1, 1), a1 + hstep, voffA);
            PG8_WAIT_L(8); PG8_BAR; PG8_WAIT_L(0); PG8_MMA(0, 0, At, B0); PG8_BAR; PG8_SCHED;
            PG8_LDB(B1, 0, 1); PG8_STAGE(PG8_SB(0, 0), b2, voffB);
            PG8_BAR; PG8_WAIT_L(0); PG8_MMA(0, 1, At, B1); PG8_BAR;
            PG8_LDA(At, 0, 1); PG8_STAGE(PG8_SA(0, 0), a2, voffA);
            PG8_BAR; PG8_WAIT_L(0); PG8_MMA(1, 0, At, B0); PG8_BAR; PG8_SCHED;
            PG8_STAGE(PG8_SB(0, 1), b2 + hstep, voffB);
            PG8_WAIT_V(6); PG8_BAR; PG8_MMA(1, 1, At, B1); PG8_BAR;
            PG8_LDB(B0, 1, 0); PG8_SCHED; PG8_LDA(At, 1, 0); PG8_STAGE(PG8_SA(0, 1), a2 + hstep, voffA);
            PG8_WAIT_L(8); PG8_BAR; PG8_WAIT_L(0); PG8_MMA(0, 0, At, B0); PG8_BAR; PG8_SCHED;
            PG8_LDB(B1, 1, 1); PG8_STAGE(PG8_SB(1, 0), b3, voffB);
            PG8_BAR; PG8_WAIT_L(0); PG8_MMA(0, 1, At, B1); PG8_BAR;
            PG8_LDA(At, 1, 1); PG8_STAGE(PG8_SA(1, 0), a3, voffA);
            PG8_BAR; PG8_WAIT_L(0); PG8_MMA(1, 0, At, B0); PG8_BAR; PG8_SCHED;
            PG8_STAGE(PG8_SB(1, 1), b3 + hstep, voffB);
            PG8_WAIT_V(6); PG8_BAR; PG8_MMA(1, 1, At, B1); PG8_BAR;
            }
        }
        if constexpr (ALIGN_EPI) { if (wr == 0) PG8_BAR; }
        if constexpr (!Epi::AFTER_DRAIN) { E(acc, cur, wr, wc, fr, fq); S.done(cur); }
        if (!has_next) break;
#pragma unroll
        for (int a = 0; a < 2; ++a)
#pragma unroll
            for (int b = 0; b < 2; ++b)
#pragma unroll
                for (int m = 0; m < 4; ++m)
#pragma unroll
                    for (int n = 0; n < 2; ++n) acc[a][b][m][n] = (f32x4){0.f, 0.f, 0.f, 0.f};
        cur = nxt; cA = nA; cB = nB; ++ui;
        if constexpr (ALIGN_EPI) { if (wr == 1) PG8_BAR; }
    }
    PG8_WAIT_V(0);
    if constexpr (!ALIGN_EPI) { if (wr == 0) PG8_BAR; }
    PG8_BAR;
    if constexpr (Epi::AFTER_DRAIN) { E.fused(acc, cur, wr, wc, fr, fq, lds, wid, lane); S.done(cur); }
#undef PG8_SA
#undef PG8_SB
#undef PG8_STAGE
#undef PG8_LDA
#undef PG8_LDB
#undef PG8_MMA
#undef PG8_WAIT_V
#undef PG8_WAIT_L
#undef PG8_BAR
#undef PG8_SCHED
}
}
#define PG8_SP2 true
#define PG8_ALIGN true
namespace att {
using bf16 = __hip_bfloat16;
constexpr int   D = 128, NW = 8, QBLK = 32, KVBLK = 64;
constexpr float SCALE = 0.088388347648318440f;
constexpr float THR = 8.f;
constexpr int SDEPTH = 2;
constexpr bool STATIC_MAX = true;
constexpr int LDQ = 2048, LDK = 2048, LDO = 2048;
constexpr size_t SHM_V = KVBLK * D * 2, SHM_K = KVBLK * D * 2, SHM_ATTN = 2 * SHM_V + 2 * SHM_K + NW * 64 * 4;
using bf16x8 = __attribute__((ext_vector_type(8))) short;
using s16x4  = __attribute__((ext_vector_type(4))) short;
using f32x16 = __attribute__((ext_vector_type(16))) float;
using f32x8  = __attribute__((ext_vector_type(8))) float;
using u32x4  = __attribute__((ext_vector_type(4))) unsigned;
#define KSWZ(row, colB) ((row) * 256 + ((colB) ^ (((row) & 7) << 4)))
#define SBAR() __builtin_amdgcn_sched_barrier(0)
__device__ __forceinline__ int crow(int r, int hi) { return (r & 3) + 8 * (r >> 2) + 4 * hi; }
__device__ __forceinline__ unsigned cvtpk(float lo, float hi) {
  unsigned r; asm volatile("v_cvt_pk_bf16_f32 %0, %1, %2" : "=v"(r) : "v"(lo), "v"(hi)); return r;
}
template <typename TIn> struct Stage;
template <> struct Stage<bf16>  { using T = bf16x8;
  __device__ static __forceinline__ T ld8(const bf16* p) { return *reinterpret_cast<const bf16x8*>(p); }
  __device__ static __forceinline__ bf16x8 tobf(T x) { return x; } };
template <> struct Stage<float> { using T = f32x8;
  __device__ static __forceinline__ T ld8(const float* p) { return *reinterpret_cast<const f32x8*>(p); }
  __device__ static __forceinline__ bf16x8 tobf(T x) {
    u32x4 w = {cvtpk(x[0], x[1]), cvtpk(x[2], x[3]), cvtpk(x[4], x[5]), cvtpk(x[6], x[7])}; return *reinterpret_cast<bf16x8*>(&w); } };

__device__ __forceinline__ void partialSM(f32x16& p0, f32x16& p1, float& m_reg, float& mn, float& alpha) {
  constexpr float C = SCALE * 1.4426950408889634f;
  if constexpr (STATIC_MAX) { mn = m_reg; alpha = 1.f; }
  else {
  float pmax = p0[0]; for (int r = 1; r < 16; ++r) pmax = fmaxf(pmax, p0[r]); for (int r = 0; r < 16; ++r) pmax = fmaxf(pmax, p1[r]);
  { auto rr = __builtin_amdgcn_permlane32_swap(__float_as_uint(pmax), __float_as_uint(pmax), false, false);
    pmax = fmaxf(__uint_as_float(rr[0]), __uint_as_float(rr[1])); }
  if (__builtin_expect(__all(pmax - m_reg <= THR / SCALE), 1)) { mn = m_reg; alpha = 1.f; }
  else { mn = fmaxf(m_reg, pmax); alpha = __builtin_amdgcn_exp2f((m_reg - mn) * C); m_reg = mn; }
  }
  float mnC = -mn * C;
  for (int r = 0; r < 16; ++r) p0[r] = fmaf(p0[r], C, mnC); for (int r = 0; r < 16; ++r) p1[r] = fmaf(p1[r], C, mnC);
  for (int r = 0; r < 16; ++r) p0[r] = __builtin_amdgcn_exp2f(p0[r]);
}
__device__ __forceinline__ void finishSM(f32x16& p0, f32x16& p1, float alpha, float& l_reg, bf16x8& pa0, bf16x8& pa1, bf16x8& pa2, bf16x8& pa3) {
  for (int r = 0; r < 16; ++r) p1[r] = __builtin_amdgcn_exp2f(p1[r]);
  float ps = 0; for (int r = 0; r < 16; ++r) ps += p0[r]; for (int r = 0; r < 16; ++r) ps += p1[r];
  { auto rr = __builtin_amdgcn_permlane32_swap(__float_as_uint(ps), __float_as_uint(ps), false, false);
    ps = __uint_as_float(rr[0]) + __uint_as_float(rr[1]); }
  l_reg = l_reg * alpha + ps;
#define PK4(P, BASE, OUT) do { unsigned a0 = cvtpk(P[BASE + 0], P[BASE + 1]), a1 = cvtpk(P[BASE + 2], P[BASE + 3]);   \
    unsigned b0 = cvtpk(P[BASE + 4], P[BASE + 5]), b1 = cvtpk(P[BASE + 6], P[BASE + 7]);                              \
    auto r0 = __builtin_amdgcn_permlane32_swap(a0, b0, false, false); auto r1 = __builtin_amdgcn_permlane32_swap(a1, b1, false, false); \
    u32x4 w = {r0[0], r1[0], r0[1], r1[1]}; OUT = *reinterpret_cast<bf16x8*>(&w); } while (0)
  PK4(p0, 0, pa0); PK4(p0, 8, pa1); PK4(p1, 0, pa2); PK4(p1, 8, pa3);
#undef PK4
}
__device__ __forceinline__ void qkt(f32x16& p0, f32x16& p1, const bf16* Ks, const bf16x8* qr, int r32, int hi) {
  p0 = f32x16{}; p1 = f32x16{};
  for (int d0 = 0; d0 < 8; ++d0) { int cb = (d0 * 16 + hi * 8) * 2;
    bf16x8 b0 = *reinterpret_cast<const bf16x8*>((const char*)Ks + KSWZ(r32, cb));
    bf16x8 b1 = *reinterpret_cast<const bf16x8*>((const char*)Ks + KSWZ(32 + r32, cb));
    p0 = __builtin_amdgcn_mfma_f32_32x32x16_bf16(b0, qr[d0], p0, 0, 0, 0);
    p1 = __builtin_amdgcn_mfma_f32_32x32x16_bf16(b1, qr[d0], p1, 0, 0, 0); }
}
__device__ __forceinline__ int v_st(int k, int c) { const int kk = (k & ~0xC) | ((k & 4) << 1) | ((k & 8) >> 1); return ((kk >> 3) * 4 + (c >> 5)) * 512 + ((kk & 7) * 32 + (c & 31)) * 2; }
__device__ __forceinline__ int v_rd_base(int lane) { return ((lane & 3) << 3) | (((lane >> 2) & 3) << 6) | (((lane >> 4) & 1) << 5) | (((lane >> 5) & 1) << 8); }
constexpr int v_rd_off(int d0, int ks, int half) { return d0 * 512 + ks * 4096 + half * 2048; }
template <int OFF> __device__ __forceinline__ s16x4 tr_read(int vb) {
  s16x4 r; asm volatile("ds_read_b64_tr_b16 %0, %1 offset:%2" : "=&v"(r) : "v"(vb), "i"(OFF) : "memory"); return r;
}
template <int D0> __device__ __forceinline__ void pv_one(f32x16& od, int vb, bf16x8 pa0, bf16x8 pa1, bf16x8 pa2, bf16x8 pa3) {
  const s16x4 l0 = tr_read<v_rd_off(D0, 0, 0)>(vb), h0 = tr_read<v_rd_off(D0, 0, 1)>(vb), l1 = tr_read<v_rd_off(D0, 1, 0)>(vb), h1 = tr_read<v_rd_off(D0, 1, 1)>(vb);
  const s16x4 l2 = tr_read<v_rd_off(D0, 2, 0)>(vb), h2 = tr_read<v_rd_off(D0, 2, 1)>(vb), l3 = tr_read<v_rd_off(D0, 3, 0)>(vb), h3 = tr_read<v_rd_off(D0, 3, 1)>(vb);
  asm volatile("s_waitcnt lgkmcnt(0)" ::: "memory"); SBAR();
#define PK(L, H) (bf16x8){L[0], L[1], L[2], L[3], H[0], H[1], H[2], H[3]}
  od = __builtin_amdgcn_mfma_f32_32x32x16_bf16(pa0, PK(l0, h0), od, 0, 0, 0);
  od = __builtin_amdgcn_mfma_f32_32x32x16_bf16(pa1, PK(l1, h1), od, 0, 0, 0);
  od = __builtin_amdgcn_mfma_f32_32x32x16_bf16(pa2, PK(l2, h2), od, 0, 0, 0);
  od = __builtin_amdgcn_mfma_f32_32x32x16_bf16(pa3, PK(l3, h3), od, 0, 0, 0);
#undef PK
}
__device__ __forceinline__ void pv_d0(f32x16* o, int vb, bf16x8 pa0, bf16x8 pa1, bf16x8 pa2, bf16x8 pa3) {
  pv_one<0>(o[0], vb, pa0, pa1, pa2, pa3); pv_one<1>(o[1], vb, pa0, pa1, pa2, pa3); pv_one<2>(o[2], vb, pa0, pa1, pa2, pa3); pv_one<3>(o[3], vb, pa0, pa1, pa2, pa3);
}
template <typename TQ>
__device__ __forceinline__ void attn_dense_body(const TQ* __restrict__ Qb, const bf16* __restrict__ Kh, const bf16* __restrict__ Vh,
                                                bf16* __restrict__ Ob, int seq, char* lds, float bound) {
  using St = Stage<bf16>; using SQ = Stage<TQ>;
  const int tid = ltid(), wid = tid >> 6, lane = tid & 63, r32 = lane & 31, hi = lane >> 5;
  bf16* V_lds = (bf16*)lds; bf16* K_lds = (bf16*)(lds + 2 * SHM_V);
  float* ws = (float*)(lds + 2 * SHM_V + 2 * SHM_K) + wid * 64; float* li_l = ws; float* al_l = ws + 32;
  float m_reg = STATIC_MAX ? bound : -1e30f, l_reg = 0; f32x16 o[4] = {}; bf16x8 qr[8];
  const TQ* Qw = Qb + (long)(wid * QBLK + r32) * LDQ + hi * 8;
#pragma unroll
  for (int d0 = 0; d0 < 8; ++d0) qr[d0] = SQ::tobf(SQ::ld8(Qw + d0 * 16));
  const int sr = tid >> 4, sc = (tid & 15) * 8, vst0 = v_st(sr, sc), vst1 = v_st(32 + sr, sc);
  const int vb0 = (int)(uintptr_t)V_lds + v_rd_base(lane);
  struct { typename St::T vs0, vs1, ks0, ks1; } sr_[SDEPTH];
#define SLOAD(i, k0) do { sr_[i].vs0 = St::ld8(&Vh[(long)((k0) + sr) * LDK + sc]); sr_[i].vs1 = St::ld8(&Vh[(long)((k0) + 32 + sr) * LDK + sc]); \
    sr_[i].ks0 = St::ld8(&Kh[(long)((k0) + sr) * LDK + sc]); sr_[i].ks1 = St::ld8(&Kh[(long)((k0) + 32 + sr) * LDK + sc]); } while (0)
#define SWRITE(b, i) do { *(bf16x8*)((char*)V_lds + (b) * SHM_V + vst0) = St::tobf(sr_[i].vs0);          \
    *(bf16x8*)((char*)V_lds + (b) * SHM_V + vst1) = St::tobf(sr_[i].vs1); int kc = sc * 2;               \
    *(bf16x8*)((char*)K_lds + (b) * SHM_K + KSWZ(sr, kc)) = St::tobf(sr_[i].ks0);                       \
    *(bf16x8*)((char*)K_lds + (b) * SHM_K + KSWZ(32 + sr, kc)) = St::tobf(sr_[i].ks1); } while (0)
#define SWAIT() do { if constexpr (SDEPTH == 2) asm volatile("s_waitcnt vmcnt(4)" ::: "memory"); else asm volatile("s_waitcnt vmcnt(0)" ::: "memory"); } while (0)
#define RESC(a) do { if (!STATIC_MAX && __any((a) < 1.f)) { if (hi == 0) al_l[r32] = (a); asm volatile("s_waitcnt lgkmcnt(0)" ::: "memory"); \
    for (int d = 0; d < 4; ++d) for (int r = 0; r < 16; ++r) o[d][r] *= al_l[crow(r, hi)]; } } while (0)
  f32x16 pA0, pA1, pB0, pB1; float mnA, mnB, alA, alB; bf16x8 pa0, pa1, pa2, pa3; const int NT = seq / KVBLK;
  constexpr int SE = 0, SO = SDEPTH - 1;
  SLOAD(SE, 0); asm volatile("s_waitcnt vmcnt(0)" ::: "memory"); SWRITE(0, SE); __syncthreads();
  qkt(pA0, pA1, K_lds, qr, r32, hi); partialSM(pA0, pA1, m_reg, mnA, alA);
  SLOAD(SO, KVBLK); if constexpr (SDEPTH == 2) { if (2 < NT) SLOAD(SE, 2 * KVBLK); }
  SWAIT(); SWRITE(1, SO); __syncthreads();
  for (int j = 1; j + 1 < NT; j += 2) {
    SBAR(); qkt(pB0, pB1, (bf16*)((char*)K_lds + SHM_K), qr, r32, hi);
    finishSM(pA0, pA1, alA, l_reg, pa0, pa1, pa2, pa3); SBAR();
    SLOAD(SO, (j + SDEPTH) * KVBLK); SBAR();
    pv_d0(o, vb0, pa0, pa1, pa2, pa3); partialSM(pB0, pB1, m_reg, mnB, alB);
    __syncthreads(); SWAIT(); SWRITE(0, SE);
    RESC(alB); __syncthreads();
    SBAR(); qkt(pA0, pA1, K_lds, qr, r32, hi);
    finishSM(pB0, pB1, alB, l_reg, pa0, pa1, pa2, pa3); SBAR();
    if (SDEPTH == 1 || j + 3 < NT) SLOAD(SE, (j + 1 + SDEPTH) * KVBLK); SBAR();
    pv_d0(o, vb0 + (int)SHM_V, pa0, pa1, pa2, pa3); partialSM(pA0, pA1, m_reg, mnA, alA);
    __syncthreads(); SWAIT(); SWRITE(1, SO);
    RESC(alA); __syncthreads();
  }
  SBAR(); qkt(pB0, pB1, (bf16*)((char*)K_lds + SHM_K), qr, r32, hi);
  finishSM(pA0, pA1, alA, l_reg, pa0, pa1, pa2, pa3); SBAR();
  pv_d0(o, vb0, pa0, pa1, pa2, pa3); partialSM(pB0, pB1, m_reg, mnB, alB);
  __syncthreads(); RESC(alB);
  finishSM(pB0, pB1, alB, l_reg, pa0, pa1, pa2, pa3); SBAR();
  pv_d0(o, vb0 + (int)SHM_V, pa0, pa1, pa2, pa3);
  if (hi == 0) li_l[r32] = l_reg; asm volatile("s_waitcnt lgkmcnt(0)" ::: "memory");
  float rli[16];
#pragma unroll
  for (int r = 0; r < 16; ++r) rli[r] = __builtin_amdgcn_rcpf(li_l[crow(r, hi)]);
  bf16* Ow = Ob + (long)(wid * QBLK) * LDO;
#pragma unroll
  for (int r = 0; r < 16; ++r) { int orow = crow(r, hi);
    for (int d0 = 0; d0 < 4; ++d0) Ow[(long)orow * LDO + d0 * 32 + r32] = __float2bfloat16(o[d0][r] * rli[r]); }
#undef SLOAD
#undef SWRITE
#undef SWAIT
#undef RESC
}

template <int NC> __device__ __forceinline__ void pv_n(f32x16* o, int vb, bf16x8 pa0, bf16x8 pa1, bf16x8 pa2, bf16x8 pa3) {
  pv_one<0>(o[0], vb, pa0, pa1, pa2, pa3);
  if constexpr (NC > 1) pv_one<1>(o[1], vb, pa0, pa1, pa2, pa3);
  if constexpr (NC > 2) { pv_one<2>(o[2], vb, pa0, pa1, pa2, pa3); pv_one<3>(o[3], vb, pa0, pa1, pa2, pa3); }
}
template <int MB, int NKT, class BR, class ST>
__device__ __forceinline__ void dft_unit(const bf16* __restrict__ A, int lda, const BR& br, const ST& st, char* lds) {
  constexpr int NBW = 8 / MB, NC = 4 / NBW;
  const int tid = ltid(), wid = tid >> 6, lane = tid & 63, r32 = lane & 31, hi = lane >> 5;
  const int mb = wid % MB, cgp = wid / MB;
  const int sr = tid >> 4, sc = (tid & 15) * 8, vst0 = v_st(sr, sc), vst1 = v_st(32 + sr, sc);
  bf16x8 bq[NKT][2], af[NKT][4];
#pragma unroll
  for (int kt = 0; kt < NKT; ++kt) {
    bq[kt][0] = *reinterpret_cast<const bf16x8*>(br.row(kt * 64 + sr) + sc);
    bq[kt][1] = *reinterpret_cast<const bf16x8*>(br.row(kt * 64 + 32 + sr) + sc);
  }
  const bf16* Aw = A + (long)(mb * 32 + r32) * lda + hi * 8;
#pragma unroll
  for (int kt = 0; kt < NKT; ++kt)
#pragma unroll
    for (int ks = 0; ks < 4; ++ks) af[kt][ks] = *reinterpret_cast<const bf16x8*>(Aw + kt * 64 + ks * 16);
  __syncthreads();
#pragma unroll
  for (int kt = 0; kt < NKT; ++kt) {
    *(bf16x8*)(lds + kt * 16384 + vst0) = bq[kt][0];
    *(bf16x8*)(lds + kt * 16384 + vst1) = bq[kt][1];
  }
  __syncthreads();
  f32x16 o[NC];
#pragma unroll
  for (int d = 0; d < NC; ++d) o[d] = f32x16{};
  const int vb = (int)(uintptr_t)lds + v_rd_base(lane) + cgp * NC * 512;
#pragma unroll
  for (int kt = 0; kt < NKT; ++kt) pv_n<NC>(o, vb + kt * 16384, af[kt][0], af[kt][1], af[kt][2], af[kt][3]);
#pragma unroll
  for (int r = 0; r < 16; ++r) {
#pragma unroll
    for (int d = 0; d < NC; ++d) st(mb * 32 + crow(r, hi), (cgp * NC + d) * 32 + r32, o[d][r]);
  }
}
#undef SBAR
#undef KSWZ
}

namespace cg = cooperative_groups;
#define LAS __attribute__((address_space(3)))
typedef unsigned short bf16_t;
typedef unsigned v4u __attribute__((ext_vector_type(4)));
typedef unsigned v2u __attribute__((ext_vector_type(2)));
typedef float f4 __attribute__((ext_vector_type(4)));

#define XB_TMO      128
#define XB_XCNT(j)  (256  + 64 * (j))
#define XB_XSUB(j)  (1280 + 64 * (j))
#define XB_XGEN(j)  (2304 + 64 * (j))
#define XB_TOP      3328
#define XB_TOPGEN   3392
#define XCD_BAR_WORDS 3456
#define XB_SPIN_CAP (1u << 18)

__device__ __forceinline__ unsigned xb_ld(unsigned* p)              { return __hip_atomic_load(p, __ATOMIC_RELAXED, __HIP_MEMORY_SCOPE_AGENT); }
__device__ __forceinline__ unsigned xb_add(unsigned* p, unsigned v) { return __hip_atomic_fetch_add(p, v, __ATOMIC_RELAXED, __HIP_MEMORY_SCOPE_AGENT); }
__device__ __forceinline__ unsigned xb_xcc_id() { return (unsigned)__builtin_amdgcn_s_getreg((3 << 11) | 20) & 0xFu; }
#define XB_SPIN(cond, bar) do { unsigned _sp = 0; while (cond) { __builtin_amdgcn_s_sleep(1); \
    if ((++_sp & 255u) == 0u) { if (xb_ld(&(bar)[XB_TMO])) break; if (_sp > XB_SPIN_CAP) { atomicAdd(&(bar)[XB_TMO], 1u); break; } } } } while (0)

struct XcdBarrier {
    unsigned* bar; unsigned x;
    volatile LAS unsigned* st;
};

__device__ __forceinline__ XcdBarrier xcd_barrier_post(unsigned* bar, volatile LAS unsigned* st) {
    XcdBarrier b; b.bar = bar; b.x = xb_xcc_id(); b.st = st;
    if (threadIdx.x == 0) (void)xb_add(&bar[XB_XCNT(b.x)], 1u);
    return b;
}
__device__ __forceinline__ void xcd_barrier_complete(unsigned* bar, unsigned x, unsigned& nloc, unsigned& nx) {
    const unsigned G = gridDim.x * gridDim.y * gridDim.z;
    unsigned sum, cnt, mine, sp = 0u;
    for (;;) {
        sum = 0u; cnt = 0u; mine = 0u;
#pragma unroll
        for (unsigned j = 0; j < 16; ++j) { const unsigned c = xb_ld(&bar[XB_XCNT(j)]); sum += c; cnt += (c > 0u) ? 1u : 0u; mine = (j == x) ? c : mine; }
        if (sum == G) break;
        __builtin_amdgcn_s_sleep(1);
        if ((++sp & 255u) == 0u) { if (xb_ld(&bar[XB_TMO])) break; if (sp > XB_SPIN_CAP) { atomicAdd(&bar[XB_TMO], 1u); break; } }
    }
    nloc = mine > 0u ? mine : 1u; nx = cnt > 0u ? cnt : 1u;
}

__device__ __forceinline__ void xcd_barrier(const XcdBarrier& b) {
    asm volatile("s_waitcnt vmcnt(0)" ::: "memory");
    __syncthreads();
    if (threadIdx.x == 0) {
        unsigned* bar = b.bar;
        __builtin_amdgcn_s_waitcnt(0);
        unsigned nloc = b.st[0], nx = b.st[1];
        if (nloc == 0u) { xcd_barrier_complete(bar, b.x, nloc, nx); b.st[0] = nloc; b.st[1] = nx; }
        const unsigned old = xb_add(&bar[XB_XSUB(b.x)], 1u);
        const unsigned gen = old / nloc;
        if (old + 1u == (gen + 1u) * nloc) {
            __builtin_amdgcn_fence(__ATOMIC_RELEASE, "agent");
            asm volatile("s_waitcnt vmcnt(0)" ::: "memory");
            const unsigned og = xb_add(&bar[XB_TOP], 1u);
            const unsigned tg = og / nx;
            if (og + 1u == (tg + 1u) * nx) xb_add(&bar[XB_TOPGEN], 1u);
            else XB_SPIN(xb_ld(&bar[XB_TOPGEN]) == tg, bar);
            __builtin_amdgcn_fence(__ATOMIC_ACQUIRE, "agent");
            xb_add(&bar[XB_XGEN(b.x)], 1u);
            asm volatile("s_waitcnt vmcnt(0)" ::: "memory");
        } else {
            XB_SPIN(xb_ld(&bar[XB_XGEN(b.x)]) == gen, bar);
            __builtin_amdgcn_fence(__ATOMIC_ACQUIRE, "agent");
            asm volatile("s_waitcnt vmcnt(0)" ::: "memory");
        }
    }
    __syncthreads();
}

constexpr int DM = 2048, MTOK = 65536, NIN = 3072, DFF = 5632, NUP = 11264, WINW = 2560;
constexpr int NPROMPT = 32768;
constexpr int CHUNK = 65536, NCHUNK = 1;
constexpr float EPS = 1e-6f;
constexpr size_t MiB = (size_t)1 << 20;
constexpr size_t WS_M2F = 0;
constexpr size_t WS_COS = 1 * MiB, WS_SIN = 5 * MiB;
constexpr size_t WS_A1P = 9 * MiB, WS_A1S = 9 * MiB + 128 * 1024;
constexpr size_t WS_A3P = 10 * MiB, WS_A3S = 18 * MiB;
constexpr size_t WS_BAR = 19 * MiB, BAR_BYTES = 16384;
constexpr size_t WS_W = 20 * MiB;
constexpr size_t W_LAYER = 86 * MiB, W_OUT_OFF = 12 * MiB, W_UP_OFF = 20 * MiB, W_DOWN_OFF = 64 * MiB;
constexpr size_t WS_XH = 192 * MiB;
constexpr size_t WS_Z = 448 * MiB;
constexpr size_t WS_G = 704 * MiB;
constexpr size_t WS_Y = 832 * MiB;
constexpr size_t WS_ACT = 448 * MiB;
constexpr size_t WS_HB = 1152 * MiB;
constexpr size_t WS_XB = 1240 * MiB;
constexpr size_t WS_END = 1496 * MiB;
constexpr int LDS_BYTES = 135168;

__device__ __forceinline__ float bf2f(unsigned short b) { return __uint_as_float((unsigned)b << 16); }
__device__ __forceinline__ float bflo(unsigned w) { return __uint_as_float(w << 16); }
__device__ __forceinline__ float bfhi(unsigned w) { return __uint_as_float(w & 0xffff0000u); }
__device__ __forceinline__ unsigned pk2(float lo, float hi) { return pg8::cvt_pk_bf16(lo, hi); }
__device__ __forceinline__ float wave_sum(float v) {
#pragma unroll
    for (int o = 1; o < 64; o <<= 1) v += __shfl_xor(v, o);
    return v;
}

struct EpiWin {
    static constexpr bool PERM = true, AFTER_DRAIN = false;
    bf16_t* Z; bf16_t* Gp;
    __device__ __forceinline__ void operator()(const pg8::f32x4 (&acc)[2][2][4][2], const pg8::Unit& u, int wr, int wc, int fr, int fq) const {
        const int row0 = u.pm * pg8::BM + wr * 64 + fr;
        bf16_t* base; size_t rstride, bjstride;
        if (u.pn < 8) { base = Z + (size_t)row0 * 2048 + u.pn * 256 + wc * 32 + 8 * fq; rstride = 2048; bjstride = 128; }
        else {
            const int g = u.pn - 8, r0 = u.pm * pg8::BM; size_t sb; int L, t0;
            if (r0 < NPROMPT) { const int s = r0 >> 14; sb = (size_t)s * (2u * 16384u * 512u); L = 16384; t0 = row0 - s * 16384; }
            else { const int s = (r0 - NPROMPT) >> 12; sb = (size_t)NPROMPT * 1024 + (size_t)s * (2u * 4096u * 512u); L = 4096; t0 = row0 - NPROMPT - s * 4096; }
            base = Gp + sb + (size_t)t0 * 512 + g * 128 + wc * 32 + 8 * fq; rstride = 512; bjstride = (size_t)L * 512;
        }
#pragma unroll
        for (int ai = 0; ai < 2; ++ai)
#pragma unroll
            for (int m = 0; m < 4; ++m) { bf16_t* rowp = base + (size_t)(ai * pg8::HALF + m * 16) * rstride;
#pragma unroll
                for (int bj = 0; bj < 2; ++bj) { const pg8::f32x4 v0 = acc[ai][bj][m][0], v1 = acc[ai][bj][m][1];
                    pg8::u32x4 w; w.x = pk2(v0[0], v0[1]); w.y = pk2(v0[2], v0[3]); w.z = pk2(v1[0], v1[1]); w.w = pk2(v1[2], v1[3]);
                    *(pg8::u32x4*)(rowp + bj * bjstride) = w; } }
    }
};

__device__ __forceinline__ void p0a_tables(const float* fourier_w, unsigned char* ws, LAS float* tab, int gtid, int NT) {
    float* M2F = (float*)(ws + WS_M2F);
    { const int t = ltid(); if (t < 128) { float sn, cs; sincospif((float)t * (2.f / 128.f), &sn, &cs); tab[t] = cs; tab[128 + t] = -sn; } }
    __syncthreads();
    for (int i = gtid; i < 2 * 4 * 128 * 256; i += NT) {
        const int lg = i >> 15, c = (i >> 8) & 127, n = i & 255, part = n >> 7, e2 = n & 127;
        const float* fw = fourier_w + (size_t)lg * 16384 + e2;
        float acc = 0.f;
#pragma unroll 8
        for (int e = 0; e < 128; ++e) { const int r = (c * e) & 127; acc += tab[part * 128 + r] * fw[e * 128]; }
        M2F[i] = acc;
    }
    __syncthreads();
    float* COS = (float*)(ws + WS_COS); float* SIN = (float*)(ws + WS_SIN);
    for (int i = gtid; i < 16384 * 64; i += NT) {
        const int t = i >> 6, j = i & 63; const float pos = (float)(j < 32 ? (t >> 6) : (t & 63));
        const float inv = 1.0f / powf(10000.0f, (float)(j & 31) / 32.0f); const float ang = pos * inv;
        COS[i] = cosf(ang); SIN[i] = sinf(ang);
    }
    bf16_t* A1P = (bf16_t*)(ws + WS_A1P);
    for (int i = gtid; i < 256 * 256; i += NT) { const int m = i >> 8, k = i & 255, pm = m >> 7, k1 = m & 127, pk = k >> 7, t1 = k & 127; const int r = (t1 * k1) & 127;
        float sn, cs; sincospif((float)r * (2.f / 128.f), &sn, &cs); const float v = (pm == pk) ? cs : (pm == 0 ? sn : -sn); A1P[i] = (bf16_t)(pk2(v, 0.f) & 0xffff); }
    bf16_t* A1S = (bf16_t*)(ws + WS_A1S);
    for (int i = gtid; i < 128 * 128; i += NT) { const int m = i >> 7, k = i & 127, pm = m >> 6, k1 = m & 63, pk = k >> 6, t1 = k & 63; const int r = (t1 * k1) & 63;
        float sn, cs; sincospif((float)r * (2.f / 64.f), &sn, &cs); const float v = (pm == pk) ? cs : (pm == 0 ? sn : -sn); A1S[i] = (bf16_t)(pk2(v, 0.f) & 0xffff); }
    bf16_t* A3P = (bf16_t*)(ws + WS_A3P);
    for (int i = gtid; i < 128 * 128 * 256; i += NT) { const int k1 = i >> 15, k2 = (i >> 8) & 127, kk = i & 255, part = kk >> 7, t2 = kk & 127; const int k = k1 + 128 * k2; const int r = (t2 * k) & 16383;
        float sn, cs; sincospif((float)r * (1.f / 8192.f), &sn, &cs); A3P[i] = (bf16_t)(pk2(part ? sn : cs, 0.f) & 0xffff); }
    bf16_t* A3S = (bf16_t*)(ws + WS_A3S);
    for (int i = gtid; i < 64 * 64 * 128; i += NT) { const int k1 = i >> 13, k2 = (i >> 7) & 63, kk = i & 127, part = kk >> 6, t2 = kk & 63; const int k = k1 + 64 * k2; const int r = (t2 * k) & 4095;
        float sn, cs; sincospif((float)r * (1.f / 2048.f), &sn, &cs); A3S[i] = (bf16_t)(pk2(part ? sn : cs, 0.f) & 0xffff); }
}

struct ValUp { const float* W; __device__ __forceinline__ const float* ptr(int k, int n) const { const int src = ((n >> 7) & 1) * DFF + (n >> 8) * 128 + (n & 127); return W + (size_t)k * NUP + src; }
    __device__ __forceinline__ float operator()(int k, int n) const { return *ptr(k, n); } };
struct ValDirect { const float* W; int ldw; __device__ __forceinline__ const float* ptr(int k, int n) const { return W + (size_t)k * ldw + n; }
    __device__ __forceinline__ float operator()(int k, int n) const { return W[(size_t)k * ldw + n]; } };
struct ValWin { const float* win; const float* poolw; const float* pscale; const float* m2f;
    __device__ __forceinline__ const float* ptr(int k, int n) const { return win + (size_t)k * WINW + n; }
    __device__ __forceinline__ float operator()(int k, int n) const {
        if (n >= 512 && n < 2048) return win[(size_t)k * WINW + n];
        if (n < 512) { const int g = n >> 7, e = n & 127; const float* wr = win + (size_t)k * WINW + g * 128; const float* pw = poolw + g * 16384 + e; float acc = 0.f;
            for (int c = 0; c < 128; ++c) acc += wr[c] * pw[c * 128]; return acc * pscale[n]; }
        const int n2 = n - 2048, g = n2 >> 8, np = n2 & 255; const float* wr = win + (size_t)k * WINW + 2048 + g * 128; const float* mf = m2f + g * 32768 + np; float acc = 0.f;
        for (int c = 0; c < 128; ++c) acc += wr[c] * mf[c * 256]; return acc; } };
template <class F> __device__ __forceinline__ void transpose_item(const F& val, int K, bf16_t* WT, int k0, int n0, LAS float* scr, int lane) {
    for (int i = 0; i < 32; ++i) { const int kk = 2 * i + (lane >> 5); scr[kk * 33 + (lane & 31)] = val(k0 + kk, n0 + (lane & 31)); }
    asm volatile("s_waitcnt lgkmcnt(0)" ::: "memory");
    const int c = lane & 7;
#pragma unroll
    for (int j = 0; j < 4; ++j) { const int n = (lane >> 3) + 8 * j; const LAS float* s = scr + (8 * c) * 33 + n;
        v4u o; o.x = pk2(s[0 * 33], s[1 * 33]); o.y = pk2(s[2 * 33], s[3 * 33]); o.z = pk2(s[4 * 33], s[5 * 33]); o.w = pk2(s[6 * 33], s[7 * 33]);
        *(v4u*)(WT + (size_t)(n0 + n) * K + k0 + 8 * c) = o; }
    asm volatile("s_waitcnt lgkmcnt(0)" ::: "memory");
}
template <class F> __device__ __forceinline__ void tr_load(const F& f, int k0, int n0, int lane, f4 (&v)[8]) {
#pragma unroll
    for (int i = 0; i < 8; ++i) v[i] = __builtin_nontemporal_load((const f4*)f.ptr(k0 + 8 * i + (lane >> 3), n0 + 4 * (lane & 7)));
}
__device__ __forceinline__ void tr_store(const f4 (&v)[8], int K, bf16_t* WT, int k0, int n0, LAS float* scr, int lane) {
#pragma unroll
    for (int i = 0; i < 8; ++i) { LAS float* d = scr + (8 * i + (lane >> 3)) * 33 + 4 * (lane & 7); d[0] = v[i].x; d[1] = v[i].y; d[2] = v[i].z; d[3] = v[i].w; }
    asm volatile("s_waitcnt lgkmcnt(0)" ::: "memory");
    const int c = lane & 7;
#pragma unroll
    for (int j = 0; j < 4; ++j) { const int n = (lane >> 3) + 8 * j; const LAS float* s = scr + (8 * c) * 33 + n;
        v4u o; o.x = pk2(s[0 * 33], s[1 * 33]); o.y = pk2(s[2 * 33], s[3 * 33]); o.z = pk2(s[4 * 33], s[5 * 33]); o.w = pk2(s[6 * 33], s[7 * 33]);
        *(v4u*)(WT + (size_t)(n0 + n) * K + k0 + 8 * c) = o; }
    asm volatile("s_waitcnt lgkmcnt(0)" ::: "memory");
}
template <class F> __device__ __forceinline__ void transpose_matrix(const F& val, int K, int N, bf16_t* WT, LAS float* scr, int gw, int NGW, int lane, int nlo, int nhi) {
    const int nblk = (nhi - nlo) / 32, nitems = (K / 64) * nblk;
    int it = gw; if (it >= nitems) return;
    f4 cur[8], nxt[8];
    tr_load(val, 64 * (it / nblk), nlo + 32 * (it % nblk), lane, cur);
    for (; it < nitems; it += NGW) {
        const int k0 = 64 * (it / nblk), n0 = nlo + 32 * (it % nblk); const int it2 = it + NGW; const bool more = it2 < nitems;
        if (more) tr_load(val, 64 * (it2 / nblk), nlo + 32 * (it2 % nblk), lane, nxt);
        tr_store(cur, K, WT, k0, n0, scr, lane);
        if (more) {
#pragma unroll
            for (int i = 0; i < 8; ++i) cur[i] = nxt[i]; }
    }
}

typedef float __attribute__((address_space(4))) cf32;
__device__ __forceinline__ void fold_items(const float* win, const float* poolw, const float* pscale, const float* m2f, bf16_t* WT, int gw, int NGW, int lane) {
    for (int it = gw; it < 64 * 24; it += NGW) {
        const int kb = it / 24, nb = it - kb * 24, k0 = 32 * kb;
        float m2[128]; int base, nout;
        if (nb < 8) { const int n = nb * 64 + lane, g = nb >> 1, e = n & 127; base = g * 128; nout = n; const float sc = pscale[n]; const float* pw = poolw + g * 16384 + e;
#pragma unroll
            for (int c = 0; c < 128; ++c) m2[c] = pw[c * 128] * sc;
        } else { const int n2 = (nb - 8) * 64 + lane, g = (nb - 8) >> 2, np = n2 & 255; base = 2048 + g * 128; nout = 2048 + n2; const float* mf = m2f + g * 32768 + np;
#pragma unroll
            for (int c = 0; c < 128; ++c) m2[c] = mf[c * 256];
        }
        bf16_t* wrow = WT + (size_t)nout * DM + k0;
        for (int kg = 0; kg < 4; ++kg) {
            float acc[8];
#pragma unroll
            for (int kk = 0; kk < 8; ++kk) { const cf32* wr = (const cf32*)(unsigned long long)(win + (size_t)(k0 + 8 * kg + kk) * WINW + base); float a = 0.f;
#pragma unroll
                for (int c = 0; c < 128; ++c) a += wr[c] * m2[c];
                acc[kk] = a; }
            v4u o; o.x = pk2(acc[0], acc[1]); o.y = pk2(acc[2], acc[3]); o.z = pk2(acc[4], acc[5]); o.w = pk2(acc[6], acc[7]);
            *(v4u*)(wrow + 8 * kg) = o;
        }
    }
}

__device__ __forceinline__ const float* xrow_ptr(const float* xa, const float* xb, int row) { return (row < NPROMPT) ? xa + (size_t)row * DM : xb + (size_t)(row - NPROMPT) * DM; }
template <bool XBF, bool OBF, int RR>
__device__ __forceinline__ void resid_rows(const float* xa, const float* xb, const bf16_t* xbf, const bf16_t* m, const float* g1, float* xout, bf16_t* xbout, bf16_t* xh, const float* g2, int gw, int NGW, int lane) {
    for (int row0 = gw; row0 < MTOK; row0 += RR * NGW) {
        f4 xf[XBF ? 1 : RR][8]; v2u xp[XBF ? RR : 1][8]; v2u mw[RR][8];
#pragma unroll
        for (int u = 0; u < RR; ++u) { const int row = row0 + u * NGW;
            if constexpr (XBF) { const bf16_t* xr = xbf + (size_t)row * DM;
#pragma unroll
                for (int j = 0; j < 8; ++j) xp[u][j] = *(const v2u*)(xr + 4 * lane + 256 * j);
            } else { const float* xr = xrow_ptr(xa, xb, row);
#pragma unroll
                for (int j = 0; j < 8; ++j) xf[u][j] = __builtin_nontemporal_load((const f4*)(xr + 4 * lane + 256 * j)); } }
        if (m) {
#pragma unroll
            for (int u = 0; u < RR; ++u) { const bf16_t* mr = m + (size_t)(row0 + u * NGW) * DM;
#pragma unroll
                for (int j = 0; j < 8; ++j) mw[u][j] = *(const v2u*)(mr + 4 * lane + 256 * j); }
        }
#pragma unroll
        for (int u = 0; u < RR; ++u) { const int row = row0 + u * NGW;
            f4 xv[8];
#pragma unroll
            for (int j = 0; j < 8; ++j) { if constexpr (XBF) { const v2u w = xp[u][j]; xv[j] = (f4){bflo(w.x), bfhi(w.x), bflo(w.y), bfhi(w.y)}; } else xv[j] = xf[u][j]; }
            if (m) { float ss = 0.f;
#pragma unroll
                for (int j = 0; j < 8; ++j) { const v2u w = mw[u][j]; const f4 mv = (f4){bflo(w.x), bfhi(w.x), bflo(w.y), bfhi(w.y)}; ss += (mv.x * mv.x + mv.y * mv.y) + (mv.z * mv.z + mv.w * mv.w); }
                const float r = 1.0f / sqrtf(wave_sum(ss) * (1.f / DM) + EPS);
#pragma unroll
                for (int j = 0; j < 8; ++j) { const v2u w = mw[u][j]; const f4 mv = (f4){bflo(w.x), bfhi(w.x), bflo(w.y), bfhi(w.y)}; const f4 gv = *(const f4*)(g1 + 4 * lane + 256 * j); xv[j] += mv * r * gv; } }
            if constexpr (OBF) { if (xbout) {
#pragma unroll
                for (int j = 0; j < 8; ++j) { v2u w; w.x = pk2(xv[j].x, xv[j].y); w.y = pk2(xv[j].z, xv[j].w); *(v2u*)(xbout + (size_t)row * DM + 4 * lane + 256 * j) = w; } }
            } else { if (xout) {
#pragma unroll
                for (int j = 0; j < 8; ++j) __builtin_nontemporal_store(xv[j], (f4*)(xout + (size_t)row * DM + 4 * lane + 256 * j)); } }
            if (xh) { float ss = 0.f;
#pragma unroll
                for (int j = 0; j < 8; ++j) ss += (xv[j].x * xv[j].x + xv[j].y * xv[j].y) + (xv[j].z * xv[j].z + xv[j].w * xv[j].w);
                const float r = 1.0f / sqrtf(wave_sum(ss) * (1.f / DM) + EPS);
#pragma unroll
                for (int j = 0; j < 8; ++j) { const f4 gv = *(const f4*)(g2 + 4 * lane + 256 * j); const f4 y = xv[j] * r * gv;
                    v2u w; w.x = pk2(y.x, y.y); w.y = pk2(y.z, y.w); *(v2u*)(xh + (size_t)row * DM + 4 * lane + 256 * j) = w; } }
        }
    }
}

__device__ __forceinline__ void rope_pass(bf16_t* Z, bf16_t* Zout, const float* qn, const float* kn, const float* COS, const float* SIN, int gtid, int NT) {
    const int hw = gtid >> 5, NHW = NT >> 5, j = gtid & 31;
    const float qa0 = qn[2 * j], qa1 = qn[2 * j + 1], qb0 = qn[64 + 2 * j], qb1 = qn[65 + 2 * j];
    const float ka0 = kn[2 * j], ka1 = kn[2 * j + 1], kb0 = kn[64 + 2 * j], kb1 = kn[65 + 2 * j];
    for (int row = hw; row < MTOK; row += NHW) {
        const int t = row < NPROMPT ? (row & 16383) : (row & 4095);
        bf16_t* p = Z + (size_t)row * DM + 512 + 2 * j;
        unsigned a[10], b[10];
#pragma unroll
        for (int hh = 0; hh < 10; ++hh) { a[hh] = *(const unsigned*)(p + hh * 128); b[hh] = *(const unsigned*)(p + hh * 128 + 64); }
        const float c0 = COS[t * 64 + 2 * j], c1 = COS[t * 64 + 2 * j + 1], s0 = SIN[t * 64 + 2 * j], s1 = SIN[t * 64 + 2 * j + 1];
#pragma unroll
        for (int hh = 0; hh < 10; ++hh) {
            float x0 = bflo(a[hh]), x1 = bfhi(a[hh]), y0 = bflo(b[hh]), y1 = bfhi(b[hh]);
            float ss = (x0 * x0 + x1 * x1) + (y0 * y0 + y1 * y1);
#pragma unroll
            for (int o = 1; o < 32; o <<= 1) ss += __shfl_xor(ss, o);
            const float r = 1.0f / sqrtf(ss * (1.f / 128.f) + EPS);
            x0 *= r * (hh < 8 ? qa0 : ka0); x1 *= r * (hh < 8 ? qa1 : ka1); y0 *= r * (hh < 8 ? qb0 : kb0); y1 *= r * (hh < 8 ? qb1 : kb1);
            const float ox0 = x0 * c0 - y0 * s0, oy0 = y0 * c0 + x0 * s0, ox1 = x1 * c1 - y1 * s1, oy1 = y1 * c1 + x1 * s1;
            bf16_t* po = Zout + (size_t)row * DM + 512 + 2 * j;
            *(unsigned*)(po + hh * 128) = pk2(ox0, ox1); *(unsigned*)(po + hh * 128 + 64) = pk2(oy0, oy1);
        }
    }
}

__device__ __forceinline__ void acc8(float* s, const bf16_t* p, float sg) { const v4u v = *(const v4u*)p;
    s[0] += sg * bflo(v.x); s[1] += sg * bfhi(v.x); s[2] += sg * bflo(v.y); s[3] += sg * bfhi(v.y); s[4] += sg * bflo(v.z); s[5] += sg * bfhi(v.z); s[6] += sg * bflo(v.w); s[7] += sg * bfhi(v.w); }
__device__ __forceinline__ void pool_pass(const bf16_t* Z, bf16_t* H, int gtid, int NT) {
    constexpr int RL = 32;
    for (int it = gtid; it < (MTOK / RL) * 64; it += NT) {
        const int ch = it & 63, run = it >> 6, c0 = ch * 8, g = ch >> 4, w = 2 << g, a = w >> 1, b = w - 1 - a;
        const int row0 = run * RL; int t0, L; if (row0 < NPROMPT) { t0 = row0 & 16383; L = 16384; } else { t0 = row0 & 4095; L = 4096; }
        const bf16_t* zb = Z + (size_t)(row0 - t0) * DM + c0;
        float s[8] = {0.f, 0.f, 0.f, 0.f, 0.f, 0.f, 0.f, 0.f};
        { const int lo = t0 - a < 0 ? 0 : t0 - a, hi = t0 + b > L - 1 ? L - 1 : t0 + b;
          for (int tt = lo; tt <= hi; ++tt) acc8(s, zb + (size_t)tt * DM, 1.f); }
#pragma unroll 4
        for (int r = 0; r < RL; ++r) {
            const int t = t0 + r; const int lo = t - a < 0 ? 0 : t - a, hi = t + b > L - 1 ? L - 1 : t + b;
            const float ic = 1.0f / (float)(hi - lo + 1);
            const v4u v = *(const v4u*)(zb + (size_t)t * DM);
            v4u o; o.x = pk2(s[0] * ic - bflo(v.x), s[1] * ic - bfhi(v.x)); o.y = pk2(s[2] * ic - bflo(v.y), s[3] * ic - bfhi(v.y));
            o.z = pk2(s[4] * ic - bflo(v.z), s[5] * ic - bfhi(v.z)); o.w = pk2(s[6] * ic - bflo(v.w), s[7] * ic - bfhi(v.w));
            *(v4u*)(H + (size_t)(row0 + r) * DM + c0) = o;
            if (t + 1 + b <= L - 1) acc8(s, zb + (size_t)(t + 1 + b) * DM, 1.f);
            if (t - a >= 0) acc8(s, zb + (size_t)(t - a) * DM, -1.f);
        }
    }
}

__device__ __forceinline__ float gelu_tanh(float x) { const float y = 0.7978845608028654f * (x + 0.044715f * x * x * x); return x * __builtin_amdgcn_rcpf(1.0f + __expf(-2.0f * y)); }
__device__ __forceinline__ void ld8f(const bf16_t* p, float* o) { const v4u v = *(const v4u*)p; o[0] = bflo(v.x); o[1] = bfhi(v.x); o[2] = bflo(v.y); o[3] = bfhi(v.y); o[4] = bflo(v.z); o[5] = bfhi(v.z); o[6] = bflo(v.w); o[7] = bfhi(v.w); }
__device__ __forceinline__ float dpp_ror1(float v) { return __int_as_float(__builtin_amdgcn_update_dpp(0, __float_as_int(v), 0x121, 0xf, 0xf, false)); }
__device__ __forceinline__ float dpp_ror15(float v) { return __int_as_float(__builtin_amdgcn_update_dpp(0, __float_as_int(v), 0x12F, 0xf, 0xf, false)); }
struct EpiGlu {
    static constexpr bool PERM = true, AFTER_DRAIN = false;
    bf16_t* ACT; bf16_t* HB; const float* cw; const float* cb;
    __device__ __forceinline__ void operator()(const pg8::f32x4 (&acc)[2][2][4][2], const pg8::Unit& u, int wr, int wc, int fr, int fq) const {
        const int jc = u.pn * 128 + wc * 32 + 8 * fq;
        const bool first = (fr == 0), last = (fr == 15);
        v2u stash[2][4];
#pragma unroll
        for (int n = 0; n < 2; ++n) {
            const f4 w0g = *(const f4*)(cw + jc + 4 * n), w1g = *(const f4*)(cw + NUP + jc + 4 * n), w2g = *(const f4*)(cw + 2 * NUP + jc + 4 * n), bg = *(const f4*)(cb + jc + 4 * n);
            const f4 w0v = *(const f4*)(cw + DFF + jc + 4 * n), w1v = *(const f4*)(cw + NUP + DFF + jc + 4 * n), w2v = *(const f4*)(cw + 2 * NUP + DFF + jc + 4 * n), bv = *(const f4*)(cb + DFF + jc + 4 * n);
#pragma unroll
            for (int ai = 0; ai < 2; ++ai) {
                float g1p[4], v1p[4], g15c[4], v15c[4];
#pragma unroll
                for (int i = 0; i < 4; ++i) { g1p[i] = 0.f; v1p[i] = 0.f; g15c[i] = dpp_ror15(acc[ai][0][0][n][i]); v15c[i] = dpp_ror15(acc[ai][1][0][n][i]); }
#pragma unroll
                for (int m = 0; m < 4; ++m) {
                    const int mn = m < 3 ? m + 1 : 3;
                    float o[4];
#pragma unroll
                    for (int i = 0; i < 4; ++i) {
                        const float g = acc[ai][0][m][n][i], v = acc[ai][1][m][n][i];
                        const float g1c = dpp_ror1(g), v1c = dpp_ror1(v), g15n = dpp_ror15(acc[ai][0][mn][n][i]), v15n = dpp_ror15(acc[ai][1][mn][n][i]);
                        const float gp = first ? g1p[i] : g1c, gn = last ? g15n : g15c[i], vp = first ? v1p[i] : v1c, vn = last ? v15n : v15c[i];
                        g1p[i] = g1c; v1p[i] = v1c; g15c[i] = g15n; v15c[i] = v15n;
                        const float a = gp * w0g[i] + g * w1g[i] + gn * w2g[i] + bg[i];
                        const float b = vp * w0v[i] + v * w1v[i] + vn * w2v[i] + bv[i];
                        const float e = __builtin_amdgcn_exp2f(a * (-2.3022082f + -0.10294324f * (a * a)));
                        o[i] = a * __builtin_amdgcn_rcpf(1.0f + e) * b;
                    }
                    const int row = u.pm * pg8::BM + ai * pg8::HALF + wr * 64 + m * 16 + fr;
                    v2u w; w.x = pk2(o[0], o[1]); w.y = pk2(o[2], o[3]);
                    if (n == 0) stash[ai][m] = w;
                    else { v4u ww; ww.x = stash[ai][m].x; ww.y = stash[ai][m].y; ww.z = w.x; ww.w = w.y; *(v4u*)(ACT + (size_t)row * DFF + jc) = ww; }
                }
            }
        }
#pragma unroll
        for (int ai = 0; ai < 2; ++ai) {
            const int grp = u.pm * 4 + ai * 2 + wr;
            if (fr < 2 || fr >= 14) {
                const int m = fr < 2 ? 0 : 3, slot = fr < 2 ? fr : fr - 12;
                bf16_t* hp = HB + ((size_t)grp * 4 + slot) * NUP + u.pn * 256 + wc * 32 + 8 * fq;
#pragma unroll
                for (int bj = 0; bj < 2; ++bj) {
                    const pg8::f32x4 v0 = fr < 2 ? acc[ai][bj][0][0] : acc[ai][bj][3][0], v1 = fr < 2 ? acc[ai][bj][0][1] : acc[ai][bj][3][1];
                    v4u w; w.x = pk2(v0[0], v0[1]); w.y = pk2(v0[2], v0[3]); w.z = pk2(v1[0], v1[1]); w.w = pk2(v1[2], v1[3]);
                    *(v4u*)(hp + bj * 128) = w;
                }
                (void)m;
            }
        }
    }
};
__device__ __forceinline__ void glu_fix(const bf16_t* HB, bf16_t* ACT, const float* cw, const float* cb, int gtid, int NT) {
    constexpr int NCC = DFF / 8, NG = CHUNK / 64;
    for (int it = gtid; it < NG * 2 * NCC; it += NT) {
        const int cc = it % NCC, rest = it / NCC, which = rest & 1, g = rest >> 1, j0 = cc * 8, colp = (j0 >> 7) * 256 + (j0 & 127);
        const int row = g * 64 + (which ? 63 : 0); const int Lc = row < NPROMPT ? 16384 : 4096;
        const bf16_t *P, *C, *N;
        if (!which) { C = HB + ((size_t)g * 4 + 0) * NUP; N = HB + ((size_t)g * 4 + 1) * NUP; P = ((row & (Lc - 1)) == 0) ? nullptr : HB + ((size_t)(g - 1) * 4 + 3) * NUP; }
        else { P = HB + ((size_t)g * 4 + 2) * NUP; C = HB + ((size_t)g * 4 + 3) * NUP; N = (((row + 1) & (Lc - 1)) == 0) ? nullptr : HB + ((size_t)(g + 1) * 4 + 0) * NUP; }
        float pg[8], pv[8], cg_[8], cv[8], ng[8], nv[8];
        if (P) { ld8f(P + colp, pg); ld8f(P + colp + 128, pv); } else {
#pragma unroll
            for (int i = 0; i < 8; ++i) { pg[i] = 0.f; pv[i] = 0.f; } }
        if (N) { ld8f(N + colp, ng); ld8f(N + colp + 128, nv); } else {
#pragma unroll
            for (int i = 0; i < 8; ++i) { ng[i] = 0.f; nv[i] = 0.f; } }
        ld8f(C + colp, cg_); ld8f(C + colp + 128, cv);
        float o[8];
#pragma unroll
        for (int h = 0; h < 2; ++h) {
            const f4 w0g = *(const f4*)(cw + j0 + 4 * h), w1g = *(const f4*)(cw + NUP + j0 + 4 * h), w2g = *(const f4*)(cw + 2 * NUP + j0 + 4 * h), bg = *(const f4*)(cb + j0 + 4 * h);
            const f4 w0v = *(const f4*)(cw + DFF + j0 + 4 * h), w1v = *(const f4*)(cw + NUP + DFF + j0 + 4 * h), w2v = *(const f4*)(cw + 2 * NUP + DFF + j0 + 4 * h), bv = *(const f4*)(cb + DFF + j0 + 4 * h);
#pragma unroll
            for (int q = 0; q < 4; ++q) { const int i = 4 * h + q;
                const float a = pg[i] * w0g[q] + cg_[i] * w1g[q] + ng[i] * w2g[q] + bg[q];
                const float b = pv[i] * w0v[q] + cv[i] * w1v[q] + nv[i] * w2v[q] + bv[q];
                o[i] = gelu_tanh(a) * b; } }
        v4u w; w.x = pk2(o[0], o[1]); w.y = pk2(o[2], o[3]); w.z = pk2(o[4], o[5]); w.w = pk2(o[6], o[7]);
        *(v4u*)(ACT + (size_t)row * DFF + j0) = w;
    }
}

struct BRow1 { const att::bf16* base; size_t ldb; __device__ __forceinline__ const att::bf16* row(int kk) const { return base + (size_t)kk * ldb; } };
struct St1 { att::bf16* base; size_t ldb; __device__ __forceinline__ void operator()(int m, int c, float v) const { base[(size_t)m * ldb + c] = __float2bfloat16(v); } };
struct BRow3 { const att::bf16* base; int R, lgR, k1; __device__ __forceinline__ const att::bf16* row(int kk) const { const int part = kk >> lgR, t2 = kk & (R - 1); return base + (size_t)(((part << lgR) + k1) * R + t2) * 512; } };
struct St3 { att::bf16* base; int R; float scale; __device__ __forceinline__ void operator()(int m, int c, float v) const { base[(size_t)(m * R) * DM + c] = __float2bfloat16(v * scale); } };

__device__ __forceinline__ void dft_stage1(const bf16_t* Gp, bf16_t* Yp, const unsigned char* ws, char* lds, int vcu, int G) {
    for (int it = 0;; ++it) { const int uid = it * G + vcu; if (uid >= 3072) break;
        if (uid < 1024) { const int s = uid >> 9, nt = uid & 511; const size_t off = (size_t)s * (2u * 16384u * 512u) + (size_t)nt * 128;
            BRow1 br{(const att::bf16*)Gp + off, 65536}; St1 st{(att::bf16*)Yp + off, 65536};
            att::dft_unit<8, 4>((const att::bf16*)(ws + WS_A1P), 256, br, st, lds);
        } else { const int u2 = uid - 1024, s = u2 >> 8, nt = u2 & 255; const size_t off = (size_t)NPROMPT * 1024 + (size_t)s * (2u * 4096u * 512u) + (size_t)nt * 128;
            BRow1 br{(const att::bf16*)Gp + off, 32768}; St1 st{(att::bf16*)Yp + off, 32768};
            att::dft_unit<4, 2>((const att::bf16*)(ws + WS_A1S), 128, br, st, lds);
        }
    }
}
__device__ __forceinline__ void dft_stage3(const bf16_t* Yp, bf16_t* H, const unsigned char* ws, char* lds, int vcu, int G) {
    for (int it = 0;; ++it) { const int uid = it * G + vcu; if (uid >= 3072) break;
        if (uid < 1024) { const int s = uid >> 9, k1 = (uid >> 2) & 127, nt = uid & 3;
            BRow3 br{(const att::bf16*)Yp + (size_t)s * (2u * 16384u * 512u) + nt * 128, 128, 7, k1};
            St3 st{(att::bf16*)H + (size_t)(s * 16384 + k1) * DM + 1536 + nt * 128, 128, 1.0f / sqrtf(16384.f * 128.f)};
            att::dft_unit<4, 4>((const att::bf16*)(ws + WS_A3P) + (size_t)k1 * (128 * 256), 256, br, st, lds);
        } else { const int u2 = uid - 1024, s = u2 >> 8, k1 = (u2 >> 2) & 63, nt = u2 & 3;
            BRow3 br{(const att::bf16*)Yp + (size_t)NPROMPT * 1024 + (size_t)s * (2u * 4096u * 512u) + nt * 128, 64, 6, k1};
            St3 st{(att::bf16*)H + (size_t)(NPROMPT + s * 4096 + k1) * DM + 1536 + nt * 128, 64, 1.0f / sqrtf(4096.f * 128.f)};
            att::dft_unit<2, 2>((const att::bf16*)(ws + WS_A3S) + (size_t)k1 * (64 * 128), 128, br, st, lds);
        }
    }
}

__device__ __forceinline__ void attn_phase(const bf16_t* Z, bf16_t* H, const float* qn, const float* kn, char* lds, int vcu, int G) {
    float mq = 0.f, mk = 0.f;
    for (int i = 0; i < 128; ++i) { mq = fmaxf(mq, fabsf(qn[i])); mk = fmaxf(mk, fabsf(kn[i])); }
    const float bound = 128.f * mq * mk * 1.02f;
    for (int it = 0;; ++it) { const int uid = it * G + vcu; if (uid >= 2048) break;
        int rowbase, h, qb, seq;
        if (uid < 1024) { const int s = uid >> 9; h = (uid >> 6) & 7; qb = uid & 63; rowbase = s * 16384; seq = 16384; }
        else { const int u2 = uid - 1024, s = u2 >> 7; h = (u2 >> 4) & 7; qb = u2 & 15; rowbase = NPROMPT + s * 4096; seq = 4096; }
        const att::bf16* Q = (const att::bf16*)Z + (size_t)(rowbase + qb * 256) * DM + 512 + h * 128;
        const att::bf16* K = (const att::bf16*)Z + (size_t)rowbase * DM + 1536 + (h >> 2) * 128;
        att::bf16* O = (att::bf16*)H + (size_t)(rowbase + qb * 256) * DM + 512 + h * 128;
        att::attn_dense_body<att::bf16>(Q, K, K + 256, O, seq, lds, bound);
        __syncthreads();
    }
}

struct Params { const float* in[17]; float* out; unsigned char* ws; int ph_lo, ph_hi; };
constexpr int NPL = 9;
constexpr int NPHASE = 2 + 2 * NPL;

__global__ void __launch_bounds__(512, 2) mega_fwd(Params p) {
    extern __shared__ __attribute__((aligned(16))) unsigned char lds[];
    cg::grid_group grid = cg::this_grid();
    const int G = gridDim.x, bx = blockIdx.x;
    const int vcu = (G % 8 == 0) ? (bx % 8) * (G / 8) + bx / 8 : bx;
    const int NGW = G * 8, NT = G * 512;
    unsigned char* ws = p.ws;
    const float *x_prompt = p.in[0], *x_sample = p.in[1], *g_pre_mix = p.in[2], *g_post_mix = p.in[3], *w_in = p.in[4], *pool_w = p.in[5], *pool_scale = p.in[6],
                *q_norm = p.in[7], *k_norm = p.in[8], *fourier_w = p.in[9], *w_out = p.in[10], *g_pre_ffn = p.in[11], *g_post_ffn = p.in[12], *w_up = p.in[13],
                *conv_w = p.in[14], *conv_b = p.in[15], *w_down = p.in[16];
    bf16_t* XH = (bf16_t*)(ws + WS_XH); bf16_t* Z = (bf16_t*)(ws + WS_Z); bf16_t* Gp = (bf16_t*)(ws + WS_G); bf16_t* Yp = (bf16_t*)(ws + WS_Y);
    bf16_t* HB = (bf16_t*)(ws + WS_HB); bf16_t* ACT = (bf16_t*)(ws + WS_ACT); bf16_t* XB = (bf16_t*)(ws + WS_XB);
    LAS unsigned char* ring = (LAS unsigned char*)lds;
    volatile LAS unsigned* bst = (volatile LAS unsigned*)(ring + 131072 + 64);
    if (threadIdx.x < 2) bst[threadIdx.x] = 0u;
    __syncthreads();
    XcdBarrier xbar = xcd_barrier_post((unsigned*)(ws + WS_BAR), bst);

    for (int ph = p.ph_lo; ph < p.ph_hi; ++ph) {
        const int tid = ltid(), lane = tid & 63, wave = __builtin_amdgcn_readfirstlane(tid >> 6);
        const int gw = vcu * 8 + wave, gtid = bx * 512 + tid;
        if (ph == 0) {
#if !defined(ONLY) || ONLY==0
            for (int rep = 0; rep < REP_P0; ++rep) p0a_tables(fourier_w, ws, (LAS float*)ring, gtid, NT);
#endif
        } else if (ph == 1) {
#if !defined(ONLY) || ONLY==1
            LAS float* scr = (LAS float*)(ring + wave * 16384);
            for (int l = 0; l < 2 * REP_P0; ++l) {
                bf16_t* Wl = (bf16_t*)(ws + WS_W + (l & 1) * W_LAYER);
                ValWin vw{w_in + (size_t)(l & 1) * DM * WINW, pool_w + (size_t)(l & 1) * 4 * 16384, pool_scale + (l & 1) * 512, (const float*)(ws + WS_M2F) + (size_t)(l & 1) * 4 * 32768};
                transpose_matrix(vw, DM, NIN, Wl, scr, gw, NGW, lane, 512, 2048);
                fold_items(vw.win, vw.poolw, vw.pscale, vw.m2f, Wl, gw, NGW, lane);
                ValDirect vo{w_out + (size_t)(l & 1) * DM * DM, DM};
                transpose_matrix(vo, DM, DM, (bf16_t*)((unsigned char*)Wl + W_OUT_OFF), scr, gw, NGW, lane, 0, DM);
                ValUp vu{w_up + (size_t)(l & 1) * DM * NUP};
                transpose_matrix(vu, DM, NUP, (bf16_t*)((unsigned char*)Wl + W_UP_OFF), scr, gw, NGW, lane, 0, NUP);
                ValDirect vd{w_down + (size_t)(l & 1) * DFF * DM, DM};
                transpose_matrix(vd, DFF, DM, (bf16_t*)((unsigned char*)Wl + W_DOWN_OFF), scr, gw, NGW, lane, 0, DM);
            }
            for (int rep = 0; rep < REP_P0; ++rep) resid_rows<false, false, 2>(x_prompt, x_sample, nullptr, nullptr, nullptr, nullptr, nullptr, XH, g_pre_mix, gw, NGW, lane);
#endif
        } else {
            const int l = (ph - 2) / NPL, q = (ph - 2) % NPL;
            const bf16_t* Wl = (const bf16_t*)(ws + WS_W + l * W_LAYER);
            if (q == 0) {
#if !defined(ONLY) || ONLY==2
                pg8::Gemm g{XH, Wl, MTOK, NIN, DM}; pg8::StaticOrder S; S.init(MTOK, NIN, G, bx);
                EpiWin E{Z, Gp};
                for (int rep = 0; rep < REP_WIN; ++rep) pg8::gemm_phase<EpiWin, pg8::StaticOrder, PG8_ALIGN, PG8_SP2>(ring, g, S, E);
#endif
            } else if (q == 1) {
#if !defined(ONLY) || ONLY==3
                for (int rep = 1; rep < REP_ROPE; ++rep) rope_pass(Z, (bf16_t*)(ws + WS_END), q_norm + l * 128, k_norm + l * 128, (const float*)(ws + WS_COS), (const float*)(ws + WS_SIN), gtid, NT);
                rope_pass(Z, Z, q_norm + l * 128, k_norm + l * 128, (const float*)(ws + WS_COS), (const float*)(ws + WS_SIN), gtid, NT);
                for (int rep = 0; rep < REP_LIGHT * REP_POOL; ++rep) pool_pass(Z, XH, gtid, NT);
                for (int rep = 0; rep < REP_LIGHT; ++rep) dft_stage1(Gp, Yp, ws, (char*)lds, vcu, G);
#endif
            } else if (q == 2) {
#if !defined(ONLY) || ONLY==4
                for (int rep = 0; rep < REP_ATTN; ++rep) attn_phase(Z, XH, q_norm + l * 128, k_norm + l * 128, (char*)lds, vcu, G);
#endif
#if !defined(ONLY) || ONLY==5
                for (int rep = 0; rep < REP_LIGHT; ++rep) dft_stage3(Yp, XH, ws, (char*)lds, vcu, G);
#endif
            } else if (q == 4) {
#if !defined(ONLY) || ONLY==6
                for (int rep = 1; rep < REP_RES; ++rep) resid_rows<true, true, 4>(nullptr, nullptr, XB, Z, g_post_mix + DM, nullptr, nullptr, (bf16_t*)(ws + WS_END), g_pre_ffn + DM, gw, NGW, lane);
                if (l == 0) resid_rows<false, true, 2>(x_prompt, x_sample, nullptr, Z, g_post_mix, nullptr, XB, XH, g_pre_ffn, gw, NGW, lane);
                else resid_rows<true, true, 4>(nullptr, nullptr, XB, Z, g_post_mix + DM, nullptr, XB, XH, g_pre_ffn + DM, gw, NGW, lane);
#endif
            } else if (q == 8) {
#if !defined(ONLY) || ONLY==6
                if (l == 0) resid_rows<true, true, 4>(nullptr, nullptr, XB, XH, g_post_ffn, nullptr, XB, XH, g_pre_mix + DM, gw, NGW, lane);
                else resid_rows<true, false, 4>(nullptr, nullptr, XB, XH, g_post_ffn + DM, p.out, nullptr, nullptr, nullptr, gw, NGW, lane);
#endif
            } else {
                const int c = 0, step = (q >= 5) ? (q - 5) : -1;
                const float* cwl = conv_w + (size_t)l * 3 * NUP; const float* cbl = conv_b + (size_t)l * NUP;
                if (step == 1) {
#if !defined(ONLY) || ONLY==7
                    for (int rep = 0; rep < REP_LIGHT; ++rep) glu_fix(HB, ACT, cwl, cbl, gtid, NT);
#endif
                } else if (step == 0) {
#if !defined(ONLY) || ONLY==9
                    pg8::Gemm g{XH + (size_t)c * CHUNK * DM, (const bf16_t*)((const unsigned char*)Wl + W_UP_OFF), CHUNK, NUP, DM};
                    pg8::StaticOrder S; S.init(g.M, g.N, G, bx);
                    EpiGlu E{ACT, HB, cwl, cbl};
                    for (int rep = 0; rep < REP_UP; ++rep) pg8::gemm_phase<EpiGlu, pg8::StaticOrder, PG8_ALIGN, PG8_SP2>(ring, g, S, E);
#endif
                } else {
#if !defined(ONLY) || ONLY==8
                    pg8::Gemm g; bf16_t* O;
                    if (q == 3) { g = pg8::Gemm{XH, (const bf16_t*)((const unsigned char*)Wl + W_OUT_OFF), MTOK, DM, DM}; O = Z; }
                    else { g = pg8::Gemm{ACT, (const bf16_t*)((const unsigned char*)Wl + W_DOWN_OFF), CHUNK, DM, DFF}; O = XH + (size_t)c * CHUNK * DM; }
                    pg8::StaticOrder S; S.init(g.M, g.N, G, bx);
                    pg8::EpiBf16<0> E{O, DM, nullptr, 0, 0, 1.f};
                    for (int rep = 0; rep < REP_PLAIN; ++rep) pg8::gemm_phase<pg8::EpiBf16<0>, pg8::StaticOrder, PG8_ALIGN, PG8_SP2>(ring, g, S, E);
#endif
                }
            }
        }
        if (ph + 1 < p.ph_hi) { for (int rep = 0; rep < REP_SYNC; ++rep) { if (MK_MULTI == 0 && ph != 0) xcd_barrier(xbar); else grid.sync(); } }
    }
}

extern "C" void kernel_launch(void* const* d_in, const int* in_sizes, int n_in, void* d_out, int out_size, void* d_ws, size_t ws_size, hipStream_t stream) {
    static int grid = 0;
    if (grid == 0) {
        if (n_in != 17 || out_size != MTOK * DM || ws_size < WS_END) { fprintf(stderr, "kernel_launch: unexpected shapes: n_in %d out %d ws %zu (need %zu)\n", n_in, out_size, ws_size, (size_t)WS_END); grid = -1; return; }
        int dev = 0, cus = 0, per_cu = 0;
        if (hipGetDevice(&dev) != hipSuccess || hipDeviceGetAttribute(&cus, hipDeviceAttributeMultiprocessorCount, dev) != hipSuccess) { grid = -1; return; }
        if (hipFuncSetAttribute((const void*)mega_fwd, hipFuncAttributeMaxDynamicSharedMemorySize, LDS_BYTES) != hipSuccess) { fprintf(stderr, "kernel_launch: hipFuncSetAttribute failed\n"); grid = -1; return; }
        if (hipOccupancyMaxActiveBlocksPerMultiprocessor(&per_cu, (const void*)mega_fwd, 512, LDS_BYTES) != hipSuccess || per_cu < 1) { fprintf(stderr, "kernel_launch: occupancy query says %d\n", per_cu); per_cu = 1; }
        (void)hipGetLastError();
        grid = cus * 1;
    }
    if (grid < 0) return;
    if (hipMemsetAsync((char*)d_ws + WS_BAR, 0, BAR_BYTES, stream) != hipSuccess) { fprintf(stderr, "kernel_launch: memset failed\n"); return; }
    Params p{};
    for (int i = 0; i < 17; ++i) p.in[i] = (const float*)d_in[i];
    p.out = (float*)d_out; p.ws = (unsigned char*)d_ws;
#if MK_MULTI
    for (int ph = 0; ph < NPHASE; ++ph) { p.ph_lo = ph; p.ph_hi = ph + 1; hipLaunchKernelGGL(mega_fwd, dim3(grid), dim3(512), LDS_BYTES, stream, p); }
#else
    p.ph_lo = 0; p.ph_hi = NPHASE;
    void* args[] = {&p};
    hipError_t e = hipLaunchCooperativeKernel((const void*)mega_fwd, dim3(grid), dim3(512), args, LDS_BYTES, stream);
    if (e != hipSuccess) fprintf(stderr, "cooperative launch failed: %s (grid %d)\n", hipGetErrorString(e), grid);
#endif
}
```

```cpp
#include <hip/hip_runtime.h>
#include <hip/hip_bf16.h>
#include <hip/hip_cooperative_groups.h>
#include <cstdio>
#include <cstdint>
#ifndef MK_MULTI
#define MK_MULTI 0
#endif
__device__ __forceinline__ int ltid() { int t = threadIdx.x; asm volatile("" : "+v"(t)); return t; }
#ifndef REP_UP
#define REP_UP 1
#endif
#ifndef REP_ATTN
#define REP_ATTN 1
#endif
#ifndef REP_PLAIN
#define REP_PLAIN 1
#endif
#ifndef REP_WIN
#define REP_WIN 1
#endif
#ifndef REP_P0
#define REP_P0 1
#endif
#ifndef REP_LIGHT
#define REP_LIGHT 1
#endif
#ifndef REP_SYNC
#define REP_SYNC 1
#endif
#ifndef REP_ROPE
#define REP_ROPE 1
#endif
#ifndef REP_RES
#define REP_RES 1
#endif
#ifndef REP_POOL
#define REP_POOL 1
#endif
namespace pg8 {
#define PG8_LAS __attribute__((address_space(3)))
typedef unsigned short bf16_t;
typedef short bf16x8 __attribute__((ext_vector_type(8)));
typedef float f32x4 __attribute__((ext_vector_type(4)));
typedef unsigned u32x4 __attribute__((ext_vector_type(4)));
constexpr int BM = 256, BK = 64, HALF = 128, HTB = HALF * BK * 2  , STAGE_BYTES = 8 * HTB, NXCD = 8, WGM = 8;

__host__ __device__ __forceinline__ int lds_byte(int r, int c) { const int st = (r >> 4) * 2 + (c >> 5), rr = r & 15, cc = c & 31, ob = rr * 64 + cc * 2; return st * 1024 + (ob ^ (((ob >> 9) & 1) << 5)); }
__host__ __device__ __forceinline__ void stage_rc(int b, int& R, int& C) { const int st = b / 1024, sb = b % 1024, swz = sb ^ (((sb >> 9) & 1) << 5); R = (st >> 1) * 16 + swz / 64; C = (st & 1) * 32 + (swz % 64) / 2; }
__host__ __device__ __forceinline__ int perm32(int rho) { const int n = rho >> 4, i = rho & 15; return 8 * (i >> 2) + 4 * n + (i & 3); }

struct Unit { int pm, pn; };
struct Gemm { const bf16_t* A; const bf16_t* Bt; int M, N, K; };

struct StaticOrder {
    int nM, nN, nwg, G, c;
    __host__ __device__ void init(int M, int N, int G_, int c_) { nM = M / BM; nN = N / BM; nwg = nM * nN; G = G_; c = c_; }
    __host__ __device__ bool next(int i, Unit& u) const {
        const long L = (long)i * G + c; if (L >= nwg) return false;
        int wgid = (int)L; { const int q = nwg / NXCD, r = nwg % NXCD, xcd = wgid % NXCD, off = wgid / NXCD; wgid = (xcd < r ? xcd * (q + 1) : r * (q + 1) + (xcd - r) * q) + off; }
        const int nig = WGM * nN, gid = wgid / nig, fm = gid * WGM, gsz = (nM - fm) < WGM ? (nM - fm) : WGM;
        u.pm = fm + ((wgid % nig) % gsz); u.pn = (wgid % nig) / gsz; return true;
    }
    __device__ __forceinline__ void a_ready(const Unit&) const {}
    __device__ __forceinline__ void done(const Unit&) const {}
};

__device__ __forceinline__ unsigned cvt_pk_bf16(float lo, float hi) { unsigned r; asm volatile("v_cvt_pk_bf16_f32 %0, %1, %2" : "=v"(r) : "v"(lo), "v"(hi)); return r; }
typedef float f32x2 __attribute__((ext_vector_type(2)));
__device__ __forceinline__ f32x2 gelu_pk(f32x2 v) {
    const f32x2 av = __builtin_elementwise_abs(v), d = av * 0.2316418882f + 1.0f;
    f32x2 t; t.x = __builtin_amdgcn_rcpf(d.x); t.y = __builtin_amdgcn_rcpf(d.y);
    f32x2 q = t * 0.5307027145f + (-0.7265760135f); q = q * t + 0.7107068705f; q = q * t + (-0.142248368f); q = q * t + 0.127414796f; q = q * t;
    const f32x2 s = (v * v) * (-0.72134752044f);
    f32x2 e; e.x = __builtin_amdgcn_exp2f(s.x); e.y = __builtin_amdgcn_exp2f(s.y);
    const f32x2 m = v * (q * e), r = v - m;
    f32x2 o; o.x = v.x < 0.f ? m.x : r.x; o.y = v.y < 0.f ? m.y : r.y; return o;
}

template <int ACT  > struct EpiBf16 {
    static constexpr bool PERM = true, AFTER_DRAIN = false; static_assert(ACT == 0 || ACT == 1, "EpiBf16: ACT is 0 (none) or 1 (gelu_pk)");
    bf16_t* O; int ldc; const float* bias; int split_cols; size_t split_stride; float scale0;
    __device__ __forceinline__ void operator()(const f32x4 (&acc)[2][2][4][2], const Unit& u, int wr, int wc, int fr, int fq) const {
        const int row0 = u.pm * BM + wr * 64 + fr; int colt = u.pn * BM; bf16_t* base = O;
        float sc = 1.f; if (split_cols) { const int t = colt / split_cols; base += (size_t)t * split_stride; colt -= t * split_cols; if (t == 0) sc = scale0; }
        const int col0 = colt + wc * 32 + 8 * fq, bcol0 = u.pn * BM + wc * 32 + 8 * fq;
        f32x4 bv[2][2];
#pragma unroll
        for (int bj = 0; bj < 2; ++bj)
#pragma unroll
            for (int n = 0; n < 2; ++n) bv[bj][n] = bias ? *(const f32x4*)(bias + bcol0 + bj * HALF + 4 * n) : (f32x4){0.f, 0.f, 0.f, 0.f};
#pragma unroll
        for (int ai = 0; ai < 2; ++ai)
#pragma unroll
            for (int m = 0; m < 4; ++m) { bf16_t* rowp = base + (size_t)(row0 + ai * HALF + m * 16) * ldc + col0;
#pragma unroll
                for (int bj = 0; bj < 2; ++bj) { f32x4 v0 = acc[ai][bj][m][0] + bv[bj][0], v1 = acc[ai][bj][m][1] + bv[bj][1];
                    if (ACT == 1) { f32x2 a = gelu_pk((f32x2){v0[0], v0[1]}), b = gelu_pk((f32x2){v0[2], v0[3]}), c = gelu_pk((f32x2){v1[0], v1[1]}), d = gelu_pk((f32x2){v1[2], v1[3]});
                        v0 = (f32x4){a.x, a.y, b.x, b.y}; v1 = (f32x4){c.x, c.y, d.x, d.y}; }
                    v0 = v0 * sc; v1 = v1 * sc; u32x4 w; w.x = cvt_pk_bf16(v0[0], v0[1]); w.y = cvt_pk_bf16(v0[2], v0[3]); w.z = cvt_pk_bf16(v1[0], v1[1]); w.w = cvt_pk_bf16(v1[2], v1[3]);
                    *(u32x4*)(rowp + bj * HALF) = w; } }
    }
};
template <class Epi, class Sched, bool ALIGN_EPI = false, bool SP2 = false>
__device__ __forceinline__ void gemm_phase(PG8_LAS unsigned char* lds, const Gemm g, const Sched& S, const Epi& E) {
    const int tid = ltid(), wid = __builtin_amdgcn_readfirstlane(tid >> 6), lane = tid & 63, wr = wid >> 2, wc = wid & 3, fr = lane & 15, fq = lane >> 4;
    const int K = g.K, nt = K / BK;
    unsigned voffA[2], voffB[2];
#pragma unroll
    for (int i = 0; i < 2; ++i) { int R, C; stage_rc(tid * 16 + i * 8192, R, C); const int Rb = Epi::PERM ? ((R & ~31) + perm32(R & 31)) : R;
        voffA[i] = (unsigned)(R * K + C) * 2u; voffB[i] = (unsigned)(Rb * K + C) * 2u; }
    const size_t kstep = (size_t)(BK * 2);
    const size_t hstep = (size_t)HALF * K * 2;
    const size_t tstep = 2 * hstep;
    const unsigned ldsw = (unsigned)wid * 1024u;
    const int aoff = lds_byte(wr * 64 + fr, fq * 8), boff = lds_byte(wc * 32 + fr, fq * 8);
#define PG8_SA(b, h) (((b) * 2 + (h)) * HTB)
#define PG8_SB(b, h) ((4 + (b) * 2 + (h)) * HTB)
#define PG8_STAGE(bufoff, gbase, voff) do { _Pragma("unroll") for (int _i = 0; _i < 2; ++_i) \
        __builtin_amdgcn_global_load_lds((const unsigned*)((const char*)(gbase) + (voff)[_i]), (PG8_LAS unsigned*)(lds + (bufoff) + ldsw + _i * 8192), 16, 0, 0); } while (0)
#define PG8_LDA(dst, b, h) do { _Pragma("unroll") for (int m = 0; m < 4; ++m) _Pragma("unroll") for (int k = 0; k < 2; ++k) dst[m][k] = *(const PG8_LAS bf16x8*)(lds + PG8_SA(b, h) + aoff + m * 2048 + k * 1024); } while (0)
#define PG8_LDB(dst, b, h) do { _Pragma("unroll") for (int n = 0; n < 2; ++n) _Pragma("unroll") for (int k = 0; k < 2; ++k) dst[n][k] = *(const PG8_LAS bf16x8*)(lds + PG8_SB(b, h) + boff + n * 2048 + k * 1024); } while (0)
#define PG8_MMA(ai, bj, At, Bt) do { __builtin_amdgcn_s_setprio(1); _Pragma("unroll") for (int m = 0; m < 4; ++m) _Pragma("unroll") for (int n = 0; n < 2; ++n) _Pragma("unroll") for (int k = 0; k < 2; ++k) \
        acc[ai][bj][m][n] = __builtin_amdgcn_mfma_f32_16x16x32_bf16(Bt[n][k], At[m][k], acc[ai][bj][m][n], 0, 0, 0); __builtin_amdgcn_s_setprio(0); } while (0)
#define PG8_WAIT_V(n) asm volatile("s_waitcnt vmcnt(" #n ")" ::: "memory")
#define PG8_WAIT_L(n) asm volatile("s_waitcnt lgkmcnt(" #n ")" ::: "memory")
#define PG8_BAR __builtin_amdgcn_s_barrier()
#define PG8_SCHED __builtin_amdgcn_sched_barrier(0)
    Unit cur, nxt; int ui = 0;
    if (!S.next(0, cur)) return;
    f32x4 acc[2][2][4][2];
#pragma unroll
    for (int a = 0; a < 2; ++a)
#pragma unroll
        for (int b = 0; b < 2; ++b)
#pragma unroll
            for (int m = 0; m < 4; ++m)
#pragma unroll
                for (int n = 0; n < 2; ++n) acc[a][b][m][n] = (f32x4){0.f, 0.f, 0.f, 0.f};
    bf16x8 At[4][2], B0[2][2], B1[2][2];
    const char* cA = (const char*)g.A + (size_t)cur.pm * tstep; const char* cB = (const char*)g.Bt + (size_t)cur.pn * tstep;
    S.a_ready(cur);
    if constexpr (SP2) {
        PG8_STAGE(PG8_SB(0, 0), cB, voffB); PG8_STAGE(PG8_SB(0, 1), cB + hstep, voffB); PG8_STAGE(PG8_SA(0, 0), cA, voffA); PG8_STAGE(PG8_SA(0, 1), cA + hstep, voffA);
        if (wr == 1) PG8_BAR;
        PG8_WAIT_V(2); PG8_BAR;
        PG8_STAGE(PG8_SB(1, 0), cB + kstep, voffB); PG8_STAGE(PG8_SA(1, 0), cA + kstep, voffA); PG8_STAGE(PG8_SB(1, 1), cB + hstep + kstep, voffB);
        PG8_WAIT_V(6); PG8_BAR;
    } else {
        PG8_STAGE(PG8_SB(0, 0), cB, voffB); PG8_STAGE(PG8_SA(0, 0), cA, voffA); PG8_STAGE(PG8_SB(0, 1), cB + hstep, voffB); PG8_STAGE(PG8_SA(0, 1), cA + hstep, voffA);
        if (wr == 1) PG8_BAR;
        PG8_WAIT_V(4); PG8_BAR;
        PG8_STAGE(PG8_SB(1, 0), cB + kstep, voffB); PG8_STAGE(PG8_SA(1, 0), cA + kstep, voffA); PG8_STAGE(PG8_SB(1, 1), cB + hstep + kstep, voffB);
        PG8_WAIT_V(6); PG8_BAR;
    }
    for (;;) {
        const bool has_next = S.next(ui + 1, nxt);
        const char* nA = has_next ? (const char*)g.A + (size_t)nxt.pm * tstep : cA; const char* nB = has_next ? (const char*)g.Bt + (size_t)nxt.pn * tstep : cB;
        for (int t = 0; t < nt; t += 2) {
            const bool last = (t == nt - 2);
            const char* a1 = cA + (size_t)(t + 1) * kstep;
            const char* a2 = last ? nA : cA + (size_t)(t + 2) * kstep; const char* b2 = last ? nB : cB + (size_t)(t + 2) * kstep;
            const char* a3 = a2 + kstep; const char* b3 = b2 + kstep;
            if (last && has_next) S.a_ready(nxt);
            if constexpr (SP2) {
            PG8_LDB(B0, 0, 0); PG8_LDB(B1, 0, 1); PG8_SCHED; PG8_LDA(At, 0, 0); PG8_STAGE(PG8_SA(1, 1), a1 + hstep, voffA);
            PG8_WAIT_V(8); PG8_WAIT_L(0); PG8_BAR; PG8_MMA(0, 0, At, B0); PG8_MMA(0, 1, At, B1); PG8_BAR; PG8_SCHED;
            PG8_LDA(At, 0, 1); PG8_STAGE(PG8_SB(0, 0), b2, voffB); PG8_STAGE(PG8_SB(0, 1), b2 + hstep, voffB); PG8_STAGE(PG8_SA(0, 0), a2, voffA);
            PG8_WAIT_V(8); PG8_WAIT_L(0); PG8_BAR; PG8_MMA(1, 0, At, B0); PG8_MMA(1, 1, At, B1); PG8_BAR; PG8_SCHED;
            PG8_LDB(B0, 1, 0); PG8_LDB(B1, 1, 1); PG8_SCHED; PG8_LDA(At, 1, 0); PG8_STAGE(PG8_SA(0, 1), a2 + hstep, voffA);
            PG8_WAIT_V(8); PG8_WAIT_L(0); PG8_BAR; PG8_MMA(0, 0, At, B0); PG8_MMA(0, 1, At, B1); PG8_BAR; PG8_SCHED;
            PG8_LDA(At, 1, 1); PG8_STAGE(PG8_SB(1, 0), b3, voffB); PG8_STAGE(PG8_SB(1, 1), b3 + hstep, voffB); PG8_STAGE(PG8_SA(1, 0), a3, voffA);
            PG8_WAIT_V(8); PG8_WAIT_L(0); PG8_BAR; PG8_MMA(1, 0, At, B0); PG8_MMA(1, 1, At, B1); PG8_BAR; PG8_SCHED;
            } else {
            PG8_LDB(B0, 0, 0); PG8_SCHED; PG8_LDA(At, 0, 0); PG8_STAGE(PG8_SA(1, 1), a1 + hstep, voffA);
            PG8_WAIT_L(8); PG8_BAR; PG8_WAIT_L(0); PG8_MMA(0, 0, At, B0); PG8_BAR; PG8_SCHED;
            PG8_LDB(B1, 0, 1); PG8_STAGE(PG8_SB(0, 0), b2, voffB);
            PG8_BAR; PG8_WAIT_L(0); PG8_MMA(0, 1, At, B1); PG8_BAR;
            PG8_LDA(At, 0, 1); PG8_STAGE(PG8_SA(0, 0), a2, voffA);
            PG8_BAR; PG8_WAIT_L(0); PG8_MMA(1, 0, At, B0); PG8_BAR; PG8_SCHED;
            PG8_STAGE(PG8_SB(0, 1), b2 + hstep, voffB);
            PG8_WAIT_V(6); PG8_BAR; PG8_MMA(1, 1, At, B1); PG8_BAR;
            PG8_LDB(B0, 1, 0); PG8_SCHED; PG8_LDA(At, 1, 0); PG8_STAGE(PG8_SA(0, 1), a2 + hstep, voffA);
            PG8_WAIT_L(8); PG8_BAR; PG8_WAIT_L(0); PG8_MMA(0, 0, At, B0); PG8_BAR; PG8_SCHED;
            PG8_LDB(B1, 1, 1); PG8_STAGE(PG8_SB(1, 0), b3, voffB);
            PG8_BAR; PG8_WAIT_L(0); PG8_MMA(0, 1, At, B1); PG8_BAR;
            PG8_LDA(At, 1, 1); PG8_STAGE(PG8_SA(1, 0), a3, voffA);
            PG8_BAR; PG8_WAIT_L(0); PG8_MMA(1, 0, At, B0); PG8_BAR; PG8_SCHED;
            PG8_STAGE(PG8_SB(1, 1), b3 + hstep, voffB);
            PG8_WAIT_V(6); PG8_BAR; PG8_MMA(1, 1, At, B1); PG8_BAR;
            }
        }
        if constexpr (ALIGN_EPI) { if (wr == 0) PG8_BAR; }
        if constexpr (!Epi::AFTER_DRAIN) { E(acc, cur, wr, wc, fr, fq); S.done(cur); }
        if (!has_next) break;
#pragma unroll
        for (int a = 0; a < 2; ++a)
#pragma unroll
            for (int b = 0; b < 2; ++b)
#pragma unroll
                for (int m = 0; m < 4; ++m)
#pragma unroll
                    for (int n = 0; n < 2; ++n) acc[a][b][m][n] = (f32x4){0.f, 0.f, 0.f, 0.f};
        cur = nxt; cA = nA; cB = nB; ++ui;
        if constexpr (ALIGN_EPI) { if (wr == 1) PG8_BAR; }
    }
    PG8_WAIT_V(0);
    if constexpr (!ALIGN_EPI) { if (wr == 0) PG8_BAR; }
    PG8_BAR;
    if constexpr (Epi::AFTER_DRAIN) { E.fused(acc, cur, wr, wc, fr, fq, lds, wid, lane); S.done(cur); }
#undef PG8_SA
#undef PG8_SB
#undef PG8_STAGE
#undef PG8_LDA
#undef PG8_LDB
#undef PG8_MMA
#undef PG8_WAIT_V
#undef PG8_WAIT_L
#undef PG8_BAR
#undef PG8_SCHED
}
}
#define PG8_SP2 true
#define PG8_ALIGN true
namespace att {
using bf16 = __hip_bfloat16;
constexpr int   D = 128, NW = 8, QBLK = 32, KVBLK = 64;
constexpr float SCALE = 0.088388347648318440f;
constexpr float THR = 8.f;
constexpr int SDEPTH = 2;
constexpr bool STATIC_MAX = true;
constexpr int LDQ = 2048, LDK = 2048, LDO = 2048;
constexpr size_t SHM_V = KVBLK * D * 2, SHM_K = KVBLK * D * 2, SHM_ATTN = 2 * SHM_V + 2 * SHM_K + NW * 64 * 4;
using bf16x8 = __attribute__((ext_vector_type(8))) short;
using s16x4  = __attribute__((ext_vector_type(4))) short;
using f32x16 = __attribute__((ext_vector_type(16))) float;
using f32x8  = __attribute__((ext_vector_type(8))) float;
using u32x4  = __attribute__((ext_vector_type(4))) unsigned;
#define KSWZ(row, colB) ((row) * 256 + ((colB) ^ (((row) & 7) << 4)))
#define SBAR() __builtin_amdgcn_sched_barrier(0)
__device__ __forceinline__ int crow(int r, int hi) { return (r & 3) + 8 * (r >> 2) + 4 * hi; }
__device__ __forceinline__ unsigned cvtpk(float lo, float hi) {
  unsigned r; asm volatile("v_cvt_pk_bf16_f32 %0, %1, %2" : "=v"(r) : "v"(lo), "v"(hi)); return r;
}
template <typename TIn> struct Stage;
template <> struct Stage<bf16>  { using T = bf16x8;
  __device__ static __forceinline__ T ld8(const bf16* p) { return *reinterpret_cast<const bf16x8*>(p); }
  __device__ static __forceinline__ bf16x8 tobf(T x) { return x; } };
template <> struct Stage<float> { using T = f32x8;
  __device__ static __forceinline__ T ld8(const float* p) { return *reinterpret_cast<const f32x8*>(p); }
  __device__ static __forceinline__ bf16x8 tobf(T x) {
    u32x4 w = {cvtpk(x[0], x[1]), cvtpk(x[2], x[3]), cvtpk(x[4], x[5]), cvtpk(x[6], x[7])}; return *reinterpret_cast<bf16x8*>(&w); } };

__device__ __forceinline__ void partialSM(f32x16& p0, f32x16& p1, float& m_reg, float& mn, float& alpha) {
  constexpr float C = SCALE * 1.4426950408889634f;
  if constexpr (STATIC_MAX) { mn = m_reg; alpha = 1.f; }
  else {
  float pmax = p0[0]; for (int r = 1; r < 16; ++r) pmax = fmaxf(pmax, p0[r]); for (int r = 0; r < 16; ++r) pmax = fmaxf(pmax, p1[r]);
  { auto rr = __builtin_amdgcn_permlane32_swap(__float_as_uint(pmax), __float_as_uint(pmax), false, false);
    pmax = fmaxf(__uint_as_float(rr[0]), __uint_as_float(rr[1])); }
  if (__builtin_expect(__all(pmax - m_reg <= THR / SCALE), 1)) { mn = m_reg; alpha = 1.f; }
  else { mn = fmaxf(m_reg, pmax); alpha = __builtin_amdgcn_exp2f((m_reg - mn) * C); m_reg = mn; }
  }
  float mnC = -mn * C;
  for (int r = 0; r < 16; ++r) p0[r] = fmaf(p0[r], C, mnC); for (int r = 0; r < 16; ++r) p1[r] = fmaf(p1[r], C, mnC);
  for (int r = 0; r < 16; ++r) p0[r] = __builtin_amdgcn_exp2f(p0[r]);
}
__device__ __forceinline__ void finishSM(f32x16& p0, f32x16& p1, float alpha, float& l_reg, bf16x8& pa0, bf16x8& pa1, bf16x8& pa2, bf16x8& pa3) {
  for (int r = 0; r < 16; ++r) p1[r] = __builtin_amdgcn_exp2f(p1[r]);
  float ps = 0; for (int r = 0; r < 16; ++r) ps += p0[r]; for (int r = 0; r < 16; ++r) ps += p1[r];
  { auto rr = __builtin_amdgcn_permlane32_swap(__float_as_uint(ps), __float_as_uint(ps), false, false);
    ps = __uint_as_float(rr[0]) + __uint_as_float(rr[1]); }
  l_reg = l_reg * alpha + ps;
#define PK4(P, BASE, OUT) do { unsigned a0 = cvtpk(P[BASE + 0], P[BASE + 1]), a1 = cvtpk(P[BASE + 2], P[BASE + 3]);   \
    unsigned b0 = cvtpk(P[BASE + 4], P[BASE + 5]), b1 = cvtpk(P[BASE + 6], P[BASE + 7]);                              \
    auto r0 = __builtin_amdgcn_permlane32_swap(a0, b0, false, false); auto r1 = __builtin_amdgcn_permlane32_swap(a1, b1, false, false); \
    u32x4 w = {r0[0], r1[0], r0[1], r1[1]}; OUT = *reinterpret_cast<bf16x8*>(&w); } while (0)
  PK4(p0, 0, pa0); PK4(p0, 8, pa1); PK4(p1, 0, pa2); PK4(p1, 8, pa3);
#undef PK4
}
__device__ __forceinline__ void qkt(f32x16& p0, f32x16& p1, const bf16* Ks, const bf16x8* qr, int r32, int hi) {
  p0 = f32x16{}; p1 = f32x16{};
  for (int d0 = 0; d0 < 8; ++d0) { int cb = (d0 * 16 + hi * 8) * 2;
    bf16x8 b0 = *reinterpret_cast<const bf16x8*>((const char*)Ks + KSWZ(r32, cb));
    bf16x8 b1 = *reinterpret_cast<const bf16x8*>((const char*)Ks + KSWZ(32 + r32, cb));
    p0 = __builtin_amdgcn_mfma_f32_32x32x16_bf16(b0, qr[d0], p0, 0, 0, 0);
    p1 = __builtin_amdgcn_mfma_f32_32x32x16_bf16(b1, qr[d0], p1, 0, 0, 0); }
}
__device__ __forceinline__ int v_st(int k, int c) { const int kk = (k & ~0xC) | ((k & 4) << 1) | ((k & 8) >> 1); return ((kk >> 3) * 4 + (c >> 5)) * 512 + ((kk & 7) * 32 + (c & 31)) * 2; }
__device__ __forceinline__ int v_rd_base(int lane) { return ((lane & 3) << 3) | (((lane >> 2) & 3) << 6) | (((lane >> 4) & 1) << 5) | (((lane >> 5) & 1) << 8); }
constexpr int v_rd_off(int d0, int ks, int half) { return d0 * 512 + ks * 4096 + half * 2048; }
template <int OFF> __device__ __forceinline__ s16x4 tr_read(int vb) {
  s16x4 r; asm volatile("ds_read_b64_tr_b16 %0, %1 offset:%2" : "=&v"(r) : "v"(vb), "i"(OFF) : "memory"); return r;
}
template <int D0> __device__ __forceinline__ void pv_one(f32x16& od, int vb, bf16x8 pa0, bf16x8 pa1, bf16x8 pa2, bf16x8 pa3) {
  const s16x4 l0 = tr_read<v_rd_off(D0, 0, 0)>(vb), h0 = tr_read<v_rd_off(D0, 0, 1)>(vb), l1 = tr_read<v_rd_off(D0, 1, 0)>(vb), h1 = tr_read<v_rd_off(D0, 1, 1)>(vb);
  const s16x4 l2 = tr_read<v_rd_off(D0, 2, 0)>(vb), h2 = tr_read<v_rd_off(D0, 2, 1)>(vb), l3 = tr_read<v_rd_off(D0, 3, 0)>(vb), h3 = tr_read<v_rd_off(D0, 3, 1)>(vb);
  asm volatile("s_waitcnt lgkmcnt(0)" ::: "memory"); SBAR();
#define PK(L, H) (bf16x8){L[0], L[1], L[2], L[3], H[0], H[1], H[2], H[3]}
  od = __builtin_amdgcn_mfma_f32_32x32x16_bf16(pa0, PK(l0, h0), od, 0, 0, 0);
  od = __builtin_amdgcn_mfma_f32_32x32x16_bf16(pa1, PK(l1, h1), od, 0, 0, 0);
  od = __builtin_amdgcn_mfma_f32_32x32x16_bf16(pa2, PK(l2, h2), od, 0, 0, 0);
  od = __builtin_amdgcn_mfma_f32_32x32x16_bf16(pa3, PK(l3, h3), od, 0, 0, 0);
#undef PK
}
__device__ __forceinline__ void pv_d0(f32x16* o, int vb, bf16x8 pa0, bf16x8 pa1, bf16x8 pa2, bf16x8 pa3) {
  pv_one<0>(o[0], vb, pa0, pa1, pa2, pa3); pv_one<1>(o[1], vb, pa0, pa1, pa2, pa3); pv_one<2>(o[2], vb, pa0, pa1, pa2, pa3); pv_one<3>(o[3], vb, pa0, pa1, pa2, pa3);
}
template <typename TQ>
__device__ __forceinline__ void attn_dense_body(const TQ* __restrict__ Qb, const bf16* __restrict__ Kh, const bf16* __restrict__ Vh,
                                                bf16* __restrict__ Ob, int seq, char* lds, float bound) {
  using St = Stage<bf16>; using SQ = Stage<TQ>;
  const int tid = ltid(), wid = tid >> 6, lane = tid & 63, r32 = lane & 31, hi = lane >> 5;
  bf16* V_lds = (bf16*)lds; bf16* K_lds = (bf16*)(lds + 2 * SHM_V);
  float* ws = (float*)(lds + 2 * SHM_V + 2 * SHM_K) + wid * 64; float* li_l = ws; float* al_l = ws + 32;
  float m_reg = STATIC_MAX ? bound : -1e30f, l_reg = 0; f32x16 o[4] = {}; bf16x8 qr[8];
  const TQ* Qw = Qb + (long)(wid * QBLK + r32) * LDQ + hi * 8;
#pragma unroll
  for (int d0 = 0; d0 < 8; ++d0) qr[d0] = SQ::tobf(SQ::ld8(Qw + d0 * 16));
  const int sr = tid >> 4, sc = (tid & 15) * 8, vst0 = v_st(sr, sc), vst1 = v_st(32 + sr, sc);
  const int vb0 = (int)(uintptr_t)V_lds + v_rd_base(lane);
  struct { typename St::T vs0, vs1, ks0, ks1; } sr_[SDEPTH];
#define SLOAD(i, k0) do { sr_[i].vs0 = St::ld8(&Vh[(long)((k0) + sr) * LDK + sc]); sr_[i].vs1 = St::ld8(&Vh[(long)((k0) + 32 + sr) * LDK + sc]); \
    sr_[i].ks0 = St::ld8(&Kh[(long)((k0) + sr) * LDK + sc]); sr_[i].ks1 = St::ld8(&Kh[(long)((k0) + 32 + sr) * LDK + sc]); } while (0)
#define SWRITE(b, i) do { *(bf16x8*)((char*)V_lds + (b) * SHM_V + vst0) = St::tobf(sr_[i].vs0);          \
    *(bf16x8*)((char*)V_lds + (b) * SHM_V + vst1) = St::tobf(sr_[i].vs1); int kc = sc * 2;               \
    *(bf16x8*)((char*)K_lds + (b) * SHM_K + KSWZ(sr, kc)) = St::tobf(sr_[i].ks0);                       \
    *(bf16x8*)((char*)K_lds + (b) * SHM_K + KSWZ(32 + sr, kc)) = St::tobf(sr_[i].ks1); } while (0)
#define SWAIT() do { if constexpr (SDEPTH == 2) asm volatile("s_waitcnt vmcnt(4)" ::: "memory"); else asm volatile("s_waitcnt vmcnt(0)" ::: "memory"); } while (0)
#define RESC(a) do { if (!STATIC_MAX && __any((a) < 1.f)) { if (hi == 0) al_l[r32] = (a); asm volatile("s_waitcnt lgkmcnt(0)" ::: "memory"); \
    for (int d = 0; d < 4; ++d) for (int r = 0; r < 16; ++r) o[d][r] *= al_l[crow(r, hi)]; } } while (0)
  f32x16 pA0, pA1, pB0, pB1; float mnA, mnB, alA, alB; bf16x8 pa0, pa1, pa2, pa3; const int NT = seq / KVBLK;
  constexpr int SE = 0, SO = SDEPTH - 1;
  SLOAD(SE, 0); asm volatile("s_waitcnt vmcnt(0)" ::: "memory"); SWRITE(0, SE); __syncthreads();
  qkt(pA0, pA1, K_lds, qr, r32, hi); partialSM(pA0, pA1, m_reg, mnA, alA);
  SLOAD(SO, KVBLK); if constexpr (SDEPTH == 2) { if (2 < NT) SLOAD(SE, 2 * KVBLK); }
  SWAIT(); SWRITE(1, SO); __syncthreads();
  for (int j = 1; j + 1 < NT; j += 2) {
    SBAR(); qkt(pB0, pB1, (bf16*)((char*)K_lds + SHM_K), qr, r32, hi);
    finishSM(pA0, pA1, alA, l_reg, pa0, pa1, pa2, pa3); SBAR();
    SLOAD(SO, (j + SDEPTH) * KVBLK); SBAR();
    pv_d0(o, vb0, pa0, pa1, pa2, pa3); partialSM(pB0, pB1, m_reg, mnB, alB);
    __syncthreads(); SWAIT(); SWRITE(0, SE);
    RESC(alB); __syncthreads();
    SBAR(); qkt(pA0, pA1, K_lds, qr, r32, hi);
    finishSM(pB0, pB1, alB, l_reg, pa0, pa1, pa2, pa3); SBAR();
    if (SDEPTH == 1 || j + 3 < NT) SLOAD(SE, (j + 1 + SDEPTH) * KVBLK); SBAR();
    pv_d0(o, vb0 + (int)SHM_V, pa0, pa1, pa2, pa3); partialSM(pA0, pA1, m_reg, mnA, alA);
    __syncthreads(); SWAIT(); SWRITE(1, SO);
    RESC(alA); __syncthreads();
  }
  SBAR(); qkt(pB0, pB1, (bf16*)((char*)K_lds + SHM_K), qr, r32, hi);
  finishSM(pA0, pA1, alA, l_reg, pa0, pa1, pa2, pa3); SBAR();
  pv_d0(o, vb0, pa0, pa1, pa2, pa3); partialSM(pB0, pB1, m_reg, mnB, alB);
  __syncthreads(); RESC(alB);
  finishSM(pB0, pB1, alB, l_reg, pa0, pa1, pa2, pa3); SBAR();
  pv_d0(o, vb0 + (int)SHM_V, pa0, pa1, pa2, pa3);
  if (hi == 0) li_l[r32] = l_reg; asm volatile("s_waitcnt lgkmcnt(0)" ::: "memory");
  float rli[16];
#pragma unroll
  for (int r = 0; r < 16; ++r) rli[r] = __builtin_amdgcn_rcpf(li_l[crow(r, hi)]);
  bf16* Ow = Ob + (long)(wid * QBLK) * LDO;
#pragma unroll
  for (int r = 0; r < 16; ++r) { int orow = crow(r, hi);
    for (int d0 = 0; d0 < 4; ++d0) Ow[(long)orow * LDO + d0 * 32 + r32] = __float2bfloat16(o[d0][r] * rli[r]); }
#undef SLOAD
#undef SWRITE
#undef SWAIT
#undef RESC
}

template <int NC> __device__ __forceinline__ void pv_n(f32x16* o, int vb, bf16x8 pa0, bf16x8 pa1, bf16x8 pa2, bf16x8 pa3) {
  pv_one<0>(o[0], vb, pa0, pa1, pa2, pa3);
  if constexpr (NC > 1) pv_one<1>(o[1], vb, pa0, pa1, pa2, pa3);
  if constexpr (NC > 2) { pv_one<2>(o[2], vb, pa0, pa1, pa2, pa3); pv_one<3>(o[3], vb, pa0, pa1, pa2, pa3); }
}
template <int MB, int NKT, class BR, class ST>
__device__ __forceinline__ void dft_unit(const bf16* __restrict__ A, int lda, const BR& br, const ST& st, char* lds) {
  constexpr int NBW = 8 / MB, NC = 4 / NBW;
  const int tid = ltid(), wid = tid >> 6, lane = tid & 63, r32 = lane & 31, hi = lane >> 5;
  const int mb = wid % MB, cgp = wid / MB;
  const int sr = tid >> 4, sc = (tid & 15) * 8, vst0 = v_st(sr, sc), vst1 = v_st(32 + sr, sc);
  bf16x8 bq[NKT][2], af[NKT][4];
#pragma unroll
  for (int kt = 0; kt < NKT; ++kt) {
    bq[kt][0] = *reinterpret_cast<const bf16x8*>(br.row(kt * 64 + sr) + sc);
    bq[kt][1] = *reinterpret_cast<const bf16x8*>(br.row(kt * 64 + 32 + sr) + sc);
  }
  const bf16* Aw = A + (long)(mb * 32 + r32) * lda + hi * 8;
#pragma unroll
  for (int kt = 0; kt < NKT; ++kt)
#pragma unroll
    for (int ks = 0; ks < 4; ++ks) af[kt][ks] = *reinterpret_cast<const bf16x8*>(Aw + kt * 64 + ks * 16);
  __syncthreads();
#pragma unroll
  for (int kt = 0; kt < NKT; ++kt) {
    *(bf16x8*)(lds + kt * 16384 + vst0) = bq[kt][0];
    *(bf16x8*)(lds + kt * 16384 + vst1) = bq[kt][1];
  }
  __syncthreads();
  f32x16 o[NC];
#pragma unroll
  for (int d = 0; d < NC; ++d) o[d] = f32x16{};
  const int vb = (int)(uintptr_t)lds + v_rd_base(lane) + cgp * NC * 512;
#pragma unroll
  for (int kt = 0; kt < NKT; ++kt) pv_n<NC>(o, vb + kt * 16384, af[kt][0], af[kt][1], af[kt][2], af[kt][3]);
  bf16* stg = (bf16*)(lds + 65536) + wid * 4096;
  const float sc_ = st.scale;
#pragma unroll
  for (int r = 0; r < 16; ++r) {
#pragma unroll
    for (int d = 0; d < NC; ++d) stg[crow(r, hi) * (NC * 32) + d * 32 + r32] = __float2bfloat16(o[d][r] * sc_);
  }
  asm volatile("s_waitcnt lgkmcnt(0)" ::: "memory");
#pragma unroll
  for (int i = 0; i < NC * 2; ++i) { const int idx = i * 64 + lane, row = idx / (NC * 4), cc = idx % (NC * 4);
    const u32x4 v = *(const u32x4*)(stg + row * (NC * 32) + cc * 8);
    st.store16(mb * 32 + row, cgp * NC * 32 + cc * 8, v); }
  asm volatile("s_waitcnt lgkmcnt(0)" ::: "memory");
}
#undef SBAR
#undef KSWZ
}

namespace cg = cooperative_groups;
#define LAS __attribute__((address_space(3)))
typedef unsigned short bf16_t;
typedef unsigned v4u __attribute__((ext_vector_type(4)));
typedef unsigned v2u __attribute__((ext_vector_type(2)));
typedef float f4 __attribute__((ext_vector_type(4)));

#define XB_TMO      128
#define XB_XCNT(j)  (256  + 64 * (j))
#define XB_XSUB(j)  (1280 + 64 * (j))
#define XB_XGEN(j)  (2304 + 64 * (j))
#define XB_TOP      3328
#define XB_TOPGEN   3392
#define XCD_BAR_WORDS 3456
#define XB_SPIN_CAP (1u << 18)

__device__ __forceinline__ unsigned xb_ld(unsigned* p)              { return __hip_atomic_load(p, __ATOMIC_RELAXED, __HIP_MEMORY_SCOPE_AGENT); }
__device__ __forceinline__ unsigned xb_add(unsigned* p, unsigned v) { return __hip_atomic_fetch_add(p, v, __ATOMIC_RELAXED, __HIP_MEMORY_SCOPE_AGENT); }
__device__ __forceinline__ unsigned xb_xcc_id() { return (unsigned)__builtin_amdgcn_s_getreg((3 << 11) | 20) & 0xFu; }
#define XB_SPIN(cond, bar) do { unsigned _sp = 0; while (cond) { __builtin_amdgcn_s_sleep(1); \
    if ((++_sp & 255u) == 0u) { if (xb_ld(&(bar)[XB_TMO])) break; if (_sp > XB_SPIN_CAP) { atomicAdd(&(bar)[XB_TMO], 1u); break; } } } } while (0)

struct XcdBarrier {
    unsigned* bar; unsigned x;
    volatile LAS unsigned* st;
};

__device__ __forceinline__ XcdBarrier xcd_barrier_post(unsigned* bar, volatile LAS unsigned* st) {
    XcdBarrier b; b.bar = bar; b.x = xb_xcc_id(); b.st = st;
    if (threadIdx.x == 0) (void)xb_add(&bar[XB_XCNT(b.x)], 1u);
    return b;
}
__device__ __forceinline__ void xcd_barrier_complete(unsigned* bar, unsigned x, unsigned& nloc, unsigned& nx) {
    const unsigned G = gridDim.x * gridDim.y * gridDim.z;
    unsigned sum, cnt, mine, sp = 0u;
    for (;;) {
        sum = 0u; cnt = 0u; mine = 0u;
#pragma unroll
        for (unsigned j = 0; j < 16; ++j) { const unsigned c = xb_ld(&bar[XB_XCNT(j)]); sum += c; cnt += (c > 0u) ? 1u : 0u; mine = (j == x) ? c : mine; }
        if (sum == G) break;
        __builtin_amdgcn_s_sleep(1);
        if ((++sp & 255u) == 0u) { if (xb_ld(&bar[XB_TMO])) break; if (sp > XB_SPIN_CAP) { atomicAdd(&bar[XB_TMO], 1u); break; } }
    }
    nloc = mine > 0u ? mine : 1u; nx = cnt > 0u ? cnt : 1u;
}

__device__ __forceinline__ void xcd_barrier(const XcdBarrier& b) {
    asm volatile("s_waitcnt vmcnt(0)" ::: "memory");
    __syncthreads();
    if (threadIdx.x == 0) {
        unsigned* bar = b.bar;
        __builtin_amdgcn_s_waitcnt(0);
        unsigned nloc = b.st[0], nx = b.st[1];
        if (nloc == 0u) { xcd_barrier_complete(bar, b.x, nloc, nx); b.st[0] = nloc; b.st[1] = nx; }
        const unsigned old = xb_add(&bar[XB_XSUB(b.x)], 1u);
        const unsigned gen = old / nloc;
        if (old + 1u == (gen + 1u) * nloc) {
            __builtin_amdgcn_fence(__ATOMIC_RELEASE, "agent");
            asm volatile("s_waitcnt vmcnt(0)" ::: "memory");
            const unsigned og = xb_add(&bar[XB_TOP], 1u);
            const unsigned tg = og / nx;
            if (og + 1u == (tg + 1u) * nx) xb_add(&bar[XB_TOPGEN], 1u);
            else XB_SPIN(xb_ld(&bar[XB_TOPGEN]) == tg, bar);
            __builtin_amdgcn_fence(__ATOMIC_ACQUIRE, "agent");
            xb_add(&bar[XB_XGEN(b.x)], 1u);
            asm volatile("s_waitcnt vmcnt(0)" ::: "memory");
        } else {
            XB_SPIN(xb_ld(&bar[XB_XGEN(b.x)]) == gen, bar);
            __builtin_amdgcn_fence(__ATOMIC_ACQUIRE, "agent");
            asm volatile("s_waitcnt vmcnt(0)" ::: "memory");
        }
    }
    __syncthreads();
}

constexpr int DM = 2048, MTOK = 65536, NIN = 3072, DFF = 5632, NUP = 11264, WINW = 2560;
constexpr int NPROMPT = 32768;
constexpr int CHUNK = 65536, NCHUNK = 1;
constexpr float EPS = 1e-6f;
constexpr size_t MiB = (size_t)1 << 20;
constexpr size_t WS_M2F = 0;
constexpr size_t WS_COS = 1 * MiB, WS_SIN = 5 * MiB;
constexpr size_t WS_A1P = 9 * MiB, WS_A1S = 9 * MiB + 128 * 1024;
constexpr size_t WS_A3P = 10 * MiB, WS_A3S = 18 * MiB;
constexpr size_t WS_BAR = 19 * MiB, BAR_BYTES = 16384;
constexpr size_t WS_W = 20 * MiB;
constexpr size_t W_LAYER = 86 * MiB, W_OUT_OFF = 12 * MiB, W_UP_OFF = 20 * MiB, W_DOWN_OFF = 64 * MiB;
constexpr size_t WS_XH = 192 * MiB;
constexpr size_t WS_Z = 448 * MiB;
constexpr size_t WS_G = 704 * MiB;
constexpr size_t WS_Y = 832 * MiB;
constexpr size_t WS_ACT = 448 * MiB;
constexpr size_t WS_HB = 1152 * MiB;
constexpr size_t WS_XB = 1240 * MiB;
constexpr size_t WS_END = 1496 * MiB;
constexpr int LDS_BYTES = 135168;

__device__ __forceinline__ float bf2f(unsigned short b) { return __uint_as_float((unsigned)b << 16); }
__device__ __forceinline__ float bflo(unsigned w) { return __uint_as_float(w << 16); }
__device__ __forceinline__ float bfhi(unsigned w) { return __uint_as_float(w & 0xffff0000u); }
__device__ __forceinline__ unsigned pk2(float lo, float hi) { return pg8::cvt_pk_bf16(lo, hi); }
__device__ __forceinline__ float wave_sum(float v) {
#pragma unroll
    for (int o = 1; o < 64; o <<= 1) v += __shfl_xor(v, o);
    return v;
}

struct EpiWin {
    static constexpr bool PERM = true, AFTER_DRAIN = false;
    bf16_t* Z; bf16_t* Gp;
    __device__ __forceinline__ void operator()(const pg8::f32x4 (&acc)[2][2][4][2], const pg8::Unit& u, int wr, int wc, int fr, int fq) const {
        const int row0 = u.pm * pg8::BM + wr * 64 + fr;
        bf16_t* base; size_t rstride, bjstride;
        if (u.pn < 8) { base = Z + (size_t)row0 * 2048 + u.pn * 256 + wc * 32 + 8 * fq; rstride = 2048; bjstride = 128; }
        else {
            const int g = u.pn - 8, r0 = u.pm * pg8::BM; size_t sb; int L, t0;
            if (r0 < NPROMPT) { const int s = r0 >> 14; sb = (size_t)s * (2u * 16384u * 512u); L = 16384; t0 = row0 - s * 16384; }
            else { const int s = (r0 - NPROMPT) >> 12; sb = (size_t)NPROMPT * 1024 + (size_t)s * (2u * 4096u * 512u); L = 4096; t0 = row0 - NPROMPT - s * 4096; }
            base = Gp + sb + (size_t)t0 * 512 + g * 128 + wc * 32 + 8 * fq; rstride = 512; bjstride = (size_t)L * 512;
        }
#pragma unroll
        for (int ai = 0; ai < 2; ++ai)
#pragma unroll
            for (int m = 0; m < 4; ++m) { bf16_t* rowp = base + (size_t)(ai * pg8::HALF + m * 16) * rstride;
#pragma unroll
                for (int bj = 0; bj < 2; ++bj) { const pg8::f32x4 v0 = acc[ai][bj][m][0], v1 = acc[ai][bj][m][1];
                    pg8::u32x4 w; w.x = pk2(v0[0], v0[1]); w.y = pk2(v0[2], v0[3]); w.z = pk2(v1[0], v1[1]); w.w = pk2(v1[2], v1[3]);
                    *(pg8::u32x4*)(rowp + bj * bjstride) = w; } }
    }
};

__device__ __forceinline__ void p0a_tables(const float* fourier_w, unsigned char* ws, LAS float* tab, int gtid, int NT) {
    float* M2F = (float*)(ws + WS_M2F);
    { const int t = ltid(); if (t < 128) { float sn, cs; sincospif((float)t * (2.f / 128.f), &sn, &cs); tab[t] = cs; tab[128 + t] = -sn; } }
    __syncthreads();
    for (int i = gtid; i < 2 * 4 * 128 * 256; i += NT) {
        const int lg = i >> 15, c = (i >> 8) & 127, n = i & 255, part = n >> 7, e2 = n & 127;
        const float* fw = fourier_w + (size_t)lg * 16384 + e2;
        float acc = 0.f;
#pragma unroll 8
        for (int e = 0; e < 128; ++e) { const int r = (c * e) & 127; acc += tab[part * 128 + r] * fw[e * 128]; }
        M2F[i] = acc;
    }
    __syncthreads();
    float* COS = (float*)(ws + WS_COS); float* SIN = (float*)(ws + WS_SIN);
    for (int i = gtid; i < 16384 * 64; i += NT) {
        const int t = i >> 6, j = i & 63; const float pos = (float)(j < 32 ? (t >> 6) : (t & 63));
        const float inv = 1.0f / powf(10000.0f, (float)(j & 31) / 32.0f); const float ang = pos * inv;
        COS[i] = cosf(ang); SIN[i] = sinf(ang);
    }
    bf16_t* A1P = (bf16_t*)(ws + WS_A1P);
    for (int i = gtid; i < 256 * 256; i += NT) { const int m = i >> 8, k = i & 255, pm = m >> 7, k1 = m & 127, pk = k >> 7, t1 = k & 127; const int r = (t1 * k1) & 127;
        float sn, cs; sincospif((float)r * (2.f / 128.f), &sn, &cs); const float v = (pm == pk) ? cs : (pm == 0 ? sn : -sn); A1P[i] = (bf16_t)(pk2(v, 0.f) & 0xffff); }
    bf16_t* A1S = (bf16_t*)(ws + WS_A1S);
    for (int i = gtid; i < 128 * 128; i += NT) { const int m = i >> 7, k = i & 127, pm = m >> 6, k1 = m & 63, pk = k >> 6, t1 = k & 63; const int r = (t1 * k1) & 63;
        float sn, cs; sincospif((float)r * (2.f / 64.f), &sn, &cs); const float v = (pm == pk) ? cs : (pm == 0 ? sn : -sn); A1S[i] = (bf16_t)(pk2(v, 0.f) & 0xffff); }
    bf16_t* A3P = (bf16_t*)(ws + WS_A3P);
    for (int i = gtid; i < 128 * 128 * 256; i += NT) { const int k1 = i >> 15, k2 = (i >> 8) & 127, kk = i & 255, part = kk >> 7, t2 = kk & 127; const int k = k1 + 128 * k2; const int r = (t2 * k) & 16383;
        float sn, cs; sincospif((float)r * (1.f / 8192.f), &sn, &cs); A3P[i] = (bf16_t)(pk2(part ? sn : cs, 0.f) & 0xffff); }
    bf16_t* A3S = (bf16_t*)(ws + WS_A3S);
    for (int i = gtid; i < 64 * 64 * 128; i += NT) { const int k1 = i >> 13, k2 = (i >> 7) & 63, kk = i & 127, part = kk >> 6, t2 = kk & 63; const int k = k1 + 64 * k2; const int r = (t2 * k) & 4095;
        float sn, cs; sincospif((float)r * (1.f / 2048.f), &sn, &cs); A3S[i] = (bf16_t)(pk2(part ? sn : cs, 0.f) & 0xffff); }
}

struct ValUp { const float* W; __device__ __forceinline__ const float* ptr(int k, int n) const { const int src = ((n >> 7) & 1) * DFF + (n >> 8) * 128 + (n & 127); return W + (size_t)k * NUP + src; }
    __device__ __forceinline__ float operator()(int k, int n) const { return *ptr(k, n); } };
struct ValDirect { const float* W; int ldw; __device__ __forceinline__ const float* ptr(int k, int n) const { return W + (size_t)k * ldw + n; }
    __device__ __forceinline__ float operator()(int k, int n) const { return W[(size_t)k * ldw + n]; } };
struct ValWin { const float* win; const float* poolw; const float* pscale; const float* m2f;
    __device__ __forceinline__ const float* ptr(int k, int n) const { return win + (size_t)k * WINW + n; }
    __device__ __forceinline__ float operator()(int k, int n) const {
        if (n >= 512 && n < 2048) return win[(size_t)k * WINW + n];
        if (n < 512) { const int g = n >> 7, e = n & 127; const float* wr = win + (size_t)k * WINW + g * 128; const float* pw = poolw + g * 16384 + e; float acc = 0.f;
            for (int c = 0; c < 128; ++c) acc += wr[c] * pw[c * 128]; return acc * pscale[n]; }
        const int n2 = n - 2048, g = n2 >> 8, np = n2 & 255; const float* wr = win + (size_t)k * WINW + 2048 + g * 128; const float* mf = m2f + g * 32768 + np; float acc = 0.f;
        for (int c = 0; c < 128; ++c) acc += wr[c] * mf[c * 256]; return acc; } };
template <class F> __device__ __forceinline__ void transpose_item(const F& val, int K, bf16_t* WT, int k0, int n0, LAS float* scr, int lane) {
    for (int i = 0; i < 32; ++i) { const int kk = 2 * i + (lane >> 5); scr[kk * 33 + (lane & 31)] = val(k0 + kk, n0 + (lane & 31)); }
    asm volatile("s_waitcnt lgkmcnt(0)" ::: "memory");
    const int c = lane & 7;
#pragma unroll
    for (int j = 0; j < 4; ++j) { const int n = (lane >> 3) + 8 * j; const LAS float* s = scr + (8 * c) * 33 + n;
        v4u o; o.x = pk2(s[0 * 33], s[1 * 33]); o.y = pk2(s[2 * 33], s[3 * 33]); o.z = pk2(s[4 * 33], s[5 * 33]); o.w = pk2(s[6 * 33], s[7 * 33]);
        *(v4u*)(WT + (size_t)(n0 + n) * K + k0 + 8 * c) = o; }
    asm volatile("s_waitcnt lgkmcnt(0)" ::: "memory");
}
template <class F> __device__ __forceinline__ void tr_load(const F& f, int k0, int n0, int lane, f4 (&v)[8]) {
#pragma unroll
    for (int i = 0; i < 8; ++i) v[i] = __builtin_nontemporal_load((const f4*)f.ptr(k0 + 8 * i + (lane >> 3), n0 + 4 * (lane & 7)));
}
__device__ __forceinline__ void tr_store(const f4 (&v)[8], int K, bf16_t* WT, int k0, int n0, LAS float* scr, int lane) {
#pragma unroll
    for (int i = 0; i < 8; ++i) { LAS float* d = scr + (8 * i + (lane >> 3)) * 33 + 4 * (lane & 7); d[0] = v[i].x; d[1] = v[i].y; d[2] = v[i].z; d[3] = v[i].w; }
    asm volatile("s_waitcnt lgkmcnt(0)" ::: "memory");
    const int c = lane & 7;
#pragma unroll
    for (int j = 0; j < 4; ++j) { const int n = (lane >> 3) + 8 * j; const LAS float* s = scr + (8 * c) * 33 + n;
        v4u o; o.x = pk2(s[0 * 33], s[1 * 33]); o.y = pk2(s[2 * 33], s[3 * 33]); o.z = pk2(s[4 * 33], s[5 * 33]); o.w = pk2(s[6 * 33], s[7 * 33]);
        *(v4u*)(WT + (size_t)(n0 + n) * K + k0 + 8 * c) = o; }
    asm volatile("s_waitcnt lgkmcnt(0)" ::: "memory");
}
template <class F> __device__ __forceinline__ void transpose_matrix(const F& val, int K, int N, bf16_t* WT, LAS float* scr, int gw, int NGW, int lane, int nlo, int nhi) {
    const int nblk = (nhi - nlo) / 32, nitems = (K / 64) * nblk;
    int it = gw; if (it >= nitems) return;
    f4 cur[8], nxt[8];
    tr_load(val, 64 * (it / nblk), nlo + 32 * (it % nblk), lane, cur);
    for (; it < nitems; it += NGW) {
        const int k0 = 64 * (it / nblk), n0 = nlo + 32 * (it % nblk); const int it2 = it + NGW; const bool more = it2 < nitems;
        if (more) tr_load(val, 64 * (it2 / nblk), nlo + 32 * (it2 % nblk), lane, nxt);
        tr_store(cur, K, WT, k0, n0, scr, lane);
        if (more) {
#pragma unroll
            for (int i = 0; i < 8; ++i) cur[i] = nxt[i]; }
    }
}

typedef float __attribute__((address_space(4))) cf32;
__device__ __forceinline__ void fold_items(const float* win, const float* poolw, const float* pscale, const float* m2f, bf16_t* WT, int gw, int NGW, int lane) {
    for (int it = gw; it < 64 * 24; it += NGW) {
        const int kb = it / 24, nb = it - kb * 24, k0 = 32 * kb;
        float m2[128]; int base, nout;
        if (nb < 8) { const int n = nb * 64 + lane, g = nb >> 1, e = n & 127; base = g * 128; nout = n; const float sc = pscale[n]; const float* pw = poolw + g * 16384 + e;
#pragma unroll
            for (int c = 0; c < 128; ++c) m2[c] = pw[c * 128] * sc;
        } else { const int n2 = (nb - 8) * 64 + lane, g = (nb - 8) >> 2, np = n2 & 255; base = 2048 + g * 128; nout = 2048 + n2; const float* mf = m2f + g * 32768 + np;
#pragma unroll
            for (int c = 0; c < 128; ++c) m2[c] = mf[c * 256];
        }
        bf16_t* wrow = WT + (size_t)nout * DM + k0;
        for (int kg = 0; kg < 4; ++kg) {
            float acc[8];
#pragma unroll
            for (int kk = 0; kk < 8; ++kk) { const cf32* wr = (const cf32*)(unsigned long long)(win + (size_t)(k0 + 8 * kg + kk) * WINW + base); float a = 0.f;
#pragma unroll
                for (int c = 0; c < 128; ++c) a += wr[c] * m2[c];
                acc[kk] = a; }
            v4u o; o.x = pk2(acc[0], acc[1]); o.y = pk2(acc[2], acc[3]); o.z = pk2(acc[4], acc[5]); o.w = pk2(acc[6], acc[7]);
            *(v4u*)(wrow + 8 * kg) = o;
        }
    }
}

__device__ __forceinline__ const float* xrow_ptr(const float* xa, const float* xb, int row) { return (row < NPROMPT) ? xa + (size_t)row * DM : xb + (size_t)(row - NPROMPT) * DM; }
template <bool XBF, bool OBF, int RR>
__device__ __forceinline__ void resid_rows(const float* xa, const float* xb, const bf16_t* xbf, const bf16_t* m, const float* g1, float* xout, bf16_t* xbout, bf16_t* xh, const float* g2, int gw, int NGW, int lane) {
    for (int row0 = gw; row0 < MTOK; row0 += RR * NGW) {
        f4 xf[XBF ? 1 : RR][8]; v2u xp[XBF ? RR : 1][8]; v2u mw[RR][8];
#pragma unroll
        for (int u = 0; u < RR; ++u) { const int row = row0 + u * NGW;
            if constexpr (XBF) { const bf16_t* xr = xbf + (size_t)row * DM;
#pragma unroll
                for (int j = 0; j < 8; ++j) xp[u][j] = *(const v2u*)(xr + 4 * lane + 256 * j);
            } else { const float* xr = xrow_ptr(xa, xb, row);
#pragma unroll
                for (int j = 0; j < 8; ++j) xf[u][j] = __builtin_nontemporal_load((const f4*)(xr + 4 * lane + 256 * j)); } }
        if (m) {
#pragma unroll
            for (int u = 0; u < RR; ++u) { const bf16_t* mr = m + (size_t)(row0 + u * NGW) * DM;
#pragma unroll
                for (int j = 0; j < 8; ++j) mw[u][j] = *(const v2u*)(mr + 4 * lane + 256 * j); }
        }
#pragma unroll
        for (int u = 0; u < RR; ++u) { const int row = row0 + u * NGW;
            f4 xv[8];
#pragma unroll
            for (int j = 0; j < 8; ++j) { if constexpr (XBF) { const v2u w = xp[u][j]; xv[j] = (f4){bflo(w.x), bfhi(w.x), bflo(w.y), bfhi(w.y)}; } else xv[j] = xf[u][j]; }
            if (m) { float ss = 0.f;
#pragma unroll
                for (int j = 0; j < 8; ++j) { const v2u w = mw[u][j]; const f4 mv = (f4){bflo(w.x), bfhi(w.x), bflo(w.y), bfhi(w.y)}; ss += (mv.x * mv.x + mv.y * mv.y) + (mv.z * mv.z + mv.w * mv.w); }
                const float r = 1.0f / sqrtf(wave_sum(ss) * (1.f / DM) + EPS);
#pragma unroll
                for (int j = 0; j < 8; ++j) { const v2u w = mw[u][j]; const f4 mv = (f4){bflo(w.x), bfhi(w.x), bflo(w.y), bfhi(w.y)}; const f4 gv = *(const f4*)(g1 + 4 * lane + 256 * j); xv[j] += mv * r * gv; } }
            if constexpr (OBF) { if (xbout) {
#pragma unroll
                for (int j = 0; j < 8; ++j) { v2u w; w.x = pk2(xv[j].x, xv[j].y); w.y = pk2(xv[j].z, xv[j].w); *(v2u*)(xbout + (size_t)row * DM + 4 * lane + 256 * j) = w; } }
            } else { if (xout) {
#pragma unroll
                for (int j = 0; j < 8; ++j) __builtin_nontemporal_store(xv[j], (f4*)(xout + (size_t)row * DM + 4 * lane + 256 * j)); } }
            if (xh) { float ss = 0.f;
#pragma unroll
                for (int j = 0; j < 8; ++j) ss += (xv[j].x * xv[j].x + xv[j].y * xv[j].y) + (xv[j].z * xv[j].z + xv[j].w * xv[j].w);
                const float r = 1.0f / sqrtf(wave_sum(ss) * (1.f / DM) + EPS);
#pragma unroll
                for (int j = 0; j < 8; ++j) { const f4 gv = *(const f4*)(g2 + 4 * lane + 256 * j); const f4 y = xv[j] * r * gv;
                    v2u w; w.x = pk2(y.x, y.y); w.y = pk2(y.z, y.w); *(v2u*)(xh + (size_t)row * DM + 4 * lane + 256 * j) = w; } }
        }
    }
}

__device__ __forceinline__ void rope_pass(bf16_t* Z, bf16_t* Zout, const float* qn, const float* kn, const float* COS, const float* SIN, int gtid, int NT) {
    const int hw = gtid >> 5, NHW = NT >> 5, j = gtid & 31;
    const float qa0 = qn[2 * j], qa1 = qn[2 * j + 1], qb0 = qn[64 + 2 * j], qb1 = qn[65 + 2 * j];
    const float ka0 = kn[2 * j], ka1 = kn[2 * j + 1], kb0 = kn[64 + 2 * j], kb1 = kn[65 + 2 * j];
    for (int row = hw; row < MTOK; row += NHW) {
        const int t = row < NPROMPT ? (row & 16383) : (row & 4095);
        bf16_t* p = Z + (size_t)row * DM + 512 + 2 * j;
        unsigned a[10], b[10];
#pragma unroll
        for (int hh = 0; hh < 10; ++hh) { a[hh] = *(const unsigned*)(p + hh * 128); b[hh] = *(const unsigned*)(p + hh * 128 + 64); }
        const float c0 = COS[t * 64 + 2 * j], c1 = COS[t * 64 + 2 * j + 1], s0 = SIN[t * 64 + 2 * j], s1 = SIN[t * 64 + 2 * j + 1];
#pragma unroll
        for (int hh = 0; hh < 10; ++hh) {
            float x0 = bflo(a[hh]), x1 = bfhi(a[hh]), y0 = bflo(b[hh]), y1 = bfhi(b[hh]);
            float ss = (x0 * x0 + x1 * x1) + (y0 * y0 + y1 * y1);
#pragma unroll
            for (int o = 1; o < 32; o <<= 1) ss += __shfl_xor(ss, o);
            const float r = 1.0f / sqrtf(ss * (1.f / 128.f) + EPS);
            x0 *= r * (hh < 8 ? qa0 : ka0); x1 *= r * (hh < 8 ? qa1 : ka1); y0 *= r * (hh < 8 ? qb0 : kb0); y1 *= r * (hh < 8 ? qb1 : kb1);
            const float ox0 = x0 * c0 - y0 * s0, oy0 = y0 * c0 + x0 * s0, ox1 = x1 * c1 - y1 * s1, oy1 = y1 * c1 + x1 * s1;
            bf16_t* po = Zout + (size_t)row * DM + 512 + 2 * j;
            *(unsigned*)(po + hh * 128) = pk2(ox0, ox1); *(unsigned*)(po + hh * 128 + 64) = pk2(oy0, oy1);
        }
    }
}

__device__ __forceinline__ void acc8(float* s, const bf16_t* p, float sg) { const v4u v = *(const v4u*)p;
    s[0] += sg * bflo(v.x); s[1] += sg * bfhi(v.x); s[2] += sg * bflo(v.y); s[3] += sg * bfhi(v.y); s[4] += sg * bflo(v.z); s[5] += sg * bfhi(v.z); s[6] += sg * bflo(v.w); s[7] += sg * bfhi(v.w); }
__device__ __forceinline__ void pool_pass(const bf16_t* Z, bf16_t* H, int gtid, int NT) {
    constexpr int RL = 32;
    for (int it = gtid; it < (MTOK / RL) * 64; it += NT) {
        const int ch = it & 63, run = it >> 6, c0 = ch * 8, g = ch >> 4, w = 2 << g, a = w >> 1, b = w - 1 - a;
        const int row0 = run * RL; int t0, L; if (row0 < NPROMPT) { t0 = row0 & 16383; L = 16384; } else { t0 = row0 & 4095; L = 4096; }
        const bf16_t* zb = Z + (size_t)(row0 - t0) * DM + c0;
        float s[8] = {0.f, 0.f, 0.f, 0.f, 0.f, 0.f, 0.f, 0.f};
        { const int lo = t0 - a < 0 ? 0 : t0 - a, hi = t0 + b > L - 1 ? L - 1 : t0 + b;
          for (int tt = lo; tt <= hi; ++tt) acc8(s, zb + (size_t)tt * DM, 1.f); }
#pragma unroll 4
        for (int r = 0; r < RL; ++r) {
            const int t = t0 + r; const int lo = t - a < 0 ? 0 : t - a, hi = t + b > L - 1 ? L - 1 : t + b;
            const float ic = 1.0f / (float)(hi - lo + 1);
            const v4u v = *(const v4u*)(zb + (size_t)t * DM);
            v4u o; o.x = pk2(s[0] * ic - bflo(v.x), s[1] * ic - bfhi(v.x)); o.y = pk2(s[2] * ic - bflo(v.y), s[3] * ic - bfhi(v.y));
            o.z = pk2(s[4] * ic - bflo(v.z), s[5] * ic - bfhi(v.z)); o.w = pk2(s[6] * ic - bflo(v.w), s[7] * ic - bfhi(v.w));
            *(v4u*)(H + (size_t)(row0 + r) * DM + c0) = o;
            if (t + 1 + b <= L - 1) acc8(s, zb + (size_t)(t + 1 + b) * DM, 1.f);
            if (t - a >= 0) acc8(s, zb + (size_t)(t - a) * DM, -1.f);
        }
    }
}

__device__ __forceinline__ float gelu_tanh(float x) { const float y = 0.7978845608028654f * (x + 0.044715f * x * x * x); return x * __builtin_amdgcn_rcpf(1.0f + __expf(-2.0f * y)); }
__device__ __forceinline__ void ld8f(const bf16_t* p, float* o) { const v4u v = *(const v4u*)p; o[0] = bflo(v.x); o[1] = bfhi(v.x); o[2] = bflo(v.y); o[3] = bfhi(v.y); o[4] = bflo(v.z); o[5] = bfhi(v.z); o[6] = bflo(v.w); o[7] = bfhi(v.w); }
__device__ __forceinline__ float dpp_ror1(float v) { return __int_as_float(__builtin_amdgcn_update_dpp(0, __float_as_int(v), 0x121, 0xf, 0xf, false)); }
__device__ __forceinline__ float dpp_ror15(float v) { return __int_as_float(__builtin_amdgcn_update_dpp(0, __float_as_int(v), 0x12F, 0xf, 0xf, false)); }
struct EpiGlu {
    static constexpr bool PERM = true, AFTER_DRAIN = false;
    bf16_t* ACT; bf16_t* HB; const float* cw; const float* cb;
    __device__ __forceinline__ void operator()(const pg8::f32x4 (&acc)[2][2][4][2], const pg8::Unit& u, int wr, int wc, int fr, int fq) const {
        const int jc = u.pn * 128 + wc * 32 + 8 * fq;
        const bool first = (fr == 0), last = (fr == 15);
        v2u stash[2][4];
#pragma unroll
        for (int n = 0; n < 2; ++n) {
            const f4 w0g = *(const f4*)(cw + jc + 4 * n), w1g = *(const f4*)(cw + NUP + jc + 4 * n), w2g = *(const f4*)(cw + 2 * NUP + jc + 4 * n), bg = *(const f4*)(cb + jc + 4 * n);
            const f4 w0v = *(const f4*)(cw + DFF + jc + 4 * n), w1v = *(const f4*)(cw + NUP + DFF + jc + 4 * n), w2v = *(const f4*)(cw + 2 * NUP + DFF + jc + 4 * n), bv = *(const f4*)(cb + DFF + jc + 4 * n);
#pragma unroll
            for (int ai = 0; ai < 2; ++ai) {
                float g1p[4], v1p[4], g15c[4], v15c[4];
#pragma unroll
                for (int i = 0; i < 4; ++i) { g1p[i] = 0.f; v1p[i] = 0.f; g15c[i] = dpp_ror15(acc[ai][0][0][n][i]); v15c[i] = dpp_ror15(acc[ai][1][0][n][i]); }
#pragma unroll
                for (int m = 0; m < 4; ++m) {
                    const int mn = m < 3 ? m + 1 : 3;
                    float o[4];
#pragma unroll
                    for (int i = 0; i < 4; ++i) {
                        const float g = acc[ai][0][m][n][i], v = acc[ai][1][m][n][i];
                        const float g1c = dpp_ror1(g), v1c = dpp_ror1(v), g15n = dpp_ror15(acc[ai][0][mn][n][i]), v15n = dpp_ror15(acc[ai][1][mn][n][i]);
                        const float gp = first ? g1p[i] : g1c, gn = last ? g15n : g15c[i], vp = first ? v1p[i] : v1c, vn = last ? v15n : v15c[i];
                        g1p[i] = g1c; v1p[i] = v1c; g15c[i] = g15n; v15c[i] = v15n;
                        const float a = gp * w0g[i] + g * w1g[i] + gn * w2g[i] + bg[i];
                        const float b = vp * w0v[i] + v * w1v[i] + vn * w2v[i] + bv[i];
                        const float e = __builtin_amdgcn_exp2f(a * (-2.3022082f + -0.10294324f * (a * a)));
                        o[i] = a * __builtin_amdgcn_rcpf(1.0f + e) * b;
                    }
                    const int row = u.pm * pg8::BM + ai * pg8::HALF + wr * 64 + m * 16 + fr;
                    v2u w; w.x = pk2(o[0], o[1]); w.y = pk2(o[2], o[3]);
                    if (n == 0) stash[ai][m] = w;
                    else { v4u ww; ww.x = stash[ai][m].x; ww.y = stash[ai][m].y; ww.z = w.x; ww.w = w.y; *(v4u*)(ACT + (size_t)row * DFF + jc) = ww; }
                }
            }
        }
#pragma unroll
        for (int ai = 0; ai < 2; ++ai) {
            const int grp = u.pm * 4 + ai * 2 + wr;
            if (fr < 2 || fr >= 14) {
                const int m = fr < 2 ? 0 : 3, slot = fr < 2 ? fr : fr - 12;
                bf16_t* hp = HB + ((size_t)grp * 4 + slot) * NUP + u.pn * 256 + wc * 32 + 8 * fq;
#pragma unroll
                for (int bj = 0; bj < 2; ++bj) {
                    const pg8::f32x4 v0 = fr < 2 ? acc[ai][bj][0][0] : acc[ai][bj][3][0], v1 = fr < 2 ? acc[ai][bj][0][1] : acc[ai][bj][3][1];
                    v4u w; w.x = pk2(v0[0], v0[1]); w.y = pk2(v0[2], v0[3]); w.z = pk2(v1[0], v1[1]); w.w = pk2(v1[2], v1[3]);
                    *(v4u*)(hp + bj * 128) = w;
                }
                (void)m;
            }
        }
    }
};
__device__ __forceinline__ void glu_fix(const bf16_t* HB, bf16_t* ACT, const float* cw, const float* cb, int gtid, int NT) {
    constexpr int NCC = DFF / 8, NG = CHUNK / 64;
    for (int it = gtid; it < NG * 2 * NCC; it += NT) {
        const int cc = it % NCC, rest = it / NCC, which = rest & 1, g = rest >> 1, j0 = cc * 8, colp = (j0 >> 7) * 256 + (j0 & 127);
        const int row = g * 64 + (which ? 63 : 0); const int Lc = row < NPROMPT ? 16384 : 4096;
        const bf16_t *P, *C, *N;
        if (!which) { C = HB + ((size_t)g * 4 + 0) * NUP; N = HB + ((size_t)g * 4 + 1) * NUP; P = ((row & (Lc - 1)) == 0) ? nullptr : HB + ((size_t)(g - 1) * 4 + 3) * NUP; }
        else { P = HB + ((size_t)g * 4 + 2) * NUP; C = HB + ((size_t)g * 4 + 3) * NUP; N = (((row + 1) & (Lc - 1)) == 0) ? nullptr : HB + ((size_t)(g + 1) * 4 + 0) * NUP; }
        float pg[8], pv[8], cg_[8], cv[8], ng[8], nv[8];
        if (P) { ld8f(P + colp, pg); ld8f(P + colp + 128, pv); } else {
#pragma unroll
            for (int i = 0; i < 8; ++i) { pg[i] = 0.f; pv[i] = 0.f; } }
        if (N) { ld8f(N + colp, ng); ld8f(N + colp + 128, nv); } else {
#pragma unroll
            for (int i = 0; i < 8; ++i) { ng[i] = 0.f; nv[i] = 0.f; } }
        ld8f(C + colp, cg_); ld8f(C + colp + 128, cv);
        float o[8];
#pragma unroll
        for (int h = 0; h < 2; ++h) {
            const f4 w0g = *(const f4*)(cw + j0 + 4 * h), w1g = *(const f4*)(cw + NUP + j0 + 4 * h), w2g = *(const f4*)(cw + 2 * NUP + j0 + 4 * h), bg = *(const f4*)(cb + j0 + 4 * h);
            const f4 w0v = *(const f4*)(cw + DFF + j0 + 4 * h), w1v = *(const f4*)(cw + NUP + DFF + j0 + 4 * h), w2v = *(const f4*)(cw + 2 * NUP + DFF + j0 + 4 * h), bv = *(const f4*)(cb + DFF + j0 + 4 * h);
#pragma unroll
            for (int q = 0; q < 4; ++q) { const int i = 4 * h + q;
                const float a = pg[i] * w0g[q] + cg_[i] * w1g[q] + ng[i] * w2g[q] + bg[q];
                const float b = pv[i] * w0v[q] + cv[i] * w1v[q] + nv[i] * w2v[q] + bv[q];
                o[i] = gelu_tanh(a) * b; } }
        v4u w; w.x = pk2(o[0], o[1]); w.y = pk2(o[2], o[3]); w.z = pk2(o[4], o[5]); w.w = pk2(o[6], o[7]);
        *(v4u*)(ACT + (size_t)row * DFF + j0) = w;
    }
}

struct BRow1 { const att::bf16* base; size_t ldb; __device__ __forceinline__ const att::bf16* row(int kk) const { return base + (size_t)kk * ldb; } };
struct St1 { att::bf16* base; size_t ldb; float scale; __device__ __forceinline__ void store16(int m, int c, att::u32x4 v) const { *(att::u32x4*)(base + (size_t)m * ldb + c) = v; } };
struct BRow3 { const att::bf16* base; int R, lgR, k1; __device__ __forceinline__ const att::bf16* row(int kk) const { const int part = kk >> lgR, t2 = kk & (R - 1); return base + (size_t)(((part << lgR) + k1) * R + t2) * 512; } };
struct St3 { att::bf16* base; int R; float scale; __device__ __forceinline__ void store16(int m, int c, att::u32x4 v) const { *(att::u32x4*)(base + (size_t)(m * R) * DM + c) = v; } };

__device__ __forceinline__ void dft_stage1(const bf16_t* Gp, bf16_t* Yp, const unsigned char* ws, char* lds, int vcu, int G) {
    for (int it = 0;; ++it) { const int uid = it * G + vcu; if (uid >= 3072) break;
        if (uid < 1024) { const int s = uid >> 9, nt = uid & 511; const size_t off = (size_t)s * (2u * 16384u * 512u) + (size_t)nt * 128;
            BRow1 br{(const att::bf16*)Gp + off, 65536}; St1 st{(att::bf16*)Yp + off, 65536, 1.f};
            att::dft_unit<8, 4>((const att::bf16*)(ws + WS_A1P), 256, br, st, lds);
        } else { const int u2 = uid - 1024, s = u2 >> 8, nt = u2 & 255; const size_t off = (size_t)NPROMPT * 1024 + (size_t)s * (2u * 4096u * 512u) + (size_t)nt * 128;
            BRow1 br{(const att::bf16*)Gp + off, 32768}; St1 st{(att::bf16*)Yp + off, 32768, 1.f};
            att::dft_unit<4, 2>((const att::bf16*)(ws + WS_A1S), 128, br, st, lds);
        }
    }
}
__device__ __forceinline__ void dft_stage3(const bf16_t* Yp, bf16_t* H, const unsigned char* ws, char* lds, int vcu, int G) {
    for (int it = 0;; ++it) { const int uid = it * G + vcu; if (uid >= 3072) break;
        if (uid < 1024) { const int s = uid >> 9, k1 = (uid >> 2) & 127, nt = uid & 3;
            BRow3 br{(const att::bf16*)Yp + (size_t)s * (2u * 16384u * 512u) + nt * 128, 128, 7, k1};
            St3 st{(att::bf16*)H + (size_t)(s * 16384 + k1) * DM + 1536 + nt * 128, 128, 1.0f / sqrtf(16384.f * 128.f)};
            att::dft_unit<4, 4>((const att::bf16*)(ws + WS_A3P) + (size_t)k1 * (128 * 256), 256, br, st, lds);
        } else { const int u2 = uid - 1024, s = u2 >> 8, k1 = (u2 >> 2) & 63, nt = u2 & 3;
            BRow3 br{(const att::bf16*)Yp + (size_t)NPROMPT * 1024 + (size_t)s * (2u * 4096u * 512u) + nt * 128, 64, 6, k1};
            St3 st{(att::bf16*)H + (size_t)(NPROMPT + s * 4096 + k1) * DM + 1536 + nt * 128, 64, 1.0f / sqrtf(4096.f * 128.f)};
            att::dft_unit<2, 2>((const att::bf16*)(ws + WS_A3S) + (size_t)k1 * (64 * 128), 128, br, st, lds);
        }
    }
}

__device__ __forceinline__ void attn_phase(const bf16_t* Z, bf16_t* H, const float* qn, const float* kn, char* lds, int vcu, int G) {
    float mq = 0.f, mk = 0.f;
    for (int i = 0; i < 128; ++i) { mq = fmaxf(mq, fabsf(qn[i])); mk = fmaxf(mk, fabsf(kn[i])); }
    const float bound = 128.f * mq * mk * 1.02f;
    for (int it = 0;; ++it) { const int uid = it * G + vcu; if (uid >= 2048) break;
        int rowbase, h, qb, seq;
        if (uid < 1024) { const int s = uid >> 9; h = (uid >> 6) & 7; qb = uid & 63; rowbase = s * 16384; seq = 16384; }
        else { const int u2 = uid - 1024, s = u2 >> 7; h = (u2 >> 4) & 7; qb = u2 & 15; rowbase = NPROMPT + s * 4096; seq = 4096; }
        const att::bf16* Q = (const att::bf16*)Z + (size_t)(rowbase + qb * 256) * DM + 512 + h * 128;
        const att::bf16* K = (const att::bf16*)Z + (size_t)rowbase * DM + 1536 + (h >> 2) * 128;
        att::bf16* O = (att::bf16*)H + (size_t)(rowbase + qb * 256) * DM + 512 + h * 128;
        att::attn_dense_body<att::bf16>(Q, K, K + 256, O, seq, lds, bound);
        __syncthreads();
    }
}

struct Params { const float* in[17]; float* out; unsigned char* ws; int ph_lo, ph_hi; };
constexpr int NPL = 9;
constexpr int NPHASE = 2 + 2 * NPL;

__global__ void __launch_bounds__(512, 2) mega_fwd(Params p) {
    extern __shared__ __attribute__((aligned(16))) unsigned char lds[];
    cg::grid_group grid = cg::this_grid();
    const int G = gridDim.x, bx = blockIdx.x;
    const int vcu = (G % 8 == 0) ? (bx % 8) * (G / 8) + bx / 8 : bx;
    const int NGW = G * 8, NT = G * 512;
    unsigned char* ws = p.ws;
    const float *x_prompt = p.in[0], *x_sample = p.in[1], *g_pre_mix = p.in[2], *g_post_mix = p.in[3], *w_in = p.in[4], *pool_w = p.in[5], *pool_scale = p.in[6],
                *q_norm = p.in[7], *k_norm = p.in[8], *fourier_w = p.in[9], *w_out = p.in[10], *g_pre_ffn = p.in[11], *g_post_ffn = p.in[12], *w_up = p.in[13],
                *conv_w = p.in[14], *conv_b = p.in[15], *w_down = p.in[16];
    bf16_t* XH = (bf16_t*)(ws + WS_XH); bf16_t* Z = (bf16_t*)(ws + WS_Z); bf16_t* Gp = (bf16_t*)(ws + WS_G); bf16_t* Yp = (bf16_t*)(ws + WS_Y);
    bf16_t* HB = (bf16_t*)(ws + WS_HB); bf16_t* ACT = (bf16_t*)(ws + WS_ACT); bf16_t* XB = (bf16_t*)(ws + WS_XB);
    LAS unsigned char* ring = (LAS unsigned char*)lds;
    volatile LAS unsigned* bst = (volatile LAS unsigned*)(ring + 131072 + 64);
    if (threadIdx.x < 2) bst[threadIdx.x] = 0u;
    __syncthreads();
    XcdBarrier xbar = xcd_barrier_post((unsigned*)(ws + WS_BAR), bst);

    for (int ph = p.ph_lo; ph < p.ph_hi; ++ph) {
        const int tid = ltid(), lane = tid & 63, wave = __builtin_amdgcn_readfirstlane(tid >> 6);
        const int gw = vcu * 8 + wave, gtid = bx * 512 + tid;
        if (ph == 0) {
#if !defined(ONLY) || ONLY==0
            for (int rep = 0; rep < REP_P0; ++rep) p0a_tables(fourier_w, ws, (LAS float*)ring, gtid, NT);
#endif
        } else if (ph == 1) {
#if !defined(ONLY) || ONLY==1
            LAS float* scr = (LAS float*)(ring + wave * 16384);
            for (int l = 0; l < 2 * REP_P0; ++l) {
                bf16_t* Wl = (bf16_t*)(ws + WS_W + (l & 1) * W_LAYER);
                ValWin vw{w_in + (size_t)(l & 1) * DM * WINW, pool_w + (size_t)(l & 1) * 4 * 16384, pool_scale + (l & 1) * 512, (const float*)(ws + WS_M2F) + (size_t)(l & 1) * 4 * 32768};
                transpose_matrix(vw, DM, NIN, Wl, scr, gw, NGW, lane, 512, 2048);
                fold_items(vw.win, vw.poolw, vw.pscale, vw.m2f, Wl, gw, NGW, lane);
                ValDirect vo{w_out + (size_t)(l & 1) * DM * DM, DM};
                transpose_matrix(vo, DM, DM, (bf16_t*)((unsigned char*)Wl + W_OUT_OFF), scr, gw, NGW, lane, 0, DM);
                ValUp vu{w_up + (size_t)(l & 1) * DM * NUP};
                transpose_matrix(vu, DM, NUP, (bf16_t*)((unsigned char*)Wl + W_UP_OFF), scr, gw, NGW, lane, 0, NUP);
                ValDirect vd{w_down + (size_t)(l & 1) * DFF * DM, DM};
                transpose_matrix(vd, DFF, DM, (bf16_t*)((unsigned char*)Wl + W_DOWN_OFF), scr, gw, NGW, lane, 0, DM);
            }
            for (int rep = 0; rep < REP_P0; ++rep) resid_rows<false, false, 2>(x_prompt, x_sample, nullptr, nullptr, nullptr, nullptr, nullptr, XH, g_pre_mix, gw, NGW, lane);
#endif
        } else {
            const int l = (ph - 2) / NPL, q = (ph - 2) % NPL;
            const bf16_t* Wl = (const bf16_t*)(ws + WS_W + l * W_LAYER);
            if (q == 0) {
#if !defined(ONLY) || ONLY==2
                pg8::Gemm g{XH, Wl, MTOK, NIN, DM}; pg8::StaticOrder S; S.init(MTOK, NIN, G, bx);
                EpiWin E{Z, Gp};
                for (int rep = 0; rep < REP_WIN; ++rep) pg8::gemm_phase<EpiWin, pg8::StaticOrder, PG8_ALIGN, PG8_SP2>(ring, g, S, E);
#endif
            } else if (q == 1) {
#if !defined(ONLY) || ONLY==3
                for (int rep = 1; rep < REP_ROPE; ++rep) rope_pass(Z, (bf16_t*)(ws + WS_END), q_norm + l * 128, k_norm + l * 128, (const float*)(ws + WS_COS), (const float*)(ws + WS_SIN), gtid, NT);
                rope_pass(Z, Z, q_norm + l * 128, k_norm + l * 128, (const float*)(ws + WS_COS), (const float*)(ws + WS_SIN), gtid, NT);
                for (int rep = 0; rep < REP_LIGHT * REP_POOL; ++rep) pool_pass(Z, XH, gtid, NT);
                for (int rep = 0; rep < REP_LIGHT; ++rep) dft_stage1(Gp, Yp, ws, (char*)lds, vcu, G);
#endif
            } else if (q == 2) {
#if !defined(ONLY) || ONLY==4
                for (int rep = 0; rep < REP_ATTN; ++rep) attn_phase(Z, XH, q_norm + l * 128, k_norm + l * 128, (char*)lds, vcu, G);
#endif
#if !defined(ONLY) || ONLY==5
                for (int rep = 0; rep < REP_LIGHT; ++rep) dft_stage3(Yp, XH, ws, (char*)lds, vcu, G);
#endif
            } else if (q == 4) {
#if !defined(ONLY) || ONLY==6
                for (int rep = 1; rep < REP_RES; ++rep) resid_rows<true, true, 4>(nullptr, nullptr, XB, Z, g_post_mix + DM, nullptr, nullptr, (bf16_t*)(ws + WS_END), g_pre_ffn + DM, gw, NGW, lane);
                if (l == 0) resid_rows<false, true, 2>(x_prompt, x_sample, nullptr, Z, g_post_mix, nullptr, XB, XH, g_pre_ffn, gw, NGW, lane);
                else resid_rows<true, true, 4>(nullptr, nullptr, XB, Z, g_post_mix + DM, nullptr, XB, XH, g_pre_ffn + DM, gw, NGW, lane);
#endif
            } else if (q == 8) {
#if !defined(ONLY) || ONLY==6
                if (l == 0) resid_rows<true, true, 4>(nullptr, nullptr, XB, XH, g_post_ffn, nullptr, XB, XH, g_pre_mix + DM, gw, NGW, lane);
                else resid_rows<true, false, 4>(nullptr, nullptr, XB, XH, g_post_ffn + DM, p.out, nullptr, nullptr, nullptr, gw, NGW, lane);
#endif
            } else {
                const int c = 0, step = (q >= 5) ? (q - 5) : -1;
                const float* cwl = conv_w + (size_t)l * 3 * NUP; const float* cbl = conv_b + (size_t)l * NUP;
                if (step == 1) {
#if !defined(ONLY) || ONLY==7
                    for (int rep = 0; rep < REP_LIGHT; ++rep) glu_fix(HB, ACT, cwl, cbl, gtid, NT);
#endif
                } else if (step == 0) {
#if !defined(ONLY) || ONLY==9
                    pg8::Gemm g{XH + (size_t)c * CHUNK * DM, (const bf16_t*)((const unsigned char*)Wl + W_UP_OFF), CHUNK, NUP, DM};
                    pg8::StaticOrder S; S.init(g.M, g.N, G, bx);
                    EpiGlu E{ACT, HB, cwl, cbl};
                    for (int rep = 0; rep < REP_UP; ++rep) pg8::gemm_phase<EpiGlu, pg8::StaticOrder, PG8_ALIGN, PG8_SP2>(ring, g, S, E);
#endif
                } else {
#if !defined(ONLY) || ONLY==8
                    pg8::Gemm g; bf16_t* O;
                    if (q == 3) { g = pg8::Gemm{XH, (const bf16_t*)((const unsigned char*)Wl + W_OUT_OFF), MTOK, DM, DM}; O = Z; }
                    else { g = pg8::Gemm{ACT, (const bf16_t*)((const unsigned char*)Wl + W_DOWN_OFF), CHUNK, DM, DFF}; O = XH + (size_t)c * CHUNK * DM; }
                    pg8::StaticOrder S; S.init(g.M, g.N, G, bx);
                    pg8::EpiBf16<0> E{O, DM, nullptr, 0, 0, 1.f};
                    for (int rep = 0; rep < REP_PLAIN; ++rep) pg8::gemm_phase<pg8::EpiBf16<0>, pg8::StaticOrder, PG8_ALIGN, PG8_SP2>(ring, g, S, E);
#endif
                }
            }
        }
        if (ph + 1 < p.ph_hi) { for (int rep = 0; rep < REP_SYNC; ++rep) { if (MK_MULTI == 0 && ph != 0) xcd_barrier(xbar); else grid.sync(); } }
    }
}

extern "C" void kernel_launch(void* const* d_in, const int* in_sizes, int n_in, void* d_out, int out_size, void* d_ws, size_t ws_size, hipStream_t stream) {
    static int grid = 0;
    if (grid == 0) {
        if (n_in != 17 || out_size != MTOK * DM || ws_size < WS_END) { fprintf(stderr, "kernel_launch: unexpected shapes: n_in %d out %d ws %zu (need %zu)\n", n_in, out_size, ws_size, (size_t)WS_END); grid = -1; return; }
        int dev = 0, cus = 0, per_cu = 0;
        if (hipGetDevice(&dev) != hipSuccess || hipDeviceGetAttribute(&cus, hipDeviceAttributeMultiprocessorCount, dev) != hipSuccess) { grid = -1; return; }
        if (hipFuncSetAttribute((const void*)mega_fwd, hipFuncAttributeMaxDynamicSharedMemorySize, LDS_BYTES) != hipSuccess) { fprintf(stderr, "kernel_launch: hipFuncSetAttribute failed\n"); grid = -1; return; }
        if (hipOccupancyMaxActiveBlocksPerMultiprocessor(&per_cu, (const void*)mega_fwd, 512, LDS_BYTES) != hipSuccess || per_cu < 1) { fprintf(stderr, "kernel_launch: occupancy query says %d\n", per_cu); per_cu = 1; }
        (void)hipGetLastError();
        grid = cus * 1;
    }
    if (grid < 0) return;
    if (hipMemsetAsync((char*)d_ws + WS_BAR, 0, BAR_BYTES, stream) != hipSuccess) { fprintf(stderr, "kernel_launch: memset failed\n"); return; }
    Params p{};
    for (int i = 0; i < 17; ++i) p.in[i] = (const float*)d_in[i];
    p.out = (float*)d_out; p.ws = (unsigned char*)d_ws;
#if MK_MULTI
    for (int ph = 0; ph < NPHASE; ++ph) { p.ph_lo = ph; p.ph_hi = ph + 1; hipLaunchKernelGGL(mega_fwd, dim3(grid), dim3(512), LDS_BYTES, stream, p); }
#else
    p.ph_lo = 0; p.ph_hi = NPHASE;
    void* args[] = {&p};
    hipError_t e = hipLaunchCooperativeKernel((const void*)mega_fwd, dim3(grid), dim3(512), args, LDS_BYTES, stream);
    if (e != hipSuccess) fprintf(stderr, "cooperative launch failed: %s (grid %d)\n", hipGetErrorString(e), grid);
#endif
}
```

```cpp
#include <hip/hip_runtime.h>
#include <hip/hip_bf16.h>
#include <hip/hip_cooperative_groups.h>
#include <cstdio>
#include <cstdint>
#ifndef MK_MULTI
#define MK_MULTI 0
#endif
__device__ __forceinline__ int ltid() { int t = threadIdx.x; asm volatile("" : "+v"(t)); return t; }
#ifndef REP_UP
#define REP_UP 1
#endif
#ifndef REP_ATTN
#define REP_ATTN 1
#endif
#ifndef REP_PLAIN
#define REP_PLAIN 1
#endif
#ifndef REP_WIN
#define REP_WIN 1
#endif
#ifndef REP_P0
#define REP_P0 1
#endif
#ifndef REP_LIGHT
#define REP_LIGHT 1
#endif
#ifndef REP_SYNC
#define REP_SYNC 1
#endif
#ifndef REP_ROPE
#define REP_ROPE 1
#endif
#ifndef REP_RES
#define REP_RES 1
#endif
#ifndef REP_POOL
#define REP_POOL 1
#endif
namespace pg8 {
#define PG8_LAS __attribute__((address_space(3)))
typedef unsigned short bf16_t;
typedef short bf16x8 __attribute__((ext_vector_type(8)));
typedef float f32x4 __attribute__((ext_vector_type(4)));
typedef unsigned u32x4 __attribute__((ext_vector_type(4)));
constexpr int BM = 256, BK = 64, HALF = 128, HTB = HALF * BK * 2  , STAGE_BYTES = 8 * HTB, NXCD = 8, WGM = 8;

__host__ __device__ __forceinline__ int lds_byte(int r, int c) { const int st = (r >> 4) * 2 + (c >> 5), rr = r & 15, cc = c & 31, ob = rr * 64 + cc * 2; return st * 1024 + (ob ^ (((ob >> 9) & 1) << 5)); }
__host__ __device__ __forceinline__ void stage_rc(int b, int& R, int& C) { const int st = b / 1024, sb = b % 1024, swz = sb ^ (((sb >> 9) & 1) << 5); R = (st >> 1) * 16 + swz / 64; C = (st & 1) * 32 + (swz % 64) / 2; }
__host__ __device__ __forceinline__ int perm32(int rho) { const int n = rho >> 4, i = rho & 15; return 8 * (i >> 2) + 4 * n + (i & 3); }

struct Unit { int pm, pn; };
struct Gemm { const bf16_t* A; const bf16_t* Bt; int M, N, K; };

struct StaticOrder {
    int nM, nN, nwg, G, c;
    __host__ __device__ void init(int M, int N, int G_, int c_) { nM = M / BM; nN = N / BM; nwg = nM * nN; G = G_; c = c_; }
    __host__ __device__ bool next(int i, Unit& u) const {
        const long L = (long)i * G + c; if (L >= nwg) return false;
        int wgid = (int)L; { const int q = nwg / NXCD, r = nwg % NXCD, xcd = wgid % NXCD, off = wgid / NXCD; wgid = (xcd < r ? xcd * (q + 1) : r * (q + 1) + (xcd - r) * q) + off; }
        const int nig = WGM * nN, gid = wgid / nig, fm = gid * WGM, gsz = (nM - fm) < WGM ? (nM - fm) : WGM;
        u.pm = fm + ((wgid % nig) % gsz); u.pn = (wgid % nig) / gsz; return true;
    }
    __device__ __forceinline__ void a_ready(const Unit&) const {}
    __device__ __forceinline__ void done(const Unit&) const {}
};

__device__ __forceinline__ unsigned cvt_pk_bf16(float lo, float hi) { unsigned r; asm volatile("v_cvt_pk_bf16_f32 %0, %1, %2" : "=v"(r) : "v"(lo), "v"(hi)); return r; }
typedef float f32x2 __attribute__((ext_vector_type(2)));
__device__ __forceinline__ f32x2 gelu_pk(f32x2 v) {
    const f32x2 av = __builtin_elementwise_abs(v), d = av * 0.2316418882f + 1.0f;
    f32x2 t; t.x = __builtin_amdgcn_rcpf(d.x); t.y = __builtin_amdgcn_rcpf(d.y);
    f32x2 q = t * 0.5307027145f + (-0.7265760135f); q = q * t + 0.7107068705f; q = q * t + (-0.142248368f); q = q * t + 0.127414796f; q = q * t;
    const f32x2 s = (v * v) * (-0.72134752044f);
    f32x2 e; e.x = __builtin_amdgcn_exp2f(s.x); e.y = __builtin_amdgcn_exp2f(s.y);
    const f32x2 m = v * (q * e), r = v - m;
    f32x2 o; o.x = v.x < 0.f ? m.x : r.x; o.y = v.y < 0.f ? m.y : r.y; return o;
}

template <int ACT  > struct EpiBf16 {
    static constexpr bool PERM = true, AFTER_DRAIN = false; static_assert(ACT == 0 || ACT == 1, "EpiBf16: ACT is 0 (none) or 1 (gelu_pk)");
    bf16_t* O; int ldc; const float* bias; int split_cols; size_t split_stride; float scale0;
    __device__ __forceinline__ void operator()(const f32x4 (&acc)[2][2][4][2], const Unit& u, int wr, int wc, int fr, int fq) const {
        const int row0 = u.pm * BM + wr * 64 + fr; int colt = u.pn * BM; bf16_t* base = O;
        float sc = 1.f; if (split_cols) { const int t = colt / split_cols; base += (size_t)t * split_stride; colt -= t * split_cols; if (t == 0) sc = scale0; }
        const int col0 = colt + wc * 32 + 8 * fq, bcol0 = u.pn * BM + wc * 32 + 8 * fq;
        f32x4 bv[2][2];
#pragma unroll
        for (int bj = 0; bj < 2; ++bj)
#pragma unroll
            for (int n = 0; n < 2; ++n) bv[bj][n] = bias ? *(const f32x4*)(bias + bcol0 + bj * HALF + 4 * n) : (f32x4){0.f, 0.f, 0.f, 0.f};
#pragma unroll
        for (int ai = 0; ai < 2; ++ai)
#pragma unroll
            for (int m = 0; m < 4; ++m) { bf16_t* rowp = base + (size_t)(row0 + ai * HALF + m * 16) * ldc + col0;
#pragma unroll
                for (int bj = 0; bj < 2; ++bj) { f32x4 v0 = acc[ai][bj][m][0] + bv[bj][0], v1 = acc[ai][bj][m][1] + bv[bj][1];
                    if (ACT == 1) { f32x2 a = gelu_pk((f32x2){v0[0], v0[1]}), b = gelu_pk((f32x2){v0[2], v0[3]}), c = gelu_pk((f32x2){v1[0], v1[1]}), d = gelu_pk((f32x2){v1[2], v1[3]});
                        v0 = (f32x4){a.x, a.y, b.x, b.y}; v1 = (f32x4){c.x, c.y, d.x, d.y}; }
                    v0 = v0 * sc; v1 = v1 * sc; u32x4 w; w.x = cvt_pk_bf16(v0[0], v0[1]); w.y = cvt_pk_bf16(v0[2], v0[3]); w.z = cvt_pk_bf16(v1[0], v1[1]); w.w = cvt_pk_bf16(v1[2], v1[3]);
                    *(u32x4*)(rowp + bj * HALF) = w; } }
    }
};
template <class Epi, class Sched, bool ALIGN_EPI = false, bool SP2 = false>
__device__ __forceinline__ void gemm_phase(PG8_LAS unsigned char* lds, const Gemm g, const Sched& S, const Epi& E) {
    const int tid = ltid(), wid = __builtin_amdgcn_readfirstlane(tid >> 6), lane = tid & 63, wr = wid >> 2, wc = wid & 3, fr = lane & 15, fq = lane >> 4;
    const int K = g.K, nt = K / BK;
    unsigned voffA[2], voffB[2];
#pragma unroll
    for (int i = 0; i < 2; ++i) { int R, C; stage_rc(tid * 16 + i * 8192, R, C); const int Rb = Epi::PERM ? ((R & ~31) + perm32(R & 31)) : R;
        voffA[i] = (unsigned)(R * K + C) * 2u; voffB[i] = (unsigned)(Rb * K + C) * 2u; }
    const size_t kstep = (size_t)(BK * 2);
    const size_t hstep = (size_t)HALF * K * 2;
    const size_t tstep = 2 * hstep;
    const unsigned ldsw = (unsigned)wid * 1024u;
    const int aoff = lds_byte(wr * 64 + fr, fq * 8), boff = lds_byte(wc * 32 + fr, fq * 8);
#define PG8_SA(b, h) (((b) * 2 + (h)) * HTB)
#define PG8_SB(b, h) ((4 + (b) * 2 + (h)) * HTB)
#define PG8_STAGE(bufoff, gbase, voff) do { _Pragma("unroll") for (int _i = 0; _i < 2; ++_i) \
        __builtin_amdgcn_global_load_lds((const unsigned*)((const char*)(gbase) + (voff)[_i]), (PG8_LAS unsigned*)(lds + (bufoff) + ldsw + _i * 8192), 16, 0, 0); } while (0)
#define PG8_LDA(dst, b, h) do { _Pragma("unroll") for (int m = 0; m < 4; ++m) _Pragma("unroll") for (int k = 0; k < 2; ++k) dst[m][k] = *(const PG8_LAS bf16x8*)(lds + PG8_SA(b, h) + aoff + m * 2048 + k * 1024); } while (0)
#define PG8_LDB(dst, b, h) do { _Pragma("unroll") for (int n = 0; n < 2; ++n) _Pragma("unroll") for (int k = 0; k < 2; ++k) dst[n][k] = *(const PG8_LAS bf16x8*)(lds + PG8_SB(b, h) + boff + n * 2048 + k * 1024); } while (0)
#define PG8_MMA(ai, bj, At, Bt) do { __builtin_amdgcn_s_setprio(1); _Pragma("unroll") for (int m = 0; m < 4; ++m) _Pragma("unroll") for (int n = 0; n < 2; ++n) _Pragma("unroll") for (int k = 0; k < 2; ++k) \
        acc[ai][bj][m][n] = __builtin_amdgcn_mfma_f32_16x16x32_bf16(Bt[n][k], At[m][k], acc[ai][bj][m][n], 0, 0, 0); __builtin_amdgcn_s_setprio(0); } while (0)
#define PG8_WAIT_V(n) asm volatile("s_waitcnt vmcnt(" #n ")" ::: "memory")
#define PG8_WAIT_L(n) asm volatile("s_waitcnt lgkmcnt(" #n ")" ::: "memory")
#define PG8_BAR __builtin_amdgcn_s_barrier()
#define PG8_SCHED __builtin_amdgcn_sched_barrier(0)
    Unit cur, nxt; int ui = 0;
    if (!S.next(0, cur)) return;
    f32x4 acc[2][2][4][2];
#pragma unroll
    for (int a = 0; a < 2; ++a)
#pragma unroll
        for (int b = 0; b < 2; ++b)
#pragma unroll
            for (int m = 0; m < 4; ++m)
#pragma unroll
                for (int n = 0; n < 2; ++n) acc[a][b][m][n] = (f32x4){0.f, 0.f, 0.f, 0.f};
    bf16x8 At[4][2], B0[2][2], B1[2][2];
    const char* cA = (const char*)g.A + (size_t)cur.pm * tstep; const char* cB = (const char*)g.Bt + (size_t)cur.pn * tstep;
    S.a_ready(cur);
    if constexpr (SP2) {
        PG8_STAGE(PG8_SB(0, 0), cB, voffB); PG8_STAGE(PG8_SB(0, 1), cB + hstep, voffB); PG8_STAGE(PG8_SA(0, 0), cA, voffA); PG8_STAGE(PG8_SA(0, 1), cA + hstep, voffA);
        if (wr == 1) PG8_BAR;
        PG8_WAIT_V(2); PG8_BAR;
        PG8_STAGE(PG8_SB(1, 0), cB + kstep, voffB); PG8_STAGE(PG8_SA(1, 0), cA + kstep, voffA); PG8_STAGE(PG8_SB(1, 1), cB + hstep + kstep, voffB);
        PG8_WAIT_V(6); PG8_BAR;
    } else {
        PG8_STAGE(PG8_SB(0, 0), cB, voffB); PG8_STAGE(PG8_SA(0, 0), cA, voffA); PG8_STAGE(PG8_SB(0, 1), cB + hstep, voffB); PG8_STAGE(PG8_SA(0, 1), cA + hstep, voffA);
        if (wr == 1) PG8_BAR;
        PG8_WAIT_V(4); PG8_BAR;
        PG8_STAGE(PG8_SB(1, 0), cB + kstep, voffB); PG8_STAGE(PG8_SA(1, 0), cA + kstep, voffA); PG8_STAGE(PG8_SB(1, 1), cB + hstep + kstep, voffB);
        PG8_WAIT_V(6); PG8_BAR;
    }
    for (;;) {
        const bool has_next = S.next(ui + 1, nxt);
        const char* nA = has_next ? (const char*)g.A + (size_t)nxt.pm * tstep : cA; const char* nB = has_next ? (const char*)g.Bt + (size_t)nxt.pn * tstep : cB;
        for (int t = 0; t < nt; t += 2) {
            const bool last = (t == nt - 2);
            const char* a1 = cA + (size_t)(t + 1) * kstep;
            const char* a2 = last ? nA : cA + (size_t)(t + 2) * kstep; const char* b2 = last ? nB : cB + (size_t)(t + 2) * kstep;
            const char* a3 = a2 + kstep; const char* b3 = b2 + kstep;
            if (last && has_next) S.a_ready(nxt);
            if constexpr (SP2) {
            PG8_LDB(B0, 0, 0); PG8_LDB(B1, 0, 1); PG8_SCHED; PG8_LDA(At, 0, 0); PG8_STAGE(PG8_SA(1, 1), a1 + hstep, voffA);
            PG8_WAIT_V(8); PG8_WAIT_L(0); PG8_BAR; PG8_MMA(0, 0, At, B0); PG8_MMA(0, 1, At, B1); PG8_BAR; PG8_SCHED;
            PG8_LDA(At, 0, 1); PG8_STAGE(PG8_SB(0, 0), b2, voffB); PG8_STAGE(PG8_SB(0, 1), b2 + hstep, voffB); PG8_STAGE(PG8_SA(0, 0), a2, voffA);
            PG8_WAIT_V(8); PG8_WAIT_L(0); PG8_BAR; PG8_MMA(1, 0, At, B0); PG8_MMA(1, 1, At, B1); PG8_BAR; PG8_SCHED;
            PG8_LDB(B0, 1, 0); PG8_LDB(B1, 1, 1); PG8_SCHED; PG8_LDA(At, 1, 0); PG8_STAGE(PG8_SA(0, 1), a2 + hstep, voffA);
            PG8_WAIT_V(8); PG8_WAIT_L(0); PG8_BAR; PG8_MMA(0, 0, At, B0); PG8_MMA(0, 1, At, B1); PG8_BAR; PG8_SCHED;
            PG8_LDA(At, 1, 1); PG8_STAGE(PG8_SB(1, 0), b3, voffB); PG8_STAGE(PG8_SB(1, 1), b3 + hstep, voffB); PG8_STAGE(PG8_SA(1, 0), a3, voffA);
            PG8_WAIT_V(8); PG8_WAIT_L(0); PG8_BAR; PG8_MMA(1, 0, At, B0); PG8_MMA(1, 1, At, B1); PG8_BAR; PG8_SCHED;
            } else {
            PG8_LDB(B0, 0, 0); PG8_SCHED; PG8_LDA(At, 0, 0); PG8_STAGE(PG8_SA(1, 1), a1 + hstep, voffA);
            PG8_WAIT_L(8); PG8_BAR; PG8_WAIT_L(0); PG8_MMA(0, 0, At, B0); PG8_BAR; PG8_SCHED;
            PG8_LDB(B1, 0, 1); PG8_STAGE(PG8_SB(0, 0), b2, voffB);
            PG8_BAR; PG8_WAIT_L(0); PG8_MMA(0, 1, At, B1); PG8_BAR;
            PG8_LDA(At, 0, 1); PG8_STAGE(PG8_SA(0, 0), a2, voffA);
            PG8_BAR; PG8_WAIT_L(0); PG8_MMA(1, 0, At, B0); PG8_BAR; PG8_SCHED;
            PG8_STAGE(PG8_SB(0, 1), b2 + hstep, voffB);
            PG8_WAIT_V(6); PG8_BAR; PG8_MMA(1, 1, At, B1); PG8_BAR;
            PG8_LDB(B0, 1, 0); PG8_SCHED; PG8_LDA(At, 1, 0); PG8_STAGE(PG8_SA(0, 1), a2 + hstep, voffA);
            PG8_WAIT_L(8); PG8_BAR; PG8_WAIT_L(0); PG8_MMA(0, 0, At, B0); PG8_BAR; PG8_SCHED;
            PG8_LDB(B1, 1, 1); PG8_STAGE(PG8_SB(1, 0), b3, voffB);
            PG8_BAR; PG8_WAIT_L(0); PG8_MMA(0, 1, At, B1); PG8_BAR;
            PG8_LDA(At, 1, 1); PG8_STAGE(PG8_SA(1, 0), a3, voffA);
            PG8_BAR; PG8_WAIT_L(0); PG8_MMA(1, 0, At, B0); PG8_BAR; PG8_SCHED;
            PG8_STAGE(PG8_SB(1, 1), b3 + hstep, voffB);
            PG8_WAIT_V(6); PG8_BAR; PG8_MMA(1, 1, At, B1); PG8_BAR;
            }
        }
        if constexpr (ALIGN_EPI) { if (wr == 0) PG8_BAR; }
        if constexpr (!Epi::AFTER_DRAIN) { E(acc, cur, wr, wc, fr, fq); S.done(cur); }
        if (!has_next) break;
#pragma unroll
        for (int a = 0; a < 2; ++a)
#pragma unroll
            for (int b = 0; b < 2; ++b)
#pragma unroll
                for (int m = 0; m < 4; ++m)
#pragma unroll
                    for (int n = 0; n < 2; ++n) acc[a][b][m][n] = (f32x4){0.f, 0.f, 0.f, 0.f};
        cur = nxt; cA = nA; cB = nB; ++ui;
        if constexpr (ALIGN_EPI) { if (wr == 1) PG8_BAR; }
    }
    PG8_WAIT_V(0);
    if constexpr (!ALIGN_EPI) { if (wr == 0) PG8_BAR; }
    PG8_BAR;
    if constexpr (Epi::AFTER_DRAIN) { E.fused(acc, cur, wr, wc, fr, fq, lds, wid, lane); S.done(cur); }
#undef PG8_SA
#undef PG8_SB
#undef PG8_STAGE
#undef PG8_LDA
#undef PG8_LDB
#undef PG8_MMA
#undef PG8_WAIT_V
#undef PG8_WAIT_L
#undef PG8_BAR
#undef PG8_SCHED
}
}
#define PG8_SP2 true
#define PG8_ALIGN true
namespace att {
using bf16 = __hip_bfloat16;
constexpr int   D = 128, NW = 8, QBLK = 32, KVBLK = 64;
constexpr float SCALE = 0.088388347648318440f;
constexpr float THR = 8.f;
constexpr int SDEPTH = 2;
constexpr bool STATIC_MAX = true;
constexpr int LDQ = 2048, LDK = 2048, LDO = 2048;
constexpr size_t SHM_V = KVBLK * D * 2, SHM_K = KVBLK * D * 2, SHM_ATTN = 2 * SHM_V + 2 * SHM_K + NW * 64 * 4;
using bf16x8 = __attribute__((ext_vector_type(8))) short;
using s16x4  = __attribute__((ext_vector_type(4))) short;
using f32x16 = __attribute__((ext_vector_type(16))) float;
using f32x8  = __attribute__((ext_vector_type(8))) float;
using u32x4  = __attribute__((ext_vector_type(4))) unsigned;
#define KSWZ(row, colB) ((row) * 256 + ((colB) ^ (((row) & 7) << 4)))
#define SBAR() __builtin_amdgcn_sched_barrier(0)
__device__ __forceinline__ int crow(int r, int hi) { return (r & 3) + 8 * (r >> 2) + 4 * hi; }
__device__ __forceinline__ unsigned cvtpk(float lo, float hi) {
  unsigned r; asm volatile("v_cvt_pk_bf16_f32 %0, %1, %2" : "=v"(r) : "v"(lo), "v"(hi)); return r;
}
template <typename TIn> struct Stage;
template <> struct Stage<bf16>  { using T = bf16x8;
  __device__ static __forceinline__ T ld8(const bf16* p) { return *reinterpret_cast<const bf16x8*>(p); }
  __device__ static __forceinline__ bf16x8 tobf(T x) { return x; } };
template <> struct Stage<float> { using T = f32x8;
  __device__ static __forceinline__ T ld8(const float* p) { return *reinterpret_cast<const f32x8*>(p); }
  __device__ static __forceinline__ bf16x8 tobf(T x) {
    u32x4 w = {cvtpk(x[0], x[1]), cvtpk(x[2], x[3]), cvtpk(x[4], x[5]), cvtpk(x[6], x[7])}; return *reinterpret_cast<bf16x8*>(&w); } };

template <bool SHIFT> __device__ __forceinline__ void partialSM(f32x16& p0, f32x16& p1, float& m_reg, float& mn, float& alpha) {
  constexpr float C = SCALE * 1.4426950408889634f;
  if constexpr (STATIC_MAX) { mn = m_reg; alpha = 1.f; }
  else {
  float pmax = p0[0]; for (int r = 1; r < 16; ++r) pmax = fmaxf(pmax, p0[r]); for (int r = 0; r < 16; ++r) pmax = fmaxf(pmax, p1[r]);
  { auto rr = __builtin_amdgcn_permlane32_swap(__float_as_uint(pmax), __float_as_uint(pmax), false, false);
    pmax = fmaxf(__uint_as_float(rr[0]), __uint_as_float(rr[1])); }
  if (__builtin_expect(__all(pmax - m_reg <= THR / SCALE), 1)) { mn = m_reg; alpha = 1.f; }
  else { mn = fmaxf(m_reg, pmax); alpha = __builtin_amdgcn_exp2f((m_reg - mn) * C); m_reg = mn; }
  }
  if constexpr (!STATIC_MAX) { float mnC = -mn * C;
  for (int r = 0; r < 16; ++r) p0[r] = fmaf(p0[r], C, mnC); for (int r = 0; r < 16; ++r) p1[r] = fmaf(p1[r], C, mnC); }
  if constexpr (STATIC_MAX && SHIFT) { for (int r = 0; r < 16; ++r) p0[r] += m_reg; for (int r = 0; r < 16; ++r) p1[r] += m_reg; }
  for (int r = 0; r < 16; ++r) p0[r] = __builtin_amdgcn_exp2f(p0[r]);
}
__device__ __forceinline__ void finishSM(f32x16& p0, f32x16& p1, float alpha, float& l_reg, bf16x8& pa0, bf16x8& pa1, bf16x8& pa2, bf16x8& pa3) {
  for (int r = 0; r < 16; ++r) p1[r] = __builtin_amdgcn_exp2f(p1[r]);
  float ps = 0; for (int r = 0; r < 16; ++r) ps += p0[r]; for (int r = 0; r < 16; ++r) ps += p1[r];
  { auto rr = __builtin_amdgcn_permlane32_swap(__float_as_uint(ps), __float_as_uint(ps), false, false);
    ps = __uint_as_float(rr[0]) + __uint_as_float(rr[1]); }
  l_reg = l_reg * alpha + ps;
#define PK4(P, BASE, OUT) do { unsigned a0 = cvtpk(P[BASE + 0], P[BASE + 1]), a1 = cvtpk(P[BASE + 2], P[BASE + 3]);   \
    unsigned b0 = cvtpk(P[BASE + 4], P[BASE + 5]), b1 = cvtpk(P[BASE + 6], P[BASE + 7]);                              \
    auto r0 = __builtin_amdgcn_permlane32_swap(a0, b0, false, false); auto r1 = __builtin_amdgcn_permlane32_swap(a1, b1, false, false); \
    u32x4 w = {r0[0], r1[0], r0[1], r1[1]}; OUT = *reinterpret_cast<bf16x8*>(&w); } while (0)
  PK4(p0, 0, pa0); PK4(p0, 8, pa1); PK4(p1, 0, pa2); PK4(p1, 8, pa3);
#undef PK4
}
__device__ __forceinline__ void qkt(f32x16& p0, f32x16& p1, const bf16* Ks, const bf16x8* qr, int r32, int hi) {
#pragma unroll
  for (int d0 = 0; d0 < 8; ++d0) { int cb = (d0 * 16 + hi * 8) * 2;
    bf16x8 b0 = *reinterpret_cast<const bf16x8*>((const char*)Ks + KSWZ(r32, cb));
    bf16x8 b1 = *reinterpret_cast<const bf16x8*>((const char*)Ks + KSWZ(32 + r32, cb));
    p0 = __builtin_amdgcn_mfma_f32_32x32x16_bf16(b0, qr[d0], d0 == 0 ? f32x16{} : p0, 0, 0, 0);
    p1 = __builtin_amdgcn_mfma_f32_32x32x16_bf16(b1, qr[d0], d0 == 0 ? f32x16{} : p1, 0, 0, 0); }
}
__device__ __forceinline__ int v_st(int k, int c) { const int kk = (k & ~0xC) | ((k & 4) << 1) | ((k & 8) >> 1); return ((kk >> 3) * 4 + (c >> 5)) * 512 + ((kk & 7) * 32 + (c & 31)) * 2; }
__device__ __forceinline__ int v_rd_base(int lane) { return ((lane & 3) << 3) | (((lane >> 2) & 3) << 6) | (((lane >> 4) & 1) << 5) | (((lane >> 5) & 1) << 8); }
constexpr int v_rd_off(int d0, int ks, int half) { return d0 * 512 + ks * 4096 + half * 2048; }
template <int OFF> __device__ __forceinline__ s16x4 tr_read(int vb) {
  s16x4 r; asm volatile("ds_read_b64_tr_b16 %0, %1 offset:%2" : "=&v"(r) : "v"(vb), "i"(OFF) : "memory"); return r;
}
template <int D0> __device__ __forceinline__ void pv_one(f32x16& od, int vb, bf16x8 pa0, bf16x8 pa1, bf16x8 pa2, bf16x8 pa3) {
  const s16x4 l0 = tr_read<v_rd_off(D0, 0, 0)>(vb), h0 = tr_read<v_rd_off(D0, 0, 1)>(vb), l1 = tr_read<v_rd_off(D0, 1, 0)>(vb), h1 = tr_read<v_rd_off(D0, 1, 1)>(vb);
  const s16x4 l2 = tr_read<v_rd_off(D0, 2, 0)>(vb), h2 = tr_read<v_rd_off(D0, 2, 1)>(vb), l3 = tr_read<v_rd_off(D0, 3, 0)>(vb), h3 = tr_read<v_rd_off(D0, 3, 1)>(vb);
  asm volatile("s_waitcnt lgkmcnt(0)" ::: "memory"); SBAR();
#define PK(L, H) (bf16x8){L[0], L[1], L[2], L[3], H[0], H[1], H[2], H[3]}
  od = __builtin_amdgcn_mfma_f32_32x32x16_bf16(pa0, PK(l0, h0), od, 0, 0, 0);
  od = __builtin_amdgcn_mfma_f32_32x32x16_bf16(pa1, PK(l1, h1), od, 0, 0, 0);
  od = __builtin_amdgcn_mfma_f32_32x32x16_bf16(pa2, PK(l2, h2), od, 0, 0, 0);
  od = __builtin_amdgcn_mfma_f32_32x32x16_bf16(pa3, PK(l3, h3), od, 0, 0, 0);
#undef PK
}
__device__ __forceinline__ void pv_d0(f32x16* o, int vb, bf16x8 pa0, bf16x8 pa1, bf16x8 pa2, bf16x8 pa3) {
  pv_one<0>(o[0], vb, pa0, pa1, pa2, pa3); pv_one<1>(o[1], vb, pa0, pa1, pa2, pa3); pv_one<2>(o[2], vb, pa0, pa1, pa2, pa3); pv_one<3>(o[3], vb, pa0, pa1, pa2, pa3);
}
template <typename TQ, bool SHIFT>
__device__ __forceinline__ void attn_dense_body(const TQ* __restrict__ Qb, const bf16* __restrict__ Kh, const bf16* __restrict__ Vh,
                                                bf16* __restrict__ Ob, int seq, char* lds, float bound) {
  using St = Stage<bf16>; using SQ = Stage<TQ>;
  const int tid = ltid(), wid = tid >> 6, lane = tid & 63, r32 = lane & 31, hi = lane >> 5;
  bf16* V_lds = (bf16*)lds; bf16* K_lds = (bf16*)(lds + 2 * SHM_V);
  float* ws = (float*)(lds + 2 * SHM_V + 2 * SHM_K) + wid * 64; float* li_l = ws; float* al_l = ws + 32;
  float m_reg = STATIC_MAX ? -bound * (SCALE * 1.4426950408889634f) : -1e30f, l_reg = 0; f32x16 o[4] = {}; bf16x8 qr[8];
  const TQ* Qw = Qb + (long)(wid * QBLK + r32) * LDQ + hi * 8;
#pragma unroll
  for (int d0 = 0; d0 < 8; ++d0) qr[d0] = SQ::tobf(SQ::ld8(Qw + d0 * 16));
  const int sr = tid >> 4, sc = (tid & 15) * 8, vst0 = v_st(sr, sc), vst1 = v_st(32 + sr, sc);
  const int vb0 = (int)(uintptr_t)V_lds + v_rd_base(lane);
  struct { typename St::T vs0, vs1, ks0, ks1; } sr_[SDEPTH];
#define SLOAD(i, k0) do { sr_[i].vs0 = St::ld8(&Vh[(long)((k0) + sr) * LDK + sc]); sr_[i].vs1 = St::ld8(&Vh[(long)((k0) + 32 + sr) * LDK + sc]); \
    sr_[i].ks0 = St::ld8(&Kh[(long)((k0) + sr) * LDK + sc]); sr_[i].ks1 = St::ld8(&Kh[(long)((k0) + 32 + sr) * LDK + sc]); } while (0)
#define SWRITE(b, i) do { *(bf16x8*)((char*)V_lds + (b) * SHM_V + vst0) = St::tobf(sr_[i].vs0);          \
    *(bf16x8*)((char*)V_lds + (b) * SHM_V + vst1) = St::tobf(sr_[i].vs1); int kc = sc * 2;               \
    *(bf16x8*)((char*)K_lds + (b) * SHM_K + KSWZ(sr, kc)) = St::tobf(sr_[i].ks0);                       \
    *(bf16x8*)((char*)K_lds + (b) * SHM_K + KSWZ(32 + sr, kc)) = St::tobf(sr_[i].ks1); } while (0)
#define SWAIT() do { if constexpr (SDEPTH == 2) asm volatile("s_waitcnt vmcnt(4)" ::: "memory"); else asm volatile("s_waitcnt vmcnt(0)" ::: "memory"); } while (0)
#define RESC(a) do { if (!STATIC_MAX && __any((a) < 1.f)) { if (hi == 0) al_l[r32] = (a); asm volatile("s_waitcnt lgkmcnt(0)" ::: "memory"); \
    for (int d = 0; d < 4; ++d) for (int r = 0; r < 16; ++r) o[d][r] *= al_l[crow(r, hi)]; } } while (0)
  f32x16 pA0, pA1, pB0, pB1; float mnA, mnB, alA, alB; bf16x8 pa0, pa1, pa2, pa3; const int NT = seq / KVBLK;
  constexpr int SE = 0, SO = SDEPTH - 1;
  SLOAD(SE, 0); asm volatile("s_waitcnt vmcnt(0)" ::: "memory"); SWRITE(0, SE); __syncthreads();
  qkt(pA0, pA1, K_lds, qr, r32, hi); partialSM<SHIFT>(pA0, pA1, m_reg, mnA, alA);
  SLOAD(SO, KVBLK); if constexpr (SDEPTH == 2) { if (2 < NT) SLOAD(SE, 2 * KVBLK); }
  SWAIT(); SWRITE(1, SO); __syncthreads();
  for (int j = 1; j + 1 < NT; j += 2) {
    SBAR(); qkt(pB0, pB1, (bf16*)((char*)K_lds + SHM_K), qr, r32, hi);
    finishSM(pA0, pA1, alA, l_reg, pa0, pa1, pa2, pa3); SBAR();
    SLOAD(SO, (j + SDEPTH) * KVBLK); SBAR();
    pv_d0(o, vb0, pa0, pa1, pa2, pa3); partialSM<SHIFT>(pB0, pB1, m_reg, mnB, alB);
    __syncthreads(); SWAIT(); SWRITE(0, SE);
    RESC(alB); __syncthreads();
    SBAR(); qkt(pA0, pA1, K_lds, qr, r32, hi);
    finishSM(pB0, pB1, alB, l_reg, pa0, pa1, pa2, pa3); SBAR();
    if (SDEPTH == 1 || j + 3 < NT) SLOAD(SE, (j + 1 + SDEPTH) * KVBLK); SBAR();
    pv_d0(o, vb0 + (int)SHM_V, pa0, pa1, pa2, pa3); partialSM<SHIFT>(pA0, pA1, m_reg, mnA, alA);
    __syncthreads(); SWAIT(); SWRITE(1, SO);
    RESC(alA); __syncthreads();
  }
  SBAR(); qkt(pB0, pB1, (bf16*)((char*)K_lds + SHM_K), qr, r32, hi);
  finishSM(pA0, pA1, alA, l_reg, pa0, pa1, pa2, pa3); SBAR();
  pv_d0(o, vb0, pa0, pa1, pa2, pa3); partialSM<SHIFT>(pB0, pB1, m_reg, mnB, alB);
  __syncthreads(); RESC(alB);
  finishSM(pB0, pB1, alB, l_reg, pa0, pa1, pa2, pa3); SBAR();
  pv_d0(o, vb0 + (int)SHM_V, pa0, pa1, pa2, pa3);
  if (hi == 0) li_l[r32] = l_reg; asm volatile("s_waitcnt lgkmcnt(0)" ::: "memory");
  float rli[16];
#pragma unroll
  for (int r = 0; r < 16; ++r) rli[r] = __builtin_amdgcn_rcpf(li_l[crow(r, hi)]);
  bf16* Ow = Ob + (long)(wid * QBLK) * LDO;
#pragma unroll
  for (int r = 0; r < 16; ++r) { int orow = crow(r, hi);
    for (int d0 = 0; d0 < 4; ++d0) Ow[(long)orow * LDO + d0 * 32 + r32] = __float2bfloat16(o[d0][r] * rli[r]); }
#undef SLOAD
#undef SWRITE
#undef SWAIT
#undef RESC
}

template <int NC> __device__ __forceinline__ void pv_n(f32x16* o, int vb, bf16x8 pa0, bf16x8 pa1, bf16x8 pa2, bf16x8 pa3) {
  pv_one<0>(o[0], vb, pa0, pa1, pa2, pa3);
  if constexpr (NC > 1) pv_one<1>(o[1], vb, pa0, pa1, pa2, pa3);
  if constexpr (NC > 2) { pv_one<2>(o[2], vb, pa0, pa1, pa2, pa3); pv_one<3>(o[3], vb, pa0, pa1, pa2, pa3); }
}
template <int MB, int NKT, class BR, class ST>
__device__ __forceinline__ void dft_unit(const bf16* __restrict__ A, int lda, const BR& br, const ST& st, char* lds) {
  constexpr int NBW = 8 / MB, NC = 4 / NBW;
  const int tid = ltid(), wid = tid >> 6, lane = tid & 63, r32 = lane & 31, hi = lane >> 5;
  const int mb = wid % MB, cgp = wid / MB;
  const int sr = tid >> 4, sc = (tid & 15) * 8, vst0 = v_st(sr, sc), vst1 = v_st(32 + sr, sc);
  bf16x8 bq[NKT][2], af[NKT][4];
#pragma unroll
  for (int kt = 0; kt < NKT; ++kt) {
    bq[kt][0] = *reinterpret_cast<const bf16x8*>(br.row(kt * 64 + sr) + sc);
    bq[kt][1] = *reinterpret_cast<const bf16x8*>(br.row(kt * 64 + 32 + sr) + sc);
  }
  const bf16* Aw = A + (long)(mb * 32 + r32) * lda + hi * 8;
#pragma unroll
  for (int kt = 0; kt < NKT; ++kt)
#pragma unroll
    for (int ks = 0; ks < 4; ++ks) af[kt][ks] = *reinterpret_cast<const bf16x8*>(Aw + kt * 64 + ks * 16);
  __syncthreads();
#pragma unroll
  for (int kt = 0; kt < NKT; ++kt) {
    *(bf16x8*)(lds + kt * 16384 + vst0) = bq[kt][0];
    *(bf16x8*)(lds + kt * 16384 + vst1) = bq[kt][1];
  }
  __syncthreads();
  f32x16 o[NC];
#pragma unroll
  for (int d = 0; d < NC; ++d) o[d] = f32x16{};
  const int vb = (int)(uintptr_t)lds + v_rd_base(lane) + cgp * NC * 512;
#pragma unroll
  for (int kt = 0; kt < NKT; ++kt) pv_n<NC>(o, vb + kt * 16384, af[kt][0], af[kt][1], af[kt][2], af[kt][3]);
  bf16* stg = (bf16*)(lds + 65536) + wid * 4096;
  const float sc_ = st.scale;
#pragma unroll
  for (int r = 0; r < 16; ++r) {
#pragma unroll
    for (int d = 0; d < NC; ++d) stg[crow(r, hi) * (NC * 32) + d * 32 + r32] = __float2bfloat16(o[d][r] * sc_);
  }
  asm volatile("s_waitcnt lgkmcnt(0)" ::: "memory");
#pragma unroll
  for (int i = 0; i < NC * 2; ++i) { const int idx = i * 64 + lane, row = idx / (NC * 4), cc = idx % (NC * 4);
    const u32x4 v = *(const u32x4*)(stg + row * (NC * 32) + cc * 8);
    st.store16(mb * 32 + row, cgp * NC * 32 + cc * 8, v); }
  asm volatile("s_waitcnt lgkmcnt(0)" ::: "memory");
}
#undef SBAR
#undef KSWZ
}

namespace cg = cooperative_groups;
#define LAS __attribute__((address_space(3)))
typedef unsigned short bf16_t;
typedef unsigned v4u __attribute__((ext_vector_type(4)));
typedef unsigned v2u __attribute__((ext_vector_type(2)));
typedef float f4 __attribute__((ext_vector_type(4)));

#define XB_TMO      128
#define XB_XCNT(j)  (256  + 64 * (j))
#define XB_XSUB(j)  (1280 + 64 * (j))
#define XB_XGEN(j)  (2304 + 64 * (j))
#define XB_TOP      3328
#define XB_TOPGEN   3392
#define XCD_BAR_WORDS 3456
#define XB_SPIN_CAP (1u << 18)

__device__ __forceinline__ unsigned xb_ld(unsigned* p)              { return __hip_atomic_load(p, __ATOMIC_RELAXED, __HIP_MEMORY_SCOPE_AGENT); }
__device__ __forceinline__ unsigned xb_add(unsigned* p, unsigned v) { return __hip_atomic_fetch_add(p, v, __ATOMIC_RELAXED, __HIP_MEMORY_SCOPE_AGENT); }
__device__ __forceinline__ unsigned xb_xcc_id() { return (unsigned)__builtin_amdgcn_s_getreg((3 << 11) | 20) & 0xFu; }
#define XB_SPIN(cond, bar) do { unsigned _sp = 0; while (cond) { __builtin_amdgcn_s_sleep(1); \
    if ((++_sp & 255u) == 0u) { if (xb_ld(&(bar)[XB_TMO])) break; if (_sp > XB_SPIN_CAP) { atomicAdd(&(bar)[XB_TMO], 1u); break; } } } } while (0)

struct XcdBarrier {
    unsigned* bar; unsigned x;
    volatile LAS unsigned* st;
};

__device__ __forceinline__ XcdBarrier xcd_barrier_post(unsigned* bar, volatile LAS unsigned* st) {
    XcdBarrier b; b.bar = bar; b.x = xb_xcc_id(); b.st = st;
    if (threadIdx.x == 0) (void)xb_add(&bar[XB_XCNT(b.x)], 1u);
    return b;
}
__device__ __forceinline__ void xcd_barrier_complete(unsigned* bar, unsigned x, unsigned& nloc, unsigned& nx) {
    const unsigned G = gridDim.x * gridDim.y * gridDim.z;
    unsigned sum, cnt, mine, sp = 0u;
    for (;;) {
        sum = 0u; cnt = 0u; mine = 0u;
#pragma unroll
        for (unsigned j = 0; j < 16; ++j) { const unsigned c = xb_ld(&bar[XB_XCNT(j)]); sum += c; cnt += (c > 0u) ? 1u : 0u; mine = (j == x) ? c : mine; }
        if (sum == G) break;
        __builtin_amdgcn_s_sleep(1);
        if ((++sp & 255u) == 0u) { if (xb_ld(&bar[XB_TMO])) break; if (sp > XB_SPIN_CAP) { atomicAdd(&bar[XB_TMO], 1u); break; } }
    }
    nloc = mine > 0u ? mine : 1u; nx = cnt > 0u ? cnt : 1u;
}

__device__ __forceinline__ void xcd_barrier(const XcdBarrier& b) {
    asm volatile("s_waitcnt vmcnt(0)" ::: "memory");
    __syncthreads();
    if (threadIdx.x == 0) {
        unsigned* bar = b.bar;
        __builtin_amdgcn_s_waitcnt(0);
        unsigned nloc = b.st[0], nx = b.st[1];
        if (nloc == 0u) { xcd_barrier_complete(bar, b.x, nloc, nx); b.st[0] = nloc; b.st[1] = nx; }
        const unsigned old = xb_add(&bar[XB_XSUB(b.x)], 1u);
        const unsigned gen = old / nloc;
        if (old + 1u == (gen + 1u) * nloc) {
            __builtin_amdgcn_fence(__ATOMIC_RELEASE, "agent");
            asm volatile("s_waitcnt vmcnt(0)" ::: "memory");
            const unsigned og = xb_add(&bar[XB_TOP], 1u);
            const unsigned tg = og / nx;
            if (og + 1u == (tg + 1u) * nx) xb_add(&bar[XB_TOPGEN], 1u);
            else XB_SPIN(xb_ld(&bar[XB_TOPGEN]) == tg, bar);
            __builtin_amdgcn_fence(__ATOMIC_ACQUIRE, "agent");
            xb_add(&bar[XB_XGEN(b.x)], 1u);
            asm volatile("s_waitcnt vmcnt(0)" ::: "memory");
        } else {
            XB_SPIN(xb_ld(&bar[XB_XGEN(b.x)]) == gen, bar);
            __builtin_amdgcn_fence(__ATOMIC_ACQUIRE, "agent");
            asm volatile("s_waitcnt vmcnt(0)" ::: "memory");
        }
    }
    __syncthreads();
}

constexpr int DM = 2048, MTOK = 65536, NIN = 3072, DFF = 5632, NUP = 11264, WINW = 2560;
constexpr int NPROMPT = 32768;
constexpr int CHUNK = 65536, NCHUNK = 1;
constexpr float EPS = 1e-6f;
constexpr size_t MiB = (size_t)1 << 20;
constexpr size_t WS_M2F = 0;
constexpr size_t WS_COS = 1 * MiB, WS_SIN = 5 * MiB;
constexpr size_t WS_A1P = 9 * MiB, WS_A1S = 9 * MiB + 128 * 1024;
constexpr size_t WS_A3P = 10 * MiB, WS_A3S = 18 * MiB;
constexpr size_t WS_BAR = 19 * MiB, BAR_BYTES = 16384;
constexpr size_t WS_W = 20 * MiB;
constexpr size_t W_LAYER = 86 * MiB, W_OUT_OFF = 12 * MiB, W_UP_OFF = 20 * MiB, W_DOWN_OFF = 64 * MiB;
constexpr size_t WS_XH = 192 * MiB;
constexpr size_t WS_Z = 448 * MiB;
constexpr size_t WS_G = 704 * MiB;
constexpr size_t WS_Y = 832 * MiB;
constexpr size_t WS_ACT = 448 * MiB;
constexpr size_t WS_HB = 1152 * MiB;
constexpr size_t WS_XB = 1240 * MiB;
constexpr size_t WS_END = 1496 * MiB;
constexpr int LDS_BYTES = 135168;

__device__ __forceinline__ float bf2f(unsigned short b) { return __uint_as_float((unsigned)b << 16); }
__device__ __forceinline__ float bflo(unsigned w) { return __uint_as_float(w << 16); }
__device__ __forceinline__ float bfhi(unsigned w) { return __uint_as_float(w & 0xffff0000u); }
__device__ __forceinline__ unsigned pk2(float lo, float hi) { return pg8::cvt_pk_bf16(lo, hi); }
__device__ __forceinline__ float wave_sum(float v) {
#pragma unroll
    for (int o = 1; o < 64; o <<= 1) v += __shfl_xor(v, o);
    return v;
}

struct EpiWin {
    static constexpr bool PERM = true, AFTER_DRAIN = false;
    bf16_t* Z; bf16_t* Gp;
    __device__ __forceinline__ void operator()(const pg8::f32x4 (&acc)[2][2][4][2], const pg8::Unit& u, int wr, int wc, int fr, int fq) const {
        const int row0 = u.pm * pg8::BM + wr * 64 + fr;
        bf16_t* base; size_t rstride, bjstride;
        if (u.pn < 8) { base = Z + (size_t)row0 * 2048 + u.pn * 256 + wc * 32 + 8 * fq; rstride = 2048; bjstride = 128; }
        else {
            const int g = u.pn - 8, r0 = u.pm * pg8::BM; size_t sb; int L, t0;
            if (r0 < NPROMPT) { const int s = r0 >> 14; sb = (size_t)s * (2u * 16384u * 512u); L = 16384; t0 = row0 - s * 16384; }
            else { const int s = (r0 - NPROMPT) >> 12; sb = (size_t)NPROMPT * 1024 + (size_t)s * (2u * 4096u * 512u); L = 4096; t0 = row0 - NPROMPT - s * 4096; }
            base = Gp + sb + (size_t)t0 * 512 + g * 128 + wc * 32 + 8 * fq; rstride = 512; bjstride = (size_t)L * 512;
        }
#pragma unroll
        for (int ai = 0; ai < 2; ++ai)
#pragma unroll
            for (int m = 0; m < 4; ++m) { bf16_t* rowp = base + (size_t)(ai * pg8::HALF + m * 16) * rstride;
#pragma unroll
                for (int bj = 0; bj < 2; ++bj) { const pg8::f32x4 v0 = acc[ai][bj][m][0], v1 = acc[ai][bj][m][1];
                    pg8::u32x4 w; w.x = pk2(v0[0], v0[1]); w.y = pk2(v0[2], v0[3]); w.z = pk2(v1[0], v1[1]); w.w = pk2(v1[2], v1[3]);
                    *(pg8::u32x4*)(rowp + bj * bjstride) = w; } }
    }
};

__device__ __forceinline__ void p0a_tables(const float* fourier_w, unsigned char* ws, LAS float* tab, int gtid, int NT) {
    float* M2F = (float*)(ws + WS_M2F);
    { const int t = ltid(); if (t < 128) { float sn, cs; sincospif((float)t * (2.f / 128.f), &sn, &cs); tab[t] = cs; tab[128 + t] = -sn; } }
    __syncthreads();
    for (int i = gtid; i < 2 * 4 * 128 * 256; i += NT) {
        const int lg = i >> 15, c = (i >> 8) & 127, n = i & 255, part = n >> 7, e2 = n & 127;
        const float* fw = fourier_w + (size_t)lg * 16384 + e2;
        float acc = 0.f;
#pragma unroll 8
        for (int e = 0; e < 128; ++e) { const int r = (c * e) & 127; acc += tab[part * 128 + r] * fw[e * 128]; }
        M2F[i] = acc;
    }
    __syncthreads();
    float* COS = (float*)(ws + WS_COS); float* SIN = (float*)(ws + WS_SIN);
    for (int i = gtid; i < 16384 * 64; i += NT) {
        const int t = i >> 6, j = i & 63; const float pos = (float)(j < 32 ? (t >> 6) : (t & 63));
        const float inv = 1.0f / powf(10000.0f, (float)(j & 31) / 32.0f); const float ang = pos * inv;
        COS[i] = cosf(ang); SIN[i] = sinf(ang);
    }
    bf16_t* A1P = (bf16_t*)(ws + WS_A1P);
    for (int i = gtid; i < 256 * 256; i += NT) { const int m = i >> 8, k = i & 255, pm = m >> 7, k1 = m & 127, pk = k >> 7, t1 = k & 127; const int r = (t1 * k1) & 127;
        float sn, cs; sincospif((float)r * (2.f / 128.f), &sn, &cs); const float v = (pm == pk) ? cs : (pm == 0 ? sn : -sn); A1P[i] = (bf16_t)(pk2(v, 0.f) & 0xffff); }
    bf16_t* A1S = (bf16_t*)(ws + WS_A1S);
    for (int i = gtid; i < 128 * 128; i += NT) { const int m = i >> 7, k = i & 127, pm = m >> 6, k1 = m & 63, pk = k >> 6, t1 = k & 63; const int r = (t1 * k1) & 63;
        float sn, cs; sincospif((float)r * (2.f / 64.f), &sn, &cs); const float v = (pm == pk) ? cs : (pm == 0 ? sn : -sn); A1S[i] = (bf16_t)(pk2(v, 0.f) & 0xffff); }
    bf16_t* A3P = (bf16_t*)(ws + WS_A3P);
    for (int i = gtid; i < 128 * 128 * 256; i += NT) { const int k1 = i >> 15, k2 = (i >> 8) & 127, kk = i & 255, part = kk >> 7, t2 = kk & 127; const int k = k1 + 128 * k2; const int r = (t2 * k) & 16383;
        float sn, cs; sincospif((float)r * (1.f / 8192.f), &sn, &cs); A3P[i] = (bf16_t)(pk2(part ? sn : cs, 0.f) & 0xffff); }
    bf16_t* A3S = (bf16_t*)(ws + WS_A3S);
    for (int i = gtid; i < 64 * 64 * 128; i += NT) { const int k1 = i >> 13, k2 = (i >> 7) & 63, kk = i & 127, part = kk >> 6, t2 = kk & 63; const int k = k1 + 64 * k2; const int r = (t2 * k) & 4095;
        float sn, cs; sincospif((float)r * (1.f / 2048.f), &sn, &cs); A3S[i] = (bf16_t)(pk2(part ? sn : cs, 0.f) & 0xffff); }
}

struct ValUp { const float* W; __device__ __forceinline__ const float* ptr(int k, int n) const { const int src = ((n >> 7) & 1) * DFF + (n >> 8) * 128 + (n & 127); return W + (size_t)k * NUP + src; }
    __device__ __forceinline__ float operator()(int k, int n) const { return *ptr(k, n); } };
struct ValDirect { const float* W; int ldw; __device__ __forceinline__ const float* ptr(int k, int n) const { return W + (size_t)k * ldw + n; }
    __device__ __forceinline__ float operator()(int k, int n) const { return W[(size_t)k * ldw + n]; } };
struct ValWin { const float* win; const float* poolw; const float* pscale; const float* m2f;
    __device__ __forceinline__ const float* ptr(int k, int n) const { return win + (size_t)k * WINW + n; }
    __device__ __forceinline__ float operator()(int k, int n) const {
        if (n >= 512 && n < 2048) return win[(size_t)k * WINW + n];
        if (n < 512) { const int g = n >> 7, e = n & 127; const float* wr = win + (size_t)k * WINW + g * 128; const float* pw = poolw + g * 16384 + e; float acc = 0.f;
            for (int c = 0; c < 128; ++c) acc += wr[c] * pw[c * 128]; return acc * pscale[n]; }
        const int n2 = n - 2048, g = n2 >> 8, np = n2 & 255; const float* wr = win + (size_t)k * WINW + 2048 + g * 128; const float* mf = m2f + g * 32768 + np; float acc = 0.f;
        for (int c = 0; c < 128; ++c) acc += wr[c] * mf[c * 256]; return acc; } };
template <class F> __device__ __forceinline__ void transpose_item(const F& val, int K, bf16_t* WT, int k0, int n0, LAS float* scr, int lane) {
    for (int i = 0; i < 32; ++i) { const int kk = 2 * i + (lane >> 5); scr[kk * 33 + (lane & 31)] = val(k0 + kk, n0 + (lane & 31)); }
    asm volatile("s_waitcnt lgkmcnt(0)" ::: "memory");
    const int c = lane & 7;
#pragma unroll
    for (int j = 0; j < 4; ++j) { const int n = (lane >> 3) + 8 * j; const LAS float* s = scr + (8 * c) * 33 + n;
        v4u o; o.x = pk2(s[0 * 33], s[1 * 33]); o.y = pk2(s[2 * 33], s[3 * 33]); o.z = pk2(s[4 * 33], s[5 * 33]); o.w = pk2(s[6 * 33], s[7 * 33]);
        *(v4u*)(WT + (size_t)(n0 + n) * K + k0 + 8 * c) = o; }
    asm volatile("s_waitcnt lgkmcnt(0)" ::: "memory");
}
template <class F> __device__ __forceinline__ void tr_load(const F& f, int k0, int n0, int lane, f4 (&v)[8]) {
#pragma unroll
    for (int i = 0; i < 8; ++i) v[i] = __builtin_nontemporal_load((const f4*)f.ptr(k0 + 8 * i + (lane >> 3), n0 + 4 * (lane & 7)));
}
__device__ __forceinline__ void tr_store(const f4 (&v)[8], int K, bf16_t* WT, int k0, int n0, LAS float* scr, int lane) {
#pragma unroll
    for (int i = 0; i < 8; ++i) { LAS float* d = scr + (8 * i + (lane >> 3)) * 33 + 4 * (lane & 7); d[0] = v[i].x; d[1] = v[i].y; d[2] = v[i].z; d[3] = v[i].w; }
    asm volatile("s_waitcnt lgkmcnt(0)" ::: "memory");
    const int c = lane & 7;
#pragma unroll
    for (int j = 0; j < 4; ++j) { const int n = (lane >> 3) + 8 * j; const LAS float* s = scr + (8 * c) * 33 + n;
        v4u o; o.x = pk2(s[0 * 33], s[1 * 33]); o.y = pk2(s[2 * 33], s[3 * 33]); o.z = pk2(s[4 * 33], s[5 * 33]); o.w = pk2(s[6 * 33], s[7 * 33]);
        *(v4u*)(WT + (size_t)(n0 + n) * K + k0 + 8 * c) = o; }
    asm volatile("s_waitcnt lgkmcnt(0)" ::: "memory");
}
template <class F> __device__ __forceinline__ void transpose_matrix(const F& val, int K, int N, bf16_t* WT, LAS float* scr, int gw, int NGW, int lane, int nlo, int nhi) {
    const int nblk = (nhi - nlo) / 32, nitems = (K / 64) * nblk;
    int it = gw; if (it >= nitems) return;
    f4 cur[8], nxt[8];
    tr_load(val, 64 * (it / nblk), nlo + 32 * (it % nblk), lane, cur);
    for (; it < nitems; it += NGW) {
        const int k0 = 64 * (it / nblk), n0 = nlo + 32 * (it % nblk); const int it2 = it + NGW; const bool more = it2 < nitems;
        if (more) tr_load(val, 64 * (it2 / nblk), nlo + 32 * (it2 % nblk), lane, nxt);
        tr_store(cur, K, WT, k0, n0, scr, lane);
        if (more) {
#pragma unroll
            for (int i = 0; i < 8; ++i) cur[i] = nxt[i]; }
    }
}

typedef float __attribute__((address_space(4))) cf32;
__device__ __forceinline__ void fold_items(const float* win, const float* poolw, const float* pscale, const float* m2f, bf16_t* WT, int gw, int NGW, int lane) {
    for (int it = gw; it < 64 * 24; it += NGW) {
        const int kb = it / 24, nb = it - kb * 24, k0 = 32 * kb;
        float m2[128]; int base, nout;
        if (nb < 8) { const int n = nb * 64 + lane, g = nb >> 1, e = n & 127; base = g * 128; nout = n; const float sc = pscale[n]; const float* pw = poolw + g * 16384 + e;
#pragma unroll
            for (int c = 0; c < 128; ++c) m2[c] = pw[c * 128] * sc;
        } else { const int n2 = (nb - 8) * 64 + lane, g = (nb - 8) >> 2, np = n2 & 255; base = 2048 + g * 128; nout = 2048 + n2; const float* mf = m2f + g * 32768 + np;
#pragma unroll
            for (int c = 0; c < 128; ++c) m2[c] = mf[c * 256];
        }
        bf16_t* wrow = WT + (size_t)nout * DM + k0;
        for (int kg = 0; kg < 4; ++kg) {
            float acc[8];
#pragma unroll
            for (int kk = 0; kk < 8; ++kk) { const cf32* wr = (const cf32*)(unsigned long long)(win + (size_t)(k0 + 8 * kg + kk) * WINW + base); float a = 0.f;
#pragma unroll
                for (int c = 0; c < 128; ++c) a += wr[c] * m2[c];
                acc[kk] = a; }
            v4u o; o.x = pk2(acc[0], acc[1]); o.y = pk2(acc[2], acc[3]); o.z = pk2(acc[4], acc[5]); o.w = pk2(acc[6], acc[7]);
            *(v4u*)(wrow + 8 * kg) = o;
        }
    }
}

__device__ __forceinline__ const float* xrow_ptr(const float* xa, const float* xb, int row) { return (row < NPROMPT) ? xa + (size_t)row * DM : xb + (size_t)(row - NPROMPT) * DM; }
template <bool XBF, bool OBF, int RR>
__device__ __forceinline__ void resid_rows(const float* xa, const float* xb, const bf16_t* xbf, const bf16_t* m, const float* g1, float* xout, bf16_t* xbout, bf16_t* xh, const float* g2, int gw, int NGW, int lane) {
    for (int row0 = gw; row0 < MTOK; row0 += RR * NGW) {
        f4 xf[XBF ? 1 : RR][8]; v2u xp[XBF ? RR : 1][8]; v2u mw[RR][8];
#pragma unroll
        for (int u = 0; u < RR; ++u) { const int row = row0 + u * NGW;
            if constexpr (XBF) { const bf16_t* xr = xbf + (size_t)row * DM;
#pragma unroll
                for (int j = 0; j < 8; ++j) xp[u][j] = *(const v2u*)(xr + 4 * lane + 256 * j);
            } else { const float* xr = xrow_ptr(xa, xb, row);
#pragma unroll
                for (int j = 0; j < 8; ++j) xf[u][j] = __builtin_nontemporal_load((const f4*)(xr + 4 * lane + 256 * j)); } }
        if (m) {
#pragma unroll
            for (int u = 0; u < RR; ++u) { const bf16_t* mr = m + (size_t)(row0 + u * NGW) * DM;
#pragma unroll
                for (int j = 0; j < 8; ++j) mw[u][j] = *(const v2u*)(mr + 4 * lane + 256 * j); }
        }
#pragma unroll
        for (int u = 0; u < RR; ++u) { const int row = row0 + u * NGW;
            f4 xv[8];
#pragma unroll
            for (int j = 0; j < 8; ++j) { if constexpr (XBF) { const v2u w = xp[u][j]; xv[j] = (f4){bflo(w.x), bfhi(w.x), bflo(w.y), bfhi(w.y)}; } else xv[j] = xf[u][j]; }
            if (m) { float ss = 0.f;
#pragma unroll
                for (int j = 0; j < 8; ++j) { const v2u w = mw[u][j]; const f4 mv = (f4){bflo(w.x), bfhi(w.x), bflo(w.y), bfhi(w.y)}; ss += (mv.x * mv.x + mv.y * mv.y) + (mv.z * mv.z + mv.w * mv.w); }
                const float r = 1.0f / sqrtf(wave_sum(ss) * (1.f / DM) + EPS);
#pragma unroll
                for (int j = 0; j < 8; ++j) { const v2u w = mw[u][j]; const f4 mv = (f4){bflo(w.x), bfhi(w.x), bflo(w.y), bfhi(w.y)}; const f4 gv = *(const f4*)(g1 + 4 * lane + 256 * j); xv[j] += mv * r * gv; } }
            if constexpr (OBF) { if (xbout) {
#pragma unroll
                for (int j = 0; j < 8; ++j) { v2u w; w.x = pk2(xv[j].x, xv[j].y); w.y = pk2(xv[j].z, xv[j].w); *(v2u*)(xbout + (size_t)row * DM + 4 * lane + 256 * j) = w; } }
            } else { if (xout) {
#pragma unroll
                for (int j = 0; j < 8; ++j) __builtin_nontemporal_store(xv[j], (f4*)(xout + (size_t)row * DM + 4 * lane + 256 * j)); } }
            if (xh) { float ss = 0.f;
#pragma unroll
                for (int j = 0; j < 8; ++j) ss += (xv[j].x * xv[j].x + xv[j].y * xv[j].y) + (xv[j].z * xv[j].z + xv[j].w * xv[j].w);
                const float r = 1.0f / sqrtf(wave_sum(ss) * (1.f / DM) + EPS);
#pragma unroll
                for (int j = 0; j < 8; ++j) { const f4 gv = *(const f4*)(g2 + 4 * lane + 256 * j); const f4 y = xv[j] * r * gv;
                    v2u w; w.x = pk2(y.x, y.y); w.y = pk2(y.z, y.w); *(v2u*)(xh + (size_t)row * DM + 4 * lane + 256 * j) = w; } }
        }
    }
}

__device__ __forceinline__ void rope_pass(bf16_t* Z, bf16_t* Zout, const float* qn, const float* kn, const float* COS, const float* SIN, int gtid, int NT) {
    const int hw = gtid >> 5, NHW = NT >> 5, j = gtid & 31;
    constexpr float QC = 0.088388347648318440f * 1.4426950408889634f;
    const float qa0 = qn[2 * j] * QC, qa1 = qn[2 * j + 1] * QC, qb0 = qn[64 + 2 * j] * QC, qb1 = qn[65 + 2 * j] * QC;
    const float ka0 = kn[2 * j], ka1 = kn[2 * j + 1], kb0 = kn[64 + 2 * j], kb1 = kn[65 + 2 * j];
    for (int row = hw; row < MTOK; row += NHW) {
        const int t = row < NPROMPT ? (row & 16383) : (row & 4095);
        bf16_t* p = Z + (size_t)row * DM + 512 + 2 * j;
        unsigned a[10], b[10];
#pragma unroll
        for (int hh = 0; hh < 10; ++hh) { a[hh] = *(const unsigned*)(p + hh * 128); b[hh] = *(const unsigned*)(p + hh * 128 + 64); }
        const float c0 = COS[t * 64 + 2 * j], c1 = COS[t * 64 + 2 * j + 1], s0 = SIN[t * 64 + 2 * j], s1 = SIN[t * 64 + 2 * j + 1];
#pragma unroll
        for (int hh = 0; hh < 10; ++hh) {
            float x0 = bflo(a[hh]), x1 = bfhi(a[hh]), y0 = bflo(b[hh]), y1 = bfhi(b[hh]);
            float ss = (x0 * x0 + x1 * x1) + (y0 * y0 + y1 * y1);
#pragma unroll
            for (int o = 1; o < 32; o <<= 1) ss += __shfl_xor(ss, o);
            const float r = 1.0f / sqrtf(ss * (1.f / 128.f) + EPS);
            x0 *= r * (hh < 8 ? qa0 : ka0); x1 *= r * (hh < 8 ? qa1 : ka1); y0 *= r * (hh < 8 ? qb0 : kb0); y1 *= r * (hh < 8 ? qb1 : kb1);
            const float ox0 = x0 * c0 - y0 * s0, oy0 = y0 * c0 + x0 * s0, ox1 = x1 * c1 - y1 * s1, oy1 = y1 * c1 + x1 * s1;
            bf16_t* po = Zout + (size_t)row * DM + 512 + 2 * j;
            *(unsigned*)(po + hh * 128) = pk2(ox0, ox1); *(unsigned*)(po + hh * 128 + 64) = pk2(oy0, oy1);
        }
    }
}

__device__ __forceinline__ void acc8(float* s, const bf16_t* p, float sg) { const v4u v = *(const v4u*)p;
    s[0] += sg * bflo(v.x); s[1] += sg * bfhi(v.x); s[2] += sg * bflo(v.y); s[3] += sg * bfhi(v.y); s[4] += sg * bflo(v.z); s[5] += sg * bfhi(v.z); s[6] += sg * bflo(v.w); s[7] += sg * bfhi(v.w); }
__device__ __forceinline__ void pool_pass(const bf16_t* Z, bf16_t* H, int gtid, int NT) {
    constexpr int RL = 32;
    for (int it = gtid; it < (MTOK / RL) * 64; it += NT) {
        const int ch = it & 63, run = it >> 6, c0 = ch * 8, g = ch >> 4, w = 2 << g, a = w >> 1, b = w - 1 - a;
        const int row0 = run * RL; int t0, L; if (row0 < NPROMPT) { t0 = row0 & 16383; L = 16384; } else { t0 = row0 & 4095; L = 4096; }
        const bf16_t* zb = Z + (size_t)(row0 - t0) * DM + c0;
        float s[8] = {0.f, 0.f, 0.f, 0.f, 0.f, 0.f, 0.f, 0.f};
        { const int lo = t0 - a < 0 ? 0 : t0 - a, hi = t0 + b > L - 1 ? L - 1 : t0 + b;
          for (int tt = lo; tt <= hi; ++tt) acc8(s, zb + (size_t)tt * DM, 1.f); }
#pragma unroll 4
        for (int r = 0; r < RL; ++r) {
            const int t = t0 + r; const int lo = t - a < 0 ? 0 : t - a, hi = t + b > L - 1 ? L - 1 : t + b;
            const float ic = 1.0f / (float)(hi - lo + 1);
            const v4u v = *(const v4u*)(zb + (size_t)t * DM);
            v4u o; o.x = pk2(s[0] * ic - bflo(v.x), s[1] * ic - bfhi(v.x)); o.y = pk2(s[2] * ic - bflo(v.y), s[3] * ic - bfhi(v.y));
            o.z = pk2(s[4] * ic - bflo(v.z), s[5] * ic - bfhi(v.z)); o.w = pk2(s[6] * ic - bflo(v.w), s[7] * ic - bfhi(v.w));
            *(v4u*)(H + (size_t)(row0 + r) * DM + c0) = o;
            if (t + 1 + b <= L - 1) acc8(s, zb + (size_t)(t + 1 + b) * DM, 1.f);
            if (t - a >= 0) acc8(s, zb + (size_t)(t - a) * DM, -1.f);
        }
    }
}

__device__ __forceinline__ float gelu_tanh(float x) { const float y = 0.7978845608028654f * (x + 0.044715f * x * x * x); return x * __builtin_amdgcn_rcpf(1.0f + __expf(-2.0f * y)); }
__device__ __forceinline__ void ld8f(const bf16_t* p, float* o) { const v4u v = *(const v4u*)p; o[0] = bflo(v.x); o[1] = bfhi(v.x); o[2] = bflo(v.y); o[3] = bfhi(v.y); o[4] = bflo(v.z); o[5] = bfhi(v.z); o[6] = bflo(v.w); o[7] = bfhi(v.w); }
__device__ __forceinline__ float dpp_ror1(float v) { return __int_as_float(__builtin_amdgcn_update_dpp(0, __float_as_int(v), 0x121, 0xf, 0xf, false)); }
__device__ __forceinline__ float dpp_ror15(float v) { return __int_as_float(__builtin_amdgcn_update_dpp(0, __float_as_int(v), 0x12F, 0xf, 0xf, false)); }
struct EpiGlu {
    static constexpr bool PERM = true, AFTER_DRAIN = false;
    bf16_t* ACT; bf16_t* HB; const float* cw; const float* cb;
    __device__ __forceinline__ void operator()(const pg8::f32x4 (&acc)[2][2][4][2], const pg8::Unit& u, int wr, int wc, int fr, int fq) const {
        const int jc = u.pn * 128 + wc * 32 + 8 * fq;
        const bool first = (fr == 0), last = (fr == 15);
        v2u stash[2][4];
#pragma unroll
        for (int n = 0; n < 2; ++n) {
            const f4 w0g = *(const f4*)(cw + jc + 4 * n), w1g = *(const f4*)(cw + NUP + jc + 4 * n), w2g = *(const f4*)(cw + 2 * NUP + jc + 4 * n), bg = *(const f4*)(cb + jc + 4 * n);
            const f4 w0v = *(const f4*)(cw + DFF + jc + 4 * n), w1v = *(const f4*)(cw + NUP + DFF + jc + 4 * n), w2v = *(const f4*)(cw + 2 * NUP + DFF + jc + 4 * n), bv = *(const f4*)(cb + DFF + jc + 4 * n);
#pragma unroll
            for (int ai = 0; ai < 2; ++ai) {
                float g1p[4], v1p[4], g15c[4], v15c[4];
#pragma unroll
                for (int i = 0; i < 4; ++i) { g1p[i] = 0.f; v1p[i] = 0.f; g15c[i] = dpp_ror15(acc[ai][0][0][n][i]); v15c[i] = dpp_ror15(acc[ai][1][0][n][i]); }
#pragma unroll
                for (int m = 0; m < 4; ++m) {
                    const int mn = m < 3 ? m + 1 : 3;
                    float o[4];
#pragma unroll
                    for (int i = 0; i < 4; ++i) {
                        const float g = acc[ai][0][m][n][i], v = acc[ai][1][m][n][i];
                        const float g1c = dpp_ror1(g), v1c = dpp_ror1(v), g15n = dpp_ror15(acc[ai][0][mn][n][i]), v15n = dpp_ror15(acc[ai][1][mn][n][i]);
                        const float gp = first ? g1p[i] : g1c, gn = last ? g15n : g15c[i], vp = first ? v1p[i] : v1c, vn = last ? v15n : v15c[i];
                        g1p[i] = g1c; v1p[i] = v1c; g15c[i] = g15n; v15c[i] = v15n;
                        const float a = gp * w0g[i] + g * w1g[i] + gn * w2g[i] + bg[i];
                        const float b = vp * w0v[i] + v * w1v[i] + vn * w2v[i] + bv[i];
                        const float e = __builtin_amdgcn_exp2f(a * (-2.3022082f + -0.10294324f * (a * a)));
                        o[i] = a * __builtin_amdgcn_rcpf(1.0f + e) * b;
                    }
                    const int row = u.pm * pg8::BM + ai * pg8::HALF + wr * 64 + m * 16 + fr;
                    v2u w; w.x = pk2(o[0], o[1]); w.y = pk2(o[2], o[3]);
                    if (n == 0) stash[ai][m] = w;
                    else { v4u ww; ww.x = stash[ai][m].x; ww.y = stash[ai][m].y; ww.z = w.x; ww.w = w.y; *(v4u*)(ACT + (size_t)row * DFF + jc) = ww; }
                }
            }
        }
#pragma unroll
        for (int ai = 0; ai < 2; ++ai) {
            const int grp = u.pm * 4 + ai * 2 + wr;
            if (fr < 2 || fr >= 14) {
                const int m = fr < 2 ? 0 : 3, slot = fr < 2 ? fr : fr - 12;
                bf16_t* hp = HB + ((size_t)grp * 4 + slot) * NUP + u.pn * 256 + wc * 32 + 8 * fq;
#pragma unroll
                for (int bj = 0; bj < 2; ++bj) {
                    const pg8::f32x4 v0 = fr < 2 ? acc[ai][bj][0][0] : acc[ai][bj][3][0], v1 = fr < 2 ? acc[ai][bj][0][1] : acc[ai][bj][3][1];
                    v4u w; w.x = pk2(v0[0], v0[1]); w.y = pk2(v0[2], v0[3]); w.z = pk2(v1[0], v1[1]); w.w = pk2(v1[2], v1[3]);
                    *(v4u*)(hp + bj * 128) = w;
                }
                (void)m;
            }
        }
    }
};
__device__ __forceinline__ void glu_fix(const bf16_t* HB, bf16_t* ACT, const float* cw, const float* cb, int gtid, int NT) {
    constexpr int NCC = DFF / 8, NG = CHUNK / 64;
    for (int it = gtid; it < NG * 2 * NCC; it += NT) {
        const int cc = it % NCC, rest = it / NCC, which = rest & 1, g = rest >> 1, j0 = cc * 8, colp = (j0 >> 7) * 256 + (j0 & 127);
        const int row = g * 64 + (which ? 63 : 0); const int Lc = row < NPROMPT ? 16384 : 4096;
        const bf16_t *P, *C, *N;
        if (!which) { C = HB + ((size_t)g * 4 + 0) * NUP; N = HB + ((size_t)g * 4 + 1) * NUP; P = ((row & (Lc - 1)) == 0) ? nullptr : HB + ((size_t)(g - 1) * 4 + 3) * NUP; }
        else { P = HB + ((size_t)g * 4 + 2) * NUP; C = HB + ((size_t)g * 4 + 3) * NUP; N = (((row + 1) & (Lc - 1)) == 0) ? nullptr : HB + ((size_t)(g + 1) * 4 + 0) * NUP; }
        float pg[8], pv[8], cg_[8], cv[8], ng[8], nv[8];
        if (P) { ld8f(P + colp, pg); ld8f(P + colp + 128, pv); } else {
#pragma unroll
            for (int i = 0; i < 8; ++i) { pg[i] = 0.f; pv[i] = 0.f; } }
        if (N) { ld8f(N + colp, ng); ld8f(N + colp + 128, nv); } else {
#pragma unroll
            for (int i = 0; i < 8; ++i) { ng[i] = 0.f; nv[i] = 0.f; } }
        ld8f(C + colp, cg_); ld8f(C + colp + 128, cv);
        float o[8];
#pragma unroll
        for (int h = 0; h < 2; ++h) {
            const f4 w0g = *(const f4*)(cw + j0 + 4 * h), w1g = *(const f4*)(cw + NUP + j0 + 4 * h), w2g = *(const f4*)(cw + 2 * NUP + j0 + 4 * h), bg = *(const f4*)(cb + j0 + 4 * h);
            const f4 w0v = *(const f4*)(cw + DFF + j0 + 4 * h), w1v = *(const f4*)(cw + NUP + DFF + j0 + 4 * h), w2v = *(const f4*)(cw + 2 * NUP + DFF + j0 + 4 * h), bv = *(const f4*)(cb + DFF + j0 + 4 * h);
#pragma unroll
            for (int q = 0; q < 4; ++q) { const int i = 4 * h + q;
                const float a = pg[i] * w0g[q] + cg_[i] * w1g[q] + ng[i] * w2g[q] + bg[q];
                const float b = pv[i] * w0v[q] + cv[i] * w1v[q] + nv[i] * w2v[q] + bv[q];
                o[i] = gelu_tanh(a) * b; } }
        v4u w; w.x = pk2(o[0], o[1]); w.y = pk2(o[2], o[3]); w.z = pk2(o[4], o[5]); w.w = pk2(o[6], o[7]);
        *(v4u*)(ACT + (size_t)row * DFF + j0) = w;
    }
}

struct BRow1 { const att::bf16* base; size_t ldb; __device__ __forceinline__ const att::bf16* row(int kk) const { return base + (size_t)kk * ldb; } };
struct St1 { att::bf16* base; size_t ldb; float scale; __device__ __forceinline__ void store16(int m, int c, att::u32x4 v) const { *(att::u32x4*)(base + (size_t)m * ldb + c) = v; } };
struct BRow3 { const att::bf16* base; int R, lgR, k1; __device__ __forceinline__ const att::bf16* row(int kk) const { const int part = kk >> lgR, t2 = kk & (R - 1); return base + (size_t)(((part << lgR) + k1) * R + t2) * 512; } };
struct St3 { att::bf16* base; int R; float scale; __device__ __forceinline__ void store16(int m, int c, att::u32x4 v) const { *(att::u32x4*)(base + (size_t)(m * R) * DM + c) = v; } };

__device__ __forceinline__ void dft_stage1(const bf16_t* Gp, bf16_t* Yp, const unsigned char* ws, char* lds, int vcu, int G) {
    for (int it = 0;; ++it) { const int uid = it * G + vcu; if (uid >= 3072) break;
        if (uid < 1024) { const int s = uid >> 9, nt = uid & 511; const size_t off = (size_t)s * (2u * 16384u * 512u) + (size_t)nt * 128;
            BRow1 br{(const att::bf16*)Gp + off, 65536}; St1 st{(att::bf16*)Yp + off, 65536, 1.f};
            att::dft_unit<8, 4>((const att::bf16*)(ws + WS_A1P), 256, br, st, lds);
        } else { const int u2 = uid - 1024, s = u2 >> 8, nt = u2 & 255; const size_t off = (size_t)NPROMPT * 1024 + (size_t)s * (2u * 4096u * 512u) + (size_t)nt * 128;
            BRow1 br{(const att::bf16*)Gp + off, 32768}; St1 st{(att::bf16*)Yp + off, 32768, 1.f};
            att::dft_unit<4, 2>((const att::bf16*)(ws + WS_A1S), 128, br, st, lds);
        }
    }
}
__device__ __forceinline__ void dft_stage3(const bf16_t* Yp, bf16_t* H, const unsigned char* ws, char* lds, int vcu, int G) {
    for (int it = 0;; ++it) { const int uid = it * G + vcu; if (uid >= 3072) break;
        if (uid < 1024) { const int s = uid >> 9, k1 = (uid >> 2) & 127, nt = uid & 3;
            BRow3 br{(const att::bf16*)Yp + (size_t)s * (2u * 16384u * 512u) + nt * 128, 128, 7, k1};
            St3 st{(att::bf16*)H + (size_t)(s * 16384 + k1) * DM + 1536 + nt * 128, 128, 1.0f / sqrtf(16384.f * 128.f)};
            att::dft_unit<4, 4>((const att::bf16*)(ws + WS_A3P) + (size_t)k1 * (128 * 256), 256, br, st, lds);
        } else { const int u2 = uid - 1024, s = u2 >> 8, k1 = (u2 >> 2) & 63, nt = u2 & 3;
            BRow3 br{(const att::bf16*)Yp + (size_t)NPROMPT * 1024 + (size_t)s * (2u * 4096u * 512u) + nt * 128, 64, 6, k1};
            St3 st{(att::bf16*)H + (size_t)(NPROMPT + s * 4096 + k1) * DM + 1536 + nt * 128, 64, 1.0f / sqrtf(4096.f * 128.f)};
            att::dft_unit<2, 2>((const att::bf16*)(ws + WS_A3S) + (size_t)k1 * (64 * 128), 128, br, st, lds);
        }
    }
}

template <bool SHIFT> __device__ __forceinline__ void attn_units(const bf16_t* Z, bf16_t* H, float bound, char* lds, int vcu, int G) {
    for (int it = 0;; ++it) { const int uid = it * G + vcu; if (uid >= 2048) break;
        int rowbase, h, qb, seq;
        if (uid < 1024) { const int s = uid >> 9; h = (uid >> 6) & 7; qb = uid & 63; rowbase = s * 16384; seq = 16384; }
        else { const int u2 = uid - 1024, s = u2 >> 7; h = (u2 >> 4) & 7; qb = u2 & 15; rowbase = NPROMPT + s * 4096; seq = 4096; }
        const att::bf16* Q = (const att::bf16*)Z + (size_t)(rowbase + qb * 256) * DM + 512 + h * 128;
        const att::bf16* K = (const att::bf16*)Z + (size_t)rowbase * DM + 1536 + (h >> 2) * 128;
        att::bf16* O = (att::bf16*)H + (size_t)(rowbase + qb * 256) * DM + 512 + h * 128;
        att::attn_dense_body<att::bf16, SHIFT>(Q, K, K + 256, O, seq, lds, bound);
        __syncthreads();
    }
}
__device__ __forceinline__ void attn_phase(const bf16_t* Z, bf16_t* H, const float* qn, const float* kn, char* lds, int vcu, int G) {
    float mq = 0.f, mk = 0.f;
    for (int i = 0; i < 128; ++i) { mq = fmaxf(mq, fabsf(qn[i])); mk = fmaxf(mk, fabsf(kn[i])); }
    const float bound = 128.f * mq * mk * 1.02f;
    const bool noshift = __builtin_amdgcn_readfirstlane((int)(bound * (att::SCALE * 1.4426950408889634f) < 60.f)) != 0;
    if (noshift) attn_units<false>(Z, H, bound, lds, vcu, G);
    else attn_units<true>(Z, H, bound, lds, vcu, G);
}

struct Params { const float* in[17]; float* out; unsigned char* ws; int ph_lo, ph_hi; };
constexpr int NPL = 9;
constexpr int NPHASE = 2 + 2 * NPL;

__global__ void __launch_bounds__(512, 2) mega_fwd(Params p) {
    extern __shared__ __attribute__((aligned(16))) unsigned char lds[];
    cg::grid_group grid = cg::this_grid();
    const int G = gridDim.x, bx = blockIdx.x;
    const int vcu = (G % 8 == 0) ? (bx % 8) * (G / 8) + bx / 8 : bx;
    const int NGW = G * 8, NT = G * 512;
    unsigned char* ws = p.ws;
    const float *x_prompt = p.in[0], *x_sample = p.in[1], *g_pre_mix = p.in[2], *g_post_mix = p.in[3], *w_in = p.in[4], *pool_w = p.in[5], *pool_scale = p.in[6],
                *q_norm = p.in[7], *k_norm = p.in[8], *fourier_w = p.in[9], *w_out = p.in[10], *g_pre_ffn = p.in[11], *g_post_ffn = p.in[12], *w_up = p.in[13],
                *conv_w = p.in[14], *conv_b = p.in[15], *w_down = p.in[16];
    bf16_t* XH = (bf16_t*)(ws + WS_XH); bf16_t* Z = (bf16_t*)(ws + WS_Z); bf16_t* Gp = (bf16_t*)(ws + WS_G); bf16_t* Yp = (bf16_t*)(ws + WS_Y);
    bf16_t* HB = (bf16_t*)(ws + WS_HB); bf16_t* ACT = (bf16_t*)(ws + WS_ACT); bf16_t* XB = (bf16_t*)(ws + WS_XB);
    LAS unsigned char* ring = (LAS unsigned char*)lds;
    volatile LAS unsigned* bst = (volatile LAS unsigned*)(ring + 131072 + 64);
    if (threadIdx.x < 2) bst[threadIdx.x] = 0u;
    __syncthreads();
    XcdBarrier xbar = xcd_barrier_post((unsigned*)(ws + WS_BAR), bst);

    for (int ph = p.ph_lo; ph < p.ph_hi; ++ph) {
        const int tid = ltid(), lane = tid & 63, wave = __builtin_amdgcn_readfirstlane(tid >> 6);
        const int gw = vcu * 8 + wave, gtid = bx * 512 + tid;
        if (ph == 0) {
#if !defined(ONLY) || ONLY==0
            for (int rep = 0; rep < REP_P0; ++rep) p0a_tables(fourier_w, ws, (LAS float*)ring, gtid, NT);
#endif
        } else if (ph == 1) {
#if !defined(ONLY) || ONLY==1
            LAS float* scr = (LAS float*)(ring + wave * 16384);
            for (int l = 0; l < 2 * REP_P0; ++l) {
                bf16_t* Wl = (bf16_t*)(ws + WS_W + (l & 1) * W_LAYER);
                ValWin vw{w_in + (size_t)(l & 1) * DM * WINW, pool_w + (size_t)(l & 1) * 4 * 16384, pool_scale + (l & 1) * 512, (const float*)(ws + WS_M2F) + (size_t)(l & 1) * 4 * 32768};
                transpose_matrix(vw, DM, NIN, Wl, scr, gw, NGW, lane, 512, 2048);
                fold_items(vw.win, vw.poolw, vw.pscale, vw.m2f, Wl, gw, NGW, lane);
                ValDirect vo{w_out + (size_t)(l & 1) * DM * DM, DM};
                transpose_matrix(vo, DM, DM, (bf16_t*)((unsigned char*)Wl + W_OUT_OFF), scr, gw, NGW, lane, 0, DM);
                ValUp vu{w_up + (size_t)(l & 1) * DM * NUP};
                transpose_matrix(vu, DM, NUP, (bf16_t*)((unsigned char*)Wl + W_UP_OFF), scr, gw, NGW, lane, 0, NUP);
                ValDirect vd{w_down + (size_t)(l & 1) * DFF * DM, DM};
                transpose_matrix(vd, DFF, DM, (bf16_t*)((unsigned char*)Wl + W_DOWN_OFF), scr, gw, NGW, lane, 0, DM);
            }
            for (int rep = 0; rep < REP_P0; ++rep) resid_rows<false, false, 2>(x_prompt, x_sample, nullptr, nullptr, nullptr, nullptr, nullptr, XH, g_pre_mix, gw, NGW, lane);
#endif
        } else {
            const int l = (ph - 2) / NPL, q = (ph - 2) % NPL;
            const bf16_t* Wl = (const bf16_t*)(ws + WS_W + l * W_LAYER);
            if (q == 0) {
#if !defined(ONLY) || ONLY==2
                pg8::Gemm g{XH, Wl, MTOK, NIN, DM}; pg8::StaticOrder S; S.init(MTOK, NIN, G, bx);
                EpiWin E{Z, Gp};
                for (int rep = 0; rep < REP_WIN; ++rep) pg8::gemm_phase<EpiWin, pg8::StaticOrder, PG8_ALIGN, PG8_SP2>(ring, g, S, E);
#endif
            } else if (q == 1) {
#if !defined(ONLY) || ONLY==3
                for (int rep = 1; rep < REP_ROPE; ++rep) rope_pass(Z, (bf16_t*)(ws + WS_END), q_norm + l * 128, k_norm + l * 128, (const float*)(ws + WS_COS), (const float*)(ws + WS_SIN), gtid, NT);
                rope_pass(Z, Z, q_norm + l * 128, k_norm + l * 128, (const float*)(ws + WS_COS), (const float*)(ws + WS_SIN), gtid, NT);
                for (int rep = 0; rep < REP_LIGHT * REP_POOL; ++rep) pool_pass(Z, XH, gtid, NT);
                for (int rep = 0; rep < REP_LIGHT; ++rep) dft_stage1(Gp, Yp, ws, (char*)lds, vcu, G);
#endif
            } else if (q == 2) {
#if !defined(ONLY) || ONLY==4
                for (int rep = 0; rep < REP_ATTN; ++rep) attn_phase(Z, XH, q_norm + l * 128, k_norm + l * 128, (char*)lds, vcu, G);
#endif
#if !defined(ONLY) || ONLY==5
                for (int rep = 0; rep < REP_LIGHT; ++rep) dft_stage3(Yp, XH, ws, (char*)lds, vcu, G);
#endif
            } else if (q == 4) {
#if !defined(ONLY) || ONLY==6
                for (int rep = 1; rep < REP_RES; ++rep) resid_rows<true, true, 4>(nullptr, nullptr, XB, Z, g_post_mix + DM, nullptr, nullptr, (bf16_t*)(ws + WS_END), g_pre_ffn + DM, gw, NGW, lane);
                if (l == 0) resid_rows<false, true, 2>(x_prompt, x_sample, nullptr, Z, g_post_mix, nullptr, XB, XH, g_pre_ffn, gw, NGW, lane);
                else resid_rows<true, true, 4>(nullptr, nullptr, XB, Z, g_post_mix + DM, nullptr, XB, XH, g_pre_ffn + DM, gw, NGW, lane);
#endif
            } else if (q == 8) {
#if !defined(ONLY) || ONLY==6
                if (l == 0) resid_rows<true, true, 4>(nullptr, nullptr, XB, XH, g_post_ffn, nullptr, XB, XH, g_pre_mix + DM, gw, NGW, lane);
                else resid_rows<true, false, 4>(nullptr, nullptr, XB, XH, g_post_ffn + DM, p.out, nullptr, nullptr, nullptr, gw, NGW, lane);
#endif
            } else {
                const int c = 0, step = (q >= 5) ? (q - 5) : -1;
                const float* cwl = conv_w + (size_t)l * 3 * NUP; const float* cbl = conv_b + (size_t)l * NUP;
                if (step == 1) {
#if !defined(ONLY) || ONLY==7
                    for (int rep = 0; rep < REP_LIGHT; ++rep) glu_fix(HB, ACT, cwl, cbl, gtid, NT);
#endif
                } else if (step == 0) {
#if !defined(ONLY) || ONLY==9
                    pg8::Gemm g{XH + (size_t)c * CHUNK * DM, (const bf16_t*)((const unsigned char*)Wl + W_UP_OFF), CHUNK, NUP, DM};
                    pg8::StaticOrder S; S.init(g.M, g.N, G, bx);
                    EpiGlu E{ACT, HB, cwl, cbl};
                    for (int rep = 0; rep < REP_UP; ++rep) pg8::gemm_phase<EpiGlu, pg8::StaticOrder, PG8_ALIGN, PG8_SP2>(ring, g, S, E);
#endif
                } else {
#if !defined(ONLY) || ONLY==8
                    pg8::Gemm g; bf16_t* O;
                    if (q == 3) { g = pg8::Gemm{XH, (const bf16_t*)((const unsigned char*)Wl + W_OUT_OFF), MTOK, DM, DM}; O = Z; }
                    else { g = pg8::Gemm{ACT, (const bf16_t*)((const unsigned char*)Wl + W_DOWN_OFF), CHUNK, DM, DFF}; O = XH + (size_t)c * CHUNK * DM; }
                    pg8::StaticOrder S; S.init(g.M, g.N, G, bx);
                    pg8::EpiBf16<0> E{O, DM, nullptr, 0, 0, 1.f};
                    for (int rep = 0; rep < REP_PLAIN; ++rep) pg8::gemm_phase<pg8::EpiBf16<0>, pg8::StaticOrder, PG8_ALIGN, PG8_SP2>(ring, g, S, E);
#endif
                }
            }
        }
        if (ph + 1 < p.ph_hi) { for (int rep = 0; rep < REP_SYNC; ++rep) { if (MK_MULTI == 0 && ph != 0) xcd_barrier(xbar); else grid.sync(); } }
    }
}

extern "C" void kernel_launch(void* const* d_in, const int* in_sizes, int n_in, void* d_out, int out_size, void* d_ws, size_t ws_size, hipStream_t stream) {
    static int grid = 0;
    if (grid == 0) {
        if (n_in != 17 || out_size != MTOK * DM || ws_size < WS_END) { fprintf(stderr, "kernel_launch: unexpected shapes: n_in %d out %d ws %zu (need %zu)\n", n_in, out_size, ws_size, (size_t)WS_END); grid = -1; return; }
        int dev = 0, cus = 0, per_cu = 0;
        if (hipGetDevice(&dev) != hipSuccess || hipDeviceGetAttribute(&cus, hipDeviceAttributeMultiprocessorCount, dev) != hipSuccess) { grid = -1; return; }
        if (hipFuncSetAttribute((const void*)mega_fwd, hipFuncAttributeMaxDynamicSharedMemorySize, LDS_BYTES) != hipSuccess) { fprintf(stderr, "kernel_launch: hipFuncSetAttribute failed\n"); grid = -1; return; }
        if (hipOccupancyMaxActiveBlocksPerMultiprocessor(&per_cu, (const void*)mega_fwd, 512, LDS_BYTES) != hipSuccess || per_cu < 1) { fprintf(stderr, "kernel_launch: occupancy query says %d\n", per_cu); per_cu = 1; }
        (void)hipGetLastError();
        grid = cus * 1;
    }
    if (grid < 0) return;
    if (hipMemsetAsync((char*)d_ws + WS_BAR, 0, BAR_BYTES, stream) != hipSuccess) { fprintf(stderr, "kernel_launch: memset failed\n"); return; }
    Params p{};
    for (int i = 0; i < 17; ++i) p.in[i] = (const float*)d_in[i];
    p.out = (float*)d_out; p.ws = (unsigned char*)d_ws;
#if MK_MULTI
    for (int ph = 0; ph < NPHASE; ++ph) { p.ph_lo = ph; p.ph_hi = ph + 1; hipLaunchKernelGGL(mega_fwd, dim3(grid), dim3(512), LDS_BYTES, stream, p); }
#else
    p.ph_lo = 0; p.ph_hi = NPHASE;
    void* args[] = {&p};
    hipError_t e = hipLaunchCooperativeKernel((const void*)mega_fwd, dim3(grid), dim3(512), args, LDS_BYTES, stream);
    if (e != hipSuccess) fprintf(stderr, "cooperative launch failed: %s (grid %d)\n", hipGetErrorString(e), grid);
#endif
}
```

```cpp
#include <hip/hip_runtime.h>
#include <hip/hip_bf16.h>
#include <hip/hip_cooperative_groups.h>
#include <cstdio>
#include <cstdint>
#ifndef MK_MULTI
#define MK_MULTI 0
#endif
__device__ __forceinline__ int ltid() { int t = threadIdx.x; asm volatile("" : "+v"(t)); return t; }
#ifndef REP_UP
#define REP_UP 1
#endif
#ifndef REP_ATTN
#define REP_ATTN 1
#endif
#ifndef REP_PLAIN
#define REP_PLAIN 1
#endif
#ifndef REP_WIN
#define REP_WIN 1
#endif
#ifndef REP_P0
#define REP_P0 1
#endif
#ifndef REP_LIGHT
#define REP_LIGHT 1
#endif
#ifndef REP_SYNC
#define REP_SYNC 1
#endif
#ifndef REP_ROPE
#define REP_ROPE 1
#endif
#ifndef REP_RES
#define REP_RES 1
#endif
#ifndef REP_POOL
#define REP_POOL 1
#endif
#ifndef REP_BAR
#define REP_BAR 0
#endif
namespace pg8 {
#define PG8_LAS __attribute__((address_space(3)))
typedef unsigned short bf16_t;
typedef short bf16x8 __attribute__((ext_vector_type(8)));
typedef float f32x4 __attribute__((ext_vector_type(4)));
typedef unsigned u32x4 __attribute__((ext_vector_type(4)));
constexpr int BM = 256, BK = 64, HALF = 128, HTB = HALF * BK * 2  , STAGE_BYTES = 8 * HTB, NXCD = 8, WGM = 4;

__host__ __device__ __forceinline__ int lds_byte(int r, int c) { const int st = (r >> 4) * 2 + (c >> 5), rr = r & 15, cc = c & 31, ob = rr * 64 + cc * 2; return st * 1024 + (ob ^ (((ob >> 9) & 1) << 5)); }
__host__ __device__ __forceinline__ void stage_rc(int b, int& R, int& C) { const int st = b / 1024, sb = b % 1024, swz = sb ^ (((sb >> 9) & 1) << 5); R = (st >> 1) * 16 + swz / 64; C = (st & 1) * 32 + (swz % 64) / 2; }
__host__ __device__ __forceinline__ int perm32(int rho) { const int n = rho >> 4, i = rho & 15; return 8 * (i >> 2) + 4 * n + (i & 3); }

struct Unit { int pm, pn; };
struct Gemm { const bf16_t* A; const bf16_t* Bt; int M, N, K; };

struct StaticOrder {
    int nM, nN, nwg, G, c;
    __host__ __device__ void init(int M, int N, int G_, int c_) { nM = M / BM; nN = N / BM; nwg = nM * nN; G = G_; c = c_; }
    __host__ __device__ bool next(int i, Unit& u) const {
        const long L = (long)i * G + c; if (L >= nwg) return false;
        int wgid = (int)L; { const int q = nwg / NXCD, r = nwg % NXCD, xcd = wgid % NXCD, off = wgid / NXCD; wgid = (xcd < r ? xcd * (q + 1) : r * (q + 1) + (xcd - r) * q) + off; }
        const int nig = WGM * nN, gid = wgid / nig, fm = gid * WGM, gsz = (nM - fm) < WGM ? (nM - fm) : WGM;
        u.pm = fm + ((wgid % nig) % gsz); u.pn = (wgid % nig) / gsz; return true;
    }
    __device__ __forceinline__ void a_ready(const Unit&) const {}
    __device__ __forceinline__ void done(const Unit&) const {}
};

__device__ __forceinline__ unsigned cvt_pk_bf16(float lo, float hi) { unsigned r; asm volatile("v_cvt_pk_bf16_f32 %0, %1, %2" : "=v"(r) : "v"(lo), "v"(hi)); return r; }
typedef float f32x2 __attribute__((ext_vector_type(2)));
__device__ __forceinline__ f32x2 gelu_pk(f32x2 v) {
    const f32x2 av = __builtin_elementwise_abs(v), d = av * 0.2316418882f + 1.0f;
    f32x2 t; t.x = __builtin_amdgcn_rcpf(d.x); t.y = __builtin_amdgcn_rcpf(d.y);
    f32x2 q = t * 0.5307027145f + (-0.7265760135f); q = q * t + 0.7107068705f; q = q * t + (-0.142248368f); q = q * t + 0.127414796f; q = q * t;
    const f32x2 s = (v * v) * (-0.72134752044f);
    f32x2 e; e.x = __builtin_amdgcn_exp2f(s.x); e.y = __builtin_amdgcn_exp2f(s.y);
    const f32x2 m = v * (q * e), r = v - m;
    f32x2 o; o.x = v.x < 0.f ? m.x : r.x; o.y = v.y < 0.f ? m.y : r.y; return o;
}

template <int ACT  > struct EpiBf16 {
    static constexpr bool PERM = true, AFTER_DRAIN = false; static_assert(ACT == 0 || ACT == 1, "EpiBf16: ACT is 0 (none) or 1 (gelu_pk)");
    bf16_t* O; int ldc; const float* bias; int split_cols; size_t split_stride; float scale0;
    __device__ __forceinline__ void operator()(const f32x4 (&acc)[2][2][4][2], const Unit& u, int wr, int wc, int fr, int fq) const {
        const int row0 = u.pm * BM + wr * 64 + fr; int colt = u.pn * BM; bf16_t* base = O;
        float sc = 1.f; if (split_cols) { const int t = colt / split_cols; base += (size_t)t * split_stride; colt -= t * split_cols; if (t == 0) sc = scale0; }
        const int col0 = colt + wc * 32 + 8 * fq, bcol0 = u.pn * BM + wc * 32 + 8 * fq;
        f32x4 bv[2][2];
#pragma unroll
        for (int bj = 0; bj < 2; ++bj)
#pragma unroll
            for (int n = 0; n < 2; ++n) bv[bj][n] = bias ? *(const f32x4*)(bias + bcol0 + bj * HALF + 4 * n) : (f32x4){0.f, 0.f, 0.f, 0.f};
#pragma unroll
        for (int ai = 0; ai < 2; ++ai)
#pragma unroll
            for (int m = 0; m < 4; ++m) { bf16_t* rowp = base + (size_t)(row0 + ai * HALF + m * 16) * ldc + col0;
#pragma unroll
                for (int bj = 0; bj < 2; ++bj) { f32x4 v0 = acc[ai][bj][m][0] + bv[bj][0], v1 = acc[ai][bj][m][1] + bv[bj][1];
                    if (ACT == 1) { f32x2 a = gelu_pk((f32x2){v0[0], v0[1]}), b = gelu_pk((f32x2){v0[2], v0[3]}), c = gelu_pk((f32x2){v1[0], v1[1]}), d = gelu_pk((f32x2){v1[2], v1[3]});
                        v0 = (f32x4){a.x, a.y, b.x, b.y}; v1 = (f32x4){c.x, c.y, d.x, d.y}; }
                    v0 = v0 * sc; v1 = v1 * sc; u32x4 w; w.x = cvt_pk_bf16(v0[0], v0[1]); w.y = cvt_pk_bf16(v0[2], v0[3]); w.z = cvt_pk_bf16(v1[0], v1[1]); w.w = cvt_pk_bf16(v1[2], v1[3]);
                    *(u32x4*)(rowp + bj * HALF) = w; } }
    }
};
template <class Epi, class Sched, bool ALIGN_EPI = false, bool SP2 = false>
__device__ __forceinline__ void gemm_phase(PG8_LAS unsigned char* lds, const Gemm g, const Sched& S, const Epi& E) {
    const int tid = ltid(), wid = __builtin_amdgcn_readfirstlane(tid >> 6), lane = tid & 63, wr = wid >> 2, wc = wid & 3, fr = lane & 15, fq = lane >> 4;
    const int K = g.K, nt = K / BK;
    unsigned voffA[2], voffB[2];
#pragma unroll
    for (int i = 0; i < 2; ++i) { int R, C; stage_rc(tid * 16 + i * 8192, R, C); const int Rb = Epi::PERM ? ((R & ~31) + perm32(R & 31)) : R;
        voffA[i] = (unsigned)(R * K + C) * 2u; voffB[i] = (unsigned)(Rb * K + C) * 2u; }
    const size_t kstep = (size_t)(BK * 2);
    const size_t hstep = (size_t)HALF * K * 2;
    const size_t tstep = 2 * hstep;
    const unsigned ldsw = (unsigned)wid * 1024u;
    const int aoff = lds_byte(wr * 64 + fr, fq * 8), boff = lds_byte(wc * 32 + fr, fq * 8);
#define PG8_SA(b, h) (((b) * 2 + (h)) * HTB)
#define PG8_SB(b, h) ((4 + (b) * 2 + (h)) * HTB)
#define PG8_STAGE(bufoff, gbase, voff) do { _Pragma("unroll") for (int _i = 0; _i < 2; ++_i) \
        __builtin_amdgcn_global_load_lds((const unsigned*)((const char*)(gbase) + (voff)[_i]), (PG8_LAS unsigned*)(lds + (bufoff) + ldsw + _i * 8192), 16, 0, 0); } while (0)
#define PG8_LDA(dst, b, h) do { _Pragma("unroll") for (int m = 0; m < 4; ++m) _Pragma("unroll") for (int k = 0; k < 2; ++k) dst[m][k] = *(const PG8_LAS bf16x8*)(lds + PG8_SA(b, h) + aoff + m * 2048 + k * 1024); } while (0)
#define PG8_LDB(dst, b, h) do { _Pragma("unroll") for (int n = 0; n < 2; ++n) _Pragma("unroll") for (int k = 0; k < 2; ++k) dst[n][k] = *(const PG8_LAS bf16x8*)(lds + PG8_SB(b, h) + boff + n * 2048 + k * 1024); } while (0)
#define PG8_MMA(ai, bj, At, Bt) do { __builtin_amdgcn_s_setprio(1); _Pragma("unroll") for (int m = 0; m < 4; ++m) _Pragma("unroll") for (int n = 0; n < 2; ++n) _Pragma("unroll") for (int k = 0; k < 2; ++k) \
        acc[ai][bj][m][n] = __builtin_amdgcn_mfma_f32_16x16x32_bf16(Bt[n][k], At[m][k], acc[ai][bj][m][n], 0, 0, 0); __builtin_amdgcn_s_setprio(0); } while (0)
#define PG8_WAIT_V(n) asm volatile("s_waitcnt vmcnt(" #n ")" ::: "memory")
#define PG8_WAIT_L(n) asm volatile("s_waitcnt lgkmcnt(" #n ")" ::: "memory")
#define PG8_BAR __builtin_amdgcn_s_barrier()
#define PG8_SCHED __builtin_amdgcn_sched_barrier(0)
    Unit cur, nxt; int ui = 0;
    if (!S.next(0, cur)) return;
    f32x4 acc[2][2][4][2];
#pragma unroll
    for (int a = 0; a < 2; ++a)
#pragma unroll
        for (int b = 0; b < 2; ++b)
#pragma unroll
            for (int m = 0; m < 4; ++m)
#pragma unroll
                for (int n = 0; n < 2; ++n) acc[a][b][m][n] = (f32x4){0.f, 0.f, 0.f, 0.f};
    bf16x8 At[4][2], B0[2][2], B1[2][2];
    const char* cA = (const char*)g.A + (size_t)cur.pm * tstep; const char* cB = (const char*)g.Bt + (size_t)cur.pn * tstep;
    S.a_ready(cur);
    if constexpr (SP2) {
        PG8_STAGE(PG8_SB(0, 0), cB, voffB); PG8_STAGE(PG8_SB(0, 1), cB + hstep, voffB); PG8_STAGE(PG8_SA(0, 0), cA, voffA); PG8_STAGE(PG8_SA(0, 1), cA + hstep, voffA);
        if (wr == 1) PG8_BAR;
        PG8_WAIT_V(2); PG8_BAR;
        PG8_STAGE(PG8_SB(1, 0), cB + kstep, voffB); PG8_STAGE(PG8_SA(1, 0), cA + kstep, voffA); PG8_STAGE(PG8_SB(1, 1), cB + hstep + kstep, voffB);
        PG8_WAIT_V(6); PG8_BAR;
    } else {
        PG8_STAGE(PG8_SB(0, 0), cB, voffB); PG8_STAGE(PG8_SA(0, 0), cA, voffA); PG8_STAGE(PG8_SB(0, 1), cB + hstep, voffB); PG8_STAGE(PG8_SA(0, 1), cA + hstep, voffA);
        if (wr == 1) PG8_BAR;
        PG8_WAIT_V(4); PG8_BAR;
        PG8_STAGE(PG8_SB(1, 0), cB + kstep, voffB); PG8_STAGE(PG8_SA(1, 0), cA + kstep, voffA); PG8_STAGE(PG8_SB(1, 1), cB + hstep + kstep, voffB);
        PG8_WAIT_V(6); PG8_BAR;
    }
    for (;;) {
        const bool has_next = S.next(ui + 1, nxt);
        const char* nA = has_next ? (const char*)g.A + (size_t)nxt.pm * tstep : cA; const char* nB = has_next ? (const char*)g.Bt + (size_t)nxt.pn * tstep : cB;
        for (int t = 0; t < nt; t += 2) {
            const bool last = (t == nt - 2);
            const char* a1 = cA + (size_t)(t + 1) * kstep;
            const char* a2 = last ? nA : cA + (size_t)(t + 2) * kstep; const char* b2 = last ? nB : cB + (size_t)(t + 2) * kstep;
            const char* a3 = a2 + kstep; const char* b3 = b2 + kstep;
            if (last && has_next) S.a_ready(nxt);
            if constexpr (SP2) {
            PG8_LDB(B0, 0, 0); PG8_LDB(B1, 0, 1); PG8_SCHED; PG8_LDA(At, 0, 0); PG8_STAGE(PG8_SA(1, 1), a1 + hstep, voffA);
            PG8_WAIT_V(8); PG8_WAIT_L(0); PG8_BAR; PG8_MMA(0, 0, At, B0); PG8_MMA(0, 1, At, B1); PG8_BAR; PG8_SCHED;
            PG8_LDA(At, 0, 1); PG8_STAGE(PG8_SB(0, 0), b2, voffB); PG8_STAGE(PG8_SB(0, 1), b2 + hstep, voffB); PG8_STAGE(PG8_SA(0, 0), a2, voffA);
            PG8_WAIT_V(8); PG8_WAIT_L(0); PG8_BAR; PG8_MMA(1, 0, At, B0); PG8_MMA(1, 1, At, B1); PG8_BAR; PG8_SCHED;
            PG8_LDB(B0, 1, 0); PG8_LDB(B1, 1, 1); PG8_SCHED; PG8_LDA(At, 1, 0); PG8_STAGE(PG8_SA(0, 1), a2 + hstep, voffA);
            PG8_WAIT_V(8); PG8_WAIT_L(0); PG8_BAR; PG8_MMA(0, 0, At, B0); PG8_MMA(0, 1, At, B1); PG8_BAR; PG8_SCHED;
            PG8_LDA(At, 1, 1); PG8_STAGE(PG8_SB(1, 0), b3, voffB); PG8_STAGE(PG8_SB(1, 1), b3 + hstep, voffB); PG8_STAGE(PG8_SA(1, 0), a3, voffA);
            PG8_WAIT_V(8); PG8_WAIT_L(0); PG8_BAR; PG8_MMA(1, 0, At, B0); PG8_MMA(1, 1, At, B1); PG8_BAR; PG8_SCHED;
            } else {
            PG8_LDB(B0, 0, 0); PG8_SCHED; PG8_LDA(At, 0, 0); PG8_STAGE(PG8_SA(1, 1), a1 + hstep, voffA);
            PG8_WAIT_L(8); PG8_BAR; PG8_WAIT_L(0); PG8_MMA(0, 0, At, B0); PG8_BAR; PG8_SCHED;
            PG8_LDB(B1, 0, 1); PG8_STAGE(PG8_SB(0, 0), b2, voffB);
            PG8_BAR; PG8_WAIT_L(0); PG8_MMA(0, 1, At, B1); PG8_BAR;
            PG8_LDA(At, 0, 1); PG8_STAGE(PG8_SA(0, 0), a2, voffA);
            PG8_BAR; PG8_WAIT_L(0); PG8_MMA(1, 0, At, B0); PG8_BAR; PG8_SCHED;
            PG8_STAGE(PG8_SB(0, 1), b2 + hstep, voffB);
            PG8_WAIT_V(6); PG8_BAR; PG8_MMA(1, 1, At, B1); PG8_BAR;
            PG8_LDB(B0, 1, 0); PG8_SCHED; PG8_LDA(At, 1, 0); PG8_STAGE(PG8_SA(0, 1), a2 + hstep, voffA);
            PG8_WAIT_L(8); PG8_BAR; PG8_WAIT_L(0); PG8_MMA(0, 0, At, B0); PG8_BAR; PG8_SCHED;
            PG8_LDB(B1, 1, 1); PG8_STAGE(PG8_SB(1, 0), b3, voffB);
            PG8_BAR; PG8_WAIT_L(0); PG8_MMA(0, 1, At, B1); PG8_BAR;
            PG8_LDA(At, 1, 1); PG8_STAGE(PG8_SA(1, 0), a3, voffA);
            PG8_BAR; PG8_WAIT_L(0); PG8_MMA(1, 0, At, B0); PG8_BAR; PG8_SCHED;
            PG8_STAGE(PG8_SB(1, 1), b3 + hstep, voffB);
            PG8_WAIT_V(6); PG8_BAR; PG8_MMA(1, 1, At, B1); PG8_BAR;
            }
        }
        if constexpr (ALIGN_EPI) { if (wr == 0) PG8_BAR; }
        if constexpr (!Epi::AFTER_DRAIN) { E(acc, cur, wr, wc, fr, fq); S.done(cur); }
        if (!has_next) break;
#pragma unroll
        for (int a = 0; a < 2; ++a)
#pragma unroll
            for (int b = 0; b < 2; ++b)
#pragma unroll
                for (int m = 0; m < 4; ++m)
#pragma unroll
                    for (int n = 0; n < 2; ++n) acc[a][b][m][n] = (f32x4){0.f, 0.f, 0.f, 0.f};
        cur = nxt; cA = nA; cB = nB; ++ui;
        if constexpr (ALIGN_EPI) { if (wr == 1) PG8_BAR; }
    }
    PG8_WAIT_V(0);
    if constexpr (!ALIGN_EPI) { if (wr == 0) PG8_BAR; }
    PG8_BAR;
    if constexpr (Epi::AFTER_DRAIN) { E.fused(acc, cur, wr, wc, fr, fq, lds, wid, lane); S.done(cur); }
#undef PG8_SA
#undef PG8_SB
#undef PG8_STAGE
#undef PG8_LDA
#undef PG8_LDB
#undef PG8_MMA
#undef PG8_WAIT_V
#undef PG8_WAIT_L
#undef PG8_BAR
#undef PG8_SCHED
}
}
#define PG8_SP2 true
#define PG8_ALIGN true
namespace att {
using bf16 = __hip_bfloat16;
constexpr int   D = 128, NW = 8, QBLK = 32, KVBLK = 64;
constexpr float SCALE = 0.088388347648318440f;
constexpr float THR = 8.f;
constexpr int SDEPTH = 2;
constexpr bool STATIC_MAX = true;
constexpr int LDQ = 2048, LDK = 2048, LDO = 2048;
constexpr size_t SHM_V = KVBLK * D * 2, SHM_K = KVBLK * D * 2, SHM_ATTN = 2 * SHM_V + 2 * SHM_K + NW * 64 * 4;
using bf16x8 = __attribute__((ext_vector_type(8))) short;
using s16x4  = __attribute__((ext_vector_type(4))) short;
using f32x16 = __attribute__((ext_vector_type(16))) float;
using f32x8  = __attribute__((ext_vector_type(8))) float;
using u32x4  = __attribute__((ext_vector_type(4))) unsigned;
#define KSWZ(row, colB) ((row) * 256 + ((colB) ^ (((row) & 7) << 4)))
#define SBAR() __builtin_amdgcn_sched_barrier(0)
__device__ __forceinline__ int crow(int r, int hi) { return (r & 3) + 8 * (r >> 2) + 4 * hi; }
__device__ __forceinline__ unsigned cvtpk(float lo, float hi) {
  unsigned r; asm volatile("v_cvt_pk_bf16_f32 %0, %1, %2" : "=v"(r) : "v"(lo), "v"(hi)); return r;
}
template <typename TIn> struct Stage;
template <> struct Stage<bf16>  { using T = bf16x8;
  __device__ static __forceinline__ T ld8(const bf16* p) { return *reinterpret_cast<const bf16x8*>(p); }
  __device__ static __forceinline__ bf16x8 tobf(T x) { return x; } };
template <> struct Stage<float> { using T = f32x8;
  __device__ static __forceinline__ T ld8(const float* p) { return *reinterpret_cast<const f32x8*>(p); }
  __device__ static __forceinline__ bf16x8 tobf(T x) {
    u32x4 w = {cvtpk(x[0], x[1]), cvtpk(x[2], x[3]), cvtpk(x[4], x[5]), cvtpk(x[6], x[7])}; return *reinterpret_cast<bf16x8*>(&w); } };

template <bool SHIFT> __device__ __forceinline__ void partialSM(f32x16& p0, f32x16& p1, float& m_reg, float& mn, float& alpha) {
  constexpr float C = SCALE * 1.4426950408889634f;
  if constexpr (STATIC_MAX) { mn = m_reg; alpha = 1.f; }
  else {
  float pmax = p0[0]; for (int r = 1; r < 16; ++r) pmax = fmaxf(pmax, p0[r]); for (int r = 0; r < 16; ++r) pmax = fmaxf(pmax, p1[r]);
  { auto rr = __builtin_amdgcn_permlane32_swap(__float_as_uint(pmax), __float_as_uint(pmax), false, false);
    pmax = fmaxf(__uint_as_float(rr[0]), __uint_as_float(rr[1])); }
  if (__builtin_expect(__all(pmax - m_reg <= THR / SCALE), 1)) { mn = m_reg; alpha = 1.f; }
  else { mn = fmaxf(m_reg, pmax); alpha = __builtin_amdgcn_exp2f((m_reg - mn) * C); m_reg = mn; }
  }
  if constexpr (!STATIC_MAX) { float mnC = -mn * C;
  for (int r = 0; r < 16; ++r) p0[r] = fmaf(p0[r], C, mnC); for (int r = 0; r < 16; ++r) p1[r] = fmaf(p1[r], C, mnC); }
  if constexpr (STATIC_MAX && SHIFT) { for (int r = 0; r < 16; ++r) p0[r] += m_reg; for (int r = 0; r < 16; ++r) p1[r] += m_reg; }
  for (int r = 0; r < 16; ++r) p0[r] = __builtin_amdgcn_exp2f(p0[r]);
}
__device__ __forceinline__ void finishSM(f32x16& p0, f32x16& p1, float alpha, float& l_reg, bf16x8& pa0, bf16x8& pa1, bf16x8& pa2, bf16x8& pa3) {
  for (int r = 0; r < 16; ++r) p1[r] = __builtin_amdgcn_exp2f(p1[r]);
  float ps = 0; for (int r = 0; r < 16; ++r) ps += p0[r]; for (int r = 0; r < 16; ++r) ps += p1[r];
  { auto rr = __builtin_amdgcn_permlane32_swap(__float_as_uint(ps), __float_as_uint(ps), false, false);
    ps = __uint_as_float(rr[0]) + __uint_as_float(rr[1]); }
  l_reg = l_reg * alpha + ps;
#define PK4(P, BASE, OUT) do { unsigned a0 = cvtpk(P[BASE + 0], P[BASE + 1]), a1 = cvtpk(P[BASE + 2], P[BASE + 3]);   \
    unsigned b0 = cvtpk(P[BASE + 4], P[BASE + 5]), b1 = cvtpk(P[BASE + 6], P[BASE + 7]);                              \
    auto r0 = __builtin_amdgcn_permlane32_swap(a0, b0, false, false); auto r1 = __builtin_amdgcn_permlane32_swap(a1, b1, false, false); \
    u32x4 w = {r0[0], r1[0], r0[1], r1[1]}; OUT = *reinterpret_cast<bf16x8*>(&w); } while (0)
  PK4(p0, 0, pa0); PK4(p0, 8, pa1); PK4(p1, 0, pa2); PK4(p1, 8, pa3);
#undef PK4
}
__device__ __forceinline__ void qkt(f32x16& p0, f32x16& p1, const bf16* Ks, const bf16x8* qr, int r32, int hi) {
#pragma unroll
  for (int d0 = 0; d0 < 8; ++d0) { int cb = (d0 * 16 + hi * 8) * 2;
    bf16x8 b0 = *reinterpret_cast<const bf16x8*>((const char*)Ks + KSWZ(r32, cb));
    bf16x8 b1 = *reinterpret_cast<const bf16x8*>((const char*)Ks + KSWZ(32 + r32, cb));
    p0 = __builtin_amdgcn_mfma_f32_32x32x16_bf16(b0, qr[d0], d0 == 0 ? f32x16{} : p0, 0, 0, 0);
    p1 = __builtin_amdgcn_mfma_f32_32x32x16_bf16(b1, qr[d0], d0 == 0 ? f32x16{} : p1, 0, 0, 0); }
}
__device__ __forceinline__ int v_st(int k, int c) { const int kk = (k & ~0xC) | ((k & 4) << 1) | ((k & 8) >> 1); return ((kk >> 3) * 4 + (c >> 5)) * 512 + ((kk & 7) * 32 + (c & 31)) * 2; }
__device__ __forceinline__ int v_rd_base(int lane) { return ((lane & 3) << 3) | (((lane >> 2) & 3) << 6) | (((lane >> 4) & 1) << 5) | (((lane >> 5) & 1) << 8); }
constexpr int v_rd_off(int d0, int ks, int half) { return d0 * 512 + ks * 4096 + half * 2048; }
template <int OFF> __device__ __forceinline__ s16x4 tr_read(int vb) {
  s16x4 r; asm volatile("ds_read_b64_tr_b16 %0, %1 offset:%2" : "=&v"(r) : "v"(vb), "i"(OFF) : "memory"); return r;
}
template <int D0> __device__ __forceinline__ void pv_one(f32x16& od, int vb, bf16x8 pa0, bf16x8 pa1, bf16x8 pa2, bf16x8 pa3) {
  const s16x4 l0 = tr_read<v_rd_off(D0, 0, 0)>(vb), h0 = tr_read<v_rd_off(D0, 0, 1)>(vb), l1 = tr_read<v_rd_off(D0, 1, 0)>(vb), h1 = tr_read<v_rd_off(D0, 1, 1)>(vb);
  const s16x4 l2 = tr_read<v_rd_off(D0, 2, 0)>(vb), h2 = tr_read<v_rd_off(D0, 2, 1)>(vb), l3 = tr_read<v_rd_off(D0, 3, 0)>(vb), h3 = tr_read<v_rd_off(D0, 3, 1)>(vb);
  asm volatile("s_waitcnt lgkmcnt(0)" ::: "memory"); SBAR();
#define PK(L, H) (bf16x8){L[0], L[1], L[2], L[3], H[0], H[1], H[2], H[3]}
  od = __builtin_amdgcn_mfma_f32_32x32x16_bf16(pa0, PK(l0, h0), od, 0, 0, 0);
  od = __builtin_amdgcn_mfma_f32_32x32x16_bf16(pa1, PK(l1, h1), od, 0, 0, 0);
  od = __builtin_amdgcn_mfma_f32_32x32x16_bf16(pa2, PK(l2, h2), od, 0, 0, 0);
  od = __builtin_amdgcn_mfma_f32_32x32x16_bf16(pa3, PK(l3, h3), od, 0, 0, 0);
#undef PK
}
__device__ __forceinline__ void pv_d0(f32x16* o, int vb, bf16x8 pa0, bf16x8 pa1, bf16x8 pa2, bf16x8 pa3) {
  pv_one<0>(o[0], vb, pa0, pa1, pa2, pa3); pv_one<1>(o[1], vb, pa0, pa1, pa2, pa3); pv_one<2>(o[2], vb, pa0, pa1, pa2, pa3); pv_one<3>(o[3], vb, pa0, pa1, pa2, pa3);
}
template <typename TQ, bool SHIFT>
__device__ __forceinline__ void attn_dense_body(const TQ* __restrict__ Qb, const bf16* __restrict__ Kh, const bf16* __restrict__ Vh,
                                                bf16* __restrict__ Ob, int seq, char* lds, float bound) {
  using St = Stage<bf16>; using SQ = Stage<TQ>;
  const int tid = ltid(), wid = tid >> 6, lane = tid & 63, r32 = lane & 31, hi = lane >> 5;
  bf16* V_lds = (bf16*)lds; bf16* K_lds = (bf16*)(lds + 2 * SHM_V);
  float* ws = (float*)(lds + 2 * SHM_V + 2 * SHM_K) + wid * 64; float* li_l = ws; float* al_l = ws + 32;
  float m_reg = STATIC_MAX ? -bound * (SCALE * 1.4426950408889634f) : -1e30f, l_reg = 0; f32x16 o[4] = {}; bf16x8 qr[8];
  const TQ* Qw = Qb + (long)(wid * QBLK + r32) * LDQ + hi * 8;
#pragma unroll
  for (int d0 = 0; d0 < 8; ++d0) qr[d0] = SQ::tobf(SQ::ld8(Qw + d0 * 16));
  const int sr = tid >> 4, sc = (tid & 15) * 8, vst0 = v_st(sr, sc), vst1 = v_st(32 + sr, sc);
  const int vb0 = (int)(uintptr_t)V_lds + v_rd_base(lane);
  struct { typename St::T vs0, vs1, ks0, ks1; } sr_[SDEPTH];
#define SLOAD(i, k0) do { sr_[i].vs0 = St::ld8(&Vh[(long)((k0) + sr) * LDK + sc]); sr_[i].vs1 = St::ld8(&Vh[(long)((k0) + 32 + sr) * LDK + sc]); \
    sr_[i].ks0 = St::ld8(&Kh[(long)((k0) + sr) * LDK + sc]); sr_[i].ks1 = St::ld8(&Kh[(long)((k0) + 32 + sr) * LDK + sc]); } while (0)
#define SWRITE(b, i) do { *(bf16x8*)((char*)V_lds + (b) * SHM_V + vst0) = St::tobf(sr_[i].vs0);          \
    *(bf16x8*)((char*)V_lds + (b) * SHM_V + vst1) = St::tobf(sr_[i].vs1); int kc = sc * 2;               \
    *(bf16x8*)((char*)K_lds + (b) * SHM_K + KSWZ(sr, kc)) = St::tobf(sr_[i].ks0);                       \
    *(bf16x8*)((char*)K_lds + (b) * SHM_K + KSWZ(32 + sr, kc)) = St::tobf(sr_[i].ks1); } while (0)
#define SWAIT() do { if constexpr (SDEPTH == 2) asm volatile("s_waitcnt vmcnt(4)" ::: "memory"); else asm volatile("s_waitcnt vmcnt(0)" ::: "memory"); } while (0)
#define RESC(a) do { if (!STATIC_MAX && __any((a) < 1.f)) { if (hi == 0) al_l[r32] = (a); asm volatile("s_waitcnt lgkmcnt(0)" ::: "memory"); \
    for (int d = 0; d < 4; ++d) for (int r = 0; r < 16; ++r) o[d][r] *= al_l[crow(r, hi)]; } } while (0)
  f32x16 pA0, pA1, pB0, pB1; float mnA, mnB, alA, alB; bf16x8 pa0, pa1, pa2, pa3; const int NT = seq / KVBLK;
  constexpr int SE = 0, SO = SDEPTH - 1;
  SLOAD(SE, 0); asm volatile("s_waitcnt vmcnt(0)" ::: "memory"); SWRITE(0, SE); __syncthreads();
  qkt(pA0, pA1, K_lds, qr, r32, hi); partialSM<SHIFT>(pA0, pA1, m_reg, mnA, alA);
  SLOAD(SO, KVBLK); if constexpr (SDEPTH == 2) { if (2 < NT) SLOAD(SE, 2 * KVBLK); }
  SWAIT(); SWRITE(1, SO); __syncthreads();
  for (int j = 1; j + 1 < NT; j += 2) {
    SBAR(); qkt(pB0, pB1, (bf16*)((char*)K_lds + SHM_K), qr, r32, hi);
    finishSM(pA0, pA1, alA, l_reg, pa0, pa1, pa2, pa3); SBAR();
    SLOAD(SO, (j + SDEPTH) * KVBLK); SBAR();
    pv_d0(o, vb0, pa0, pa1, pa2, pa3); partialSM<SHIFT>(pB0, pB1, m_reg, mnB, alB);
    __syncthreads(); SWAIT(); SWRITE(0, SE);
    RESC(alB); __syncthreads();
    SBAR(); qkt(pA0, pA1, K_lds, qr, r32, hi);
    finishSM(pB0, pB1, alB, l_reg, pa0, pa1, pa2, pa3); SBAR();
    if (SDEPTH == 1 || j + 3 < NT) SLOAD(SE, (j + 1 + SDEPTH) * KVBLK); SBAR();
    pv_d0(o, vb0 + (int)SHM_V, pa0, pa1, pa2, pa3); partialSM<SHIFT>(pA0, pA1, m_reg, mnA, alA);
    __syncthreads(); SWAIT(); SWRITE(1, SO);
    RESC(alA); __syncthreads();
  }
  SBAR(); qkt(pB0, pB1, (bf16*)((char*)K_lds + SHM_K), qr, r32, hi);
  finishSM(pA0, pA1, alA, l_reg, pa0, pa1, pa2, pa3); SBAR();
  pv_d0(o, vb0, pa0, pa1, pa2, pa3); partialSM<SHIFT>(pB0, pB1, m_reg, mnB, alB);
  __syncthreads(); RESC(alB);
  finishSM(pB0, pB1, alB, l_reg, pa0, pa1, pa2, pa3); SBAR();
  pv_d0(o, vb0 + (int)SHM_V, pa0, pa1, pa2, pa3);
  if (hi == 0) li_l[r32] = l_reg; asm volatile("s_waitcnt lgkmcnt(0)" ::: "memory");
  float rli[16];
#pragma unroll
  for (int r = 0; r < 16; ++r) rli[r] = __builtin_amdgcn_rcpf(li_l[crow(r, hi)]);
  bf16* Ow = Ob + (long)(wid * QBLK) * LDO;
#pragma unroll
  for (int r = 0; r < 16; ++r) { int orow = crow(r, hi);
    for (int d0 = 0; d0 < 4; ++d0) Ow[(long)orow * LDO + d0 * 32 + r32] = __float2bfloat16(o[d0][r] * rli[r]); }
#undef SLOAD
#undef SWRITE
#undef SWAIT
#undef RESC
}

template <int NC> __device__ __forceinline__ void pv_n(f32x16* o, int vb, bf16x8 pa0, bf16x8 pa1, bf16x8 pa2, bf16x8 pa3) {
  pv_one<0>(o[0], vb, pa0, pa1, pa2, pa3);
  if constexpr (NC > 1) pv_one<1>(o[1], vb, pa0, pa1, pa2, pa3);
  if constexpr (NC > 2) { pv_one<2>(o[2], vb, pa0, pa1, pa2, pa3); pv_one<3>(o[3], vb, pa0, pa1, pa2, pa3); }
}
template <int MB, int NKT, class BR, class ST>
__device__ __forceinline__ void dft_unit(const bf16* __restrict__ A, int lda, const BR& br, const ST& st, char* lds) {
  constexpr int NBW = 8 / MB, NC = 4 / NBW;
  const int tid = ltid(), wid = tid >> 6, lane = tid & 63, r32 = lane & 31, hi = lane >> 5;
  const int mb = wid % MB, cgp = wid / MB;
  const int sr = tid >> 4, sc = (tid & 15) * 8, vst0 = v_st(sr, sc), vst1 = v_st(32 + sr, sc);
  bf16x8 bq[NKT][2], af[NKT][4];
#pragma unroll
  for (int kt = 0; kt < NKT; ++kt) {
    bq[kt][0] = *reinterpret_cast<const bf16x8*>(br.row(kt * 64 + sr) + sc);
    bq[kt][1] = *reinterpret_cast<const bf16x8*>(br.row(kt * 64 + 32 + sr) + sc);
  }
  const bf16* Aw = A + (long)(mb * 32 + r32) * lda + hi * 8;
#pragma unroll
  for (int kt = 0; kt < NKT; ++kt)
#pragma unroll
    for (int ks = 0; ks < 4; ++ks) af[kt][ks] = *reinterpret_cast<const bf16x8*>(Aw + kt * 64 + ks * 16);
  __syncthreads();
#pragma unroll
  for (int kt = 0; kt < NKT; ++kt) {
    *(bf16x8*)(lds + kt * 16384 + vst0) = bq[kt][0];
    *(bf16x8*)(lds + kt * 16384 + vst1) = bq[kt][1];
  }
  __syncthreads();
  f32x16 o[NC];
#pragma unroll
  for (int d = 0; d < NC; ++d) o[d] = f32x16{};
  const int vb = (int)(uintptr_t)lds + v_rd_base(lane) + cgp * NC * 512;
#pragma unroll
  for (int kt = 0; kt < NKT; ++kt) pv_n<NC>(o, vb + kt * 16384, af[kt][0], af[kt][1], af[kt][2], af[kt][3]);
  bf16* stg = (bf16*)(lds + 65536) + wid * 4096;
  const float sc_ = st.scale;
#pragma unroll
  for (int r = 0; r < 16; ++r) {
#pragma unroll
    for (int d = 0; d < NC; ++d) stg[crow(r, hi) * (NC * 32) + d * 32 + r32] = __float2bfloat16(o[d][r] * sc_);
  }
  asm volatile("s_waitcnt lgkmcnt(0)" ::: "memory");
#pragma unroll
  for (int i = 0; i < NC * 2; ++i) { const int idx = i * 64 + lane, row = idx / (NC * 4), cc = idx % (NC * 4);
    const u32x4 v = *(const u32x4*)(stg + row * (NC * 32) + cc * 8);
    st.store16(mb * 32 + row, cgp * NC * 32 + cc * 8, v); }
  asm volatile("s_waitcnt lgkmcnt(0)" ::: "memory");
}
#undef SBAR
#undef KSWZ
}

namespace cg = cooperative_groups;
#define LAS __attribute__((address_space(3)))
typedef unsigned short bf16_t;
typedef unsigned v4u __attribute__((ext_vector_type(4)));
typedef unsigned v2u __attribute__((ext_vector_type(2)));
typedef float f4 __attribute__((ext_vector_type(4)));

#define XB_TMO      128
#define XB_XCNT(j)  (256  + 64 * (j))
#define XB_XSUB(j)  (1280 + 64 * (j))
#define XB_XGEN(j)  (2304 + 64 * (j))
#define XB_TOP      3328
#define XB_TOPGEN   3392
#define XCD_BAR_WORDS 3456
#define XB_SPIN_CAP (1u << 18)

__device__ __forceinline__ unsigned xb_ld(unsigned* p)              { return __hip_atomic_load(p, __ATOMIC_RELAXED, __HIP_MEMORY_SCOPE_AGENT); }
__device__ __forceinline__ unsigned xb_add(unsigned* p, unsigned v) { return __hip_atomic_fetch_add(p, v, __ATOMIC_RELAXED, __HIP_MEMORY_SCOPE_AGENT); }
__device__ __forceinline__ unsigned xb_xcc_id() { return (unsigned)__builtin_amdgcn_s_getreg((3 << 11) | 20) & 0xFu; }
#define XB_SPIN(cond, bar) do { unsigned _sp = 0; while (cond) { __builtin_amdgcn_s_sleep(1); \
    if ((++_sp & 255u) == 0u) { if (xb_ld(&(bar)[XB_TMO])) break; if (_sp > XB_SPIN_CAP) { atomicAdd(&(bar)[XB_TMO], 1u); break; } } } } while (0)

struct XcdBarrier {
    unsigned* bar; unsigned x;
    volatile LAS unsigned* st;
};

__device__ __forceinline__ XcdBarrier xcd_barrier_post(unsigned* bar, volatile LAS unsigned* st) {
    XcdBarrier b; b.bar = bar; b.x = xb_xcc_id(); b.st = st;
    if (threadIdx.x == 0) (void)xb_add(&bar[XB_XCNT(b.x)], 1u);
    return b;
}
__device__ __forceinline__ void xcd_barrier_complete(unsigned* bar, unsigned x, unsigned& nloc, unsigned& nx) {
    const unsigned G = gridDim.x * gridDim.y * gridDim.z;
    unsigned sum, cnt, mine, sp = 0u;
    for (;;) {
        sum = 0u; cnt = 0u; mine = 0u;
#pragma unroll
        for (unsigned j = 0; j < 16; ++j) { const unsigned c = xb_ld(&bar[XB_XCNT(j)]); sum += c; cnt += (c > 0u) ? 1u : 0u; mine = (j == x) ? c : mine; }
        if (sum == G) break;
        __builtin_amdgcn_s_sleep(1);
        if ((++sp & 255u) == 0u) { if (xb_ld(&bar[XB_TMO])) break; if (sp > XB_SPIN_CAP) { atomicAdd(&bar[XB_TMO], 1u); break; } }
    }
    nloc = mine > 0u ? mine : 1u; nx = cnt > 0u ? cnt : 1u;
}

__device__ __forceinline__ void xcd_barrier(const XcdBarrier& b) {
    asm volatile("s_waitcnt vmcnt(0)" ::: "memory");
    __syncthreads();
    if (threadIdx.x == 0) {
        unsigned* bar = b.bar;
        __builtin_amdgcn_s_waitcnt(0);
        unsigned nloc = b.st[0], nx = b.st[1];
        if (nloc == 0u) { xcd_barrier_complete(bar, b.x, nloc, nx); b.st[0] = nloc; b.st[1] = nx; }
        const unsigned old = xb_add(&bar[XB_XSUB(b.x)], 1u);
        const unsigned gen = old / nloc;
        if (old + 1u == (gen + 1u) * nloc) {
            __builtin_amdgcn_fence(__ATOMIC_RELEASE, "agent");
            asm volatile("s_waitcnt vmcnt(0)" ::: "memory");
            const unsigned og = xb_add(&bar[XB_TOP], 1u);
            const unsigned tg = og / nx;
            if (og + 1u == (tg + 1u) * nx) xb_add(&bar[XB_TOPGEN], 1u);
            else XB_SPIN(xb_ld(&bar[XB_TOPGEN]) == tg, bar);
            __builtin_amdgcn_fence(__ATOMIC_ACQUIRE, "agent");
            xb_add(&bar[XB_XGEN(b.x)], 1u);
            asm volatile("s_waitcnt vmcnt(0)" ::: "memory");
        } else {
            XB_SPIN(xb_ld(&bar[XB_XGEN(b.x)]) == gen, bar);
            __builtin_amdgcn_fence(__ATOMIC_ACQUIRE, "agent");
            asm volatile("s_waitcnt vmcnt(0)" ::: "memory");
        }
    }
    __syncthreads();
}

constexpr int DM = 2048, MTOK = 65536, NIN = 3072, DFF = 5632, NUP = 11264, WINW = 2560;
constexpr int NPROMPT = 32768;
constexpr int CHUNK = 65536, NCHUNK = 1;
constexpr float EPS = 1e-6f;
constexpr size_t MiB = (size_t)1 << 20;
constexpr size_t WS_M2F = 0;
constexpr size_t WS_COS = 1 * MiB, WS_SIN = 5 * MiB;
constexpr size_t WS_A1P = 9 * MiB, WS_A1S = 9 * MiB + 128 * 1024;
constexpr size_t WS_A3P = 10 * MiB, WS_A3S = 18 * MiB;
constexpr size_t WS_BAR = 19 * MiB, BAR_BYTES = 16384;
constexpr size_t WS_W = 20 * MiB;
constexpr size_t W_LAYER = 86 * MiB, W_OUT_OFF = 12 * MiB, W_UP_OFF = 20 * MiB, W_DOWN_OFF = 64 * MiB;
constexpr size_t WS_XH = 192 * MiB;
constexpr size_t WS_Z = 448 * MiB;
constexpr size_t WS_G = 704 * MiB;
constexpr size_t WS_Y = 832 * MiB;
constexpr size_t WS_ACT = 448 * MiB;
constexpr size_t WS_HB = 1152 * MiB;
constexpr size_t WS_XB = 1240 * MiB;
constexpr size_t WS_END = 1496 * MiB;
constexpr int LDS_BYTES = 135168;

__device__ __forceinline__ float bf2f(unsigned short b) { return __uint_as_float((unsigned)b << 16); }
__device__ __forceinline__ float bflo(unsigned w) { return __uint_as_float(w << 16); }
__device__ __forceinline__ float bfhi(unsigned w) { return __uint_as_float(w & 0xffff0000u); }
__device__ __forceinline__ unsigned pk2(float lo, float hi) { return pg8::cvt_pk_bf16(lo, hi); }
__device__ __forceinline__ float wave_sum(float v) {
#pragma unroll
    for (int o = 1; o < 64; o <<= 1) v += __shfl_xor(v, o);
    return v;
}

struct EpiWin {
    static constexpr bool PERM = true, AFTER_DRAIN = false;
    bf16_t* Z; bf16_t* Gp;
    __device__ __forceinline__ void operator()(const pg8::f32x4 (&acc)[2][2][4][2], const pg8::Unit& u, int wr, int wc, int fr, int fq) const {
        const int row0 = u.pm * pg8::BM + wr * 64 + fr;
        bf16_t* base; size_t rstride, bjstride;
        if (u.pn < 8) { base = Z + (size_t)row0 * 2048 + u.pn * 256 + wc * 32 + 8 * fq; rstride = 2048; bjstride = 128; }
        else {
            const int g = u.pn - 8, r0 = u.pm * pg8::BM; size_t sb; int L, t0;
            if (r0 < NPROMPT) { const int s = r0 >> 14; sb = (size_t)s * (2u * 16384u * 512u); L = 16384; t0 = row0 - s * 16384; }
            else { const int s = (r0 - NPROMPT) >> 12; sb = (size_t)NPROMPT * 1024 + (size_t)s * (2u * 4096u * 512u); L = 4096; t0 = row0 - NPROMPT - s * 4096; }
            base = Gp + sb + (size_t)t0 * 512 + g * 128 + wc * 32 + 8 * fq; rstride = 512; bjstride = (size_t)L * 512;
        }
#pragma unroll
        for (int ai = 0; ai < 2; ++ai)
#pragma unroll
            for (int m = 0; m < 4; ++m) { bf16_t* rowp = base + (size_t)(ai * pg8::HALF + m * 16) * rstride;
#pragma unroll
                for (int bj = 0; bj < 2; ++bj) { const pg8::f32x4 v0 = acc[ai][bj][m][0], v1 = acc[ai][bj][m][1];
                    pg8::u32x4 w; w.x = pk2(v0[0], v0[1]); w.y = pk2(v0[2], v0[3]); w.z = pk2(v1[0], v1[1]); w.w = pk2(v1[2], v1[3]);
                    *(pg8::u32x4*)(rowp + bj * bjstride) = w; } }
    }
};

__device__ __forceinline__ void p0a_tables(const float* fourier_w, unsigned char* ws, LAS float* tab, int gtid, int NT) {
    float* M2F = (float*)(ws + WS_M2F);
    { const int t = ltid(); if (t < 128) { float sn, cs; sincospif((float)t * (2.f / 128.f), &sn, &cs); tab[t] = cs; tab[128 + t] = -sn; } }
    __syncthreads();
    for (int i = gtid; i < 2 * 4 * 128 * 256; i += NT) {
        const int lg = i >> 15, c = (i >> 8) & 127, n = i & 255, part = n >> 7, e2 = n & 127;
        const float* fw = fourier_w + (size_t)lg * 16384 + e2;
        float acc = 0.f;
#pragma unroll 8
        for (int e = 0; e < 128; ++e) { const int r = (c * e) & 127; acc += tab[part * 128 + r] * fw[e * 128]; }
        M2F[i] = acc;
    }
    __syncthreads();
    float* COS = (float*)(ws + WS_COS); float* SIN = (float*)(ws + WS_SIN);
    for (int i = gtid; i < 16384 * 64; i += NT) {
        const int t = i >> 6, j = i & 63; const float pos = (float)(j < 32 ? (t >> 6) : (t & 63));
        const float inv = 1.0f / powf(10000.0f, (float)(j & 31) / 32.0f); const float ang = pos * inv;
        COS[i] = cosf(ang); SIN[i] = sinf(ang);
    }
    bf16_t* A1P = (bf16_t*)(ws + WS_A1P);
    for (int i = gtid; i < 256 * 256; i += NT) { const int m = i >> 8, k = i & 255, pm = m >> 7, k1 = m & 127, pk = k >> 7, t1 = k & 127; const int r = (t1 * k1) & 127;
        float sn, cs; sincospif((float)r * (2.f / 128.f), &sn, &cs); const float v = (pm == pk) ? cs : (pm == 0 ? sn : -sn); A1P[i] = (bf16_t)(pk2(v, 0.f) & 0xffff); }
    bf16_t* A1S = (bf16_t*)(ws + WS_A1S);
    for (int i = gtid; i < 128 * 128; i += NT) { const int m = i >> 7, k = i & 127, pm = m >> 6, k1 = m & 63, pk = k >> 6, t1 = k & 63; const int r = (t1 * k1) & 63;
        float sn, cs; sincospif((float)r * (2.f / 64.f), &sn, &cs); const float v = (pm == pk) ? cs : (pm == 0 ? sn : -sn); A1S[i] = (bf16_t)(pk2(v, 0.f) & 0xffff); }
    bf16_t* A3P = (bf16_t*)(ws + WS_A3P);
    for (int i = gtid; i < 128 * 128 * 256; i += NT) { const int k1 = i >> 15, k2 = (i >> 8) & 127, kk = i & 255, part = kk >> 7, t2 = kk & 127; const int k = k1 + 128 * k2; const int r = (t2 * k) & 16383;
        float sn, cs; sincospif((float)r * (1.f / 8192.f), &sn, &cs); A3P[i] = (bf16_t)(pk2(part ? sn : cs, 0.f) & 0xffff); }
    bf16_t* A3S = (bf16_t*)(ws + WS_A3S);
    for (int i = gtid; i < 64 * 64 * 128; i += NT) { const int k1 = i >> 13, k2 = (i >> 7) & 63, kk = i & 127, part = kk >> 6, t2 = kk & 63; const int k = k1 + 64 * k2; const int r = (t2 * k) & 4095;
        float sn, cs; sincospif((float)r * (1.f / 2048.f), &sn, &cs); A3S[i] = (bf16_t)(pk2(part ? sn : cs, 0.f) & 0xffff); }
}

struct ValUp { const float* W; __device__ __forceinline__ const float* ptr(int k, int n) const { const int src = ((n >> 7) & 1) * DFF + (n >> 8) * 128 + (n & 127); return W + (size_t)k * NUP + src; }
    __device__ __forceinline__ float operator()(int k, int n) const { return *ptr(k, n); } };
struct ValDirect { const float* W; int ldw; __device__ __forceinline__ const float* ptr(int k, int n) const { return W + (size_t)k * ldw + n; }
    __device__ __forceinline__ float operator()(int k, int n) const { return W[(size_t)k * ldw + n]; } };
struct ValWin { const float* win; const float* poolw; const float* pscale; const float* m2f;
    __device__ __forceinline__ const float* ptr(int k, int n) const { return win + (size_t)k * WINW + n; }
    __device__ __forceinline__ float operator()(int k, int n) const {
        if (n >= 512 && n < 2048) return win[(size_t)k * WINW + n];
        if (n < 512) { const int g = n >> 7, e = n & 127; const float* wr = win + (size_t)k * WINW + g * 128; const float* pw = poolw + g * 16384 + e; float acc = 0.f;
            for (int c = 0; c < 128; ++c) acc += wr[c] * pw[c * 128]; return acc * pscale[n]; }
        const int n2 = n - 2048, g = n2 >> 8, np = n2 & 255; const float* wr = win + (size_t)k * WINW + 2048 + g * 128; const float* mf = m2f + g * 32768 + np; float acc = 0.f;
        for (int c = 0; c < 128; ++c) acc += wr[c] * mf[c * 256]; return acc; } };
template <class F> __device__ __forceinline__ void transpose_item(const F& val, int K, bf16_t* WT, int k0, int n0, LAS float* scr, int lane) {
    for (int i = 0; i < 32; ++i) { const int kk = 2 * i + (lane >> 5); scr[kk * 33 + (lane & 31)] = val(k0 + kk, n0 + (lane & 31)); }
    asm volatile("s_waitcnt lgkmcnt(0)" ::: "memory");
    const int c = lane & 7;
#pragma unroll
    for (int j = 0; j < 4; ++j) { const int n = (lane >> 3) + 8 * j; const LAS float* s = scr + (8 * c) * 33 + n;
        v4u o; o.x = pk2(s[0 * 33], s[1 * 33]); o.y = pk2(s[2 * 33], s[3 * 33]); o.z = pk2(s[4 * 33], s[5 * 33]); o.w = pk2(s[6 * 33], s[7 * 33]);
        *(v4u*)(WT + (size_t)(n0 + n) * K + k0 + 8 * c) = o; }
    asm volatile("s_waitcnt lgkmcnt(0)" ::: "memory");
}
template <class F> __device__ __forceinline__ void tr_load(const F& f, int k0, int n0, int lane, f4 (&v)[8]) {
#pragma unroll
    for (int i = 0; i < 8; ++i) v[i] = __builtin_nontemporal_load((const f4*)f.ptr(k0 + 8 * i + (lane >> 3), n0 + 4 * (lane & 7)));
}
__device__ __forceinline__ void tr_store(const f4 (&v)[8], int K, bf16_t* WT, int k0, int n0, LAS float* scr, int lane) {
#pragma unroll
    for (int i = 0; i < 8; ++i) { LAS float* d = scr + (8 * i + (lane >> 3)) * 33 + 4 * (lane & 7); d[0] = v[i].x; d[1] = v[i].y; d[2] = v[i].z; d[3] = v[i].w; }
    asm volatile("s_waitcnt lgkmcnt(0)" ::: "memory");
    const int c = lane & 7;
#pragma unroll
    for (int j = 0; j < 4; ++j) { const int n = (lane >> 3) + 8 * j; const LAS float* s = scr + (8 * c) * 33 + n;
        v4u o; o.x = pk2(s[0 * 33], s[1 * 33]); o.y = pk2(s[2 * 33], s[3 * 33]); o.z = pk2(s[4 * 33], s[5 * 33]); o.w = pk2(s[6 * 33], s[7 * 33]);
        *(v4u*)(WT + (size_t)(n0 + n) * K + k0 + 8 * c) = o; }
    asm volatile("s_waitcnt lgkmcnt(0)" ::: "memory");
}
template <class F> __device__ __forceinline__ void transpose_matrix(const F& val, int K, int N, bf16_t* WT, LAS float* scr, int gw, int NGW, int lane, int nlo, int nhi) {
    const int nblk = (nhi - nlo) / 32, nitems = (K / 64) * nblk;
    int it = gw; if (it >= nitems) return;
    f4 cur[8], nxt[8];
    tr_load(val, 64 * (it / nblk), nlo + 32 * (it % nblk), lane, cur);
    for (; it < nitems; it += NGW) {
        const int k0 = 64 * (it / nblk), n0 = nlo + 32 * (it % nblk); const int it2 = it + NGW; const bool more = it2 < nitems;
        if (more) tr_load(val, 64 * (it2 / nblk), nlo + 32 * (it2 % nblk), lane, nxt);
        tr_store(cur, K, WT, k0, n0, scr, lane);
        if (more) {
#pragma unroll
            for (int i = 0; i < 8; ++i) cur[i] = nxt[i]; }
    }
}

typedef float __attribute__((address_space(4))) cf32;
__device__ __forceinline__ void fold_items(const float* win, const float* poolw, const float* pscale, const float* m2f, bf16_t* WT, int gw, int NGW, int lane) {
    for (int it = gw; it < 64 * 24; it += NGW) {
        const int kb = it / 24, nb = it - kb * 24, k0 = 32 * kb;
        float m2[128]; int base, nout;
        if (nb < 8) { const int n = nb * 64 + lane, g = nb >> 1, e = n & 127; base = g * 128; nout = n; const float sc = pscale[n]; const float* pw = poolw + g * 16384 + e;
#pragma unroll
            for (int c = 0; c < 128; ++c) m2[c] = pw[c * 128] * sc;
        } else { const int n2 = (nb - 8) * 64 + lane, g = (nb - 8) >> 2, np = n2 & 255; base = 2048 + g * 128; nout = 2048 + n2; const float* mf = m2f + g * 32768 + np;
#pragma unroll
            for (int c = 0; c < 128; ++c) m2[c] = mf[c * 256];
        }
        bf16_t* wrow = WT + (size_t)nout * DM + k0;
        for (int kg = 0; kg < 4; ++kg) {
            float acc[8];
#pragma unroll
            for (int kk = 0; kk < 8; ++kk) { const cf32* wr = (const cf32*)(unsigned long long)(win + (size_t)(k0 + 8 * kg + kk) * WINW + base); float a = 0.f;
#pragma unroll
                for (int c = 0; c < 128; ++c) a += wr[c] * m2[c];
                acc[kk] = a; }
            v4u o; o.x = pk2(acc[0], acc[1]); o.y = pk2(acc[2], acc[3]); o.z = pk2(acc[4], acc[5]); o.w = pk2(acc[6], acc[7]);
            *(v4u*)(wrow + 8 * kg) = o;
        }
    }
}

__device__ __forceinline__ const float* xrow_ptr(const float* xa, const float* xb, int row) { return (row < NPROMPT) ? xa + (size_t)row * DM : xb + (size_t)(row - NPROMPT) * DM; }
template <bool XBF, bool OBF, int RR>
__device__ __forceinline__ void resid_rows(const float* xa, const float* xb, const bf16_t* xbf, const bf16_t* m, const float* g1, float* xout, bf16_t* xbout, bf16_t* xh, const float* g2, int gw, int NGW, int lane) {
    for (int row0 = gw; row0 < MTOK; row0 += RR * NGW) {
        f4 xf[XBF ? 1 : RR][8]; v2u xp[XBF ? RR : 1][8]; v2u mw[RR][8];
#pragma unroll
        for (int u = 0; u < RR; ++u) { const int row = row0 + u * NGW;
            if constexpr (XBF) { const bf16_t* xr = xbf + (size_t)row * DM;
#pragma unroll
                for (int j = 0; j < 8; ++j) xp[u][j] = *(const v2u*)(xr + 4 * lane + 256 * j);
            } else { const float* xr = xrow_ptr(xa, xb, row);
#pragma unroll
                for (int j = 0; j < 8; ++j) xf[u][j] = __builtin_nontemporal_load((const f4*)(xr + 4 * lane + 256 * j)); } }
        if (m) {
#pragma unroll
            for (int u = 0; u < RR; ++u) { const bf16_t* mr = m + (size_t)(row0 + u * NGW) * DM;
#pragma unroll
                for (int j = 0; j < 8; ++j) mw[u][j] = *(const v2u*)(mr + 4 * lane + 256 * j); }
        }
#pragma unroll
        for (int u = 0; u < RR; ++u) { const int row = row0 + u * NGW;
            f4 xv[8];
#pragma unroll
            for (int j = 0; j < 8; ++j) { if constexpr (XBF) { const v2u w = xp[u][j]; xv[j] = (f4){bflo(w.x), bfhi(w.x), bflo(w.y), bfhi(w.y)}; } else xv[j] = xf[u][j]; }
            if (m) { float ss = 0.f;
#pragma unroll
                for (int j = 0; j < 8; ++j) { const v2u w = mw[u][j]; const f4 mv = (f4){bflo(w.x), bfhi(w.x), bflo(w.y), bfhi(w.y)}; ss += (mv.x * mv.x + mv.y * mv.y) + (mv.z * mv.z + mv.w * mv.w); }
                const float r = 1.0f / sqrtf(wave_sum(ss) * (1.f / DM) + EPS);
#pragma unroll
                for (int j = 0; j < 8; ++j) { const v2u w = mw[u][j]; const f4 mv = (f4){bflo(w.x), bfhi(w.x), bflo(w.y), bfhi(w.y)}; const f4 gv = *(const f4*)(g1 + 4 * lane + 256 * j); xv[j] += mv * r * gv; } }
            if constexpr (OBF) { if (xbout) {
#pragma unroll
                for (int j = 0; j < 8; ++j) { v2u w; w.x = pk2(xv[j].x, xv[j].y); w.y = pk2(xv[j].z, xv[j].w); *(v2u*)(xbout + (size_t)row * DM + 4 * lane + 256 * j) = w; } }
            } else { if (xout) {
#pragma unroll
                for (int j = 0; j < 8; ++j) __builtin_nontemporal_store(xv[j], (f4*)(xout + (size_t)row * DM + 4 * lane + 256 * j)); } }
            if (xh) { float ss = 0.f;
#pragma unroll
                for (int j = 0; j < 8; ++j) ss += (xv[j].x * xv[j].x + xv[j].y * xv[j].y) + (xv[j].z * xv[j].z + xv[j].w * xv[j].w);
                const float r = 1.0f / sqrtf(wave_sum(ss) * (1.f / DM) + EPS);
#pragma unroll
                for (int j = 0; j < 8; ++j) { const f4 gv = *(const f4*)(g2 + 4 * lane + 256 * j); const f4 y = xv[j] * r * gv;
                    v2u w; w.x = pk2(y.x, y.y); w.y = pk2(y.z, y.w); *(v2u*)(xh + (size_t)row * DM + 4 * lane + 256 * j) = w; } }
        }
    }
}

__device__ __forceinline__ void rope_pass(bf16_t* Z, bf16_t* Zout, const float* qn, const float* kn, const float* COS, const float* SIN, int gtid, int NT) {
    const int hw = gtid >> 5, NHW = NT >> 5, j = gtid & 31;
    constexpr float QC = 0.088388347648318440f * 1.4426950408889634f;
    const float qa0 = qn[2 * j] * QC, qa1 = qn[2 * j + 1] * QC, qb0 = qn[64 + 2 * j] * QC, qb1 = qn[65 + 2 * j] * QC;
    const float ka0 = kn[2 * j], ka1 = kn[2 * j + 1], kb0 = kn[64 + 2 * j], kb1 = kn[65 + 2 * j];
    for (int row = hw; row < MTOK; row += NHW) {
        const int t = row < NPROMPT ? (row & 16383) : (row & 4095);
        bf16_t* p = Z + (size_t)row * DM + 512 + 2 * j;
        unsigned a[10], b[10];
#pragma unroll
        for (int hh = 0; hh < 10; ++hh) { a[hh] = *(const unsigned*)(p + hh * 128); b[hh] = *(const unsigned*)(p + hh * 128 + 64); }
        const float c0 = COS[t * 64 + 2 * j], c1 = COS[t * 64 + 2 * j + 1], s0 = SIN[t * 64 + 2 * j], s1 = SIN[t * 64 + 2 * j + 1];
#pragma unroll
        for (int hh = 0; hh < 10; ++hh) {
            float x0 = bflo(a[hh]), x1 = bfhi(a[hh]), y0 = bflo(b[hh]), y1 = bfhi(b[hh]);
            float ss = (x0 * x0 + x1 * x1) + (y0 * y0 + y1 * y1);
#pragma unroll
            for (int o = 1; o < 32; o <<= 1) ss += __shfl_xor(ss, o);
            const float r = 1.0f / sqrtf(ss * (1.f / 128.f) + EPS);
            x0 *= r * (hh < 8 ? qa0 : ka0); x1 *= r * (hh < 8 ? qa1 : ka1); y0 *= r * (hh < 8 ? qb0 : kb0); y1 *= r * (hh < 8 ? qb1 : kb1);
            const float ox0 = x0 * c0 - y0 * s0, oy0 = y0 * c0 + x0 * s0, ox1 = x1 * c1 - y1 * s1, oy1 = y1 * c1 + x1 * s1;
            bf16_t* po = Zout + (size_t)row * DM + 512 + 2 * j;
            *(unsigned*)(po + hh * 128) = pk2(ox0, ox1); *(unsigned*)(po + hh * 128 + 64) = pk2(oy0, oy1);
        }
    }
}

__device__ __forceinline__ void acc8(float* s, const bf16_t* p, float sg) { const v4u v = *(const v4u*)p;
    s[0] += sg * bflo(v.x); s[1] += sg * bfhi(v.x); s[2] += sg * bflo(v.y); s[3] += sg * bfhi(v.y); s[4] += sg * bflo(v.z); s[5] += sg * bfhi(v.z); s[6] += sg * bflo(v.w); s[7] += sg * bfhi(v.w); }
__device__ __forceinline__ void pool_pass(const bf16_t* Z, bf16_t* H, int gtid, int NT) {
    constexpr int RL = 32;
    for (int it = gtid; it < (MTOK / RL) * 64; it += NT) {
        const int ch = it & 63, run = it >> 6, c0 = ch * 8, g = ch >> 4, w = 2 << g, a = w >> 1, b = w - 1 - a;
        const int row0 = run * RL; int t0, L; if (row0 < NPROMPT) { t0 = row0 & 16383; L = 16384; } else { t0 = row0 & 4095; L = 4096; }
        const bf16_t* zb = Z + (size_t)(row0 - t0) * DM + c0;
        float s[8] = {0.f, 0.f, 0.f, 0.f, 0.f, 0.f, 0.f, 0.f};
        { const int lo = t0 - a < 0 ? 0 : t0 - a, hi = t0 + b > L - 1 ? L - 1 : t0 + b;
          for (int tt = lo; tt <= hi; ++tt) acc8(s, zb + (size_t)tt * DM, 1.f); }
#pragma unroll 4
        for (int r = 0; r < RL; ++r) {
            const int t = t0 + r; const int lo = t - a < 0 ? 0 : t - a, hi = t + b > L - 1 ? L - 1 : t + b;
            const float ic = 1.0f / (float)(hi - lo + 1);
            const v4u v = *(const v4u*)(zb + (size_t)t * DM);
            v4u o; o.x = pk2(s[0] * ic - bflo(v.x), s[1] * ic - bfhi(v.x)); o.y = pk2(s[2] * ic - bflo(v.y), s[3] * ic - bfhi(v.y));
            o.z = pk2(s[4] * ic - bflo(v.z), s[5] * ic - bfhi(v.z)); o.w = pk2(s[6] * ic - bflo(v.w), s[7] * ic - bfhi(v.w));
            *(v4u*)(H + (size_t)(row0 + r) * DM + c0) = o;
            if (t + 1 + b <= L - 1) acc8(s, zb + (size_t)(t + 1 + b) * DM, 1.f);
            if (t - a >= 0) acc8(s, zb + (size_t)(t - a) * DM, -1.f);
        }
    }
}

__device__ __forceinline__ float gelu_tanh(float x) { const float y = 0.7978845608028654f * (x + 0.044715f * x * x * x); return x * __builtin_amdgcn_rcpf(1.0f + __expf(-2.0f * y)); }
__device__ __forceinline__ void ld8f(const bf16_t* p, float* o) { const v4u v = *(const v4u*)p; o[0] = bflo(v.x); o[1] = bfhi(v.x); o[2] = bflo(v.y); o[3] = bfhi(v.y); o[4] = bflo(v.z); o[5] = bfhi(v.z); o[6] = bflo(v.w); o[7] = bfhi(v.w); }
__device__ __forceinline__ float dpp_ror1(float v) { return __int_as_float(__builtin_amdgcn_update_dpp(0, __float_as_int(v), 0x121, 0xf, 0xf, false)); }
__device__ __forceinline__ float dpp_ror15(float v) { return __int_as_float(__builtin_amdgcn_update_dpp(0, __float_as_int(v), 0x12F, 0xf, 0xf, false)); }
struct EpiGlu {
    static constexpr bool PERM = true, AFTER_DRAIN = false;
    bf16_t* ACT; bf16_t* HB; const float* cw; const float* cb;
    __device__ __forceinline__ void operator()(const pg8::f32x4 (&acc)[2][2][4][2], const pg8::Unit& u, int wr, int wc, int fr, int fq) const {
        const int jc = u.pn * 128 + wc * 32 + 8 * fq;
        const bool first = (fr == 0), last = (fr == 15);
        v2u stash[2][4];
#pragma unroll
        for (int n = 0; n < 2; ++n) {
            const f4 w0g = *(const f4*)(cw + jc + 4 * n), w1g = *(const f4*)(cw + NUP + jc + 4 * n), w2g = *(const f4*)(cw + 2 * NUP + jc + 4 * n), bg = *(const f4*)(cb + jc + 4 * n);
            const f4 w0v = *(const f4*)(cw + DFF + jc + 4 * n), w1v = *(const f4*)(cw + NUP + DFF + jc + 4 * n), w2v = *(const f4*)(cw + 2 * NUP + DFF + jc + 4 * n), bv = *(const f4*)(cb + DFF + jc + 4 * n);
#pragma unroll
            for (int ai = 0; ai < 2; ++ai) {
                float g1p[4], v1p[4], g15c[4], v15c[4];
#pragma unroll
                for (int i = 0; i < 4; ++i) { g1p[i] = 0.f; v1p[i] = 0.f; g15c[i] = dpp_ror15(acc[ai][0][0][n][i]); v15c[i] = dpp_ror15(acc[ai][1][0][n][i]); }
#pragma unroll
                for (int m = 0; m < 4; ++m) {
                    const int mn = m < 3 ? m + 1 : 3;
                    float o[4];
#pragma unroll
                    for (int i = 0; i < 4; ++i) {
                        const float g = acc[ai][0][m][n][i], v = acc[ai][1][m][n][i];
                        const float g1c = dpp_ror1(g), v1c = dpp_ror1(v), g15n = dpp_ror15(acc[ai][0][mn][n][i]), v15n = dpp_ror15(acc[ai][1][mn][n][i]);
                        const float gp = first ? g1p[i] : g1c, gn = last ? g15n : g15c[i], vp = first ? v1p[i] : v1c, vn = last ? v15n : v15c[i];
                        g1p[i] = g1c; v1p[i] = v1c; g15c[i] = g15n; v15c[i] = v15n;
                        const float a = gp * w0g[i] + g * w1g[i] + gn * w2g[i] + bg[i];
                        const float b = vp * w0v[i] + v * w1v[i] + vn * w2v[i] + bv[i];
                        const float e = __builtin_amdgcn_exp2f(a * (-2.3022082f + -0.10294324f * (a * a)));
                        o[i] = a * __builtin_amdgcn_rcpf(1.0f + e) * b;
                    }
                    const int row = u.pm * pg8::BM + ai * pg8::HALF + wr * 64 + m * 16 + fr;
                    v2u w; w.x = pk2(o[0], o[1]); w.y = pk2(o[2], o[3]);
                    if (n == 0) stash[ai][m] = w;
                    else { v4u ww; ww.x = stash[ai][m].x; ww.y = stash[ai][m].y; ww.z = w.x; ww.w = w.y; *(v4u*)(ACT + (size_t)row * DFF + jc) = ww; }
                }
            }
        }
#pragma unroll
        for (int ai = 0; ai < 2; ++ai) {
            const int grp = u.pm * 4 + ai * 2 + wr;
            if (fr < 2 || fr >= 14) {
                const int m = fr < 2 ? 0 : 3, slot = fr < 2 ? fr : fr - 12;
                bf16_t* hp = HB + ((size_t)grp * 4 + slot) * NUP + u.pn * 256 + wc * 32 + 8 * fq;
#pragma unroll
                for (int bj = 0; bj < 2; ++bj) {
                    const pg8::f32x4 v0 = fr < 2 ? acc[ai][bj][0][0] : acc[ai][bj][3][0], v1 = fr < 2 ? acc[ai][bj][0][1] : acc[ai][bj][3][1];
                    v4u w; w.x = pk2(v0[0], v0[1]); w.y = pk2(v0[2], v0[3]); w.z = pk2(v1[0], v1[1]); w.w = pk2(v1[2], v1[3]);
                    *(v4u*)(hp + bj * 128) = w;
                }
                (void)m;
            }
        }
    }
};
__device__ __forceinline__ void glu_fix(const bf16_t* HB, bf16_t* ACT, const float* cw, const float* cb, int gtid, int NT) {
    constexpr int NCC = DFF / 8, NG = CHUNK / 64;
    for (int it = gtid; it < NG * 2 * NCC; it += NT) {
        const int cc = it % NCC, rest = it / NCC, which = rest & 1, g = rest >> 1, j0 = cc * 8, colp = (j0 >> 7) * 256 + (j0 & 127);
        const int row = g * 64 + (which ? 63 : 0); const int Lc = row < NPROMPT ? 16384 : 4096;
        const bf16_t *P, *C, *N;
        if (!which) { C = HB + ((size_t)g * 4 + 0) * NUP; N = HB + ((size_t)g * 4 + 1) * NUP; P = ((row & (Lc - 1)) == 0) ? nullptr : HB + ((size_t)(g - 1) * 4 + 3) * NUP; }
        else { P = HB + ((size_t)g * 4 + 2) * NUP; C = HB + ((size_t)g * 4 + 3) * NUP; N = (((row + 1) & (Lc - 1)) == 0) ? nullptr : HB + ((size_t)(g + 1) * 4 + 0) * NUP; }
        float pg[8], pv[8], cg_[8], cv[8], ng[8], nv[8];
        if (P) { ld8f(P + colp, pg); ld8f(P + colp + 128, pv); } else {
#pragma unroll
            for (int i = 0; i < 8; ++i) { pg[i] = 0.f; pv[i] = 0.f; } }
        if (N) { ld8f(N + colp, ng); ld8f(N + colp + 128, nv); } else {
#pragma unroll
            for (int i = 0; i < 8; ++i) { ng[i] = 0.f; nv[i] = 0.f; } }
        ld8f(C + colp, cg_); ld8f(C + colp + 128, cv);
        float o[8];
#pragma unroll
        for (int h = 0; h < 2; ++h) {
            const f4 w0g = *(const f4*)(cw + j0 + 4 * h), w1g = *(const f4*)(cw + NUP + j0 + 4 * h), w2g = *(const f4*)(cw + 2 * NUP + j0 + 4 * h), bg = *(const f4*)(cb + j0 + 4 * h);
            const f4 w0v = *(const f4*)(cw + DFF + j0 + 4 * h), w1v = *(const f4*)(cw + NUP + DFF + j0 + 4 * h), w2v = *(const f4*)(cw + 2 * NUP + DFF + j0 + 4 * h), bv = *(const f4*)(cb + DFF + j0 + 4 * h);
#pragma unroll
            for (int q = 0; q < 4; ++q) { const int i = 4 * h + q;
                const float a = pg[i] * w0g[q] + cg_[i] * w1g[q] + ng[i] * w2g[q] + bg[q];
                const float b = pv[i] * w0v[q] + cv[i] * w1v[q] + nv[i] * w2v[q] + bv[q];
                o[i] = gelu_tanh(a) * b; } }
        v4u w; w.x = pk2(o[0], o[1]); w.y = pk2(o[2], o[3]); w.z = pk2(o[4], o[5]); w.w = pk2(o[6], o[7]);
        *(v4u*)(ACT + (size_t)row * DFF + j0) = w;
    }
}

struct BRow1 { const att::bf16* base; size_t ldb; __device__ __forceinline__ const att::bf16* row(int kk) const { return base + (size_t)kk * ldb; } };
struct St1 { att::bf16* base; size_t ldb; float scale; __device__ __forceinline__ void store16(int m, int c, att::u32x4 v) const { *(att::u32x4*)(base + (size_t)m * ldb + c) = v; } };
struct BRow3 { const att::bf16* base; int R, lgR, k1; __device__ __forceinline__ const att::bf16* row(int kk) const { const int part = kk >> lgR, t2 = kk & (R - 1); return base + (size_t)(((part << lgR) + k1) * R + t2) * 512; } };
struct St3 { att::bf16* base; int R; float scale; __device__ __forceinline__ void store16(int m, int c, att::u32x4 v) const { *(att::u32x4*)(base + (size_t)(m * R) * DM + c) = v; } };

__device__ __forceinline__ void dft_stage1(const bf16_t* Gp, bf16_t* Yp, const unsigned char* ws, char* lds, int vcu, int G) {
    for (int it = 0;; ++it) { const int uid = it * G + vcu; if (uid >= 3072) break;
        if (uid < 1024) { const int s = uid >> 9, nt = uid & 511; const size_t off = (size_t)s * (2u * 16384u * 512u) + (size_t)nt * 128;
            BRow1 br{(const att::bf16*)Gp + off, 65536}; St1 st{(att::bf16*)Yp + off, 65536, 1.f};
            att::dft_unit<8, 4>((const att::bf16*)(ws + WS_A1P), 256, br, st, lds);
        } else { const int u2 = uid - 1024, s = u2 >> 8, nt = u2 & 255; const size_t off = (size_t)NPROMPT * 1024 + (size_t)s * (2u * 4096u * 512u) + (size_t)nt * 128;
            BRow1 br{(const att::bf16*)Gp + off, 32768}; St1 st{(att::bf16*)Yp + off, 32768, 1.f};
            att::dft_unit<4, 2>((const att::bf16*)(ws + WS_A1S), 128, br, st, lds);
        }
    }
}
__device__ __forceinline__ void dft_stage3(const bf16_t* Yp, bf16_t* H, const unsigned char* ws, char* lds, int vcu, int G) {
    for (int it = 0;; ++it) { const int uid = it * G + vcu; if (uid >= 3072) break;
        if (uid < 1024) { const int s = uid >> 9, k1 = (uid >> 2) & 127, nt = uid & 3;
            BRow3 br{(const att::bf16*)Yp + (size_t)s * (2u * 16384u * 512u) + nt * 128, 128, 7, k1};
            St3 st{(att::bf16*)H + (size_t)(s * 16384 + k1) * DM + 1536 + nt * 128, 128, 1.0f / sqrtf(16384.f * 128.f)};
            att::dft_unit<4, 4>((const att::bf16*)(ws + WS_A3P) + (size_t)k1 * (128 * 256), 256, br, st, lds);
        } else { const int u2 = uid - 1024, s = u2 >> 8, k1 = (u2 >> 2) & 63, nt = u2 & 3;
            BRow3 br{(const att::bf16*)Yp + (size_t)NPROMPT * 1024 + (size_t)s * (2u * 4096u * 512u) + nt * 128, 64, 6, k1};
            St3 st{(att::bf16*)H + (size_t)(NPROMPT + s * 4096 + k1) * DM + 1536 + nt * 128, 64, 1.0f / sqrtf(4096.f * 128.f)};
            att::dft_unit<2, 2>((const att::bf16*)(ws + WS_A3S) + (size_t)k1 * (64 * 128), 128, br, st, lds);
        }
    }
}

template <bool SHIFT> __device__ __forceinline__ void attn_units(const bf16_t* Z, bf16_t* H, float bound, char* lds, int vcu, int G) {
    for (int it = 0;; ++it) { const int uid = it * G + vcu; if (uid >= 2048) break;
        int rowbase, h, qb, seq;
        if (uid < 1024) { const int s = uid >> 9; h = (uid >> 6) & 7; qb = uid & 63; rowbase = s * 16384; seq = 16384; }
        else { const int u2 = uid - 1024, s = u2 >> 7; h = (u2 >> 4) & 7; qb = u2 & 15; rowbase = NPROMPT + s * 4096; seq = 4096; }
        const att::bf16* Q = (const att::bf16*)Z + (size_t)(rowbase + qb * 256) * DM + 512 + h * 128;
        const att::bf16* K = (const att::bf16*)Z + (size_t)rowbase * DM + 1536 + (h >> 2) * 128;
        att::bf16* O = (att::bf16*)H + (size_t)(rowbase + qb * 256) * DM + 512 + h * 128;
        att::attn_dense_body<att::bf16, SHIFT>(Q, K, K + 256, O, seq, lds, bound);
        __syncthreads();
    }
}
__device__ __forceinline__ void attn_phase(const bf16_t* Z, bf16_t* H, const float* qn, const float* kn, char* lds, int vcu, int G) {
    float mq = 0.f, mk = 0.f;
    for (int i = 0; i < 128; ++i) { mq = fmaxf(mq, fabsf(qn[i])); mk = fmaxf(mk, fabsf(kn[i])); }
    const float bound = 128.f * mq * mk * 1.02f;
    const bool noshift = __builtin_amdgcn_readfirstlane((int)(bound * (att::SCALE * 1.4426950408889634f) < 60.f)) != 0;
    if (noshift) attn_units<false>(Z, H, bound, lds, vcu, G);
    else attn_units<true>(Z, H, bound, lds, vcu, G);
}

struct Params { const float* in[17]; float* out; unsigned char* ws; int ph_lo, ph_hi; };
constexpr int NPL = 9;
constexpr int NPHASE = 2 + 2 * NPL;

__global__ void __launch_bounds__(512, 2) mega_fwd(Params p) {
    extern __shared__ __attribute__((aligned(16))) unsigned char lds[];
    cg::grid_group grid = cg::this_grid();
    const int G = gridDim.x, bx = blockIdx.x;
    const int vcu = (G % 8 == 0) ? (bx % 8) * (G / 8) + bx / 8 : bx;
    const int NGW = G * 8, NT = G * 512;
    unsigned char* ws = p.ws;
    const float *x_prompt = p.in[0], *x_sample = p.in[1], *g_pre_mix = p.in[2], *g_post_mix = p.in[3], *w_in = p.in[4], *pool_w = p.in[5], *pool_scale = p.in[6],
                *q_norm = p.in[7], *k_norm = p.in[8], *fourier_w = p.in[9], *w_out = p.in[10], *g_pre_ffn = p.in[11], *g_post_ffn = p.in[12], *w_up = p.in[13],
                *conv_w = p.in[14], *conv_b = p.in[15], *w_down = p.in[16];
    bf16_t* XH = (bf16_t*)(ws + WS_XH); bf16_t* Z = (bf16_t*)(ws + WS_Z); bf16_t* Gp = (bf16_t*)(ws + WS_G); bf16_t* Yp = (bf16_t*)(ws + WS_Y);
    bf16_t* HB = (bf16_t*)(ws + WS_HB); bf16_t* ACT = (bf16_t*)(ws + WS_ACT); bf16_t* XB = (bf16_t*)(ws + WS_XB);
    LAS unsigned char* ring = (LAS unsigned char*)lds;
    volatile LAS unsigned* bst = (volatile LAS unsigned*)(ring + 131072 + 64);
    if (threadIdx.x < 2) bst[threadIdx.x] = 0u;
    __syncthreads();
    XcdBarrier xbar = xcd_barrier_post((unsigned*)(ws + WS_BAR), bst);

    for (int ph = p.ph_lo; ph < p.ph_hi; ++ph) {
        const int tid = ltid(), lane = tid & 63, wave = __builtin_amdgcn_readfirstlane(tid >> 6);
        const int gw = vcu * 8 + wave, gtid = bx * 512 + tid;
        if (ph == 0) {
#if !defined(ONLY) || ONLY==0
            for (int rep = 0; rep < REP_P0; ++rep) p0a_tables(fourier_w, ws, (LAS float*)ring, gtid, NT);
#endif
        } else if (ph == 1) {
#if !defined(ONLY) || ONLY==1
            LAS float* scr = (LAS float*)(ring + wave * 16384);
            for (int l = 0; l < 2 * REP_P0; ++l) {
                bf16_t* Wl = (bf16_t*)(ws + WS_W + (l & 1) * W_LAYER);
                ValWin vw{w_in + (size_t)(l & 1) * DM * WINW, pool_w + (size_t)(l & 1) * 4 * 16384, pool_scale + (l & 1) * 512, (const float*)(ws + WS_M2F) + (size_t)(l & 1) * 4 * 32768};
                transpose_matrix(vw, DM, NIN, Wl, scr, gw, NGW, lane, 512, 2048);
                fold_items(vw.win, vw.poolw, vw.pscale, vw.m2f, Wl, gw, NGW, lane);
                ValDirect vo{w_out + (size_t)(l & 1) * DM * DM, DM};
                transpose_matrix(vo, DM, DM, (bf16_t*)((unsigned char*)Wl + W_OUT_OFF), scr, gw, NGW, lane, 0, DM);
                ValUp vu{w_up + (size_t)(l & 1) * DM * NUP};
                transpose_matrix(vu, DM, NUP, (bf16_t*)((unsigned char*)Wl + W_UP_OFF), scr, gw, NGW, lane, 0, NUP);
                ValDirect vd{w_down + (size_t)(l & 1) * DFF * DM, DM};
                transpose_matrix(vd, DFF, DM, (bf16_t*)((unsigned char*)Wl + W_DOWN_OFF), scr, gw, NGW, lane, 0, DM);
            }
            for (int rep = 0; rep < REP_P0; ++rep) resid_rows<false, false, 2>(x_prompt, x_sample, nullptr, nullptr, nullptr, nullptr, nullptr, XH, g_pre_mix, gw, NGW, lane);
#endif
        } else {
            const int l = (ph - 2) / NPL, q = (ph - 2) % NPL;
            const bf16_t* Wl = (const bf16_t*)(ws + WS_W + l * W_LAYER);
            if (q == 0) {
#if !defined(ONLY) || ONLY==2
                pg8::Gemm g{XH, Wl, MTOK, NIN, DM}; pg8::StaticOrder S; S.init(MTOK, NIN, G, bx);
                EpiWin E{Z, Gp};
                for (int rep = 0; rep < REP_WIN; ++rep) pg8::gemm_phase<EpiWin, pg8::StaticOrder, PG8_ALIGN, PG8_SP2>(ring, g, S, E);
#endif
            } else if (q == 1) {
#if !defined(ONLY) || ONLY==3
                for (int rep = 1; rep < REP_ROPE; ++rep) rope_pass(Z, (bf16_t*)(ws + WS_END), q_norm + l * 128, k_norm + l * 128, (const float*)(ws + WS_COS), (const float*)(ws + WS_SIN), gtid, NT);
                rope_pass(Z, Z, q_norm + l * 128, k_norm + l * 128, (const float*)(ws + WS_COS), (const float*)(ws + WS_SIN), gtid, NT);
                for (int rep = 0; rep < REP_LIGHT * REP_POOL; ++rep) pool_pass(Z, XH, gtid, NT);
                for (int rep = 0; rep < REP_LIGHT; ++rep) dft_stage1(Gp, Yp, ws, (char*)lds, vcu, G);
#endif
            } else if (q == 2) {
#if !defined(ONLY) || ONLY==4
                for (int rep = 0; rep < REP_ATTN; ++rep) attn_phase(Z, XH, q_norm + l * 128, k_norm + l * 128, (char*)lds, vcu, G);
#endif
#if !defined(ONLY) || ONLY==5
                for (int rep = 0; rep < REP_LIGHT; ++rep) dft_stage3(Yp, XH, ws, (char*)lds, vcu, G);
#endif
            } else if (q == 4) {
#if !defined(ONLY) || ONLY==6
                for (int rep = 1; rep < REP_RES; ++rep) resid_rows<true, true, 4>(nullptr, nullptr, XB, Z, g_post_mix + DM, nullptr, nullptr, (bf16_t*)(ws + WS_END), g_pre_ffn + DM, gw, NGW, lane);
                if (l == 0) resid_rows<false, true, 2>(x_prompt, x_sample, nullptr, Z, g_post_mix, nullptr, XB, XH, g_pre_ffn, gw, NGW, lane);
                else resid_rows<true, true, 4>(nullptr, nullptr, XB, Z, g_post_mix + DM, nullptr, XB, XH, g_pre_ffn + DM, gw, NGW, lane);
#endif
            } else if (q == 8) {
#if !defined(ONLY) || ONLY==6
                if (l == 0) resid_rows<true, true, 4>(nullptr, nullptr, XB, XH, g_post_ffn, nullptr, XB, XH, g_pre_mix + DM, gw, NGW, lane);
                else resid_rows<true, false, 4>(nullptr, nullptr, XB, XH, g_post_ffn + DM, p.out, nullptr, nullptr, nullptr, gw, NGW, lane);
#endif
            } else {
                const int c = 0, step = (q >= 5) ? (q - 5) : -1;
                const float* cwl = conv_w + (size_t)l * 3 * NUP; const float* cbl = conv_b + (size_t)l * NUP;
                if (step == 1) {
#if !defined(ONLY) || ONLY==7
                    for (int rep = 0; rep < REP_LIGHT; ++rep) glu_fix(HB, ACT, cwl, cbl, gtid, NT);
#endif
                } else if (step == 0) {
#if !defined(ONLY) || ONLY==9
                    pg8::Gemm g{XH + (size_t)c * CHUNK * DM, (const bf16_t*)((const unsigned char*)Wl + W_UP_OFF), CHUNK, NUP, DM};
                    pg8::StaticOrder S; S.init(g.M, g.N, G, bx);
                    EpiGlu E{ACT, HB, cwl, cbl};
                    for (int rep = 0; rep < REP_UP; ++rep) pg8::gemm_phase<EpiGlu, pg8::StaticOrder, PG8_ALIGN, PG8_SP2>(ring, g, S, E);
#endif
                } else {
#if !defined(ONLY) || ONLY==8
                    pg8::Gemm g; bf16_t* O;
                    if (q == 3) { g = pg8::Gemm{XH, (const bf16_t*)((const unsigned char*)Wl + W_OUT_OFF), MTOK, DM, DM}; O = Z; }
                    else { g = pg8::Gemm{ACT, (const bf16_t*)((const unsigned char*)Wl + W_DOWN_OFF), CHUNK, DM, DFF}; O = XH + (size_t)c * CHUNK * DM; }
                    pg8::StaticOrder S; S.init(g.M, g.N, G, bx);
                    pg8::EpiBf16<0> E{O, DM, nullptr, 0, 0, 1.f};
                    for (int rep = 0; rep < REP_PLAIN; ++rep) pg8::gemm_phase<pg8::EpiBf16<0>, pg8::StaticOrder, PG8_ALIGN, PG8_SP2>(ring, g, S, E);
#endif
                }
            }
        }
        if (ph + 1 < p.ph_hi) { for (int rep = 0; rep < REP_SYNC; ++rep) { if (MK_MULTI == 0 && ph != 0) xcd_barrier(xbar); else grid.sync(); } }
    }
}

extern "C" void kernel_launch(void* const* d_in, const int* in_sizes, int n_in, void* d_out, int out_size, void* d_ws, size_t ws_size, hipStream_t stream) {
    static int grid = 0;
    if (grid == 0) {
        if (n_in != 17 || out_size != MTOK * DM || ws_size < WS_END) { fprintf(stderr, "kernel_launch: unexpected shapes: n_in %d out %d ws %zu (need %zu)\n", n_in, out_size, ws_size, (size_t)WS_END); grid = -1; return; }
        int dev = 0, cus = 0, per_cu = 0;
        if (hipGetDevice(&dev) != hipSuccess || hipDeviceGetAttribute(&cus, hipDeviceAttributeMultiprocessorCount, dev) != hipSuccess) { grid = -1; return; }
        if (hipFuncSetAttribute((const void*)mega_fwd, hipFuncAttributeMaxDynamicSharedMemorySize, LDS_BYTES) != hipSuccess) { fprintf(stderr, "kernel_launch: hipFuncSetAttribute failed\n"); grid = -1; return; }
        if (hipOccupancyMaxActiveBlocksPerMultiprocessor(&per_cu, (const void*)mega_fwd, 512, LDS_BYTES) != hipSuccess || per_cu < 1) { fprintf(stderr, "kernel_launch: occupancy query says %d\n", per_cu); per_cu = 1; }
        (void)hipGetLastError();
        grid = cus * 1;
    }
    if (grid < 0) return;
    if (hipMemsetAsync((char*)d_ws + WS_BAR, 0, BAR_BYTES, stream) != hipSuccess) { fprintf(stderr, "kernel_launch: memset failed\n"); return; }
    Params p{};
    for (int i = 0; i < 17; ++i) p.in[i] = (const float*)d_in[i];
    p.out = (float*)d_out; p.ws = (unsigned char*)d_ws;
#if MK_MULTI
    for (int ph = 0; ph < NPHASE; ++ph) { p.ph_lo = ph; p.ph_hi = ph + 1; hipLaunchKernelGGL(mega_fwd, dim3(grid), dim3(512), LDS_BYTES, stream, p); }
#else
    p.ph_lo = 0; p.ph_hi = NPHASE;
    void* args[] = {&p};
    hipError_t e = hipLaunchCooperativeKernel((const void*)mega_fwd, dim3(grid), dim3(512), args, LDS_BYTES, stream);
    if (e != hipSuccess) fprintf(stderr, "cooperative launch failed: %s (grid %d)\n", hipGetErrorString(e), grid);
#endif
}
```

```cpp
#include <hip/hip_runtime.h>
#include <hip/hip_bf16.h>
#include <hip/hip_cooperative_groups.h>
#include <cstdio>
#include <cstdint>
#ifndef MK_MULTI
#define MK_MULTI 0
#endif
__device__ __forceinline__ int ltid() { int t = threadIdx.x; asm volatile("" : "+v"(t)); return t; }
#ifndef REP_UP
#define REP_UP 1
#endif
#ifndef REP_ATTN
#define REP_ATTN 1
#endif
#ifndef REP_PLAIN
#define REP_PLAIN 1
#endif
#ifndef REP_WIN
#define REP_WIN 1
#endif
#ifndef REP_P0
#define REP_P0 1
#endif
#ifndef REP_LIGHT
#define REP_LIGHT 1
#endif
#ifndef REP_SYNC
#define REP_SYNC 1
#endif
#ifndef REP_ROPE
#define REP_ROPE 1
#endif
#ifndef REP_RES
#define REP_RES 1
#endif
#ifndef REP_POOL
#define REP_POOL 1
#endif
#ifndef REP_BAR
#define REP_BAR 0
#endif
namespace pg8 {
#define PG8_LAS __attribute__((address_space(3)))
typedef unsigned short bf16_t;
typedef short bf16x8 __attribute__((ext_vector_type(8)));
typedef float f32x4 __attribute__((ext_vector_type(4)));
typedef unsigned u32x4 __attribute__((ext_vector_type(4)));
constexpr int BM = 256, BK = 64, HALF = 128, HTB = HALF * BK * 2  , STAGE_BYTES = 8 * HTB, NXCD = 8, WGM = 4;

__host__ __device__ __forceinline__ int lds_byte(int r, int c) { const int st = (r >> 4) * 2 + (c >> 5), rr = r & 15, cc = c & 31, ob = rr * 64 + cc * 2; return st * 1024 + (ob ^ (((ob >> 9) & 1) << 5)); }
__host__ __device__ __forceinline__ void stage_rc(int b, int& R, int& C) { const int st = b / 1024, sb = b % 1024, swz = sb ^ (((sb >> 9) & 1) << 5); R = (st >> 1) * 16 + swz / 64; C = (st & 1) * 32 + (swz % 64) / 2; }
__host__ __device__ __forceinline__ int perm32(int rho) { const int n = rho >> 4, i = rho & 15; return 8 * (i >> 2) + 4 * n + (i & 3); }

struct Unit { int pm, pn; };
struct Gemm { const bf16_t* A; const bf16_t* Bt; int M, N, K; };

struct StaticOrder {
    int nM, nN, nwg, G, c;
    __host__ __device__ void init(int M, int N, int G_, int c_) { nM = M / BM; nN = N / BM; nwg = nM * nN; G = G_; c = c_; }
    __host__ __device__ bool next(int i, Unit& u) const {
        const long L = (long)i * G + c; if (L >= nwg) return false;
        int wgid = (int)L; { const int q = nwg / NXCD, r = nwg % NXCD, xcd = wgid % NXCD, off = wgid / NXCD; wgid = (xcd < r ? xcd * (q + 1) : r * (q + 1) + (xcd - r) * q) + off; }
        const int nig = WGM * nN, gid = wgid / nig, fm = gid * WGM, gsz = (nM - fm) < WGM ? (nM - fm) : WGM;
        u.pm = fm + ((wgid % nig) % gsz); u.pn = (wgid % nig) / gsz; return true;
    }
    __device__ __forceinline__ void a_ready(const Unit&) const {}
    __device__ __forceinline__ void done(const Unit&) const {}
};

__device__ __forceinline__ unsigned cvt_pk_bf16(float lo, float hi) { unsigned r; asm volatile("v_cvt_pk_bf16_f32 %0, %1, %2" : "=v"(r) : "v"(lo), "v"(hi)); return r; }
typedef float f32x2 __attribute__((ext_vector_type(2)));
__device__ __forceinline__ f32x2 gelu_pk(f32x2 v) {
    const f32x2 av = __builtin_elementwise_abs(v), d = av * 0.2316418882f + 1.0f;
    f32x2 t; t.x = __builtin_amdgcn_rcpf(d.x); t.y = __builtin_amdgcn_rcpf(d.y);
    f32x2 q = t * 0.5307027145f + (-0.7265760135f); q = q * t + 0.7107068705f; q = q * t + (-0.142248368f); q = q * t + 0.127414796f; q = q * t;
    const f32x2 s = (v * v) * (-0.72134752044f);
    f32x2 e; e.x = __builtin_amdgcn_exp2f(s.x); e.y = __builtin_amdgcn_exp2f(s.y);
    const f32x2 m = v * (q * e), r = v - m;
    f32x2 o; o.x = v.x < 0.f ? m.x : r.x; o.y = v.y < 0.f ? m.y : r.y; return o;
}

template <int ACT  > struct EpiBf16 {
    static constexpr bool PERM = true, AFTER_DRAIN = false; static_assert(ACT == 0 || ACT == 1, "EpiBf16: ACT is 0 (none) or 1 (gelu_pk)");
    bf16_t* O; int ldc; const float* bias; int split_cols; size_t split_stride; float scale0;
    __device__ __forceinline__ void operator()(const f32x4 (&acc)[2][2][4][2], const Unit& u, int wr, int wc, int fr, int fq) const {
        const int row0 = u.pm * BM + wr * 64 + fr; int colt = u.pn * BM; bf16_t* base = O;
        float sc = 1.f; if (split_cols) { const int t = colt / split_cols; base += (size_t)t * split_stride; colt -= t * split_cols; if (t == 0) sc = scale0; }
        const int col0 = colt + wc * 32 + 8 * fq, bcol0 = u.pn * BM + wc * 32 + 8 * fq;
        f32x4 bv[2][2];
#pragma unroll
        for (int bj = 0; bj < 2; ++bj)
#pragma unroll
            for (int n = 0; n < 2; ++n) bv[bj][n] = bias ? *(const f32x4*)(bias + bcol0 + bj * HALF + 4 * n) : (f32x4){0.f, 0.f, 0.f, 0.f};
#pragma unroll
        for (int ai = 0; ai < 2; ++ai)
#pragma unroll
            for (int m = 0; m < 4; ++m) { bf16_t* rowp = base + (size_t)(row0 + ai * HALF + m * 16) * ldc + col0;
#pragma unroll
                for (int bj = 0; bj < 2; ++bj) { f32x4 v0 = acc[ai][bj][m][0] + bv[bj][0], v1 = acc[ai][bj][m][1] + bv[bj][1];
                    if (ACT == 1) { f32x2 a = gelu_pk((f32x2){v0[0], v0[1]}), b = gelu_pk((f32x2){v0[2], v0[3]}), c = gelu_pk((f32x2){v1[0], v1[1]}), d = gelu_pk((f32x2){v1[2], v1[3]});
                        v0 = (f32x4){a.x, a.y, b.x, b.y}; v1 = (f32x4){c.x, c.y, d.x, d.y}; }
                    v0 = v0 * sc; v1 = v1 * sc; u32x4 w; w.x = cvt_pk_bf16(v0[0], v0[1]); w.y = cvt_pk_bf16(v0[2], v0[3]); w.z = cvt_pk_bf16(v1[0], v1[1]); w.w = cvt_pk_bf16(v1[2], v1[3]);
                    *(u32x4*)(rowp + bj * HALF) = w; } }
    }
};
template <class Epi, class Sched, bool ALIGN_EPI = false, bool SP2 = false>
__device__ __forceinline__ void gemm_phase(PG8_LAS unsigned char* lds, const Gemm g, const Sched& S, const Epi& E) {
    const int tid = ltid(), wid = __builtin_amdgcn_readfirstlane(tid >> 6), lane = tid & 63, wr = wid >> 2, wc = wid & 3, fr = lane & 15, fq = lane >> 4;
    const int K = g.K, nt = K / BK;
    unsigned voffA[2], voffB[2];
#pragma unroll
    for (int i = 0; i < 2; ++i) { int R, C; stage_rc(tid * 16 + i * 8192, R, C); const int Rb = Epi::PERM ? ((R & ~31) + perm32(R & 31)) : R;
        voffA[i] = (unsigned)(R * K + C) * 2u; voffB[i] = (unsigned)(Rb * K + C) * 2u; }
    const size_t kstep = (size_t)(BK * 2);
    const size_t hstep = (size_t)HALF * K * 2;
    const size_t tstep = 2 * hstep;
    const unsigned ldsw = (unsigned)wid * 1024u;
    const int aoff = lds_byte(wr * 64 + fr, fq * 8), boff = lds_byte(wc * 32 + fr, fq * 8);
#define PG8_SA(b, h) (((b) * 2 + (h)) * HTB)
#define PG8_SB(b, h) ((4 + (b) * 2 + (h)) * HTB)
#define PG8_STAGE(bufoff, gbase, voff) do { _Pragma("unroll") for (int _i = 0; _i < 2; ++_i) \
        __builtin_amdgcn_global_load_lds((const unsigned*)((const char*)(gbase) + (voff)[_i]), (PG8_LAS unsigned*)(lds + (bufoff) + ldsw + _i * 8192), 16, 0, 0); } while (0)
#define PG8_LDA(dst, b, h) do { _Pragma("unroll") for (int m = 0; m < 4; ++m) _Pragma("unroll") for (int k = 0; k < 2; ++k) dst[m][k] = *(const PG8_LAS bf16x8*)(lds + PG8_SA(b, h) + aoff + m * 2048 + k * 1024); } while (0)
#define PG8_LDB(dst, b, h) do { _Pragma("unroll") for (int n = 0; n < 2; ++n) _Pragma("unroll") for (int k = 0; k < 2; ++k) dst[n][k] = *(const PG8_LAS bf16x8*)(lds + PG8_SB(b, h) + boff + n * 2048 + k * 1024); } while (0)
#define PG8_MMA(ai, bj, At, Bt) do { __builtin_amdgcn_s_setprio(1); _Pragma("unroll") for (int m = 0; m < 4; ++m) _Pragma("unroll") for (int n = 0; n < 2; ++n) _Pragma("unroll") for (int k = 0; k < 2; ++k) \
        acc[ai][bj][m][n] = __builtin_amdgcn_mfma_f32_16x16x32_bf16(Bt[n][k], At[m][k], acc[ai][bj][m][n], 0, 0, 0); __builtin_amdgcn_s_setprio(0); } while (0)
#define PG8_WAIT_V(n) asm volatile("s_waitcnt vmcnt(" #n ")" ::: "memory")
#define PG8_WAIT_L(n) asm volatile("s_waitcnt lgkmcnt(" #n ")" ::: "memory")
#define PG8_BAR __builtin_amdgcn_s_barrier()
#define PG8_SCHED __builtin_amdgcn_sched_barrier(0)
    Unit cur, nxt; int ui = 0;
    if (!S.next(0, cur)) return;
    f32x4 acc[2][2][4][2];
#pragma unroll
    for (int a = 0; a < 2; ++a)
#pragma unroll
        for (int b = 0; b < 2; ++b)
#pragma unroll
            for (int m = 0; m < 4; ++m)
#pragma unroll
                for (int n = 0; n < 2; ++n) acc[a][b][m][n] = (f32x4){0.f, 0.f, 0.f, 0.f};
    bf16x8 At[4][2], B0[2][2], B1[2][2];
    const char* cA = (const char*)g.A + (size_t)cur.pm * tstep; const char* cB = (const char*)g.Bt + (size_t)cur.pn * tstep;
    S.a_ready(cur);
    if constexpr (SP2) {
        PG8_STAGE(PG8_SB(0, 0), cB, voffB); PG8_STAGE(PG8_SB(0, 1), cB + hstep, voffB); PG8_STAGE(PG8_SA(0, 0), cA, voffA); PG8_STAGE(PG8_SA(0, 1), cA + hstep, voffA);
        if (wr == 1) PG8_BAR;
        PG8_WAIT_V(2); PG8_BAR;
        PG8_STAGE(PG8_SB(1, 0), cB + kstep, voffB); PG8_STAGE(PG8_SA(1, 0), cA + kstep, voffA); PG8_STAGE(PG8_SB(1, 1), cB + hstep + kstep, voffB);
        PG8_WAIT_V(6); PG8_BAR;
    } else {
        PG8_STAGE(PG8_SB(0, 0), cB, voffB); PG8_STAGE(PG8_SA(0, 0), cA, voffA); PG8_STAGE(PG8_SB(0, 1), cB + hstep, voffB); PG8_STAGE(PG8_SA(0, 1), cA + hstep, voffA);
        if (wr == 1) PG8_BAR;
        PG8_WAIT_V(4); PG8_BAR;
        PG8_STAGE(PG8_SB(1, 0), cB + kstep, voffB); PG8_STAGE(PG8_SA(1, 0), cA + kstep, voffA); PG8_STAGE(PG8_SB(1, 1), cB + hstep + kstep, voffB);
        PG8_WAIT_V(6); PG8_BAR;
    }
    for (;;) {
        const bool has_next = S.next(ui + 1, nxt);
        const char* nA = has_next ? (const char*)g.A + (size_t)nxt.pm * tstep : cA; const char* nB = has_next ? (const char*)g.Bt + (size_t)nxt.pn * tstep : cB;
        for (int t = 0; t < nt; t += 2) {
            const bool last = (t == nt - 2);
            const char* a1 = cA + (size_t)(t + 1) * kstep;
            const char* a2 = last ? nA : cA + (size_t)(t + 2) * kstep; const char* b2 = last ? nB : cB + (size_t)(t + 2) * kstep;
            const char* a3 = a2 + kstep; const char* b3 = b2 + kstep;
            if (last && has_next) S.a_ready(nxt);
            if constexpr (SP2) {
            PG8_LDB(B0, 0, 0); PG8_LDB(B1, 0, 1); PG8_SCHED; PG8_LDA(At, 0, 0); PG8_STAGE(PG8_SA(1, 1), a1 + hstep, voffA);
            PG8_WAIT_V(8); PG8_WAIT_L(0); PG8_BAR; PG8_MMA(0, 0, At, B0); PG8_MMA(0, 1, At, B1); PG8_BAR; PG8_SCHED;
            PG8_LDA(At, 0, 1); PG8_STAGE(PG8_SB(0, 0), b2, voffB); PG8_STAGE(PG8_SB(0, 1), b2 + hstep, voffB); PG8_STAGE(PG8_SA(0, 0), a2, voffA);
            PG8_WAIT_V(8); PG8_WAIT_L(0); PG8_BAR; PG8_MMA(1, 0, At, B0); PG8_MMA(1, 1, At, B1); PG8_BAR; PG8_SCHED;
            PG8_LDB(B0, 1, 0); PG8_LDB(B1, 1, 1); PG8_SCHED; PG8_LDA(At, 1, 0); PG8_STAGE(PG8_SA(0, 1), a2 + hstep, voffA);
            PG8_WAIT_V(8); PG8_WAIT_L(0); PG8_BAR; PG8_MMA(0, 0, At, B0); PG8_MMA(0, 1, At, B1); PG8_BAR; PG8_SCHED;
            PG8_LDA(At, 1, 1); PG8_STAGE(PG8_SB(1, 0), b3, voffB); PG8_STAGE(PG8_SB(1, 1), b3 + hstep, voffB); PG8_STAGE(PG8_SA(1, 0), a3, voffA);
            PG8_WAIT_V(8); PG8_WAIT_L(0); PG8_BAR; PG8_MMA(1, 0, At, B0); PG8_MMA(1, 1, At, B1); PG8_BAR; PG8_SCHED;
            } else {
            PG8_LDB(B0, 0, 0); PG8_SCHED; PG8_LDA(At, 0, 0); PG8_STAGE(PG8_SA(1, 1), a1 + hstep, voffA);
            PG8_WAIT_L(8); PG8_BAR; PG8_WAIT_L(0); PG8_MMA(0, 0, At, B0); PG8_BAR; PG8_SCHED;
            PG8_LDB(B1, 0, 1); PG8_STAGE(PG8_SB(0, 0), b2, voffB);
            PG8_BAR; PG8_WAIT_L(0); PG8_MMA(0, 1, At, B1); PG8_BAR;
            PG8_LDA(At, 0, 1); PG8_STAGE(PG8_SA(0, 0), a2, voffA);
            PG8_BAR; PG8_WAIT_L(0); PG8_MMA(1, 0, At, B0); PG8_BAR; PG8_SCHED;
            PG8_STAGE(PG8_SB(0, 1), b2 + hstep, voffB);
            PG8_WAIT_V(6); PG8_BAR; PG8_MMA(1, 1, At, B1); PG8_BAR;
            PG8_LDB(B0, 1, 0); PG8_SCHED; PG8_LDA(At, 1, 0); PG8_STAGE(PG8_SA(0, 1), a2 + hstep, voffA);
            PG8_WAIT_L(8); PG8_BAR; PG8_WAIT_L(0); PG8_MMA(0, 0, At, B0); PG8_BAR; PG8_SCHED;
            PG8_LDB(B1, 1, 1); PG8_STAGE(PG8_SB(1, 0), b3, voffB);
            PG8_BAR; PG8_WAIT_L(0); PG8_MMA(0, 1, At, B1); PG8_BAR;
            PG8_LDA(At, 1, 1); PG8_STAGE(PG8_SA(1, 0), a3, voffA);
            PG8_BAR; PG8_WAIT_L(0); PG8_MMA(1, 0, At, B0); PG8_BAR; PG8_SCHED;
            PG8_STAGE(PG8_SB(1, 1), b3 + hstep, voffB);
            PG8_WAIT_V(6); PG8_BAR; PG8_MMA(1, 1, At, B1); PG8_BAR;
            }
        }
        if constexpr (ALIGN_EPI) { if (wr == 0) PG8_BAR; }
        if constexpr (!Epi::AFTER_DRAIN) { E(acc, cur, wr, wc, fr, fq); S.done(cur); }
        if (!has_next) break;
#pragma unroll
        for (int a = 0; a < 2; ++a)
#pragma unroll
            for (int b = 0; b < 2; ++b)
#pragma unroll
                for (int m = 0; m < 4; ++m)
#pragma unroll
                    for (int n = 0; n < 2; ++n) acc[a][b][m][n] = (f32x4){0.f, 0.f, 0.f, 0.f};
        cur = nxt; cA = nA; cB = nB; ++ui;
        if constexpr (ALIGN_EPI) { if (wr == 1) PG8_BAR; }
    }
    PG8_WAIT_V(0);
    if constexpr (!ALIGN_EPI) { if (wr == 0) PG8_BAR; }
    PG8_BAR;
    if constexpr (Epi::AFTER_DRAIN) { E.fused(acc, cur, wr, wc, fr, fq, lds, wid, lane); S.done(cur); }
#undef PG8_SA
#undef PG8_SB
#undef PG8_STAGE
#undef PG8_LDA
#undef PG8_LDB
#undef PG8_MMA
#undef PG8_WAIT_V
#undef PG8_WAIT_L
#undef PG8_BAR
#undef PG8_SCHED
}
}
#define PG8_SP2 true
#define PG8_ALIGN true
namespace att {
using bf16 = __hip_bfloat16;
constexpr int   D = 128, NW = 8, QBLK = 32, KVBLK = 64;
constexpr float SCALE = 0.088388347648318440f;
constexpr float THR = 8.f;
constexpr int SDEPTH = 2;
constexpr bool STATIC_MAX = true;
constexpr int LDQ = 2048, LDK = 2048, LDO = 2048;
constexpr size_t SHM_V = KVBLK * D * 2, SHM_K = KVBLK * D * 2, SHM_ATTN = 2 * SHM_V + 2 * SHM_K + NW * 64 * 4;
using bf16x8 = __attribute__((ext_vector_type(8))) short;
using s16x4  = __attribute__((ext_vector_type(4))) short;
using f32x16 = __attribute__((ext_vector_type(16))) float;
using f32x8  = __attribute__((ext_vector_type(8))) float;
using u32x4  = __attribute__((ext_vector_type(4))) unsigned;
#define KSWZ(row, colB) ((row) * 256 + ((colB) ^ (((row) & 7) << 4)))
#define SBAR() __builtin_amdgcn_sched_barrier(0)
__device__ __forceinline__ int crow(int r, int hi) { return (r & 3) + 8 * (r >> 2) + 4 * hi; }
__device__ __forceinline__ unsigned cvtpk(float lo, float hi) {
  unsigned r; asm volatile("v_cvt_pk_bf16_f32 %0, %1, %2" : "=v"(r) : "v"(lo), "v"(hi)); return r;
}
template <typename TIn> struct Stage;
template <> struct Stage<bf16>  { using T = bf16x8;
  __device__ static __forceinline__ T ld8(const bf16* p) { return *reinterpret_cast<const bf16x8*>(p); }
  __device__ static __forceinline__ bf16x8 tobf(T x) { return x; } };
template <> struct Stage<float> { using T = f32x8;
  __device__ static __forceinline__ T ld8(const float* p) { return *reinterpret_cast<const f32x8*>(p); }
  __device__ static __forceinline__ bf16x8 tobf(T x) {
    u32x4 w = {cvtpk(x[0], x[1]), cvtpk(x[2], x[3]), cvtpk(x[4], x[5]), cvtpk(x[6], x[7])}; return *reinterpret_cast<bf16x8*>(&w); } };

template <bool SHIFT> __device__ __forceinline__ void partialSM(f32x16& p0, f32x16& p1, float& m_reg, float& mn, float& alpha) {
  constexpr float C = SCALE * 1.4426950408889634f;
  if constexpr (STATIC_MAX) { mn = m_reg; alpha = 1.f; }
  else {
  float pmax = p0[0]; for (int r = 1; r < 16; ++r) pmax = fmaxf(pmax, p0[r]); for (int r = 0; r < 16; ++r) pmax = fmaxf(pmax, p1[r]);
  { auto rr = __builtin_amdgcn_permlane32_swap(__float_as_uint(pmax), __float_as_uint(pmax), false, false);
    pmax = fmaxf(__uint_as_float(rr[0]), __uint_as_float(rr[1])); }
  if (__builtin_expect(__all(pmax - m_reg <= THR / SCALE), 1)) { mn = m_reg; alpha = 1.f; }
  else { mn = fmaxf(m_reg, pmax); alpha = __builtin_amdgcn_exp2f((m_reg - mn) * C); m_reg = mn; }
  }
  if constexpr (!STATIC_MAX) { float mnC = -mn * C;
  for (int r = 0; r < 16; ++r) p0[r] = fmaf(p0[r], C, mnC); for (int r = 0; r < 16; ++r) p1[r] = fmaf(p1[r], C, mnC); }
  if constexpr (STATIC_MAX && SHIFT) { for (int r = 0; r < 16; ++r) p0[r] += m_reg; for (int r = 0; r < 16; ++r) p1[r] += m_reg; }
  for (int r = 0; r < 16; ++r) p0[r] = __builtin_amdgcn_exp2f(p0[r]);
}
__device__ __forceinline__ void finishSM(f32x16& p0, f32x16& p1, float alpha, float& l_reg, bf16x8& pa0, bf16x8& pa1, bf16x8& pa2, bf16x8& pa3) {
  for (int r = 0; r < 16; ++r) p1[r] = __builtin_amdgcn_exp2f(p1[r]);
  float ps = 0; for (int r = 0; r < 16; ++r) ps += p0[r]; for (int r = 0; r < 16; ++r) ps += p1[r];
  { auto rr = __builtin_amdgcn_permlane32_swap(__float_as_uint(ps), __float_as_uint(ps), false, false);
    ps = __uint_as_float(rr[0]) + __uint_as_float(rr[1]); }
  l_reg = l_reg * alpha + ps;
#define PK4(P, BASE, OUT) do { unsigned a0 = cvtpk(P[BASE + 0], P[BASE + 1]), a1 = cvtpk(P[BASE + 2], P[BASE + 3]);   \
    unsigned b0 = cvtpk(P[BASE + 4], P[BASE + 5]), b1 = cvtpk(P[BASE + 6], P[BASE + 7]);                              \
    auto r0 = __builtin_amdgcn_permlane32_swap(a0, b0, false, false); auto r1 = __builtin_amdgcn_permlane32_swap(a1, b1, false, false); \
    u32x4 w = {r0[0], r1[0], r0[1], r1[1]}; OUT = *reinterpret_cast<bf16x8*>(&w); } while (0)
  PK4(p0, 0, pa0); PK4(p0, 8, pa1); PK4(p1, 0, pa2); PK4(p1, 8, pa3);
#undef PK4
}
__device__ __forceinline__ void qkt(f32x16& p0, f32x16& p1, const bf16* Ks, const bf16x8* qr, int r32, int hi) {
#pragma unroll
  for (int d0 = 0; d0 < 8; ++d0) { int cb = (d0 * 16 + hi * 8) * 2;
    bf16x8 b0 = *reinterpret_cast<const bf16x8*>((const char*)Ks + KSWZ(r32, cb));
    bf16x8 b1 = *reinterpret_cast<const bf16x8*>((const char*)Ks + KSWZ(32 + r32, cb));
    p0 = __builtin_amdgcn_mfma_f32_32x32x16_bf16(b0, qr[d0], d0 == 0 ? f32x16{} : p0, 0, 0, 0);
    p1 = __builtin_amdgcn_mfma_f32_32x32x16_bf16(b1, qr[d0], d0 == 0 ? f32x16{} : p1, 0, 0, 0); }
}
__device__ __forceinline__ int v_st(int k, int c) { const int kk = (k & ~0xC) | ((k & 4) << 1) | ((k & 8) >> 1); return ((kk >> 3) * 4 + (c >> 5)) * 512 + ((kk & 7) * 32 + (c & 31)) * 2; }
__device__ __forceinline__ int v_rd_base(int lane) { return ((lane & 3) << 3) | (((lane >> 2) & 3) << 6) | (((lane >> 4) & 1) << 5) | (((lane >> 5) & 1) << 8); }
constexpr int v_rd_off(int d0, int ks, int half) { return d0 * 512 + ks * 4096 + half * 2048; }
template <int OFF> __device__ __forceinline__ s16x4 tr_read(int vb) {
  s16x4 r; asm volatile("ds_read_b64_tr_b16 %0, %1 offset:%2" : "=&v"(r) : "v"(vb), "i"(OFF) : "memory"); return r;
}
template <int D0> __device__ __forceinline__ void pv_one(f32x16& od, int vb, bf16x8 pa0, bf16x8 pa1, bf16x8 pa2, bf16x8 pa3) {
  const s16x4 l0 = tr_read<v_rd_off(D0, 0, 0)>(vb), h0 = tr_read<v_rd_off(D0, 0, 1)>(vb), l1 = tr_read<v_rd_off(D0, 1, 0)>(vb), h1 = tr_read<v_rd_off(D0, 1, 1)>(vb);
  const s16x4 l2 = tr_read<v_rd_off(D0, 2, 0)>(vb), h2 = tr_read<v_rd_off(D0, 2, 1)>(vb), l3 = tr_read<v_rd_off(D0, 3, 0)>(vb), h3 = tr_read<v_rd_off(D0, 3, 1)>(vb);
  asm volatile("s_waitcnt lgkmcnt(0)" ::: "memory"); SBAR();
#define PK(L, H) (bf16x8){L[0], L[1], L[2], L[3], H[0], H[1], H[2], H[3]}
  od = __builtin_amdgcn_mfma_f32_32x32x16_bf16(pa0, PK(l0, h0), od, 0, 0, 0);
  od = __builtin_amdgcn_mfma_f32_32x32x16_bf16(pa1, PK(l1, h1), od, 0, 0, 0);
  od = __builtin_amdgcn_mfma_f32_32x32x16_bf16(pa2, PK(l2, h2), od, 0, 0, 0);
  od = __builtin_amdgcn_mfma_f32_32x32x16_bf16(pa3, PK(l3, h3), od, 0, 0, 0);
#undef PK
}
__device__ __forceinline__ void pv_d0(f32x16* o, int vb, bf16x8 pa0, bf16x8 pa1, bf16x8 pa2, bf16x8 pa3) {
  pv_one<0>(o[0], vb, pa0, pa1, pa2, pa3); pv_one<1>(o[1], vb, pa0, pa1, pa2, pa3); pv_one<2>(o[2], vb, pa0, pa1, pa2, pa3); pv_one<3>(o[3], vb, pa0, pa1, pa2, pa3);
}
template <typename TQ, bool SHIFT>
__device__ __forceinline__ void attn_dense_body(const TQ* __restrict__ Qb, const bf16* __restrict__ Kh, const bf16* __restrict__ Vh,
                                                bf16* __restrict__ Ob, int seq, char* lds, float bound) {
  using St = Stage<bf16>; using SQ = Stage<TQ>;
  const int tid = ltid(), wid = tid >> 6, lane = tid & 63, r32 = lane & 31, hi = lane >> 5;
  bf16* V_lds = (bf16*)lds; bf16* K_lds = (bf16*)(lds + 2 * SHM_V);
  float* ws = (float*)(lds + 2 * SHM_V + 2 * SHM_K) + wid * 64; float* li_l = ws; float* al_l = ws + 32;
  float m_reg = STATIC_MAX ? -bound * (SCALE * 1.4426950408889634f) : -1e30f, l_reg = 0; f32x16 o[4] = {}; bf16x8 qr[8];
  const TQ* Qw = Qb + (long)(wid * QBLK + r32) * LDQ + hi * 8;
#pragma unroll
  for (int d0 = 0; d0 < 8; ++d0) qr[d0] = SQ::tobf(SQ::ld8(Qw + d0 * 16));
  const int sr = tid >> 4, sc = (tid & 15) * 8, vst0 = v_st(sr, sc), vst1 = v_st(32 + sr, sc);
  const int vb0 = (int)(uintptr_t)V_lds + v_rd_base(lane);
  struct { typename St::T vs0, vs1, ks0, ks1; } sr_[SDEPTH];
#define SLOAD(i, k0) do { sr_[i].vs0 = St::ld8(&Vh[(long)((k0) + sr) * LDK + sc]); sr_[i].vs1 = St::ld8(&Vh[(long)((k0) + 32 + sr) * LDK + sc]); \
    sr_[i].ks0 = St::ld8(&Kh[(long)((k0) + sr) * LDK + sc]); sr_[i].ks1 = St::ld8(&Kh[(long)((k0) + 32 + sr) * LDK + sc]); } while (0)
#define SWRITE(b, i) do { *(bf16x8*)((char*)V_lds + (b) * SHM_V + vst0) = St::tobf(sr_[i].vs0);          \
    *(bf16x8*)((char*)V_lds + (b) * SHM_V + vst1) = St::tobf(sr_[i].vs1); int kc = sc * 2;               \
    *(bf16x8*)((char*)K_lds + (b) * SHM_K + KSWZ(sr, kc)) = St::tobf(sr_[i].ks0);                       \
    *(bf16x8*)((char*)K_lds + (b) * SHM_K + KSWZ(32 + sr, kc)) = St::tobf(sr_[i].ks1); } while (0)
#define SWAIT() do { if constexpr (SDEPTH == 2) asm volatile("s_waitcnt vmcnt(4)" ::: "memory"); else asm volatile("s_waitcnt vmcnt(0)" ::: "memory"); } while (0)
#define RESC(a) do { if (!STATIC_MAX && __any((a) < 1.f)) { if (hi == 0) al_l[r32] = (a); asm volatile("s_waitcnt lgkmcnt(0)" ::: "memory"); \
    for (int d = 0; d < 4; ++d) for (int r = 0; r < 16; ++r) o[d][r] *= al_l[crow(r, hi)]; } } while (0)
  f32x16 pA0, pA1, pB0, pB1; float mnA, mnB, alA, alB; bf16x8 pa0, pa1, pa2, pa3; const int NT = seq / KVBLK;
  constexpr int SE = 0, SO = SDEPTH - 1;
  SLOAD(SE, 0); asm volatile("s_waitcnt vmcnt(0)" ::: "memory"); SWRITE(0, SE); __syncthreads();
  qkt(pA0, pA1, K_lds, qr, r32, hi); partialSM<SHIFT>(pA0, pA1, m_reg, mnA, alA);
  SLOAD(SO, KVBLK); if constexpr (SDEPTH == 2) { if (2 < NT) SLOAD(SE, 2 * KVBLK); }
  SWAIT(); SWRITE(1, SO); __syncthreads();
  for (int j = 1; j + 1 < NT; j += 2) {
    SBAR(); qkt(pB0, pB1, (bf16*)((char*)K_lds + SHM_K), qr, r32, hi);
    finishSM(pA0, pA1, alA, l_reg, pa0, pa1, pa2, pa3); SBAR();
    SLOAD(SO, (j + SDEPTH) * KVBLK); SBAR();
    pv_d0(o, vb0, pa0, pa1, pa2, pa3); partialSM<SHIFT>(pB0, pB1, m_reg, mnB, alB);
    __syncthreads(); SWAIT(); SWRITE(0, SE);
    RESC(alB); __syncthreads();
    SBAR(); qkt(pA0, pA1, K_lds, qr, r32, hi);
    finishSM(pB0, pB1, alB, l_reg, pa0, pa1, pa2, pa3); SBAR();
    if (SDEPTH == 1 || j + 3 < NT) SLOAD(SE, (j + 1 + SDEPTH) * KVBLK); SBAR();
    pv_d0(o, vb0 + (int)SHM_V, pa0, pa1, pa2, pa3); partialSM<SHIFT>(pA0, pA1, m_reg, mnA, alA);
    __syncthreads(); SWAIT(); SWRITE(1, SO);
    RESC(alA); __syncthreads();
  }
  SBAR(); qkt(pB0, pB1, (bf16*)((char*)K_lds + SHM_K), qr, r32, hi);
  finishSM(pA0, pA1, alA, l_reg, pa0, pa1, pa2, pa3); SBAR();
  pv_d0(o, vb0, pa0, pa1, pa2, pa3); partialSM<SHIFT>(pB0, pB1, m_reg, mnB, alB);
  __syncthreads(); RESC(alB);
  finishSM(pB0, pB1, alB, l_reg, pa0, pa1, pa2, pa3); SBAR();
  pv_d0(o, vb0 + (int)SHM_V, pa0, pa1, pa2, pa3);
  if (hi == 0) li_l[r32] = l_reg; asm volatile("s_waitcnt lgkmcnt(0)" ::: "memory");
  float rli[16];
#pragma unroll
  for (int r = 0; r < 16; ++r) rli[r] = __builtin_amdgcn_rcpf(li_l[crow(r, hi)]);
  bf16* Ow = Ob + (long)(wid * QBLK) * LDO;
#pragma unroll
  for (int r = 0; r < 16; ++r) { int orow = crow(r, hi);
    for (int d0 = 0; d0 < 4; ++d0) Ow[(long)orow * LDO + d0 * 32 + r32] = __float2bfloat16(o[d0][r] * rli[r]); }
#undef SLOAD
#undef SWRITE
#undef SWAIT
#undef RESC
}

template <int NC> __device__ __forceinline__ void pv_n(f32x16* o, int vb, bf16x8 pa0, bf16x8 pa1, bf16x8 pa2, bf16x8 pa3) {
  pv_one<0>(o[0], vb, pa0, pa1, pa2, pa3);
  if constexpr (NC > 1) pv_one<1>(o[1], vb, pa0, pa1, pa2, pa3);
  if constexpr (NC > 2) { pv_one<2>(o[2], vb, pa0, pa1, pa2, pa3); pv_one<3>(o[3], vb, pa0, pa1, pa2, pa3); }
}
template <int MB, int NKT, class BR, class ST>
__device__ __forceinline__ void dft_unit(const bf16* __restrict__ A, int lda, const BR& br, const ST& st, char* lds) {
  constexpr int NBW = 8 / MB, NC = 4 / NBW;
  const int tid = ltid(), wid = tid >> 6, lane = tid & 63, r32 = lane & 31, hi = lane >> 5;
  const int mb = wid % MB, cgp = wid / MB;
  const int sr = tid >> 4, sc = (tid & 15) * 8, vst0 = v_st(sr, sc), vst1 = v_st(32 + sr, sc);
  bf16x8 bq[NKT][2], af[NKT][4];
#pragma unroll
  for (int kt = 0; kt < NKT; ++kt) {
    bq[kt][0] = *reinterpret_cast<const bf16x8*>(br.row(kt * 64 + sr) + sc);
    bq[kt][1] = *reinterpret_cast<const bf16x8*>(br.row(kt * 64 + 32 + sr) + sc);
  }
  const bf16* Aw = A + (long)(mb * 32 + r32) * lda + hi * 8;
#pragma unroll
  for (int kt = 0; kt < NKT; ++kt)
#pragma unroll
    for (int ks = 0; ks < 4; ++ks) af[kt][ks] = *reinterpret_cast<const bf16x8*>(Aw + kt * 64 + ks * 16);
  __syncthreads();
#pragma unroll
  for (int kt = 0; kt < NKT; ++kt) {
    *(bf16x8*)(lds + kt * 16384 + vst0) = bq[kt][0];
    *(bf16x8*)(lds + kt * 16384 + vst1) = bq[kt][1];
  }
  __syncthreads();
  f32x16 o[NC];
#pragma unroll
  for (int d = 0; d < NC; ++d) o[d] = f32x16{};
  const int vb = (int)(uintptr_t)lds + v_rd_base(lane) + cgp * NC * 512;
#pragma unroll
  for (int kt = 0; kt < NKT; ++kt) pv_n<NC>(o, vb + kt * 16384, af[kt][0], af[kt][1], af[kt][2], af[kt][3]);
  bf16* stg = (bf16*)(lds + 65536) + wid * 4096;
  const float sc_ = st.scale;
#pragma unroll
  for (int r = 0; r < 16; ++r) {
#pragma unroll
    for (int d = 0; d < NC; ++d) stg[crow(r, hi) * (NC * 32) + d * 32 + r32] = __float2bfloat16(o[d][r] * sc_);
  }
  asm volatile("s_waitcnt lgkmcnt(0)" ::: "memory");
#pragma unroll
  for (int i = 0; i < NC * 2; ++i) { const int idx = i * 64 + lane, row = idx / (NC * 4), cc = idx % (NC * 4);
    const u32x4 v = *(const u32x4*)(stg + row * (NC * 32) + cc * 8);
    st.store16(mb * 32 + row, cgp * NC * 32 + cc * 8, v); }
  asm volatile("s_waitcnt lgkmcnt(0)" ::: "memory");
}
#undef SBAR
#undef KSWZ
}

namespace cg = cooperative_groups;
#define LAS __attribute__((address_space(3)))
typedef unsigned short bf16_t;
typedef unsigned v4u __attribute__((ext_vector_type(4)));
typedef unsigned v2u __attribute__((ext_vector_type(2)));
typedef float f4 __attribute__((ext_vector_type(4)));

#define XB_TMO      128
#define XB_XCNT(j)  (256  + 64 * (j))
#define XB_XSUB(j)  (1280 + 64 * (j))
#define XB_XGEN(j)  (2304 + 64 * (j))
#define XB_TOP      3328
#define XB_TOPGEN   3392
#define XCD_BAR_WORDS 3456
#define XB_SPIN_CAP (1u << 18)

__device__ __forceinline__ unsigned xb_ld(unsigned* p)              { return __hip_atomic_load(p, __ATOMIC_RELAXED, __HIP_MEMORY_SCOPE_AGENT); }
__device__ __forceinline__ unsigned xb_add(unsigned* p, unsigned v) { return __hip_atomic_fetch_add(p, v, __ATOMIC_RELAXED, __HIP_MEMORY_SCOPE_AGENT); }
__device__ __forceinline__ unsigned xb_xcc_id() { return (unsigned)__builtin_amdgcn_s_getreg((3 << 11) | 20) & 0xFu; }
#define XB_SPIN(cond, bar) do { unsigned _sp = 0; while (cond) { __builtin_amdgcn_s_sleep(1); \
    if ((++_sp & 255u) == 0u) { if (xb_ld(&(bar)[XB_TMO])) break; if (_sp > XB_SPIN_CAP) { atomicAdd(&(bar)[XB_TMO], 1u); break; } } } } while (0)

struct XcdBarrier {
    unsigned* bar; unsigned x;
    volatile LAS unsigned* st;
};

__device__ __forceinline__ XcdBarrier xcd_barrier_post(unsigned* bar, volatile LAS unsigned* st) {
    XcdBarrier b; b.bar = bar; b.x = xb_xcc_id(); b.st = st;
    if (threadIdx.x == 0) (void)xb_add(&bar[XB_XCNT(b.x)], 1u);
    return b;
}
__device__ __forceinline__ void xcd_barrier_complete(unsigned* bar, unsigned x, unsigned& nloc, unsigned& nx) {
    const unsigned G = gridDim.x * gridDim.y * gridDim.z;
    unsigned sum, cnt, mine, sp = 0u;
    for (;;) {
        sum = 0u; cnt = 0u; mine = 0u;
#pragma unroll
        for (unsigned j = 0; j < 16; ++j) { const unsigned c = xb_ld(&bar[XB_XCNT(j)]); sum += c; cnt += (c > 0u) ? 1u : 0u; mine = (j == x) ? c : mine; }
        if (sum == G) break;
        __builtin_amdgcn_s_sleep(1);
        if ((++sp & 255u) == 0u) { if (xb_ld(&bar[XB_TMO])) break; if (sp > XB_SPIN_CAP) { atomicAdd(&bar[XB_TMO], 1u); break; } }
    }
    nloc = mine > 0u ? mine : 1u; nx = cnt > 0u ? cnt : 1u;
}

__device__ __forceinline__ void xcd_barrier(const XcdBarrier& b) {
    asm volatile("s_waitcnt vmcnt(0)" ::: "memory");
    __syncthreads();
    if (threadIdx.x == 0) {
        unsigned* bar = b.bar;
        __builtin_amdgcn_s_waitcnt(0);
        unsigned nloc = b.st[0], nx = b.st[1];
        if (nloc == 0u) { xcd_barrier_complete(bar, b.x, nloc, nx); b.st[0] = nloc; b.st[1] = nx; }
        const unsigned old = xb_add(&bar[XB_XSUB(b.x)], 1u);
        const unsigned gen = old / nloc;
        if (old + 1u == (gen + 1u) * nloc) {
            __builtin_amdgcn_fence(__ATOMIC_RELEASE, "agent");
            asm volatile("s_waitcnt vmcnt(0)" ::: "memory");
            const unsigned og = xb_add(&bar[XB_TOP], 1u);
            const unsigned tg = og / nx;
            if (og + 1u == (tg + 1u) * nx) xb_add(&bar[XB_TOPGEN], 1u);
            else XB_SPIN(xb_ld(&bar[XB_TOPGEN]) == tg, bar);
            __builtin_amdgcn_fence(__ATOMIC_ACQUIRE, "agent");
            xb_add(&bar[XB_XGEN(b.x)], 1u);
            asm volatile("s_waitcnt vmcnt(0)" ::: "memory");
        } else {
            XB_SPIN(xb_ld(&bar[XB_XGEN(b.x)]) == gen, bar);
            __builtin_amdgcn_fence(__ATOMIC_ACQUIRE, "agent");
            asm volatile("s_waitcnt vmcnt(0)" ::: "memory");
        }
    }
    __syncthreads();
}

constexpr int DM = 2048, MTOK = 65536, NIN = 3072, DFF = 5632, NUP = 11264, WINW = 2560;
constexpr int NPROMPT = 32768;
constexpr int CHUNK = 65536, NCHUNK = 1;
constexpr float EPS = 1e-6f;
constexpr size_t MiB = (size_t)1 << 20;
constexpr size_t WS_M2F = 0;
constexpr size_t WS_COS = 1 * MiB, WS_SIN = 5 * MiB;
constexpr size_t WS_A1P = 9 * MiB, WS_A1S = 9 * MiB + 128 * 1024;
constexpr size_t WS_A3P = 10 * MiB, WS_A3S = 18 * MiB;
constexpr size_t WS_BAR = 19 * MiB, BAR_BYTES = 16384;
constexpr size_t WS_W = 20 * MiB;
constexpr size_t W_LAYER = 86 * MiB, W_OUT_OFF = 12 * MiB, W_UP_OFF = 20 * MiB, W_DOWN_OFF = 64 * MiB;
constexpr size_t WS_XH = 192 * MiB;
constexpr size_t WS_Z = 448 * MiB;
constexpr size_t WS_G = 704 * MiB;
constexpr size_t WS_Y = 832 * MiB;
constexpr size_t WS_ACT = 448 * MiB;
constexpr size_t WS_HB = 1152 * MiB;
constexpr size_t WS_XB = 1240 * MiB;
constexpr size_t WS_END = 1496 * MiB;
constexpr int LDS_BYTES = 135168;

__device__ __forceinline__ float bf2f(unsigned short b) { return __uint_as_float((unsigned)b << 16); }
__device__ __forceinline__ float bflo(unsigned w) { return __uint_as_float(w << 16); }
__device__ __forceinline__ float bfhi(unsigned w) { return __uint_as_float(w & 0xffff0000u); }
__device__ __forceinline__ unsigned pk2(float lo, float hi) { return pg8::cvt_pk_bf16(lo, hi); }
__device__ __forceinline__ float wave_sum(float v) {
#pragma unroll
    for (int o = 1; o < 64; o <<= 1) v += __shfl_xor(v, o);
    return v;
}

struct EpiWin {
    static constexpr bool PERM = true, AFTER_DRAIN = false;
    bf16_t* Z; bf16_t* Gp;
    __device__ __forceinline__ void operator()(const pg8::f32x4 (&acc)[2][2][4][2], const pg8::Unit& u, int wr, int wc, int fr, int fq) const {
        const int row0 = u.pm * pg8::BM + wr * 64 + fr;
        bf16_t* base; size_t rstride, bjstride;
        if (u.pn < 8) { base = Z + (size_t)row0 * 2048 + u.pn * 256 + wc * 32 + 8 * fq; rstride = 2048; bjstride = 128; }
        else {
            const int g = u.pn - 8, r0 = u.pm * pg8::BM; size_t sb; int L, t0;
            if (r0 < NPROMPT) { const int s = r0 >> 14; sb = (size_t)s * (2u * 16384u * 512u); L = 16384; t0 = row0 - s * 16384; }
            else { const int s = (r0 - NPROMPT) >> 12; sb = (size_t)NPROMPT * 1024 + (size_t)s * (2u * 4096u * 512u); L = 4096; t0 = row0 - NPROMPT - s * 4096; }
            base = Gp + sb + (size_t)t0 * 512 + g * 128 + wc * 32 + 8 * fq; rstride = 512; bjstride = (size_t)L * 512;
        }
#pragma unroll
        for (int ai = 0; ai < 2; ++ai)
#pragma unroll
            for (int m = 0; m < 4; ++m) { bf16_t* rowp = base + (size_t)(ai * pg8::HALF + m * 16) * rstride;
#pragma unroll
                for (int bj = 0; bj < 2; ++bj) { const pg8::f32x4 v0 = acc[ai][bj][m][0], v1 = acc[ai][bj][m][1];
                    pg8::u32x4 w; w.x = pk2(v0[0], v0[1]); w.y = pk2(v0[2], v0[3]); w.z = pk2(v1[0], v1[1]); w.w = pk2(v1[2], v1[3]);
                    *(pg8::u32x4*)(rowp + bj * bjstride) = w; } }
    }
};

__device__ __forceinline__ void p0a_tables(const float* fourier_w, unsigned char* ws, LAS float* tab, int gtid, int NT) {
    float* M2F = (float*)(ws + WS_M2F);
    { const int t = ltid(); if (t < 128) { float sn, cs; sincospif((float)t * (2.f / 128.f), &sn, &cs); tab[t] = cs; tab[128 + t] = -sn; } }
    __syncthreads();
    for (int i = gtid; i < 2 * 4 * 128 * 256; i += NT) {
        const int lg = i >> 15, c = (i >> 8) & 127, n = i & 255, part = n >> 7, e2 = n & 127;
        const float* fw = fourier_w + (size_t)lg * 16384 + e2;
        float acc = 0.f;
#pragma unroll 8
        for (int e = 0; e < 128; ++e) { const int r = (c * e) & 127; acc += tab[part * 128 + r] * fw[e * 128]; }
        M2F[i] = acc;
    }
    __syncthreads();
    float* COS = (float*)(ws + WS_COS); float* SIN = (float*)(ws + WS_SIN);
    for (int i = gtid; i < 16384 * 64; i += NT) {
        const int t = i >> 6, j = i & 63; const float pos = (float)(j < 32 ? (t >> 6) : (t & 63));
        const float inv = 1.0f / powf(10000.0f, (float)(j & 31) / 32.0f); const float ang = pos * inv;
        COS[i] = cosf(ang); SIN[i] = sinf(ang);
    }
    bf16_t* A1P = (bf16_t*)(ws + WS_A1P);
    for (int i = gtid; i < 256 * 256; i += NT) { const int m = i >> 8, k = i & 255, pm = m >> 7, k1 = m & 127, pk = k >> 7, t1 = k & 127; const int r = (t1 * k1) & 127;
        float sn, cs; sincospif((float)r * (2.f / 128.f), &sn, &cs); const float v = (pm == pk) ? cs : (pm == 0 ? sn : -sn); A1P[i] = (bf16_t)(pk2(v, 0.f) & 0xffff); }
    bf16_t* A1S = (bf16_t*)(ws + WS_A1S);
    for (int i = gtid; i < 128 * 128; i += NT) { const int m = i >> 7, k = i & 127, pm = m >> 6, k1 = m & 63, pk = k >> 6, t1 = k & 63; const int r = (t1 * k1) & 63;
        float sn, cs; sincospif((float)r * (2.f / 64.f), &sn, &cs); const float v = (pm == pk) ? cs : (pm == 0 ? sn : -sn); A1S[i] = (bf16_t)(pk2(v, 0.f) & 0xffff); }
    bf16_t* A3P = (bf16_t*)(ws + WS_A3P);
    for (int i = gtid; i < 128 * 128 * 256; i += NT) { const int k1 = i >> 15, k2 = (i >> 8) & 127, kk = i & 255, part = kk >> 7, t2 = kk & 127; const int k = k1 + 128 * k2; const int r = (t2 * k) & 16383;
        float sn, cs; sincospif((float)r * (1.f / 8192.f), &sn, &cs); A3P[i] = (bf16_t)(pk2(part ? sn : cs, 0.f) & 0xffff); }
    bf16_t* A3S = (bf16_t*)(ws + WS_A3S);
    for (int i = gtid; i < 64 * 64 * 128; i += NT) { const int k1 = i >> 13, k2 = (i >> 7) & 63, kk = i & 127, part = kk >> 6, t2 = kk & 63; const int k = k1 + 64 * k2; const int r = (t2 * k) & 4095;
        float sn, cs; sincospif((float)r * (1.f / 2048.f), &sn, &cs); A3S[i] = (bf16_t)(pk2(part ? sn : cs, 0.f) & 0xffff); }
}

struct ValUp { const float* W; __device__ __forceinline__ const float* ptr(int k, int n) const { const int src = ((n >> 7) & 1) * DFF + (n >> 8) * 128 + (n & 127); return W + (size_t)k * NUP + src; }
    __device__ __forceinline__ float operator()(int k, int n) const { return *ptr(k, n); } };
struct ValDirect { const float* W; int ldw; __device__ __forceinline__ const float* ptr(int k, int n) const { return W + (size_t)k * ldw + n; }
    __device__ __forceinline__ float operator()(int k, int n) const { return W[(size_t)k * ldw + n]; } };
struct ValWin { const float* win; const float* poolw; const float* pscale; const float* m2f;
    __device__ __forceinline__ const float* ptr(int k, int n) const { return win + (size_t)k * WINW + n; }
    __device__ __forceinline__ float operator()(int k, int n) const {
        if (n >= 512 && n < 2048) return win[(size_t)k * WINW + n];
        if (n < 512) { const int g = n >> 7, e = n & 127; const float* wr = win + (size_t)k * WINW + g * 128; const float* pw = poolw + g * 16384 + e; float acc = 0.f;
            for (int c = 0; c < 128; ++c) acc += wr[c] * pw[c * 128]; return acc * pscale[n]; }
        const int n2 = n - 2048, g = n2 >> 8, np = n2 & 255; const float* wr = win + (size_t)k * WINW + 2048 + g * 128; const float* mf = m2f + g * 32768 + np; float acc = 0.f;
        for (int c = 0; c < 128; ++c) acc += wr[c] * mf[c * 256]; return acc; } };
template <class F> __device__ __forceinline__ void transpose_item(const F& val, int K, bf16_t* WT, int k0, int n0, LAS float* scr, int lane) {
    for (int i = 0; i < 32; ++i) { const int kk = 2 * i + (lane >> 5); scr[kk * 33 + (lane & 31)] = val(k0 + kk, n0 + (lane & 31)); }
    asm volatile("s_waitcnt lgkmcnt(0)" ::: "memory");
    const int c = lane & 7;
#pragma unroll
    for (int j = 0; j < 4; ++j) { const int n = (lane >> 3) + 8 * j; const LAS float* s = scr + (8 * c) * 33 + n;
        v4u o; o.x = pk2(s[0 * 33], s[1 * 33]); o.y = pk2(s[2 * 33], s[3 * 33]); o.z = pk2(s[4 * 33], s[5 * 33]); o.w = pk2(s[6 * 33], s[7 * 33]);
        *(v4u*)(WT + (size_t)(n0 + n) * K + k0 + 8 * c) = o; }
    asm volatile("s_waitcnt lgkmcnt(0)" ::: "memory");
}
template <class F> __device__ __forceinline__ void tr_load(const F& f, int k0, int n0, int lane, f4 (&v)[8]) {
#pragma unroll
    for (int i = 0; i < 8; ++i) v[i] = __builtin_nontemporal_load((const f4*)f.ptr(k0 + 8 * i + (lane >> 3), n0 + 4 * (lane & 7)));
}
__device__ __forceinline__ void tr_store(const f4 (&v)[8], int K, bf16_t* WT, int k0, int n0, LAS float* scr, int lane) {
#pragma unroll
    for (int i = 0; i < 8; ++i) { LAS float* d = scr + (8 * i + (lane >> 3)) * 33 + 4 * (lane & 7); d[0] = v[i].x; d[1] = v[i].y; d[2] = v[i].z; d[3] = v[i].w; }
    asm volatile("s_waitcnt lgkmcnt(0)" ::: "memory");
    const int c = lane & 7;
#pragma unroll
    for (int j = 0; j < 4; ++j) { const int n = (lane >> 3) + 8 * j; const LAS float* s = scr + (8 * c) * 33 + n;
        v4u o; o.x = pk2(s[0 * 33], s[1 * 33]); o.y = pk2(s[2 * 33], s[3 * 33]); o.z = pk2(s[4 * 33], s[5 * 33]); o.w = pk2(s[6 * 33], s[7 * 33]);
        *(v4u*)(WT + (size_t)(n0 + n) * K + k0 + 8 * c) = o; }
    asm volatile("s_waitcnt lgkmcnt(0)" ::: "memory");
}
template <class F> __device__ __forceinline__ void transpose_matrix(const F& val, int K, int N, bf16_t* WT, LAS float* scr, int gw, int NGW, int lane, int nlo, int nhi) {
    const int nblk = (nhi - nlo) / 32, nitems = (K / 64) * nblk;
    int it = gw; if (it >= nitems) return;
    f4 cur[8], nxt[8];
    tr_load(val, 64 * (it / nblk), nlo + 32 * (it % nblk), lane, cur);
    for (; it < nitems; it += NGW) {
        const int k0 = 64 * (it / nblk), n0 = nlo + 32 * (it % nblk); const int it2 = it + NGW; const bool more = it2 < nitems;
        if (more) tr_load(val, 64 * (it2 / nblk), nlo + 32 * (it2 % nblk), lane, nxt);
        tr_store(cur, K, WT, k0, n0, scr, lane);
        if (more) {
#pragma unroll
            for (int i = 0; i < 8; ++i) cur[i] = nxt[i]; }
    }
}

typedef float __attribute__((address_space(4))) cf32;
__device__ __forceinline__ void fold_items(const float* win, const float* poolw, const float* pscale, const float* m2f, bf16_t* WT, int gw, int NGW, int lane) {
    for (int it = gw; it < 64 * 24; it += NGW) {
        const int kb = it / 24, nb = it - kb * 24, k0 = 32 * kb;
        float m2[128]; int base, nout;
        if (nb < 8) { const int n = nb * 64 + lane, g = nb >> 1, e = n & 127; base = g * 128; nout = n; const float sc = pscale[n]; const float* pw = poolw + g * 16384 + e;
#pragma unroll
            for (int c = 0; c < 128; ++c) m2[c] = pw[c * 128] * sc;
        } else { const int n2 = (nb - 8) * 64 + lane, g = (nb - 8) >> 2, np = n2 & 255; base = 2048 + g * 128; nout = 2048 + n2; const float* mf = m2f + g * 32768 + np;
#pragma unroll
            for (int c = 0; c < 128; ++c) m2[c] = mf[c * 256];
        }
        bf16_t* wrow = WT + (size_t)nout * DM + k0;
        for (int kg = 0; kg < 4; ++kg) {
            float acc[8];
#pragma unroll
            for (int kk = 0; kk < 8; ++kk) { const cf32* wr = (const cf32*)(unsigned long long)(win + (size_t)(k0 + 8 * kg + kk) * WINW + base); float a = 0.f;
#pragma unroll
                for (int c = 0; c < 128; ++c) a += wr[c] * m2[c];
                acc[kk] = a; }
            v4u o; o.x = pk2(acc[0], acc[1]); o.y = pk2(acc[2], acc[3]); o.z = pk2(acc[4], acc[5]); o.w = pk2(acc[6], acc[7]);
            *(v4u*)(wrow + 8 * kg) = o;
        }
    }
}

__device__ __forceinline__ const float* xrow_ptr(const float* xa, const float* xb, int row) { return (row < NPROMPT) ? xa + (size_t)row * DM : xb + (size_t)(row - NPROMPT) * DM; }
template <bool XBF, bool OBF, int RR>
__device__ __forceinline__ void resid_rows(const float* xa, const float* xb, const bf16_t* xbf, const bf16_t* m, const float* g1, float* xout, bf16_t* xbout, bf16_t* xh, const float* g2, int gw, int NGW, int lane) {
    for (int row0 = gw; row0 < MTOK; row0 += RR * NGW) {
        f4 xf[XBF ? 1 : RR][8]; v2u xp[XBF ? RR : 1][8]; v2u mw[RR][8];
#pragma unroll
        for (int u = 0; u < RR; ++u) { const int row = row0 + u * NGW;
            if constexpr (XBF) { const bf16_t* xr = xbf + (size_t)row * DM;
#pragma unroll
                for (int j = 0; j < 8; ++j) xp[u][j] = __builtin_nontemporal_load((const v2u*)(xr + 4 * lane + 256 * j));
            } else { const float* xr = xrow_ptr(xa, xb, row);
#pragma unroll
                for (int j = 0; j < 8; ++j) xf[u][j] = __builtin_nontemporal_load((const f4*)(xr + 4 * lane + 256 * j)); } }
        if (m) {
#pragma unroll
            for (int u = 0; u < RR; ++u) { const bf16_t* mr = m + (size_t)(row0 + u * NGW) * DM;
#pragma unroll
                for (int j = 0; j < 8; ++j) mw[u][j] = __builtin_nontemporal_load((const v2u*)(mr + 4 * lane + 256 * j)); }
        }
#pragma unroll
        for (int u = 0; u < RR; ++u) { const int row = row0 + u * NGW;
            f4 xv[8];
#pragma unroll
            for (int j = 0; j < 8; ++j) { if constexpr (XBF) { const v2u w = xp[u][j]; xv[j] = (f4){bflo(w.x), bfhi(w.x), bflo(w.y), bfhi(w.y)}; } else xv[j] = xf[u][j]; }
            if (m) { float ss = 0.f;
#pragma unroll
                for (int j = 0; j < 8; ++j) { const v2u w = mw[u][j]; const f4 mv = (f4){bflo(w.x), bfhi(w.x), bflo(w.y), bfhi(w.y)}; ss += (mv.x * mv.x + mv.y * mv.y) + (mv.z * mv.z + mv.w * mv.w); }
                const float r = 1.0f / sqrtf(wave_sum(ss) * (1.f / DM) + EPS);
#pragma unroll
                for (int j = 0; j < 8; ++j) { const v2u w = mw[u][j]; const f4 mv = (f4){bflo(w.x), bfhi(w.x), bflo(w.y), bfhi(w.y)}; const f4 gv = *(const f4*)(g1 + 4 * lane + 256 * j); xv[j] += mv * r * gv; } }
            if constexpr (OBF) { if (xbout) {
#pragma unroll
                for (int j = 0; j < 8; ++j) { v2u w; w.x = pk2(xv[j].x, xv[j].y); w.y = pk2(xv[j].z, xv[j].w); __builtin_nontemporal_store(w, (v2u*)(xbout + (size_t)row * DM + 4 * lane + 256 * j)); } }
            } else { if (xout) {
#pragma unroll
                for (int j = 0; j < 8; ++j) __builtin_nontemporal_store(xv[j], (f4*)(xout + (size_t)row * DM + 4 * lane + 256 * j)); } }
            if (xh) { float ss = 0.f;
#pragma unroll
                for (int j = 0; j < 8; ++j) ss += (xv[j].x * xv[j].x + xv[j].y * xv[j].y) + (xv[j].z * xv[j].z + xv[j].w * xv[j].w);
                const float r = 1.0f / sqrtf(wave_sum(ss) * (1.f / DM) + EPS);
#pragma unroll
                for (int j = 0; j < 8; ++j) { const f4 gv = *(const f4*)(g2 + 4 * lane + 256 * j); const f4 y = xv[j] * r * gv;
                    v2u w; w.x = pk2(y.x, y.y); w.y = pk2(y.z, y.w); *(v2u*)(xh + (size_t)row * DM + 4 * lane + 256 * j) = w; } }
        }
    }
}

__device__ __forceinline__ void rope_pass(bf16_t* Z, bf16_t* Zout, const float* qn, const float* kn, const float* COS, const float* SIN, int gtid, int NT) {
    const int hw = gtid >> 5, NHW = NT >> 5, j = gtid & 31;
    constexpr float QC = 0.088388347648318440f * 1.4426950408889634f;
    const float qa0 = qn[2 * j] * QC, qa1 = qn[2 * j + 1] * QC, qb0 = qn[64 + 2 * j] * QC, qb1 = qn[65 + 2 * j] * QC;
    const float ka0 = kn[2 * j], ka1 = kn[2 * j + 1], kb0 = kn[64 + 2 * j], kb1 = kn[65 + 2 * j];
    for (int row = hw; row < MTOK; row += NHW) {
        const int t = row < NPROMPT ? (row & 16383) : (row & 4095);
        bf16_t* p = Z + (size_t)row * DM + 512 + 2 * j;
        unsigned a[10], b[10];
#pragma unroll
        for (int hh = 0; hh < 10; ++hh) { a[hh] = *(const unsigned*)(p + hh * 128); b[hh] = *(const unsigned*)(p + hh * 128 + 64); }
        const float c0 = COS[t * 64 + 2 * j], c1 = COS[t * 64 + 2 * j + 1], s0 = SIN[t * 64 + 2 * j], s1 = SIN[t * 64 + 2 * j + 1];
#pragma unroll
        for (int hh = 0; hh < 10; ++hh) {
            float x0 = bflo(a[hh]), x1 = bfhi(a[hh]), y0 = bflo(b[hh]), y1 = bfhi(b[hh]);
            float ss = (x0 * x0 + x1 * x1) + (y0 * y0 + y1 * y1);
#pragma unroll
            for (int o = 1; o < 32; o <<= 1) ss += __shfl_xor(ss, o);
            const float r = 1.0f / sqrtf(ss * (1.f / 128.f) + EPS);
            x0 *= r * (hh < 8 ? qa0 : ka0); x1 *= r * (hh < 8 ? qa1 : ka1); y0 *= r * (hh < 8 ? qb0 : kb0); y1 *= r * (hh < 8 ? qb1 : kb1);
            const float ox0 = x0 * c0 - y0 * s0, oy0 = y0 * c0 + x0 * s0, ox1 = x1 * c1 - y1 * s1, oy1 = y1 * c1 + x1 * s1;
            bf16_t* po = Zout + (size_t)row * DM + 512 + 2 * j;
            *(unsigned*)(po + hh * 128) = pk2(ox0, ox1); *(unsigned*)(po + hh * 128 + 64) = pk2(oy0, oy1);
        }
    }
}

__device__ __forceinline__ void acc8(float* s, const bf16_t* p, float sg) { const v4u v = *(const v4u*)p;
    s[0] += sg * bflo(v.x); s[1] += sg * bfhi(v.x); s[2] += sg * bflo(v.y); s[3] += sg * bfhi(v.y); s[4] += sg * bflo(v.z); s[5] += sg * bfhi(v.z); s[6] += sg * bflo(v.w); s[7] += sg * bfhi(v.w); }
__device__ __forceinline__ void pool_pass(const bf16_t* Z, bf16_t* H, int gtid, int NT) {
    constexpr int RL = 32;
    for (int it = gtid; it < (MTOK / RL) * 64; it += NT) {
        const int ch = it & 63, run = it >> 6, c0 = ch * 8, g = ch >> 4, w = 2 << g, a = w >> 1, b = w - 1 - a;
        const int row0 = run * RL; int t0, L; if (row0 < NPROMPT) { t0 = row0 & 16383; L = 16384; } else { t0 = row0 & 4095; L = 4096; }
        const bf16_t* zb = Z + (size_t)(row0 - t0) * DM + c0;
        float s[8] = {0.f, 0.f, 0.f, 0.f, 0.f, 0.f, 0.f, 0.f};
        { const int lo = t0 - a < 0 ? 0 : t0 - a, hi = t0 + b > L - 1 ? L - 1 : t0 + b;
          for (int tt = lo; tt <= hi; ++tt) acc8(s, zb + (size_t)tt * DM, 1.f); }
#pragma unroll 4
        for (int r = 0; r < RL; ++r) {
            const int t = t0 + r; const int lo = t - a < 0 ? 0 : t - a, hi = t + b > L - 1 ? L - 1 : t + b;
            const float ic = 1.0f / (float)(hi - lo + 1);
            const v4u v = *(const v4u*)(zb + (size_t)t * DM);
            v4u o; o.x = pk2(s[0] * ic - bflo(v.x), s[1] * ic - bfhi(v.x)); o.y = pk2(s[2] * ic - bflo(v.y), s[3] * ic - bfhi(v.y));
            o.z = pk2(s[4] * ic - bflo(v.z), s[5] * ic - bfhi(v.z)); o.w = pk2(s[6] * ic - bflo(v.w), s[7] * ic - bfhi(v.w));
            *(v4u*)(H + (size_t)(row0 + r) * DM + c0) = o;
            if (t + 1 + b <= L - 1) acc8(s, zb + (size_t)(t + 1 + b) * DM, 1.f);
            if (t - a >= 0) acc8(s, zb + (size_t)(t - a) * DM, -1.f);
        }
    }
}

__device__ __forceinline__ float gelu_tanh(float x) { const float y = 0.7978845608028654f * (x + 0.044715f * x * x * x); return x * __builtin_amdgcn_rcpf(1.0f + __expf(-2.0f * y)); }
__device__ __forceinline__ void ld8f(const bf16_t* p, float* o) { const v4u v = *(const v4u*)p; o[0] = bflo(v.x); o[1] = bfhi(v.x); o[2] = bflo(v.y); o[3] = bfhi(v.y); o[4] = bflo(v.z); o[5] = bfhi(v.z); o[6] = bflo(v.w); o[7] = bfhi(v.w); }
__device__ __forceinline__ float dpp_ror1(float v) { return __int_as_float(__builtin_amdgcn_update_dpp(0, __float_as_int(v), 0x121, 0xf, 0xf, false)); }
__device__ __forceinline__ float dpp_ror15(float v) { return __int_as_float(__builtin_amdgcn_update_dpp(0, __float_as_int(v), 0x12F, 0xf, 0xf, false)); }
struct EpiGlu {
    static constexpr bool PERM = true, AFTER_DRAIN = false;
    bf16_t* ACT; bf16_t* HB; const float* cw; const float* cb;
    __device__ __forceinline__ void operator()(const pg8::f32x4 (&acc)[2][2][4][2], const pg8::Unit& u, int wr, int wc, int fr, int fq) const {
        const int jc = u.pn * 128 + wc * 32 + 8 * fq;
        const bool first = (fr == 0), last = (fr == 15);
        v2u stash[2][4];
#pragma unroll
        for (int n = 0; n < 2; ++n) {
            const f4 w0g = *(const f4*)(cw + jc + 4 * n), w1g = *(const f4*)(cw + NUP + jc + 4 * n), w2g = *(const f4*)(cw + 2 * NUP + jc + 4 * n), bg = *(const f4*)(cb + jc + 4 * n);
            const f4 w0v = *(const f4*)(cw + DFF + jc + 4 * n), w1v = *(const f4*)(cw + NUP + DFF + jc + 4 * n), w2v = *(const f4*)(cw + 2 * NUP + DFF + jc + 4 * n), bv = *(const f4*)(cb + DFF + jc + 4 * n);
#pragma unroll
            for (int ai = 0; ai < 2; ++ai) {
                float g1p[4], v1p[4], g15c[4], v15c[4];
#pragma unroll
                for (int i = 0; i < 4; ++i) { g1p[i] = 0.f; v1p[i] = 0.f; g15c[i] = dpp_ror15(acc[ai][0][0][n][i]); v15c[i] = dpp_ror15(acc[ai][1][0][n][i]); }
#pragma unroll
                for (int m = 0; m < 4; ++m) {
                    const int mn = m < 3 ? m + 1 : 3;
                    float o[4];
#pragma unroll
                    for (int i = 0; i < 4; ++i) {
                        const float g = acc[ai][0][m][n][i], v = acc[ai][1][m][n][i];
                        const float g1c = dpp_ror1(g), v1c = dpp_ror1(v), g15n = dpp_ror15(acc[ai][0][mn][n][i]), v15n = dpp_ror15(acc[ai][1][mn][n][i]);
                        const float gp = first ? g1p[i] : g1c, gn = last ? g15n : g15c[i], vp = first ? v1p[i] : v1c, vn = last ? v15n : v15c[i];
                        g1p[i] = g1c; v1p[i] = v1c; g15c[i] = g15n; v15c[i] = v15n;
                        const float a = gp * w0g[i] + g * w1g[i] + gn * w2g[i] + bg[i];
                        const float b = vp * w0v[i] + v * w1v[i] + vn * w2v[i] + bv[i];
                        const float e = __builtin_amdgcn_exp2f(a * (-2.3022082f + -0.10294324f * (a * a)));
                        o[i] = a * __builtin_amdgcn_rcpf(1.0f + e) * b;
                    }
                    const int row = u.pm * pg8::BM + ai * pg8::HALF + wr * 64 + m * 16 + fr;
                    v2u w; w.x = pk2(o[0], o[1]); w.y = pk2(o[2], o[3]);
                    if (n == 0) stash[ai][m] = w;
                    else { v4u ww; ww.x = stash[ai][m].x; ww.y = stash[ai][m].y; ww.z = w.x; ww.w = w.y; *(v4u*)(ACT + (size_t)row * DFF + jc) = ww; }
                }
            }
        }
#pragma unroll
        for (int ai = 0; ai < 2; ++ai) {
            const int grp = u.pm * 4 + ai * 2 + wr;
            if (fr < 2 || fr >= 14) {
                const int m = fr < 2 ? 0 : 3, slot = fr < 2 ? fr : fr - 12;
                bf16_t* hp = HB + ((size_t)grp * 4 + slot) * NUP + u.pn * 256 + wc * 32 + 8 * fq;
#pragma unroll
                for (int bj = 0; bj < 2; ++bj) {
                    const pg8::f32x4 v0 = fr < 2 ? acc[ai][bj][0][0] : acc[ai][bj][3][0], v1 = fr < 2 ? acc[ai][bj][0][1] : acc[ai][bj][3][1];
                    v4u w; w.x = pk2(v0[0], v0[1]); w.y = pk2(v0[2], v0[3]); w.z = pk2(v1[0], v1[1]); w.w = pk2(v1[2], v1[3]);
                    *(v4u*)(hp + bj * 128) = w;
                }
                (void)m;
            }
        }
    }
};
__device__ __forceinline__ void glu_fix(const bf16_t* HB, bf16_t* ACT, const float* cw, const float* cb, int gtid, int NT) {
    constexpr int NCC = DFF / 8, NG = CHUNK / 64;
    for (int it = gtid; it < NG * 2 * NCC; it += NT) {
        const int cc = it % NCC, rest = it / NCC, which = rest & 1, g = rest >> 1, j0 = cc * 8, colp = (j0 >> 7) * 256 + (j0 & 127);
        const int row = g * 64 + (which ? 63 : 0); const int Lc = row < NPROMPT ? 16384 : 4096;
        const bf16_t *P, *C, *N;
        if (!which) { C = HB + ((size_t)g * 4 + 0) * NUP; N = HB + ((size_t)g * 4 + 1) * NUP; P = ((row & (Lc - 1)) == 0) ? nullptr : HB + ((size_t)(g - 1) * 4 + 3) * NUP; }
        else { P = HB + ((size_t)g * 4 + 2) * NUP; C = HB + ((size_t)g * 4 + 3) * NUP; N = (((row + 1) & (Lc - 1)) == 0) ? nullptr : HB + ((size_t)(g + 1) * 4 + 0) * NUP; }
        float pg[8], pv[8], cg_[8], cv[8], ng[8], nv[8];
        if (P) { ld8f(P + colp, pg); ld8f(P + colp + 128, pv); } else {
#pragma unroll
            for (int i = 0; i < 8; ++i) { pg[i] = 0.f; pv[i] = 0.f; } }
        if (N) { ld8f(N + colp, ng); ld8f(N + colp + 128, nv); } else {
#pragma unroll
            for (int i = 0; i < 8; ++i) { ng[i] = 0.f; nv[i] = 0.f; } }
        ld8f(C + colp, cg_); ld8f(C + colp + 128, cv);
        float o[8];
#pragma unroll
        for (int h = 0; h < 2; ++h) {
            const f4 w0g = *(const f4*)(cw + j0 + 4 * h), w1g = *(const f4*)(cw + NUP + j0 + 4 * h), w2g = *(const f4*)(cw + 2 * NUP + j0 + 4 * h), bg = *(const f4*)(cb + j0 + 4 * h);
            const f4 w0v = *(const f4*)(cw + DFF + j0 + 4 * h), w1v = *(const f4*)(cw + NUP + DFF + j0 + 4 * h), w2v = *(const f4*)(cw + 2 * NUP + DFF + j0 + 4 * h), bv = *(const f4*)(cb + DFF + j0 + 4 * h);
#pragma unroll
            for (int q = 0; q < 4; ++q) { const int i = 4 * h + q;
                const float a = pg[i] * w0g[q] + cg_[i] * w1g[q] + ng[i] * w2g[q] + bg[q];
                const float b = pv[i] * w0v[q] + cv[i] * w1v[q] + nv[i] * w2v[q] + bv[q];
                o[i] = gelu_tanh(a) * b; } }
        v4u w; w.x = pk2(o[0], o[1]); w.y = pk2(o[2], o[3]); w.z = pk2(o[4], o[5]); w.w = pk2(o[6], o[7]);
        *(v4u*)(ACT + (size_t)row * DFF + j0) = w;
    }
}

struct BRow1 { const att::bf16* base; size_t ldb; __device__ __forceinline__ const att::bf16* row(int kk) const { return base + (size_t)kk * ldb; } };
struct St1 { att::bf16* base; size_t ldb; float scale; __device__ __forceinline__ void store16(int m, int c, att::u32x4 v) const { *(att::u32x4*)(base + (size_t)m * ldb + c) = v; } };
struct BRow3 { const att::bf16* base; int R, lgR, k1; __device__ __forceinline__ const att::bf16* row(int kk) const { const int part = kk >> lgR, t2 = kk & (R - 1); return base + (size_t)(((part << lgR) + k1) * R + t2) * 512; } };
struct St3 { att::bf16* base; int R; float scale; __device__ __forceinline__ void store16(int m, int c, att::u32x4 v) const { *(att::u32x4*)(base + (size_t)(m * R) * DM + c) = v; } };

__device__ __forceinline__ void dft_stage1(const bf16_t* Gp, bf16_t* Yp, const unsigned char* ws, char* lds, int vcu, int G) {
    for (int it = 0;; ++it) { const int uid = it * G + vcu; if (uid >= 3072) break;
        if (uid < 1024) { const int s = uid >> 9, nt = uid & 511; const size_t off = (size_t)s * (2u * 16384u * 512u) + (size_t)nt * 128;
            BRow1 br{(const att::bf16*)Gp + off, 65536}; St1 st{(att::bf16*)Yp + off, 65536, 1.f};
            att::dft_unit<8, 4>((const att::bf16*)(ws + WS_A1P), 256, br, st, lds);
        } else { const int u2 = uid - 1024, s = u2 >> 8, nt = u2 & 255; const size_t off = (size_t)NPROMPT * 1024 + (size_t)s * (2u * 4096u * 512u) + (size_t)nt * 128;
            BRow1 br{(const att::bf16*)Gp + off, 32768}; St1 st{(att::bf16*)Yp + off, 32768, 1.f};
            att::dft_unit<4, 2>((const att::bf16*)(ws + WS_A1S), 128, br, st, lds);
        }
    }
}
__device__ __forceinline__ void dft_stage3(const bf16_t* Yp, bf16_t* H, const unsigned char* ws, char* lds, int vcu, int G) {
    for (int it = 0;; ++it) { const int uid = it * G + vcu; if (uid >= 3072) break;
        if (uid < 1024) { const int s = uid >> 9, k1 = (uid >> 2) & 127, nt = uid & 3;
            BRow3 br{(const att::bf16*)Yp + (size_t)s * (2u * 16384u * 512u) + nt * 128, 128, 7, k1};
            St3 st{(att::bf16*)H + (size_t)(s * 16384 + k1) * DM + 1536 + nt * 128, 128, 1.0f / sqrtf(16384.f * 128.f)};
            att::dft_unit<4, 4>((const att::bf16*)(ws + WS_A3P) + (size_t)k1 * (128 * 256), 256, br, st, lds);
        } else { const int u2 = uid - 1024, s = u2 >> 8, k1 = (u2 >> 2) & 63, nt = u2 & 3;
            BRow3 br{(const att::bf16*)Yp + (size_t)NPROMPT * 1024 + (size_t)s * (2u * 4096u * 512u) + nt * 128, 64, 6, k1};
            St3 st{(att::bf16*)H + (size_t)(NPROMPT + s * 4096 + k1) * DM + 1536 + nt * 128, 64, 1.0f / sqrtf(4096.f * 128.f)};
            att::dft_unit<2, 2>((const att::bf16*)(ws + WS_A3S) + (size_t)k1 * (64 * 128), 128, br, st, lds);
        }
    }
}

template <bool SHIFT> __device__ __forceinline__ void attn_units(const bf16_t* Z, bf16_t* H, float bound, char* lds, int vcu, int G) {
    for (int it = 0;; ++it) { const int uid = it * G + vcu; if (uid >= 2048) break;
        int rowbase, h, qb, seq;
        if (uid < 1024) { const int s = uid >> 9; h = (uid >> 6) & 7; qb = uid & 63; rowbase = s * 16384; seq = 16384; }
        else { const int u2 = uid - 1024, s = u2 >> 7; h = (u2 >> 4) & 7; qb = u2 & 15; rowbase = NPROMPT + s * 4096; seq = 4096; }
        const att::bf16* Q = (const att::bf16*)Z + (size_t)(rowbase + qb * 256) * DM + 512 + h * 128;
        const att::bf16* K = (const att::bf16*)Z + (size_t)rowbase * DM + 1536 + (h >> 2) * 128;
        att::bf16* O = (att::bf16*)H + (size_t)(rowbase + qb * 256) * DM + 512 + h * 128;
        att::attn_dense_body<att::bf16, SHIFT>(Q, K, K + 256, O, seq, lds, bound);
        __syncthreads();
    }
}
__device__ __forceinline__ void attn_phase(const bf16_t* Z, bf16_t* H, const float* qn, const float* kn, char* lds, int vcu, int G) {
    float mq = 0.f, mk = 0.f;
    for (int i = 0; i < 128; ++i) { mq = fmaxf(mq, fabsf(qn[i])); mk = fmaxf(mk, fabsf(kn[i])); }
    const float bound = 128.f * mq * mk * 1.02f;
    const bool noshift = __builtin_amdgcn_readfirstlane((int)(bound * (att::SCALE * 1.4426950408889634f) < 60.f)) != 0;
    if (noshift) attn_units<false>(Z, H, bound, lds, vcu, G);
    else attn_units<true>(Z, H, bound, lds, vcu, G);
}

struct Params { const float* in[17]; float* out; unsigned char* ws; int ph_lo, ph_hi; };
constexpr int NPL = 9;
constexpr int NPHASE = 2 + 2 * NPL;

__global__ void __launch_bounds__(512, 2) mega_fwd(Params p) {
    extern __shared__ __attribute__((aligned(16))) unsigned char lds[];
    cg::grid_group grid = cg::this_grid();
    const int G = gridDim.x, bx = blockIdx.x;
    const int vcu = (G % 8 == 0) ? (bx % 8) * (G / 8) + bx / 8 : bx;
    const int NGW = G * 8, NT = G * 512;
    unsigned char* ws = p.ws;
    const float *x_prompt = p.in[0], *x_sample = p.in[1], *g_pre_mix = p.in[2], *g_post_mix = p.in[3], *w_in = p.in[4], *pool_w = p.in[5], *pool_scale = p.in[6],
                *q_norm = p.in[7], *k_norm = p.in[8], *fourier_w = p.in[9], *w_out = p.in[10], *g_pre_ffn = p.in[11], *g_post_ffn = p.in[12], *w_up = p.in[13],
                *conv_w = p.in[14], *conv_b = p.in[15], *w_down = p.in[16];
    bf16_t* XH = (bf16_t*)(ws + WS_XH); bf16_t* Z = (bf16_t*)(ws + WS_Z); bf16_t* Gp = (bf16_t*)(ws + WS_G); bf16_t* Yp = (bf16_t*)(ws + WS_Y);
    bf16_t* HB = (bf16_t*)(ws + WS_HB); bf16_t* ACT = (bf16_t*)(ws + WS_ACT); bf16_t* XB = (bf16_t*)(ws + WS_XB);
    LAS unsigned char* ring = (LAS unsigned char*)lds;
    volatile LAS unsigned* bst = (volatile LAS unsigned*)(ring + 131072 + 64);
    if (threadIdx.x < 2) bst[threadIdx.x] = 0u;
    __syncthreads();
    XcdBarrier xbar = xcd_barrier_post((unsigned*)(ws + WS_BAR), bst);

    for (int ph = p.ph_lo; ph < p.ph_hi; ++ph) {
        const int tid = ltid(), lane = tid & 63, wave = __builtin_amdgcn_readfirstlane(tid >> 6);
        const int gw = vcu * 8 + wave, gtid = bx * 512 + tid;
        if (ph == 0) {
#if !defined(ONLY) || ONLY==0
            for (int rep = 0; rep < REP_P0; ++rep) p0a_tables(fourier_w, ws, (LAS float*)ring, gtid, NT);
#endif
        } else if (ph == 1) {
#if !defined(ONLY) || ONLY==1
            LAS float* scr = (LAS float*)(ring + wave * 16384);
            for (int l = 0; l < 2 * REP_P0; ++l) {
                bf16_t* Wl = (bf16_t*)(ws + WS_W + (l & 1) * W_LAYER);
                ValWin vw{w_in + (size_t)(l & 1) * DM * WINW, pool_w + (size_t)(l & 1) * 4 * 16384, pool_scale + (l & 1) * 512, (const float*)(ws + WS_M2F) + (size_t)(l & 1) * 4 * 32768};
                transpose_matrix(vw, DM, NIN, Wl, scr, gw, NGW, lane, 512, 2048);
                fold_items(vw.win, vw.poolw, vw.pscale, vw.m2f, Wl, gw, NGW, lane);
                ValDirect vo{w_out + (size_t)(l & 1) * DM * DM, DM};
                transpose_matrix(vo, DM, DM, (bf16_t*)((unsigned char*)Wl + W_OUT_OFF), scr, gw, NGW, lane, 0, DM);
                ValUp vu{w_up + (size_t)(l & 1) * DM * NUP};
                transpose_matrix(vu, DM, NUP, (bf16_t*)((unsigned char*)Wl + W_UP_OFF), scr, gw, NGW, lane, 0, NUP);
                ValDirect vd{w_down + (size_t)(l & 1) * DFF * DM, DM};
                transpose_matrix(vd, DFF, DM, (bf16_t*)((unsigned char*)Wl + W_DOWN_OFF), scr, gw, NGW, lane, 0, DM);
            }
            for (int rep = 0; rep < REP_P0; ++rep) resid_rows<false, false, 2>(x_prompt, x_sample, nullptr, nullptr, nullptr, nullptr, nullptr, XH, g_pre_mix, gw, NGW, lane);
#endif
        } else {
            const int l = (ph - 2) / NPL, q = (ph - 2) % NPL;
            const bf16_t* Wl = (const bf16_t*)(ws + WS_W + l * W_LAYER);
            if (q == 0) {
#if !defined(ONLY) || ONLY==2
                pg8::Gemm g{XH, Wl, MTOK, NIN, DM}; pg8::StaticOrder S; S.init(MTOK, NIN, G, bx);
                EpiWin E{Z, Gp};
                for (int rep = 0; rep < REP_WIN; ++rep) pg8::gemm_phase<EpiWin, pg8::StaticOrder, PG8_ALIGN, PG8_SP2>(ring, g, S, E);
#endif
            } else if (q == 1) {
#if !defined(ONLY) || ONLY==3
                for (int rep = 1; rep < REP_ROPE; ++rep) rope_pass(Z, (bf16_t*)(ws + WS_END), q_norm + l * 128, k_norm + l * 128, (const float*)(ws + WS_COS), (const float*)(ws + WS_SIN), gtid, NT);
                rope_pass(Z, Z, q_norm + l * 128, k_norm + l * 128, (const float*)(ws + WS_COS), (const float*)(ws + WS_SIN), gtid, NT);
                for (int rep = 0; rep < REP_LIGHT * REP_POOL; ++rep) pool_pass(Z, XH, gtid, NT);
                for (int rep = 0; rep < REP_LIGHT; ++rep) dft_stage1(Gp, Yp, ws, (char*)lds, vcu, G);
#endif
            } else if (q == 2) {
#if !defined(ONLY) || ONLY==4
                for (int rep = 0; rep < REP_ATTN; ++rep) attn_phase(Z, XH, q_norm + l * 128, k_norm + l * 128, (char*)lds, vcu, G);
#endif
#if !defined(ONLY) || ONLY==5
                for (int rep = 0; rep < REP_LIGHT; ++rep) dft_stage3(Yp, XH, ws, (char*)lds, vcu, G);
#endif
            } else if (q == 4) {
#if !defined(ONLY) || ONLY==6
                for (int rep = 1; rep < REP_RES; ++rep) resid_rows<true, true, 4>(nullptr, nullptr, XB, Z, g_post_mix + DM, nullptr, nullptr, (bf16_t*)(ws + WS_END), g_pre_ffn + DM, gw, NGW, lane);
                if (l == 0) resid_rows<false, true, 2>(x_prompt, x_sample, nullptr, Z, g_post_mix, nullptr, XB, XH, g_pre_ffn, gw, NGW, lane);
                else resid_rows<true, true, 4>(nullptr, nullptr, XB, Z, g_post_mix + DM, nullptr, XB, XH, g_pre_ffn + DM, gw, NGW, lane);
#endif
            } else if (q == 8) {
#if !defined(ONLY) || ONLY==6
                if (l == 0) resid_rows<true, true, 4>(nullptr, nullptr, XB, XH, g_post_ffn, nullptr, XB, XH, g_pre_mix + DM, gw, NGW, lane);
                else resid_rows<true, false, 4>(nullptr, nullptr, XB, XH, g_post_ffn + DM, p.out, nullptr, nullptr, nullptr, gw, NGW, lane);
#endif
            } else {
                const int c = 0, step = (q >= 5) ? (q - 5) : -1;
                const float* cwl = conv_w + (size_t)l * 3 * NUP; const float* cbl = conv_b + (size_t)l * NUP;
                if (step == 1) {
#if !defined(ONLY) || ONLY==7
                    for (int rep = 0; rep < REP_LIGHT; ++rep) glu_fix(HB, ACT, cwl, cbl, gtid, NT);
#endif
                } else if (step == 0) {
#if !defined(ONLY) || ONLY==9
                    pg8::Gemm g{XH + (size_t)c * CHUNK * DM, (const bf16_t*)((const unsigned char*)Wl + W_UP_OFF), CHUNK, NUP, DM};
                    pg8::StaticOrder S; S.init(g.M, g.N, G, bx);
                    EpiGlu E{ACT, HB, cwl, cbl};
                    for (int rep = 0; rep < REP_UP; ++rep) pg8::gemm_phase<EpiGlu, pg8::StaticOrder, PG8_ALIGN, PG8_SP2>(ring, g, S, E);
#endif
                } else {
#if !defined(ONLY) || ONLY==8
                    pg8::Gemm g; bf16_t* O;
                    if (q == 3) { g = pg8::Gemm{XH, (const bf16_t*)((const unsigned char*)Wl + W_OUT_OFF), MTOK, DM, DM}; O = Z; }
                    else { g = pg8::Gemm{ACT, (const bf16_t*)((const unsigned char*)Wl + W_DOWN_OFF), CHUNK, DM, DFF}; O = XH + (size_t)c * CHUNK * DM; }
                    pg8::StaticOrder S; S.init(g.M, g.N, G, bx);
                    pg8::EpiBf16<0> E{O, DM, nullptr, 0, 0, 1.f};
                    for (int rep = 0; rep < REP_PLAIN; ++rep) pg8::gemm_phase<pg8::EpiBf16<0>, pg8::StaticOrder, PG8_ALIGN, PG8_SP2>(ring, g, S, E);
#endif
                }
            }
        }
        if (ph + 1 < p.ph_hi) { for (int rep = 0; rep < REP_SYNC; ++rep) { if (MK_MULTI == 0 && ph != 0) xcd_barrier(xbar); else grid.sync(); } }
    }
}

extern "C" void kernel_launch(void* const* d_in, const int* in_sizes, int n_in, void* d_out, int out_size, void* d_ws, size_t ws_size, hipStream_t stream) {
    static int grid = 0;
    if (grid == 0) {
        if (n_in != 17 || out_size != MTOK * DM || ws_size < WS_END) { fprintf(stderr, "kernel_launch: unexpected shapes: n_in %d out %d ws %zu (need %zu)\n", n_in, out_size, ws_size, (size_t)WS_END); grid = -1; return; }
        int dev = 0, cus = 0, per_cu = 0;
        if (hipGetDevice(&dev) != hipSuccess || hipDeviceGetAttribute(&cus, hipDeviceAttributeMultiprocessorCount, dev) != hipSuccess) { grid = -1; return; }
        if (hipFuncSetAttribute((const void*)mega_fwd, hipFuncAttributeMaxDynamicSharedMemorySize, LDS_BYTES) != hipSuccess) { fprintf(stderr, "kernel_launch: hipFuncSetAttribute failed\n"); grid = -1; return; }
        if (hipOccupancyMaxActiveBlocksPerMultiprocessor(&per_cu, (const void*)mega_fwd, 512, LDS_BYTES) != hipSuccess || per_cu < 1) { fprintf(stderr, "kernel_launch: occupancy query says %d\n", per_cu); per_cu = 1; }
        (void)hipGetLastError();
        grid = cus * 1;
    }
    if (grid < 0) return;
    if (hipMemsetAsync((char*)d_ws + WS_BAR, 0, BAR_BYTES, stream) != hipSuccess) { fprintf(stderr, "kernel_launch: memset failed\n"); return; }
    Params p{};
    for (int i = 0; i < 17; ++i) p.in[i] = (const float*)d_in[i];
    p.out = (float*)d_out; p.ws = (unsigned char*)d_ws;
#if MK_MULTI
    for (int ph = 0; ph < NPHASE; ++ph) { p.ph_lo = ph; p.ph_hi = ph + 1; hipLaunchKernelGGL(mega_fwd, dim3(grid), dim3(512), LDS_BYTES, stream, p); }
#else
    p.ph_lo = 0; p.ph_hi = NPHASE;
    void* args[] = {&p};
    hipError_t e = hipLaunchCooperativeKernel((const void*)mega_fwd, dim3(grid), dim3(512), args, LDS_BYTES, stream);
    if (e != hipSuccess) fprintf(stderr, "cooperative launch failed: %s (grid %d)\n", hipGetErrorString(e), grid);
#endif
}
```

```cpp
#include <hip/hip_runtime.h>
#include <hip/hip_bf16.h>
#include <hip/hip_cooperative_groups.h>
#include <cstdio>
#include <cstdint>
#ifndef MK_MULTI
#define MK_MULTI 0
#endif
__device__ __forceinline__ int ltid() { int t = threadIdx.x; asm volatile("" : "+v"(t)); return t; }
#ifndef REP_UP
#define REP_UP 1
#endif
#ifndef REP_ATTN
#define REP_ATTN 1
#endif
#ifndef REP_PLAIN
#define REP_PLAIN 1
#endif
#ifndef REP_WIN
#define REP_WIN 1
#endif
#ifndef REP_P0
#define REP_P0 1
#endif
#ifndef REP_LIGHT
#define REP_LIGHT 1
#endif
#ifndef REP_SYNC
#define REP_SYNC 1
#endif
#ifndef REP_ROPE
#define REP_ROPE 1
#endif
#ifndef REP_RES
#define REP_RES 1
#endif
#ifndef REP_POOL
#define REP_POOL 1
#endif
#ifndef REP_BAR
#define REP_BAR 0
#endif
namespace pg8 {
#define PG8_LAS __attribute__((address_space(3)))
typedef unsigned short bf16_t;
typedef short bf16x8 __attribute__((ext_vector_type(8)));
typedef float f32x4 __attribute__((ext_vector_type(4)));
typedef unsigned u32x4 __attribute__((ext_vector_type(4)));
constexpr int BM = 256, BK = 64, HALF = 128, HTB = HALF * BK * 2  , STAGE_BYTES = 8 * HTB, NXCD = 8, WGM = 4;

__host__ __device__ __forceinline__ int lds_byte(int r, int c) { const int st = (r >> 4) * 2 + (c >> 5), rr = r & 15, cc = c & 31, ob = rr * 64 + cc * 2; return st * 1024 + (ob ^ (((ob >> 9) & 1) << 5)); }
__host__ __device__ __forceinline__ void stage_rc(int b, int& R, int& C) { const int st = b / 1024, sb = b % 1024, swz = sb ^ (((sb >> 9) & 1) << 5); R = (st >> 1) * 16 + swz / 64; C = (st & 1) * 32 + (swz % 64) / 2; }
__host__ __device__ __forceinline__ int perm32(int rho) { const int n = rho >> 4, i = rho & 15; return 8 * (i >> 2) + 4 * n + (i & 3); }

struct Unit { int pm, pn; };
struct Gemm { const bf16_t* A; const bf16_t* Bt; int M, N, K; };

struct StaticOrder {
    int nM, nN, nwg, G, c;
    __host__ __device__ void init(int M, int N, int G_, int c_) { nM = M / BM; nN = N / BM; nwg = nM * nN; G = G_; c = c_; }
    __host__ __device__ bool next(int i, Unit& u) const {
        const long L = (long)i * G + c; if (L >= nwg) return false;
        int wgid = (int)L; { const int q = nwg / NXCD, r = nwg % NXCD, xcd = wgid % NXCD, off = wgid / NXCD; wgid = (xcd < r ? xcd * (q + 1) : r * (q + 1) + (xcd - r) * q) + off; }
        const int nig = WGM * nN, gid = wgid / nig, fm = gid * WGM, gsz = (nM - fm) < WGM ? (nM - fm) : WGM;
        u.pm = fm + ((wgid % nig) % gsz); u.pn = (wgid % nig) / gsz; return true;
    }
    __device__ __forceinline__ void a_ready(const Unit&) const {}
    __device__ __forceinline__ void done(const Unit&) const {}
};

__device__ __forceinline__ unsigned cvt_pk_bf16(float lo, float hi) { unsigned r; asm volatile("v_cvt_pk_bf16_f32 %0, %1, %2" : "=v"(r) : "v"(lo), "v"(hi)); return r; }
typedef float f32x2 __attribute__((ext_vector_type(2)));
__device__ __forceinline__ f32x2 gelu_pk(f32x2 v) {
    const f32x2 av = __builtin_elementwise_abs(v), d = av * 0.2316418882f + 1.0f;
    f32x2 t; t.x = __builtin_amdgcn_rcpf(d.x); t.y = __builtin_amdgcn_rcpf(d.y);
    f32x2 q = t * 0.5307027145f + (-0.7265760135f); q = q * t + 0.7107068705f; q = q * t + (-0.142248368f); q = q * t + 0.127414796f; q = q * t;
    const f32x2 s = (v * v) * (-0.72134752044f);
    f32x2 e; e.x = __builtin_amdgcn_exp2f(s.x); e.y = __builtin_amdgcn_exp2f(s.y);
    const f32x2 m = v * (q * e), r = v - m;
    f32x2 o; o.x = v.x < 0.f ? m.x : r.x; o.y = v.y < 0.f ? m.y : r.y; return o;
}

template <int ACT  > struct EpiBf16 {
    static constexpr bool PERM = true, AFTER_DRAIN = false; static_assert(ACT == 0 || ACT == 1, "EpiBf16: ACT is 0 (none) or 1 (gelu_pk)");
    bf16_t* O; int ldc; const float* bias; int split_cols; size_t split_stride; float scale0;
    __device__ __forceinline__ void operator()(const f32x4 (&acc)[2][2][4][2], const Unit& u, int wr, int wc, int fr, int fq) const {
        const int row0 = u.pm * BM + wr * 64 + fr; int colt = u.pn * BM; bf16_t* base = O;
        float sc = 1.f; if (split_cols) { const int t = colt / split_cols; base += (size_t)t * split_stride; colt -= t * split_cols; if (t == 0) sc = scale0; }
        const int col0 = colt + wc * 32 + 8 * fq, bcol0 = u.pn * BM + wc * 32 + 8 * fq;
        f32x4 bv[2][2];
#pragma unroll
        for (int bj = 0; bj < 2; ++bj)
#pragma unroll
            for (int n = 0; n < 2; ++n) bv[bj][n] = bias ? *(const f32x4*)(bias + bcol0 + bj * HALF + 4 * n) : (f32x4){0.f, 0.f, 0.f, 0.f};
#pragma unroll
        for (int ai = 0; ai < 2; ++ai)
#pragma unroll
            for (int m = 0; m < 4; ++m) { bf16_t* rowp = base + (size_t)(row0 + ai * HALF + m * 16) * ldc + col0;
#pragma unroll
                for (int bj = 0; bj < 2; ++bj) { f32x4 v0 = acc[ai][bj][m][0] + bv[bj][0], v1 = acc[ai][bj][m][1] + bv[bj][1];
                    if (ACT == 1) { f32x2 a = gelu_pk((f32x2){v0[0], v0[1]}), b = gelu_pk((f32x2){v0[2], v0[3]}), c = gelu_pk((f32x2){v1[0], v1[1]}), d = gelu_pk((f32x2){v1[2], v1[3]});
                        v0 = (f32x4){a.x, a.y, b.x, b.y}; v1 = (f32x4){c.x, c.y, d.x, d.y}; }
                    v0 = v0 * sc; v1 = v1 * sc; u32x4 w; w.x = cvt_pk_bf16(v0[0], v0[1]); w.y = cvt_pk_bf16(v0[2], v0[3]); w.z = cvt_pk_bf16(v1[0], v1[1]); w.w = cvt_pk_bf16(v1[2], v1[3]);
                    *(u32x4*)(rowp + bj * HALF) = w; } }
    }
};
template <class Epi, class Sched, bool ALIGN_EPI = false, bool SP2 = false>
__device__ __forceinline__ void gemm_phase(PG8_LAS unsigned char* lds, const Gemm g, const Sched& S, const Epi& E) {
    const int tid = ltid(), wid = __builtin_amdgcn_readfirstlane(tid >> 6), lane = tid & 63, wr = wid >> 2, wc = wid & 3, fr = lane & 15, fq = lane >> 4;
    const int K = g.K, nt = K / BK;
    unsigned voffA[2], voffB[2];
#pragma unroll
    for (int i = 0; i < 2; ++i) { int R, C; stage_rc(tid * 16 + i * 8192, R, C); const int Rb = Epi::PERM ? ((R & ~31) + perm32(R & 31)) : R;
        voffA[i] = (unsigned)(R * K + C) * 2u; voffB[i] = (unsigned)(Rb * K + C) * 2u; }
    const size_t kstep = (size_t)(BK * 2);
    const size_t hstep = (size_t)HALF * K * 2;
    const size_t tstep = 2 * hstep;
    const unsigned ldsw = (unsigned)wid * 1024u;
    const int aoff = lds_byte(wr * 64 + fr, fq * 8), boff = lds_byte(wc * 32 + fr, fq * 8);
#define PG8_SA(b, h) (((b) * 2 + (h)) * HTB)
#define PG8_SB(b, h) ((4 + (b) * 2 + (h)) * HTB)
#define PG8_STAGE(bufoff, gbase, voff) do { _Pragma("unroll") for (int _i = 0; _i < 2; ++_i) \
        __builtin_amdgcn_global_load_lds((const unsigned*)((const char*)(gbase) + (voff)[_i]), (PG8_LAS unsigned*)(lds + (bufoff) + ldsw + _i * 8192), 16, 0, 0); } while (0)
#define PG8_LDA(dst, b, h) do { _Pragma("unroll") for (int m = 0; m < 4; ++m) _Pragma("unroll") for (int k = 0; k < 2; ++k) dst[m][k] = *(const PG8_LAS bf16x8*)(lds + PG8_SA(b, h) + aoff + m * 2048 + k * 1024); } while (0)
#define PG8_LDB(dst, b, h) do { _Pragma("unroll") for (int n = 0; n < 2; ++n) _Pragma("unroll") for (int k = 0; k < 2; ++k) dst[n][k] = *(const PG8_LAS bf16x8*)(lds + PG8_SB(b, h) + boff + n * 2048 + k * 1024); } while (0)
#define PG8_MMA(ai, bj, At, Bt) do { __builtin_amdgcn_s_setprio(1); _Pragma("unroll") for (int m = 0; m < 4; ++m) _Pragma("unroll") for (int n = 0; n < 2; ++n) _Pragma("unroll") for (int k = 0; k < 2; ++k) \
        acc[ai][bj][m][n] = __builtin_amdgcn_mfma_f32_16x16x32_bf16(Bt[n][k], At[m][k], acc[ai][bj][m][n], 0, 0, 0); __builtin_amdgcn_s_setprio(0); } while (0)
#define PG8_WAIT_V(n) asm volatile("s_waitcnt vmcnt(" #n ")" ::: "memory")
#define PG8_WAIT_L(n) asm volatile("s_waitcnt lgkmcnt(" #n ")" ::: "memory")
#define PG8_BAR __builtin_amdgcn_s_barrier()
#define PG8_SCHED __builtin_amdgcn_sched_barrier(0)
    Unit cur, nxt; int ui = 0;
    if (!S.next(0, cur)) return;
    f32x4 acc[2][2][4][2];
#pragma unroll
    for (int a = 0; a < 2; ++a)
#pragma unroll
        for (int b = 0; b < 2; ++b)
#pragma unroll
            for (int m = 0; m < 4; ++m)
#pragma unroll
                for (int n = 0; n < 2; ++n) acc[a][b][m][n] = (f32x4){0.f, 0.f, 0.f, 0.f};
    bf16x8 At[4][2], B0[2][2], B1[2][2];
    const char* cA = (const char*)g.A + (size_t)cur.pm * tstep; const char* cB = (const char*)g.Bt + (size_t)cur.pn * tstep;
    S.a_ready(cur);
    if constexpr (SP2) {
        PG8_STAGE(PG8_SB(0, 0), cB, voffB); PG8_STAGE(PG8_SB(0, 1), cB + hstep, voffB); PG8_STAGE(PG8_SA(0, 0), cA, voffA); PG8_STAGE(PG8_SA(0, 1), cA + hstep, voffA);
        if (wr == 1) PG8_BAR;
        PG8_WAIT_V(2); PG8_BAR;
        PG8_STAGE(PG8_SB(1, 0), cB + kstep, voffB); PG8_STAGE(PG8_SA(1, 0), cA + kstep, voffA); PG8_STAGE(PG8_SB(1, 1), cB + hstep + kstep, voffB);
        PG8_WAIT_V(6); PG8_BAR;
    } else {
        PG8_STAGE(PG8_SB(0, 0), cB, voffB); PG8_STAGE(PG8_SA(0, 0), cA, voffA); PG8_STAGE(PG8_SB(0, 1), cB + hstep, voffB); PG8_STAGE(PG8_SA(0, 1), cA + hstep, voffA);
        if (wr == 1) PG8_BAR;
        PG8_WAIT_V(4); PG8_BAR;
        PG8_STAGE(PG8_SB(1, 0), cB + kstep, voffB); PG8_STAGE(PG8_SA(1, 0), cA + kstep, voffA); PG8_STAGE(PG8_SB(1, 1), cB + hstep + kstep, voffB);
        PG8_WAIT_V(6); PG8_BAR;
    }
    for (;;) {
        const bool has_next = S.next(ui + 1, nxt);
        const char* nA = has_next ? (const char*)g.A + (size_t)nxt.pm * tstep : cA; const char* nB = has_next ? (const char*)g.Bt + (size_t)nxt.pn * tstep : cB;
        for (int t = 0; t < nt; t += 2) {
            const bool last = (t == nt - 2);
            const char* a1 = cA + (size_t)(t + 1) * kstep;
            const char* a2 = last ? nA : cA + (size_t)(t + 2) * kstep; const char* b2 = last ? nB : cB + (size_t)(t + 2) * kstep;
            const char* a3 = a2 + kstep; const char* b3 = b2 + kstep;
            if (last && has_next) S.a_ready(nxt);
            if constexpr (SP2) {
            PG8_LDB(B0, 0, 0); PG8_LDB(B1, 0, 1); PG8_SCHED; PG8_LDA(At, 0, 0); PG8_STAGE(PG8_SA(1, 1), a1 + hstep, voffA);
            PG8_WAIT_V(8); PG8_WAIT_L(0); PG8_BAR; PG8_MMA(0, 0, At, B0); PG8_MMA(0, 1, At, B1); PG8_BAR; PG8_SCHED;
            PG8_LDA(At, 0, 1); PG8_STAGE(PG8_SB(0, 0), b2, voffB); PG8_STAGE(PG8_SB(0, 1), b2 + hstep, voffB); PG8_STAGE(PG8_SA(0, 0), a2, voffA);
            PG8_WAIT_V(8); PG8_WAIT_L(0); PG8_BAR; PG8_MMA(1, 0, At, B0); PG8_MMA(1, 1, At, B1); PG8_BAR; PG8_SCHED;
            PG8_LDB(B0, 1, 0); PG8_LDB(B1, 1, 1); PG8_SCHED; PG8_LDA(At, 1, 0); PG8_STAGE(PG8_SA(0, 1), a2 + hstep, voffA);
            PG8_WAIT_V(8); PG8_WAIT_L(0); PG8_BAR; PG8_MMA(0, 0, At, B0); PG8_MMA(0, 1, At, B1); PG8_BAR; PG8_SCHED;
            PG8_LDA(At, 1, 1); PG8_STAGE(PG8_SB(1, 0), b3, voffB); PG8_STAGE(PG8_SB(1, 1), b3 + hstep, voffB); PG8_STAGE(PG8_SA(1, 0), a3, voffA);
            PG8_WAIT_V(8); PG8_WAIT_L(0); PG8_BAR; PG8_MMA(1, 0, At, B0); PG8_MMA(1, 1, At, B1); PG8_BAR; PG8_SCHED;
            } else {
            PG8_LDB(B0, 0, 0); PG8_SCHED; PG8_LDA(At, 0, 0); PG8_STAGE(PG8_SA(1, 1), a1 + hstep, voffA);
            PG8_WAIT_L(8); PG8_BAR; PG8_WAIT_L(0); PG8_MMA(0, 0, At, B0); PG8_BAR; PG8_SCHED;
            PG8_LDB(B1, 0, 1); PG8_STAGE(PG8_SB(0, 0), b2, voffB);
            PG8_BAR; PG8_WAIT_L(0); PG8_MMA(0, 1, At, B1); PG8_BAR;
            PG8_LDA(At, 0, 1); PG8_STAGE(PG8_SA(0, 0), a2, voffA);
            PG8_BAR; PG8_WAIT_L(0); PG8_MMA(1, 0, At, B0); PG8_BAR; PG8_SCHED;
            PG8_STAGE(PG8_SB(0, 1), b2 + hstep, voffB);
            PG8_WAIT_V(6); PG8_BAR; PG8_MMA(1, 1, At, B1); PG8_BAR;
            PG8_LDB(B0, 1, 0); PG8_SCHED; PG8_LDA(At, 1, 0); PG8_STAGE(PG8_SA(0, 1), a2 + hstep, voffA);
            PG8_WAIT_L(8); PG8_BAR; PG8_WAIT_L(0); PG8_MMA(0, 0, At, B0); PG8_BAR; PG8_SCHED;
            PG8_LDB(B1, 1, 1); PG8_STAGE(PG8_SB(1, 0), b3, voffB);
            PG8_BAR; PG8_WAIT_L(0); PG8_MMA(0, 1, At, B1); PG8_BAR;
            PG8_LDA(At, 1, 1); PG8_STAGE(PG8_SA(1, 0), a3, voffA);
            PG8_BAR; PG8_WAIT_L(0); PG8_MMA(1, 0, At, B0); PG8_BAR; PG8_SCHED;
            PG8_STAGE(PG8_SB(1, 1), b3 + hstep, voffB);
            PG8_WAIT_V(6); PG8_BAR; PG8_MMA(1, 1, At, B1); PG8_BAR;
            }
        }
        if constexpr (ALIGN_EPI) { if (wr == 0) PG8_BAR; }
        if constexpr (!Epi::AFTER_DRAIN) { E(acc, cur, wr, wc, fr, fq); S.done(cur); }
        if (!has_next) break;
#pragma unroll
        for (int a = 0; a < 2; ++a)
#pragma unroll
            for (int b = 0; b < 2; ++b)
#pragma unroll
                for (int m = 0; m < 4; ++m)
#pragma unroll
                    for (int n = 0; n < 2; ++n) acc[a][b][m][n] = (f32x4){0.f, 0.f, 0.f, 0.f};
        cur = nxt; cA = nA; cB = nB; ++ui;
        if constexpr (ALIGN_EPI) { if (wr == 1) PG8_BAR; }
    }
    PG8_WAIT_V(0);
    if constexpr (!ALIGN_EPI) { if (wr == 0) PG8_BAR; }
    PG8_BAR;
    if constexpr (Epi::AFTER_DRAIN) { E.fused(acc, cur, wr, wc, fr, fq, lds, wid, lane); S.done(cur); }
#undef PG8_SA
#undef PG8_SB
#undef PG8_STAGE
#undef PG8_LDA
#undef PG8_LDB
#undef PG8_MMA
#undef PG8_WAIT_V
#undef PG8_WAIT_L
#undef PG8_BAR
#undef PG8_SCHED
}
}
#define PG8_SP2 true
#define PG8_ALIGN true
namespace att {
using bf16 = __hip_bfloat16;
constexpr int   D = 128, NW = 8, QBLK = 32, KVBLK = 64;
constexpr float SCALE = 0.088388347648318440f;
constexpr float THR = 8.f;
constexpr int SDEPTH = 2;
constexpr bool STATIC_MAX = true;
constexpr int LDQ = 2048, LDK = 2048, LDO = 2048;
constexpr size_t SHM_V = KVBLK * D * 2, SHM_K = KVBLK * D * 2, SHM_ATTN = 2 * SHM_V + 2 * SHM_K + NW * 64 * 4;
using bf16x8 = __attribute__((ext_vector_type(8))) short;
using s16x4  = __attribute__((ext_vector_type(4))) short;
using f32x16 = __attribute__((ext_vector_type(16))) float;
using f32x8  = __attribute__((ext_vector_type(8))) float;
using u32x4  = __attribute__((ext_vector_type(4))) unsigned;
#define KSWZ(row, colB) ((row) * 256 + ((colB) ^ (((row) & 7) << 4)))
#define SBAR() __builtin_amdgcn_sched_barrier(0)
__device__ __forceinline__ int crow(int r, int hi) { return (r & 3) + 8 * (r >> 2) + 4 * hi; }
__device__ __forceinline__ unsigned cvtpk(float lo, float hi) {
  unsigned r; asm volatile("v_cvt_pk_bf16_f32 %0, %1, %2" : "=v"(r) : "v"(lo), "v"(hi)); return r;
}
template <typename TIn> struct Stage;
template <> struct Stage<bf16>  { using T = bf16x8;
  __device__ static __forceinline__ T ld8(const bf16* p) { return *reinterpret_cast<const bf16x8*>(p); }
  __device__ static __forceinline__ bf16x8 tobf(T x) { return x; } };
template <> struct Stage<float> { using T = f32x8;
  __device__ static __forceinline__ T ld8(const float* p) { return *reinterpret_cast<const f32x8*>(p); }
  __device__ static __forceinline__ bf16x8 tobf(T x) {
    u32x4 w = {cvtpk(x[0], x[1]), cvtpk(x[2], x[3]), cvtpk(x[4], x[5]), cvtpk(x[6], x[7])}; return *reinterpret_cast<bf16x8*>(&w); } };

template <bool SHIFT> __device__ __forceinline__ void partialSM(f32x16& p0, f32x16& p1, float& m_reg, float& mn, float& alpha) {
  constexpr float C = SCALE * 1.4426950408889634f;
  if constexpr (STATIC_MAX) { mn = m_reg; alpha = 1.f; }
  else {
  float pmax = p0[0]; for (int r = 1; r < 16; ++r) pmax = fmaxf(pmax, p0[r]); for (int r = 0; r < 16; ++r) pmax = fmaxf(pmax, p1[r]);
  { auto rr = __builtin_amdgcn_permlane32_swap(__float_as_uint(pmax), __float_as_uint(pmax), false, false);
    pmax = fmaxf(__uint_as_float(rr[0]), __uint_as_float(rr[1])); }
  if (__builtin_expect(__all(pmax - m_reg <= THR / SCALE), 1)) { mn = m_reg; alpha = 1.f; }
  else { mn = fmaxf(m_reg, pmax); alpha = __builtin_amdgcn_exp2f((m_reg - mn) * C); m_reg = mn; }
  }
  if constexpr (!STATIC_MAX) { float mnC = -mn * C;
  for (int r = 0; r < 16; ++r) p0[r] = fmaf(p0[r], C, mnC); for (int r = 0; r < 16; ++r) p1[r] = fmaf(p1[r], C, mnC); }
  if constexpr (STATIC_MAX && SHIFT) { for (int r = 0; r < 16; ++r) p0[r] += m_reg; for (int r = 0; r < 16; ++r) p1[r] += m_reg; }
  for (int r = 0; r < 16; ++r) p0[r] = __builtin_amdgcn_exp2f(p0[r]);
}
__device__ __forceinline__ void finishSM(f32x16& p0, f32x16& p1, float alpha, float& l_reg, bf16x8& pa0, bf16x8& pa1, bf16x8& pa2, bf16x8& pa3) {
  for (int r = 0; r < 16; ++r) p1[r] = __builtin_amdgcn_exp2f(p1[r]);
  float ps = 0; for (int r = 0; r < 16; ++r) ps += p0[r]; for (int r = 0; r < 16; ++r) ps += p1[r];
  { auto rr = __builtin_amdgcn_permlane32_swap(__float_as_uint(ps), __float_as_uint(ps), false, false);
    ps = __uint_as_float(rr[0]) + __uint_as_float(rr[1]); }
  l_reg = l_reg * alpha + ps;
#define PK4(P, BASE, OUT) do { unsigned a0 = cvtpk(P[BASE + 0], P[BASE + 1]), a1 = cvtpk(P[BASE + 2], P[BASE + 3]);   \
    unsigned b0 = cvtpk(P[BASE + 4], P[BASE + 5]), b1 = cvtpk(P[BASE + 6], P[BASE + 7]);                              \
    auto r0 = __builtin_amdgcn_permlane32_swap(a0, b0, false, false); auto r1 = __builtin_amdgcn_permlane32_swap(a1, b1, false, false); \
    u32x4 w = {r0[0], r1[0], r0[1], r1[1]}; OUT = *reinterpret_cast<bf16x8*>(&w); } while (0)
  PK4(p0, 0, pa0); PK4(p0, 8, pa1); PK4(p1, 0, pa2); PK4(p1, 8, pa3);
#undef PK4
}
__device__ __forceinline__ void qkt(f32x16& p0, f32x16& p1, const bf16* Ks, const bf16x8* qr, int r32, int hi) {
#pragma unroll
  for (int d0 = 0; d0 < 8; ++d0) { int cb = (d0 * 16 + hi * 8) * 2;
    bf16x8 b0 = *reinterpret_cast<const bf16x8*>((const char*)Ks + KSWZ(r32, cb));
    bf16x8 b1 = *reinterpret_cast<const bf16x8*>((const char*)Ks + KSWZ(32 + r32, cb));
    p0 = __builtin_amdgcn_mfma_f32_32x32x16_bf16(b0, qr[d0], d0 == 0 ? f32x16{} : p0, 0, 0, 0);
    p1 = __builtin_amdgcn_mfma_f32_32x32x16_bf16(b1, qr[d0], d0 == 0 ? f32x16{} : p1, 0, 0, 0); }
}
__device__ __forceinline__ int v_st(int k, int c) { const int kk = (k & ~0xC) | ((k & 4) << 1) | ((k & 8) >> 1); return ((kk >> 3) * 4 + (c >> 5)) * 512 + ((kk & 7) * 32 + (c & 31)) * 2; }
__device__ __forceinline__ int v_rd_base(int lane) { return ((lane & 3) << 3) | (((lane >> 2) & 3) << 6) | (((lane >> 4) & 1) << 5) | (((lane >> 5) & 1) << 8); }
constexpr int v_rd_off(int d0, int ks, int half) { return d0 * 512 + ks * 4096 + half * 2048; }
template <int OFF> __device__ __forceinline__ s16x4 tr_read(int vb) {
  s16x4 r; asm volatile("ds_read_b64_tr_b16 %0, %1 offset:%2" : "=&v"(r) : "v"(vb), "i"(OFF) : "memory"); return r;
}
template <int D0> __device__ __forceinline__ void pv_one(f32x16& od, int vb, bf16x8 pa0, bf16x8 pa1, bf16x8 pa2, bf16x8 pa3) {
  const s16x4 l0 = tr_read<v_rd_off(D0, 0, 0)>(vb), h0 = tr_read<v_rd_off(D0, 0, 1)>(vb), l1 = tr_read<v_rd_off(D0, 1, 0)>(vb), h1 = tr_read<v_rd_off(D0, 1, 1)>(vb);
  const s16x4 l2 = tr_read<v_rd_off(D0, 2, 0)>(vb), h2 = tr_read<v_rd_off(D0, 2, 1)>(vb), l3 = tr_read<v_rd_off(D0, 3, 0)>(vb), h3 = tr_read<v_rd_off(D0, 3, 1)>(vb);
  asm volatile("s_waitcnt lgkmcnt(0)" ::: "memory"); SBAR();
#define PK(L, H) (bf16x8){L[0], L[1], L[2], L[3], H[0], H[1], H[2], H[3]}
  od = __builtin_amdgcn_mfma_f32_32x32x16_bf16(pa0, PK(l0, h0), od, 0, 0, 0);
  od = __builtin_amdgcn_mfma_f32_32x32x16_bf16(pa1, PK(l1, h1), od, 0, 0, 0);
  od = __builtin_amdgcn_mfma_f32_32x32x16_bf16(pa2, PK(l2, h2), od, 0, 0, 0);
  od = __builtin_amdgcn_mfma_f32_32x32x16_bf16(pa3, PK(l3, h3), od, 0, 0, 0);
#undef PK
}
__device__ __forceinline__ void pv_d0(f32x16* o, int vb, bf16x8 pa0, bf16x8 pa1, bf16x8 pa2, bf16x8 pa3) {
  pv_one<0>(o[0], vb, pa0, pa1, pa2, pa3); pv_one<1>(o[1], vb, pa0, pa1, pa2, pa3); pv_one<2>(o[2], vb, pa0, pa1, pa2, pa3); pv_one<3>(o[3], vb, pa0, pa1, pa2, pa3);
}
template <typename TQ, bool SHIFT>
__device__ __forceinline__ void attn_dense_body(const TQ* __restrict__ Qb, const bf16* __restrict__ Kh, const bf16* __restrict__ Vh,
                                                bf16* __restrict__ Ob, int seq, char* lds, float bound) {
  using St = Stage<bf16>; using SQ = Stage<TQ>;
  const int tid = ltid(), wid = tid >> 6, lane = tid & 63, r32 = lane & 31, hi = lane >> 5;
  bf16* V_lds = (bf16*)lds; bf16* K_lds = (bf16*)(lds + 2 * SHM_V);
  float* ws = (float*)(lds + 2 * SHM_V + 2 * SHM_K) + wid * 64; float* li_l = ws; float* al_l = ws + 32;
  float m_reg = STATIC_MAX ? -bound * (SCALE * 1.4426950408889634f) : -1e30f, l_reg = 0; f32x16 o[4] = {}; bf16x8 qr[8];
  const TQ* Qw = Qb + (long)(wid * QBLK + r32) * LDQ + hi * 8;
#pragma unroll
  for (int d0 = 0; d0 < 8; ++d0) qr[d0] = SQ::tobf(SQ::ld8(Qw + d0 * 16));
  const int sr = tid >> 4, sc = (tid & 15) * 8, vst0 = v_st(sr, sc), vst1 = v_st(32 + sr, sc);
  const int vb0 = (int)(uintptr_t)V_lds + v_rd_base(lane);
  struct { typename St::T vs0, vs1, ks0, ks1; } sr_[SDEPTH];
#define SLOAD(i, k0) do { sr_[i].vs0 = St::ld8(&Vh[(long)((k0) + sr) * LDK + sc]); sr_[i].vs1 = St::ld8(&Vh[(long)((k0) + 32 + sr) * LDK + sc]); \
    sr_[i].ks0 = St::ld8(&Kh[(long)((k0) + sr) * LDK + sc]); sr_[i].ks1 = St::ld8(&Kh[(long)((k0) + 32 + sr) * LDK + sc]); } while (0)
#define SWRITE(b, i) do { *(bf16x8*)((char*)V_lds + (b) * SHM_V + vst0) = St::tobf(sr_[i].vs0);          \
    *(bf16x8*)((char*)V_lds + (b) * SHM_V + vst1) = St::tobf(sr_[i].vs1); int kc = sc * 2;               \
    *(bf16x8*)((char*)K_lds + (b) * SHM_K + KSWZ(sr, kc)) = St::tobf(sr_[i].ks0);                       \
    *(bf16x8*)((char*)K_lds + (b) * SHM_K + KSWZ(32 + sr, kc)) = St::tobf(sr_[i].ks1); } while (0)
#define SWAIT() do { if constexpr (SDEPTH == 2) asm volatile("s_waitcnt vmcnt(4)" ::: "memory"); else asm volatile("s_waitcnt vmcnt(0)" ::: "memory"); } while (0)
#define RESC(a) do { if (!STATIC_MAX && __any((a) < 1.f)) { if (hi == 0) al_l[r32] = (a); asm volatile("s_waitcnt lgkmcnt(0)" ::: "memory"); \
    for (int d = 0; d < 4; ++d) for (int r = 0; r < 16; ++r) o[d][r] *= al_l[crow(r, hi)]; } } while (0)
  f32x16 pA0, pA1, pB0, pB1; float mnA, mnB, alA, alB; bf16x8 pa0, pa1, pa2, pa3; const int NT = seq / KVBLK;
  constexpr int SE = 0, SO = SDEPTH - 1;
  SLOAD(SE, 0); asm volatile("s_waitcnt vmcnt(0)" ::: "memory"); SWRITE(0, SE); __syncthreads();
  qkt(pA0, pA1, K_lds, qr, r32, hi); partialSM<SHIFT>(pA0, pA1, m_reg, mnA, alA);
  SLOAD(SO, KVBLK); if constexpr (SDEPTH == 2) { if (2 < NT) SLOAD(SE, 2 * KVBLK); }
  SWAIT(); SWRITE(1, SO); __syncthreads();
  for (int j = 1; j + 1 < NT; j += 2) {
    SBAR(); qkt(pB0, pB1, (bf16*)((char*)K_lds + SHM_K), qr, r32, hi);
    finishSM(pA0, pA1, alA, l_reg, pa0, pa1, pa2, pa3); SBAR();
    SLOAD(SO, (j + SDEPTH) * KVBLK); SBAR();
    pv_d0(o, vb0, pa0, pa1, pa2, pa3); partialSM<SHIFT>(pB0, pB1, m_reg, mnB, alB);
    __syncthreads(); SWAIT(); SWRITE(0, SE);
    RESC(alB); __syncthreads();
    SBAR(); qkt(pA0, pA1, K_lds, qr, r32, hi);
    finishSM(pB0, pB1, alB, l_reg, pa0, pa1, pa2, pa3); SBAR();
    if (SDEPTH == 1 || j + 3 < NT) SLOAD(SE, (j + 1 + SDEPTH) * KVBLK); SBAR();
    pv_d0(o, vb0 + (int)SHM_V, pa0, pa1, pa2, pa3); partialSM<SHIFT>(pA0, pA1, m_reg, mnA, alA);
    __syncthreads(); SWAIT(); SWRITE(1, SO);
    RESC(alA); __syncthreads();
  }
  SBAR(); qkt(pB0, pB1, (bf16*)((char*)K_lds + SHM_K), qr, r32, hi);
  finishSM(pA0, pA1, alA, l_reg, pa0, pa1, pa2, pa3); SBAR();
  pv_d0(o, vb0, pa0, pa1, pa2, pa3); partialSM<SHIFT>(pB0, pB1, m_reg, mnB, alB);
  __syncthreads(); RESC(alB);
  finishSM(pB0, pB1, alB, l_reg, pa0, pa1, pa2, pa3); SBAR();
  pv_d0(o, vb0 + (int)SHM_V, pa0, pa1, pa2, pa3);
  if (hi == 0) li_l[r32] = l_reg; asm volatile("s_waitcnt lgkmcnt(0)" ::: "memory");
  float rli[16];
#pragma unroll
  for (int r = 0; r < 16; ++r) rli[r] = __builtin_amdgcn_rcpf(li_l[crow(r, hi)]);
  bf16* Ow = Ob + (long)(wid * QBLK) * LDO;
#pragma unroll
  for (int r = 0; r < 16; ++r) { int orow = crow(r, hi);
    for (int d0 = 0; d0 < 4; ++d0) Ow[(long)orow * LDO + d0 * 32 + r32] = __float2bfloat16(o[d0][r] * rli[r]); }
#undef SLOAD
#undef SWRITE
#undef SWAIT
#undef RESC
}

template <int NC> __device__ __forceinline__ void pv_n(f32x16* o, int vb, bf16x8 pa0, bf16x8 pa1, bf16x8 pa2, bf16x8 pa3) {
  pv_one<0>(o[0], vb, pa0, pa1, pa2, pa3);
  if constexpr (NC > 1) pv_one<1>(o[1], vb, pa0, pa1, pa2, pa3);
  if constexpr (NC > 2) { pv_one<2>(o[2], vb, pa0, pa1, pa2, pa3); pv_one<3>(o[3], vb, pa0, pa1, pa2, pa3); }
}
template <int MB, int NKT, class BR, class ST>
__device__ __forceinline__ void dft_unit(const bf16* __restrict__ A, int lda, const BR& br, const ST& st, char* lds) {
  constexpr int NBW = 8 / MB, NC = 4 / NBW;
  const int tid = ltid(), wid = tid >> 6, lane = tid & 63, r32 = lane & 31, hi = lane >> 5;
  const int mb = wid % MB, cgp = wid / MB;
  const int sr = tid >> 4, sc = (tid & 15) * 8, vst0 = v_st(sr, sc), vst1 = v_st(32 + sr, sc);
  bf16x8 bq[NKT][2], af[NKT][4];
#pragma unroll
  for (int kt = 0; kt < NKT; ++kt) {
    bq[kt][0] = *reinterpret_cast<const bf16x8*>(br.row(kt * 64 + sr) + sc);
    bq[kt][1] = *reinterpret_cast<const bf16x8*>(br.row(kt * 64 + 32 + sr) + sc);
  }
  const bf16* Aw = A + (long)(mb * 32 + r32) * lda + hi * 8;
#pragma unroll
  for (int kt = 0; kt < NKT; ++kt)
#pragma unroll
    for (int ks = 0; ks < 4; ++ks) af[kt][ks] = *reinterpret_cast<const bf16x8*>(Aw + kt * 64 + ks * 16);
  __syncthreads();
#pragma unroll
  for (int kt = 0; kt < NKT; ++kt) {
    *(bf16x8*)(lds + kt * 16384 + vst0) = bq[kt][0];
    *(bf16x8*)(lds + kt * 16384 + vst1) = bq[kt][1];
  }
  __syncthreads();
  f32x16 o[NC];
#pragma unroll
  for (int d = 0; d < NC; ++d) o[d] = f32x16{};
  const int vb = (int)(uintptr_t)lds + v_rd_base(lane) + cgp * NC * 512;
#pragma unroll
  for (int kt = 0; kt < NKT; ++kt) pv_n<NC>(o, vb + kt * 16384, af[kt][0], af[kt][1], af[kt][2], af[kt][3]);
  bf16* stg = (bf16*)(lds + 65536) + wid * 4096;
  const float sc_ = st.scale;
#pragma unroll
  for (int r = 0; r < 16; ++r) {
#pragma unroll
    for (int d = 0; d < NC; ++d) stg[crow(r, hi) * (NC * 32) + d * 32 + r32] = __float2bfloat16(o[d][r] * sc_);
  }
  asm volatile("s_waitcnt lgkmcnt(0)" ::: "memory");
#pragma unroll
  for (int i = 0; i < NC * 2; ++i) { const int idx = i * 64 + lane, row = idx / (NC * 4), cc = idx % (NC * 4);
    const u32x4 v = *(const u32x4*)(stg + row * (NC * 32) + cc * 8);
    st.store16(mb * 32 + row, cgp * NC * 32 + cc * 8, v); }
  asm volatile("s_waitcnt lgkmcnt(0)" ::: "memory");
}
#undef SBAR
#undef KSWZ
}

namespace cg = cooperative_groups;
#define LAS __attribute__((address_space(3)))
typedef unsigned short bf16_t;
typedef unsigned v4u __attribute__((ext_vector_type(4)));
typedef unsigned v2u __attribute__((ext_vector_type(2)));
typedef float f4 __attribute__((ext_vector_type(4)));

#define XB_TMO      128
#define XB_XCNT(j)  (256  + 64 * (j))
#define XB_XSUB(j)  (1280 + 64 * (j))
#define XB_XGEN(j)  (2304 + 64 * (j))
#define XB_TOP      3328
#define XB_TOPGEN   3392
#define XCD_BAR_WORDS 3456
#define XB_SPIN_CAP (1u << 18)

__device__ __forceinline__ unsigned xb_ld(unsigned* p)              { return __hip_atomic_load(p, __ATOMIC_RELAXED, __HIP_MEMORY_SCOPE_AGENT); }
__device__ __forceinline__ unsigned xb_add(unsigned* p, unsigned v) { return __hip_atomic_fetch_add(p, v, __ATOMIC_RELAXED, __HIP_MEMORY_SCOPE_AGENT); }
__device__ __forceinline__ unsigned xb_xcc_id() { return (unsigned)__builtin_amdgcn_s_getreg((3 << 11) | 20) & 0xFu; }
#define XB_SPIN(cond, bar) do { unsigned _sp = 0; while (cond) { __builtin_amdgcn_s_sleep(1); \
    if ((++_sp & 255u) == 0u) { if (xb_ld(&(bar)[XB_TMO])) break; if (_sp > XB_SPIN_CAP) { atomicAdd(&(bar)[XB_TMO], 1u); break; } } } } while (0)

struct XcdBarrier {
    unsigned* bar; unsigned x;
    volatile LAS unsigned* st;
};

__device__ __forceinline__ XcdBarrier xcd_barrier_post(unsigned* bar, volatile LAS unsigned* st) {
    XcdBarrier b; b.bar = bar; b.x = xb_xcc_id(); b.st = st;
    if (threadIdx.x == 0) (void)xb_add(&bar[XB_XCNT(b.x)], 1u);
    return b;
}
__device__ __forceinline__ void xcd_barrier_complete(unsigned* bar, unsigned x, unsigned& nloc, unsigned& nx) {
    const unsigned G = gridDim.x * gridDim.y * gridDim.z;
    unsigned sum, cnt, mine, sp = 0u;
    for (;;) {
        sum = 0u; cnt = 0u; mine = 0u;
#pragma unroll
        for (unsigned j = 0; j < 16; ++j) { const unsigned c = xb_ld(&bar[XB_XCNT(j)]); sum += c; cnt += (c > 0u) ? 1u : 0u; mine = (j == x) ? c : mine; }
        if (sum == G) break;
        __builtin_amdgcn_s_sleep(1);
        if ((++sp & 255u) == 0u) { if (xb_ld(&bar[XB_TMO])) break; if (sp > XB_SPIN_CAP) { atomicAdd(&bar[XB_TMO], 1u); break; } }
    }
    nloc = mine > 0u ? mine : 1u; nx = cnt > 0u ? cnt : 1u;
}

__device__ __forceinline__ void xcd_barrier(const XcdBarrier& b) {
    asm volatile("s_waitcnt vmcnt(0)" ::: "memory");
    __syncthreads();
    if (threadIdx.x == 0) {
        unsigned* bar = b.bar;
        __builtin_amdgcn_s_waitcnt(0);
        unsigned nloc = b.st[0], nx = b.st[1];
        if (nloc == 0u) { xcd_barrier_complete(bar, b.x, nloc, nx); b.st[0] = nloc; b.st[1] = nx; }
        const unsigned old = xb_add(&bar[XB_XSUB(b.x)], 1u);
        const unsigned gen = old / nloc;
        if (old + 1u == (gen + 1u) * nloc) {
            __builtin_amdgcn_fence(__ATOMIC_RELEASE, "agent");
            asm volatile("s_waitcnt vmcnt(0)" ::: "memory");
            const unsigned og = xb_add(&bar[XB_TOP], 1u);
            const unsigned tg = og / nx;
            if (og + 1u == (tg + 1u) * nx) xb_add(&bar[XB_TOPGEN], 1u);
            else XB_SPIN(xb_ld(&bar[XB_TOPGEN]) == tg, bar);
            __builtin_amdgcn_fence(__ATOMIC_ACQUIRE, "agent");
            xb_add(&bar[XB_XGEN(b.x)], 1u);
            asm volatile("s_waitcnt vmcnt(0)" ::: "memory");
        } else {
            XB_SPIN(xb_ld(&bar[XB_XGEN(b.x)]) == gen, bar);
            __builtin_amdgcn_fence(__ATOMIC_ACQUIRE, "agent");
            asm volatile("s_waitcnt vmcnt(0)" ::: "memory");
        }
    }
    __syncthreads();
}

constexpr int DM = 2048, MTOK = 65536, NIN = 3072, DFF = 5632, NUP = 11264, WINW = 2560;
constexpr int NPROMPT = 32768;
constexpr int CHUNK = 65536, NCHUNK = 1;
constexpr float EPS = 1e-6f;
constexpr size_t MiB = (size_t)1 << 20;
constexpr size_t WS_M2F = 0;
constexpr size_t WS_COS = 1 * MiB, WS_SIN = 5 * MiB;
constexpr size_t WS_A1P = 9 * MiB, WS_A1S = 9 * MiB + 128 * 1024;
constexpr size_t WS_A3P = 10 * MiB, WS_A3S = 18 * MiB;
constexpr size_t WS_BAR = 19 * MiB, BAR_BYTES = 16384;
constexpr size_t WS_W = 20 * MiB;
constexpr size_t W_LAYER = 86 * MiB, W_OUT_OFF = 12 * MiB, W_UP_OFF = 20 * MiB, W_DOWN_OFF = 64 * MiB;
constexpr size_t WS_XH = 192 * MiB;
constexpr size_t WS_Z = 448 * MiB;
constexpr size_t WS_G = 704 * MiB;
constexpr size_t WS_Y = 832 * MiB;
constexpr size_t WS_ACT = 448 * MiB;
constexpr size_t WS_HB = 1152 * MiB;
constexpr size_t WS_XB = 1240 * MiB;
constexpr size_t WS_END = 1496 * MiB;
constexpr int LDS_BYTES = 135168;

__device__ __forceinline__ float bf2f(unsigned short b) { return __uint_as_float((unsigned)b << 16); }
__device__ __forceinline__ float bflo(unsigned w) { return __uint_as_float(w << 16); }
__device__ __forceinline__ float bfhi(unsigned w) { return __uint_as_float(w & 0xffff0000u); }
__device__ __forceinline__ unsigned pk2(float lo, float hi) { return pg8::cvt_pk_bf16(lo, hi); }
__device__ __forceinline__ float wave_sum(float v) {
#pragma unroll
    for (int o = 1; o < 64; o <<= 1) v += __shfl_xor(v, o);
    return v;
}

struct EpiWin {
    static constexpr bool PERM = true, AFTER_DRAIN = false;
    bf16_t* Z; bf16_t* Gp;
    __device__ __forceinline__ void operator()(const pg8::f32x4 (&acc)[2][2][4][2], const pg8::Unit& u, int wr, int wc, int fr, int fq) const {
        const int row0 = u.pm * pg8::BM + wr * 64 + fr;
        bf16_t* base; size_t rstride, bjstride;
        if (u.pn < 8) { base = Z + (size_t)row0 * 2048 + u.pn * 256 + wc * 32 + 8 * fq; rstride = 2048; bjstride = 128; }
        else {
            const int g = u.pn - 8, r0 = u.pm * pg8::BM; size_t sb; int L, t0;
            if (r0 < NPROMPT) { const int s = r0 >> 14; sb = (size_t)s * (2u * 16384u * 512u); L = 16384; t0 = row0 - s * 16384; }
            else { const int s = (r0 - NPROMPT) >> 12; sb = (size_t)NPROMPT * 1024 + (size_t)s * (2u * 4096u * 512u); L = 4096; t0 = row0 - NPROMPT - s * 4096; }
            base = Gp + sb + (size_t)t0 * 512 + g * 128 + wc * 32 + 8 * fq; rstride = 512; bjstride = (size_t)L * 512;
        }
#pragma unroll
        for (int ai = 0; ai < 2; ++ai)
#pragma unroll
            for (int m = 0; m < 4; ++m) { bf16_t* rowp = base + (size_t)(ai * pg8::HALF + m * 16) * rstride;
#pragma unroll
                for (int bj = 0; bj < 2; ++bj) { const pg8::f32x4 v0 = acc[ai][bj][m][0], v1 = acc[ai][bj][m][1];
                    pg8::u32x4 w; w.x = pk2(v0[0], v0[1]); w.y = pk2(v0[2], v0[3]); w.z = pk2(v1[0], v1[1]); w.w = pk2(v1[2], v1[3]);
                    *(pg8::u32x4*)(rowp + bj * bjstride) = w; } }
    }
};

__device__ __forceinline__ void p0a_tables(const float* fourier_w, unsigned char* ws, LAS float* tab, int gtid, int NT) {
    float* M2F = (float*)(ws + WS_M2F);
    { const int t = ltid(); if (t < 128) { float sn, cs; sincospif((float)t * (2.f / 128.f), &sn, &cs); tab[t] = cs; tab[128 + t] = -sn; } }
    __syncthreads();
    for (int i = gtid; i < 2 * 4 * 128 * 256; i += NT) {
        const int lg = i >> 15, c = (i >> 8) & 127, n = i & 255, part = n >> 7, e2 = n & 127;
        const float* fw = fourier_w + (size_t)lg * 16384 + e2;
        float acc = 0.f;
#pragma unroll 8
        for (int e = 0; e < 128; ++e) { const int r = (c * e) & 127; acc += tab[part * 128 + r] * fw[e * 128]; }
        M2F[i] = acc;
    }
    __syncthreads();
    float* COS = (float*)(ws + WS_COS); float* SIN = (float*)(ws + WS_SIN);
    for (int i = gtid; i < 16384 * 64; i += NT) {
        const int t = i >> 6, j = i & 63; const float pos = (float)(j < 32 ? (t >> 6) : (t & 63));
        const float inv = 1.0f / powf(10000.0f, (float)(j & 31) / 32.0f); const float ang = pos * inv;
        COS[i] = cosf(ang); SIN[i] = sinf(ang);
    }
    bf16_t* A1P = (bf16_t*)(ws + WS_A1P);
    for (int i = gtid; i < 256 * 256; i += NT) { const int m = i >> 8, k = i & 255, pm = m >> 7, k1 = m & 127, pk = k >> 7, t1 = k & 127; const int r = (t1 * k1) & 127;
        float sn, cs; sincospif((float)r * (2.f / 128.f), &sn, &cs); const float v = (pm == pk) ? cs : (pm == 0 ? sn : -sn); A1P[i] = (bf16_t)(pk2(v, 0.f) & 0xffff); }
    bf16_t* A1S = (bf16_t*)(ws + WS_A1S);
    for (int i = gtid; i < 128 * 128; i += NT) { const int m = i >> 7, k = i & 127, pm = m >> 6, k1 = m & 63, pk = k >> 6, t1 = k & 63; const int r = (t1 * k1) & 63;
        float sn, cs; sincospif((float)r * (2.f / 64.f), &sn, &cs); const float v = (pm == pk) ? cs : (pm == 0 ? sn : -sn); A1S[i] = (bf16_t)(pk2(v, 0.f) & 0xffff); }
    bf16_t* A3P = (bf16_t*)(ws + WS_A3P);
    for (int i = gtid; i < 128 * 128 * 256; i += NT) { const int k1 = i >> 15, k2 = (i >> 8) & 127, kk = i & 255, part = kk >> 7, t2 = kk & 127; const int k = k1 + 128 * k2; const int r = (t2 * k) & 16383;
        float sn, cs; sincospif((float)r * (1.f / 8192.f), &sn, &cs); A3P[i] = (bf16_t)(pk2(part ? sn : cs, 0.f) & 0xffff); }
    bf16_t* A3S = (bf16_t*)(ws + WS_A3S);
    for (int i = gtid; i < 64 * 64 * 128; i += NT) { const int k1 = i >> 13, k2 = (i >> 7) & 63, kk = i & 127, part = kk >> 6, t2 = kk & 63; const int k = k1 + 64 * k2; const int r = (t2 * k) & 4095;
        float sn, cs; sincospif((float)r * (1.f / 2048.f), &sn, &cs); A3S[i] = (bf16_t)(pk2(part ? sn : cs, 0.f) & 0xffff); }
}

struct ValUp { const float* W; __device__ __forceinline__ const float* ptr(int k, int n) const { const int src = ((n >> 7) & 1) * DFF + (n >> 8) * 128 + (n & 127); return W + (size_t)k * NUP + src; }
    __device__ __forceinline__ float operator()(int k, int n) const { return *ptr(k, n); } };
struct ValDirect { const float* W; int ldw; __device__ __forceinline__ const float* ptr(int k, int n) const { return W + (size_t)k * ldw + n; }
    __device__ __forceinline__ float operator()(int k, int n) const { return W[(size_t)k * ldw + n]; } };
struct ValWin { const float* win; const float* poolw; const float* pscale; const float* m2f;
    __device__ __forceinline__ const float* ptr(int k, int n) const { return win + (size_t)k * WINW + n; }
    __device__ __forceinline__ float operator()(int k, int n) const {
        if (n >= 512 && n < 2048) return win[(size_t)k * WINW + n];
        if (n < 512) { const int g = n >> 7, e = n & 127; const float* wr = win + (size_t)k * WINW + g * 128; const float* pw = poolw + g * 16384 + e; float acc = 0.f;
            for (int c = 0; c < 128; ++c) acc += wr[c] * pw[c * 128]; return acc * pscale[n]; }
        const int n2 = n - 2048, g = n2 >> 8, np = n2 & 255; const float* wr = win + (size_t)k * WINW + 2048 + g * 128; const float* mf = m2f + g * 32768 + np; float acc = 0.f;
        for (int c = 0; c < 128; ++c) acc += wr[c] * mf[c * 256]; return acc; } };
template <class F> __device__ __forceinline__ void transpose_item(const F& val, int K, bf16_t* WT, int k0, int n0, LAS float* scr, int lane) {
    for (int i = 0; i < 32; ++i) { const int kk = 2 * i + (lane >> 5); scr[kk * 33 + (lane & 31)] = val(k0 + kk, n0 + (lane & 31)); }
    asm volatile("s_waitcnt lgkmcnt(0)" ::: "memory");
    const int c = lane & 7;
#pragma unroll
    for (int j = 0; j < 4; ++j) { const int n = (lane >> 3) + 8 * j; const LAS float* s = scr + (8 * c) * 33 + n;
        v4u o; o.x = pk2(s[0 * 33], s[1 * 33]); o.y = pk2(s[2 * 33], s[3 * 33]); o.z = pk2(s[4 * 33], s[5 * 33]); o.w = pk2(s[6 * 33], s[7 * 33]);
        *(v4u*)(WT + (size_t)(n0 + n) * K + k0 + 8 * c) = o; }
    asm volatile("s_waitcnt lgkmcnt(0)" ::: "memory");
}
template <class F> __device__ __forceinline__ void tr_load(const F& f, int k0, int n0, int lane, f4 (&v)[8]) {
#pragma unroll
    for (int i = 0; i < 8; ++i) v[i] = __builtin_nontemporal_load((const f4*)f.ptr(k0 + 8 * i + (lane >> 3), n0 + 4 * (lane & 7)));
}
__device__ __forceinline__ void tr_store(const f4 (&v)[8], int K, bf16_t* WT, int k0, int n0, LAS float* scr, int lane) {
#pragma unroll
    for (int i = 0; i < 8; ++i) { LAS float* d = scr + (8 * i + (lane >> 3)) * 33 + 4 * (lane & 7); d[0] = v[i].x; d[1] = v[i].y; d[2] = v[i].z; d[3] = v[i].w; }
    asm volatile("s_waitcnt lgkmcnt(0)" ::: "memory");
    const int c = lane & 7;
#pragma unroll
    for (int j = 0; j < 4; ++j) { const int n = (lane >> 3) + 8 * j; const LAS float* s = scr + (8 * c) * 33 + n;
        v4u o; o.x = pk2(s[0 * 33], s[1 * 33]); o.y = pk2(s[2 * 33], s[3 * 33]); o.z = pk2(s[4 * 33], s[5 * 33]); o.w = pk2(s[6 * 33], s[7 * 33]);
        *(v4u*)(WT + (size_t)(n0 + n) * K + k0 + 8 * c) = o; }
    asm volatile("s_waitcnt lgkmcnt(0)" ::: "memory");
}
template <class F> __device__ __forceinline__ void transpose_matrix(const F& val, int K, int N, bf16_t* WT, LAS float* scr, int gw, int NGW, int lane, int nlo, int nhi) {
    const int nblk = (nhi - nlo) / 32, nitems = (K / 64) * nblk;
    int it = gw; if (it >= nitems) return;
    f4 cur[8], nxt[8];
    tr_load(val, 64 * (it / nblk), nlo + 32 * (it % nblk), lane, cur);
    for (; it < nitems; it += NGW) {
        const int k0 = 64 * (it / nblk), n0 = nlo + 32 * (it % nblk); const int it2 = it + NGW; const bool more = it2 < nitems;
        if (more) tr_load(val, 64 * (it2 / nblk), nlo + 32 * (it2 % nblk), lane, nxt);
        tr_store(cur, K, WT, k0, n0, scr, lane);
        if (more) {
#pragma unroll
            for (int i = 0; i < 8; ++i) cur[i] = nxt[i]; }
    }
}

typedef float __attribute__((address_space(4))) cf32;
__device__ __forceinline__ void fold_items(const float* win, const float* poolw, const float* pscale, const float* m2f, bf16_t* WT, int gw, int NGW, int lane) {
    for (int it = gw; it < 64 * 24; it += NGW) {
        const int kb = it / 24, nb = it - kb * 24, k0 = 32 * kb;
        float m2[128]; int base, nout;
        if (nb < 8) { const int n = nb * 64 + lane, g = nb >> 1, e = n & 127; base = g * 128; nout = n; const float sc = pscale[n]; const float* pw = poolw + g * 16384 + e;
#pragma unroll
            for (int c = 0; c < 128; ++c) m2[c] = pw[c * 128] * sc;
        } else { const int n2 = (nb - 8) * 64 + lane, g = (nb - 8) >> 2, np = n2 & 255; base = 2048 + g * 128; nout = 2048 + n2; const float* mf = m2f + g * 32768 + np;
#pragma unroll
            for (int c = 0; c < 128; ++c) m2[c] = mf[c * 256];
        }
        bf16_t* wrow = WT + (size_t)nout * DM + k0;
        for (int kg = 0; kg < 4; ++kg) {
            float acc[8];
#pragma unroll
            for (int kk = 0; kk < 8; ++kk) { const cf32* wr = (const cf32*)(unsigned long long)(win + (size_t)(k0 + 8 * kg + kk) * WINW + base); float a = 0.f;
#pragma unroll
                for (int c = 0; c < 128; ++c) a += wr[c] * m2[c];
                acc[kk] = a; }
            v4u o; o.x = pk2(acc[0], acc[1]); o.y = pk2(acc[2], acc[3]); o.z = pk2(acc[4], acc[5]); o.w = pk2(acc[6], acc[7]);
            *(v4u*)(wrow + 8 * kg) = o;
        }
    }
}

__device__ __forceinline__ const float* xrow_ptr(const float* xa, const float* xb, int row) { return (row < NPROMPT) ? xa + (size_t)row * DM : xb + (size_t)(row - NPROMPT) * DM; }
template <bool XBF, bool OBF, int RR>
__device__ __forceinline__ void resid_rows(const float* xa, const float* xb, const bf16_t* xbf, const bf16_t* m, const float* g1, float* xout, bf16_t* xbout, bf16_t* xh, const float* g2, int gw, int NGW, int lane) {
    constexpr bool W = XBF;
#define EO(k) (W ? (8 * lane + 512 * ((k) >> 1) + 4 * ((k) & 1)) : (4 * lane + 256 * (k)))
    for (int row0 = gw; row0 < MTOK; row0 += RR * NGW) {
        f4 xf[XBF ? 1 : RR][8]; v2u xp[XBF ? RR : 1][8]; v2u mw[RR][8];
#pragma unroll
        for (int u = 0; u < RR; ++u) { const int row = row0 + u * NGW;
            if constexpr (XBF) { const bf16_t* xr = xbf + (size_t)row * DM;
#pragma unroll
                for (int j = 0; j < 4; ++j) { const v4u t = __builtin_nontemporal_load((const v4u*)(xr + 8 * lane + 512 * j)); xp[u][2 * j] = (v2u){t.x, t.y}; xp[u][2 * j + 1] = (v2u){t.z, t.w}; }
            } else { const float* xr = xrow_ptr(xa, xb, row);
#pragma unroll
                for (int k = 0; k < 8; ++k) xf[u][k] = __builtin_nontemporal_load((const f4*)(xr + EO(k))); } }
        if (m) {
#pragma unroll
            for (int u = 0; u < RR; ++u) { const bf16_t* mr = m + (size_t)(row0 + u * NGW) * DM;
                if constexpr (W) {
#pragma unroll
                    for (int j = 0; j < 4; ++j) { const v4u t = __builtin_nontemporal_load((const v4u*)(mr + 8 * lane + 512 * j)); mw[u][2 * j] = (v2u){t.x, t.y}; mw[u][2 * j + 1] = (v2u){t.z, t.w}; }
                } else {
#pragma unroll
                    for (int k = 0; k < 8; ++k) mw[u][k] = __builtin_nontemporal_load((const v2u*)(mr + EO(k))); } }
        }
#pragma unroll
        for (int u = 0; u < RR; ++u) { const int row = row0 + u * NGW;
            f4 xv[8];
#pragma unroll
            for (int k = 0; k < 8; ++k) { if constexpr (XBF) { const v2u w = xp[u][k]; xv[k] = (f4){bflo(w.x), bfhi(w.x), bflo(w.y), bfhi(w.y)}; } else xv[k] = xf[u][k]; }
            if (m) { float ss = 0.f;
#pragma unroll
                for (int k = 0; k < 8; ++k) { const v2u w = mw[u][k]; const f4 mv = (f4){bflo(w.x), bfhi(w.x), bflo(w.y), bfhi(w.y)}; ss += (mv.x * mv.x + mv.y * mv.y) + (mv.z * mv.z + mv.w * mv.w); }
                const float r = 1.0f / sqrtf(wave_sum(ss) * (1.f / DM) + EPS);
#pragma unroll
                for (int k = 0; k < 8; ++k) { const v2u w = mw[u][k]; const f4 mv = (f4){bflo(w.x), bfhi(w.x), bflo(w.y), bfhi(w.y)}; const f4 gv = *(const f4*)(g1 + EO(k)); xv[k] += mv * r * gv; } }
            if constexpr (OBF) { if (xbout) {
                if constexpr (W) {
#pragma unroll
                    for (int j = 0; j < 4; ++j) { v4u w; w.x = pk2(xv[2 * j].x, xv[2 * j].y); w.y = pk2(xv[2 * j].z, xv[2 * j].w); w.z = pk2(xv[2 * j + 1].x, xv[2 * j + 1].y); w.w = pk2(xv[2 * j + 1].z, xv[2 * j + 1].w);
                        __builtin_nontemporal_store(w, (v4u*)(xbout + (size_t)row * DM + 8 * lane + 512 * j)); }
                } else {
#pragma unroll
                    for (int k = 0; k < 8; ++k) { v2u w; w.x = pk2(xv[k].x, xv[k].y); w.y = pk2(xv[k].z, xv[k].w); __builtin_nontemporal_store(w, (v2u*)(xbout + (size_t)row * DM + EO(k))); } } }
            } else { if (xout) {
#pragma unroll
                for (int k = 0; k < 8; ++k) __builtin_nontemporal_store(xv[k], (f4*)(xout + (size_t)row * DM + EO(k))); } }
            if (xh) { float ss = 0.f;
#pragma unroll
                for (int k = 0; k < 8; ++k) ss += (xv[k].x * xv[k].x + xv[k].y * xv[k].y) + (xv[k].z * xv[k].z + xv[k].w * xv[k].w);
                const float r = 1.0f / sqrtf(wave_sum(ss) * (1.f / DM) + EPS);
                if constexpr (W) {
#pragma unroll
                    for (int j = 0; j < 4; ++j) { const f4 ga = *(const f4*)(g2 + EO(2 * j)), gb = *(const f4*)(g2 + EO(2 * j + 1)); const f4 ya = xv[2 * j] * r * ga, yb = xv[2 * j + 1] * r * gb;
                        v4u w; w.x = pk2(ya.x, ya.y); w.y = pk2(ya.z, ya.w); w.z = pk2(yb.x, yb.y); w.w = pk2(yb.z, yb.w); *(v4u*)(xh + (size_t)row * DM + 8 * lane + 512 * j) = w; }
                } else {
#pragma unroll
                    for (int k = 0; k < 8; ++k) { const f4 gv = *(const f4*)(g2 + EO(k)); const f4 y = xv[k] * r * gv;
                        v2u w; w.x = pk2(y.x, y.y); w.y = pk2(y.z, y.w); *(v2u*)(xh + (size_t)row * DM + EO(k)) = w; } } }
        }
    }
#undef EO
}

__device__ __forceinline__ void rope_pass(bf16_t* Z, bf16_t* Zout, const float* qn, const float* kn, const float* COS, const float* SIN, int gtid, int NT) {
    const int hw = gtid >> 5, NHW = NT >> 5, j = gtid & 31;
    constexpr float QC = 0.088388347648318440f * 1.4426950408889634f;
    const float qa0 = qn[2 * j] * QC, qa1 = qn[2 * j + 1] * QC, qb0 = qn[64 + 2 * j] * QC, qb1 = qn[65 + 2 * j] * QC;
    const float ka0 = kn[2 * j], ka1 = kn[2 * j + 1], kb0 = kn[64 + 2 * j], kb1 = kn[65 + 2 * j];
    for (int row = hw; row < MTOK; row += NHW) {
        const int t = row < NPROMPT ? (row & 16383) : (row & 4095);
        bf16_t* p = Z + (size_t)row * DM + 512 + 2 * j;
        unsigned a[10], b[10];
#pragma unroll
        for (int hh = 0; hh < 10; ++hh) { a[hh] = *(const unsigned*)(p + hh * 128); b[hh] = *(const unsigned*)(p + hh * 128 + 64); }
        const float c0 = COS[t * 64 + 2 * j], c1 = COS[t * 64 + 2 * j + 1], s0 = SIN[t * 64 + 2 * j], s1 = SIN[t * 64 + 2 * j + 1];
#pragma unroll
        for (int hh = 0; hh < 10; ++hh) {
            float x0 = bflo(a[hh]), x1 = bfhi(a[hh]), y0 = bflo(b[hh]), y1 = bfhi(b[hh]);
            float ss = (x0 * x0 + x1 * x1) + (y0 * y0 + y1 * y1);
#pragma unroll
            for (int o = 1; o < 32; o <<= 1) ss += __shfl_xor(ss, o);
            const float r = 1.0f / sqrtf(ss * (1.f / 128.f) + EPS);
            x0 *= r * (hh < 8 ? qa0 : ka0); x1 *= r * (hh < 8 ? qa1 : ka1); y0 *= r * (hh < 8 ? qb0 : kb0); y1 *= r * (hh < 8 ? qb1 : kb1);
            const float ox0 = x0 * c0 - y0 * s0, oy0 = y0 * c0 + x0 * s0, ox1 = x1 * c1 - y1 * s1, oy1 = y1 * c1 + x1 * s1;
            bf16_t* po = Zout + (size_t)row * DM + 512 + 2 * j;
            *(unsigned*)(po + hh * 128) = pk2(ox0, ox1); *(unsigned*)(po + hh * 128 + 64) = pk2(oy0, oy1);
        }
    }
}

__device__ __forceinline__ void acc8(float* s, const bf16_t* p, float sg) { const v4u v = *(const v4u*)p;
    s[0] += sg * bflo(v.x); s[1] += sg * bfhi(v.x); s[2] += sg * bflo(v.y); s[3] += sg * bfhi(v.y); s[4] += sg * bflo(v.z); s[5] += sg * bfhi(v.z); s[6] += sg * bflo(v.w); s[7] += sg * bfhi(v.w); }
__device__ __forceinline__ void pool_pass(const bf16_t* Z, bf16_t* H, int gtid, int NT) {
    constexpr int RL = 32;
    for (int it = gtid; it < (MTOK / RL) * 64; it += NT) {
        const int ch = it & 63, run = it >> 6, c0 = ch * 8, g = ch >> 4, w = 2 << g, a = w >> 1, b = w - 1 - a;
        const int row0 = run * RL; int t0, L; if (row0 < NPROMPT) { t0 = row0 & 16383; L = 16384; } else { t0 = row0 & 4095; L = 4096; }
        const bf16_t* zb = Z + (size_t)(row0 - t0) * DM + c0;
        float s[8] = {0.f, 0.f, 0.f, 0.f, 0.f, 0.f, 0.f, 0.f};
        { const int lo = t0 - a < 0 ? 0 : t0 - a, hi = t0 + b > L - 1 ? L - 1 : t0 + b;
          for (int tt = lo; tt <= hi; ++tt) acc8(s, zb + (size_t)tt * DM, 1.f); }
#pragma unroll 4
        for (int r = 0; r < RL; ++r) {
            const int t = t0 + r; const int lo = t - a < 0 ? 0 : t - a, hi = t + b > L - 1 ? L - 1 : t + b;
            const float ic = 1.0f / (float)(hi - lo + 1);
            const v4u v = *(const v4u*)(zb + (size_t)t * DM);
            v4u o; o.x = pk2(s[0] * ic - bflo(v.x), s[1] * ic - bfhi(v.x)); o.y = pk2(s[2] * ic - bflo(v.y), s[3] * ic - bfhi(v.y));
            o.z = pk2(s[4] * ic - bflo(v.z), s[5] * ic - bfhi(v.z)); o.w = pk2(s[6] * ic - bflo(v.w), s[7] * ic - bfhi(v.w));
            *(v4u*)(H + (size_t)(row0 + r) * DM + c0) = o;
            if (t + 1 + b <= L - 1) acc8(s, zb + (size_t)(t + 1 + b) * DM, 1.f);
            if (t - a >= 0) acc8(s, zb + (size_t)(t - a) * DM, -1.f);
        }
    }
}

__device__ __forceinline__ float gelu_tanh(float x) { const float y = 0.7978845608028654f * (x + 0.044715f * x * x * x); return x * __builtin_amdgcn_rcpf(1.0f + __expf(-2.0f * y)); }
__device__ __forceinline__ void ld8f(const bf16_t* p, float* o) { const v4u v = *(const v4u*)p; o[0] = bflo(v.x); o[1] = bfhi(v.x); o[2] = bflo(v.y); o[3] = bfhi(v.y); o[4] = bflo(v.z); o[5] = bfhi(v.z); o[6] = bflo(v.w); o[7] = bfhi(v.w); }
__device__ __forceinline__ float dpp_ror1(float v) { return __int_as_float(__builtin_amdgcn_update_dpp(0, __float_as_int(v), 0x121, 0xf, 0xf, false)); }
__device__ __forceinline__ float dpp_ror15(float v) { return __int_as_float(__builtin_amdgcn_update_dpp(0, __float_as_int(v), 0x12F, 0xf, 0xf, false)); }
struct EpiGlu {
    static constexpr bool PERM = true, AFTER_DRAIN = false;
    bf16_t* ACT; bf16_t* HB; const float* cw; const float* cb;
    __device__ __forceinline__ void operator()(const pg8::f32x4 (&acc)[2][2][4][2], const pg8::Unit& u, int wr, int wc, int fr, int fq) const {
        const int jc = u.pn * 128 + wc * 32 + 8 * fq;
        const bool first = (fr == 0), last = (fr == 15);
        v2u stash[2][4];
#pragma unroll
        for (int n = 0; n < 2; ++n) {
            const f4 w0g = *(const f4*)(cw + jc + 4 * n), w1g = *(const f4*)(cw + NUP + jc + 4 * n), w2g = *(const f4*)(cw + 2 * NUP + jc + 4 * n), bg = *(const f4*)(cb + jc + 4 * n);
            const f4 w0v = *(const f4*)(cw + DFF + jc + 4 * n), w1v = *(const f4*)(cw + NUP + DFF + jc + 4 * n), w2v = *(const f4*)(cw + 2 * NUP + DFF + jc + 4 * n), bv = *(const f4*)(cb + DFF + jc + 4 * n);
#pragma unroll
            for (int ai = 0; ai < 2; ++ai) {
                float g1p[4], v1p[4], g15c[4], v15c[4];
#pragma unroll
                for (int i = 0; i < 4; ++i) { g1p[i] = 0.f; v1p[i] = 0.f; g15c[i] = dpp_ror15(acc[ai][0][0][n][i]); v15c[i] = dpp_ror15(acc[ai][1][0][n][i]); }
#pragma unroll
                for (int m = 0; m < 4; ++m) {
                    const int mn = m < 3 ? m + 1 : 3;
                    float o[4];
#pragma unroll
                    for (int i = 0; i < 4; ++i) {
                        const float g = acc[ai][0][m][n][i], v = acc[ai][1][m][n][i];
                        const float g1c = dpp_ror1(g), v1c = dpp_ror1(v), g15n = dpp_ror15(acc[ai][0][mn][n][i]), v15n = dpp_ror15(acc[ai][1][mn][n][i]);
                        const float gp = first ? g1p[i] : g1c, gn = last ? g15n : g15c[i], vp = first ? v1p[i] : v1c, vn = last ? v15n : v15c[i];
                        g1p[i] = g1c; v1p[i] = v1c; g15c[i] = g15n; v15c[i] = v15n;
                        const float a = gp * w0g[i] + g * w1g[i] + gn * w2g[i] + bg[i];
                        const float b = vp * w0v[i] + v * w1v[i] + vn * w2v[i] + bv[i];
                        const float e = __builtin_amdgcn_exp2f(a * (-2.3022082f + -0.10294324f * (a * a)));
                        o[i] = a * __builtin_amdgcn_rcpf(1.0f + e) * b;
                    }
                    const int row = u.pm * pg8::BM + ai * pg8::HALF + wr * 64 + m * 16 + fr;
                    v2u w; w.x = pk2(o[0], o[1]); w.y = pk2(o[2], o[3]);
                    if (n == 0) stash[ai][m] = w;
                    else { v4u ww; ww.x = stash[ai][m].x; ww.y = stash[ai][m].y; ww.z = w.x; ww.w = w.y; *(v4u*)(ACT + (size_t)row * DFF + jc) = ww; }
                }
            }
        }
#pragma unroll
        for (int ai = 0; ai < 2; ++ai) {
            const int grp = u.pm * 4 + ai * 2 + wr;
            if (fr < 2 || fr >= 14) {
                const int m = fr < 2 ? 0 : 3, slot = fr < 2 ? fr : fr - 12;
                bf16_t* hp = HB + ((size_t)grp * 4 + slot) * NUP + u.pn * 256 + wc * 32 + 8 * fq;
#pragma unroll
                for (int bj = 0; bj < 2; ++bj) {
                    const pg8::f32x4 v0 = fr < 2 ? acc[ai][bj][0][0] : acc[ai][bj][3][0], v1 = fr < 2 ? acc[ai][bj][0][1] : acc[ai][bj][3][1];
                    v4u w; w.x = pk2(v0[0], v0[1]); w.y = pk2(v0[2], v0[3]); w.z = pk2(v1[0], v1[1]); w.w = pk2(v1[2], v1[3]);
                    *(v4u*)(hp + bj * 128) = w;
                }
                (void)m;
            }
        }
    }
};
__device__ __forceinline__ void glu_fix(const bf16_t* HB, bf16_t* ACT, const float* cw, const float* cb, int gtid, int NT) {
    constexpr int NCC = DFF / 8, NG = CHUNK / 64;
    for (int it = gtid; it < NG * 2 * NCC; it += NT) {
        const int cc = it % NCC, rest = it / NCC, which = rest & 1, g = rest >> 1, j0 = cc * 8, colp = (j0 >> 7) * 256 + (j0 & 127);
        const int row = g * 64 + (which ? 63 : 0); const int Lc = row < NPROMPT ? 16384 : 4096;
        const bf16_t *P, *C, *N;
        if (!which) { C = HB + ((size_t)g * 4 + 0) * NUP; N = HB + ((size_t)g * 4 + 1) * NUP; P = ((row & (Lc - 1)) == 0) ? nullptr : HB + ((size_t)(g - 1) * 4 + 3) * NUP; }
        else { P = HB + ((size_t)g * 4 + 2) * NUP; C = HB + ((size_t)g * 4 + 3) * NUP; N = (((row + 1) & (Lc - 1)) == 0) ? nullptr : HB + ((size_t)(g + 1) * 4 + 0) * NUP; }
        float pg[8], pv[8], cg_[8], cv[8], ng[8], nv[8];
        if (P) { ld8f(P + colp, pg); ld8f(P + colp + 128, pv); } else {
#pragma unroll
            for (int i = 0; i < 8; ++i) { pg[i] = 0.f; pv[i] = 0.f; } }
        if (N) { ld8f(N + colp, ng); ld8f(N + colp + 128, nv); } else {
#pragma unroll
            for (int i = 0; i < 8; ++i) { ng[i] = 0.f; nv[i] = 0.f; } }
        ld8f(C + colp, cg_); ld8f(C + colp + 128, cv);
        float o[8];
#pragma unroll
        for (int h = 0; h < 2; ++h) {
            const f4 w0g = *(const f4*)(cw + j0 + 4 * h), w1g = *(const f4*)(cw + NUP + j0 + 4 * h), w2g = *(const f4*)(cw + 2 * NUP + j0 + 4 * h), bg = *(const f4*)(cb + j0 + 4 * h);
            const f4 w0v = *(const f4*)(cw + DFF + j0 + 4 * h), w1v = *(const f4*)(cw + NUP + DFF + j0 + 4 * h), w2v = *(const f4*)(cw + 2 * NUP + DFF + j0 + 4 * h), bv = *(const f4*)(cb + DFF + j0 + 4 * h);
#pragma unroll
            for (int q = 0; q < 4; ++q) { const int i = 4 * h + q;
                const float a = pg[i] * w0g[q] + cg_[i] * w1g[q] + ng[i] * w2g[q] + bg[q];
                const float b = pv[i] * w0v[q] + cv[i] * w1v[q] + nv[i] * w2v[q] + bv[q];
                o[i] = gelu_tanh(a) * b; } }
        v4u w; w.x = pk2(o[0], o[1]); w.y = pk2(o[2], o[3]); w.z = pk2(o[4], o[5]); w.w = pk2(o[6], o[7]);
        *(v4u*)(ACT + (size_t)row * DFF + j0) = w;
    }
}

struct BRow1 { const att::bf16* base; size_t ldb; __device__ __forceinline__ const att::bf16* row(int kk) const { return base + (size_t)kk * ldb; } };
struct St1 { att::bf16* base; size_t ldb; float scale; __device__ __forceinline__ void store16(int m, int c, att::u32x4 v) const { *(att::u32x4*)(base + (size_t)m * ldb + c) = v; } };
struct BRow3 { const att::bf16* base; int R, lgR, k1; __device__ __forceinline__ const att::bf16* row(int kk) const { const int part = kk >> lgR, t2 = kk & (R - 1); return base + (size_t)(((part << lgR) + k1) * R + t2) * 512; } };
struct St3 { att::bf16* base; int R; float scale; __device__ __forceinline__ void store16(int m, int c, att::u32x4 v) const { *(att::u32x4*)(base + (size_t)(m * R) * DM + c) = v; } };

__device__ __forceinline__ void dft_stage1(const bf16_t* Gp, bf16_t* Yp, const unsigned char* ws, char* lds, int vcu, int G) {
    for (int it = 0;; ++it) { const int uid = it * G + vcu; if (uid >= 3072) break;
        if (uid < 1024) { const int s = uid >> 9, nt = uid & 511; const size_t off = (size_t)s * (2u * 16384u * 512u) + (size_t)nt * 128;
            BRow1 br{(const att::bf16*)Gp + off, 65536}; St1 st{(att::bf16*)Yp + off, 65536, 1.f};
            att::dft_unit<8, 4>((const att::bf16*)(ws + WS_A1P), 256, br, st, lds);
        } else { const int u2 = uid - 1024, s = u2 >> 8, nt = u2 & 255; const size_t off = (size_t)NPROMPT * 1024 + (size_t)s * (2u * 4096u * 512u) + (size_t)nt * 128;
            BRow1 br{(const att::bf16*)Gp + off, 32768}; St1 st{(att::bf16*)Yp + off, 32768, 1.f};
            att::dft_unit<4, 2>((const att::bf16*)(ws + WS_A1S), 128, br, st, lds);
        }
    }
}
__device__ __forceinline__ void dft_stage3(const bf16_t* Yp, bf16_t* H, const unsigned char* ws, char* lds, int vcu, int G) {
    for (int it = 0;; ++it) { const int uid = it * G + vcu; if (uid >= 3072) break;
        if (uid < 1024) { const int s = uid >> 9, k1 = (uid >> 2) & 127, nt = uid & 3;
            BRow3 br{(const att::bf16*)Yp + (size_t)s * (2u * 16384u * 512u) + nt * 128, 128, 7, k1};
            St3 st{(att::bf16*)H + (size_t)(s * 16384 + k1) * DM + 1536 + nt * 128, 128, 1.0f / sqrtf(16384.f * 128.f)};
            att::dft_unit<4, 4>((const att::bf16*)(ws + WS_A3P) + (size_t)k1 * (128 * 256), 256, br, st, lds);
        } else { const int u2 = uid - 1024, s = u2 >> 8, k1 = (u2 >> 2) & 63, nt = u2 & 3;
            BRow3 br{(const att::bf16*)Yp + (size_t)NPROMPT * 1024 + (size_t)s * (2u * 4096u * 512u) + nt * 128, 64, 6, k1};
            St3 st{(att::bf16*)H + (size_t)(NPROMPT + s * 4096 + k1) * DM + 1536 + nt * 128, 64, 1.0f / sqrtf(4096.f * 128.f)};
            att::dft_unit<2, 2>((const att::bf16*)(ws + WS_A3S) + (size_t)k1 * (64 * 128), 128, br, st, lds);
        }
    }
}

template <bool SHIFT> __device__ __forceinline__ void attn_units(const bf16_t* Z, bf16_t* H, float bound, char* lds, int vcu, int G) {
    for (int it = 0;; ++it) { const int uid = it * G + vcu; if (uid >= 2048) break;
        int rowbase, h, qb, seq;
        if (uid < 1024) { const int s = uid >> 9; h = (uid >> 6) & 7; qb = uid & 63; rowbase = s * 16384; seq = 16384; }
        else { const int u2 = uid - 1024, s = u2 >> 7; h = (u2 >> 4) & 7; qb = u2 & 15; rowbase = NPROMPT + s * 4096; seq = 4096; }
        const att::bf16* Q = (const att::bf16*)Z + (size_t)(rowbase + qb * 256) * DM + 512 + h * 128;
        const att::bf16* K = (const att::bf16*)Z + (size_t)rowbase * DM + 1536 + (h >> 2) * 128;
        att::bf16* O = (att::bf16*)H + (size_t)(rowbase + qb * 256) * DM + 512 + h * 128;
        att::attn_dense_body<att::bf16, SHIFT>(Q, K, K + 256, O, seq, lds, bound);
        __syncthreads();
    }
}
__device__ __forceinline__ void attn_phase(const bf16_t* Z, bf16_t* H, const float* qn, const float* kn, char* lds, int vcu, int G) {
    float mq = 0.f, mk = 0.f;
    for (int i = 0; i < 128; ++i) { mq = fmaxf(mq, fabsf(qn[i])); mk = fmaxf(mk, fabsf(kn[i])); }
    const float bound = 128.f * mq * mk * 1.02f;
    const bool noshift = __builtin_amdgcn_readfirstlane((int)(bound * (att::SCALE * 1.4426950408889634f) < 60.f)) != 0;
    if (noshift) attn_units<false>(Z, H, bound, lds, vcu, G);
    else attn_units<true>(Z, H, bound, lds, vcu, G);
}

struct Params { const float* in[17]; float* out; unsigned char* ws; int ph_lo, ph_hi; };
constexpr int NPL = 9;
constexpr int NPHASE = 2 + 2 * NPL;

__global__ void __launch_bounds__(512, 2) mega_fwd(Params p) {
    extern __shared__ __attribute__((aligned(16))) unsigned char lds[];
    cg::grid_group grid = cg::this_grid();
    const int G = gridDim.x, bx = blockIdx.x;
    const int vcu = (G % 8 == 0) ? (bx % 8) * (G / 8) + bx / 8 : bx;
    const int NGW = G * 8, NT = G * 512;
    unsigned char* ws = p.ws;
    const float *x_prompt = p.in[0], *x_sample = p.in[1], *g_pre_mix = p.in[2], *g_post_mix = p.in[3], *w_in = p.in[4], *pool_w = p.in[5], *pool_scale = p.in[6],
                *q_norm = p.in[7], *k_norm = p.in[8], *fourier_w = p.in[9], *w_out = p.in[10], *g_pre_ffn = p.in[11], *g_post_ffn = p.in[12], *w_up = p.in[13],
                *conv_w = p.in[14], *conv_b = p.in[15], *w_down = p.in[16];
    bf16_t* XH = (bf16_t*)(ws + WS_XH); bf16_t* Z = (bf16_t*)(ws + WS_Z); bf16_t* Gp = (bf16_t*)(ws + WS_G); bf16_t* Yp = (bf16_t*)(ws + WS_Y);
    bf16_t* HB = (bf16_t*)(ws + WS_HB); bf16_t* ACT = (bf16_t*)(ws + WS_ACT); bf16_t* XB = (bf16_t*)(ws + WS_XB);
    LAS unsigned char* ring = (LAS unsigned char*)lds;
    volatile LAS unsigned* bst = (volatile LAS unsigned*)(ring + 131072 + 64);
    if (threadIdx.x < 2) bst[threadIdx.x] = 0u;
    __syncthreads();
    XcdBarrier xbar = xcd_barrier_post((unsigned*)(ws + WS_BAR), bst);

    for (int ph = p.ph_lo; ph < p.ph_hi; ++ph) {
        const int tid = ltid(), lane = tid & 63, wave = __builtin_amdgcn_readfirstlane(tid >> 6);
        const int gw = vcu * 8 + wave, gtid = bx * 512 + tid;
        if (ph == 0) {
#if !defined(ONLY) || ONLY==0
            for (int rep = 0; rep < REP_P0; ++rep) p0a_tables(fourier_w, ws, (LAS float*)ring, gtid, NT);
#endif
        } else if (ph == 1) {
#if !defined(ONLY) || ONLY==1
            LAS float* scr = (LAS float*)(ring + wave * 16384);
            for (int l = 0; l < 2 * REP_P0; ++l) {
                bf16_t* Wl = (bf16_t*)(ws + WS_W + (l & 1) * W_LAYER);
                ValWin vw{w_in + (size_t)(l & 1) * DM * WINW, pool_w + (size_t)(l & 1) * 4 * 16384, pool_scale + (l & 1) * 512, (const float*)(ws + WS_M2F) + (size_t)(l & 1) * 4 * 32768};
                transpose_matrix(vw, DM, NIN, Wl, scr, gw, NGW, lane, 512, 2048);
                fold_items(vw.win, vw.poolw, vw.pscale, vw.m2f, Wl, gw, NGW, lane);
                ValDirect vo{w_out + (size_t)(l & 1) * DM * DM, DM};
                transpose_matrix(vo, DM, DM, (bf16_t*)((unsigned char*)Wl + W_OUT_OFF), scr, gw, NGW, lane, 0, DM);
                ValUp vu{w_up + (size_t)(l & 1) * DM * NUP};
                transpose_matrix(vu, DM, NUP, (bf16_t*)((unsigned char*)Wl + W_UP_OFF), scr, gw, NGW, lane, 0, NUP);
                ValDirect vd{w_down + (size_t)(l & 1) * DFF * DM, DM};
                transpose_matrix(vd, DFF, DM, (bf16_t*)((unsigned char*)Wl + W_DOWN_OFF), scr, gw, NGW, lane, 0, DM);
            }
            for (int rep = 0; rep < REP_P0; ++rep) resid_rows<false, false, 2>(x_prompt, x_sample, nullptr, nullptr, nullptr, nullptr, nullptr, XH, g_pre_mix, gw, NGW, lane);
#endif
        } else {
            const int l = (ph - 2) / NPL, q = (ph - 2) % NPL;
            const bf16_t* Wl = (const bf16_t*)(ws + WS_W + l * W_LAYER);
            if (q == 0) {
#if !defined(ONLY) || ONLY==2
                pg8::Gemm g{XH, Wl, MTOK, NIN, DM}; pg8::StaticOrder S; S.init(MTOK, NIN, G, bx);
                EpiWin E{Z, Gp};
                for (int rep = 0; rep < REP_WIN; ++rep) pg8::gemm_phase<EpiWin, pg8::StaticOrder, PG8_ALIGN, PG8_SP2>(ring, g, S, E);
#endif
            } else if (q == 1) {
#if !defined(ONLY) || ONLY==3
                for (int rep = 1; rep < REP_ROPE; ++rep) rope_pass(Z, (bf16_t*)(ws + WS_END), q_norm + l * 128, k_norm + l * 128, (const float*)(ws + WS_COS), (const float*)(ws + WS_SIN), gtid, NT);
                rope_pass(Z, Z, q_norm + l * 128, k_norm + l * 128, (const float*)(ws + WS_COS), (const float*)(ws + WS_SIN), gtid, NT);
                for (int rep = 0; rep < REP_LIGHT * REP_POOL; ++rep) pool_pass(Z, XH, gtid, NT);
                for (int rep = 0; rep < REP_LIGHT; ++rep) dft_stage1(Gp, Yp, ws, (char*)lds, vcu, G);
#endif
            } else if (q == 2) {
#if !defined(ONLY) || ONLY==4
                for (int rep = 0; rep < REP_ATTN; ++rep) attn_phase(Z, XH, q_norm + l * 128, k_norm + l * 128, (char*)lds, vcu, G);
#endif
#if !defined(ONLY) || ONLY==5
                for (int rep = 0; rep < REP_LIGHT; ++rep) dft_stage3(Yp, XH, ws, (char*)lds, vcu, G);
#endif
            } else if (q == 4) {
#if !defined(ONLY) || ONLY==6
                for (int rep = 1; rep < REP_RES; ++rep) resid_rows<true, true, 4>(nullptr, nullptr, XB, Z, g_post_mix + DM, nullptr, nullptr, (bf16_t*)(ws + WS_END), g_pre_ffn + DM, gw, NGW, lane);
                if (l == 0) resid_rows<false, true, 2>(x_prompt, x_sample, nullptr, Z, g_post_mix, nullptr, XB, XH, g_pre_ffn, gw, NGW, lane);
                else resid_rows<true, true, 4>(nullptr, nullptr, XB, Z, g_post_mix + DM, nullptr, XB, XH, g_pre_ffn + DM, gw, NGW, lane);
#endif
            } else if (q == 8) {
#if !defined(ONLY) || ONLY==6
                if (l == 0) resid_rows<true, true, 4>(nullptr, nullptr, XB, XH, g_post_ffn, nullptr, XB, XH, g_pre_mix + DM, gw, NGW, lane);
                else resid_rows<true, false, 4>(nullptr, nullptr, XB, XH, g_post_ffn + DM, p.out, nullptr, nullptr, nullptr, gw, NGW, lane);
#endif
            } else {
                const int c = 0, step = (q >= 5) ? (q - 5) : -1;
                const float* cwl = conv_w + (size_t)l * 3 * NUP; const float* cbl = conv_b + (size_t)l * NUP;
                if (step == 1) {
#if !defined(ONLY) || ONLY==7
                    for (int rep = 0; rep < REP_LIGHT; ++rep) glu_fix(HB, ACT, cwl, cbl, gtid, NT);
#endif
                } else if (step == 0) {
#if !defined(ONLY) || ONLY==9
                    pg8::Gemm g{XH + (size_t)c * CHUNK * DM, (const bf16_t*)((const unsigned char*)Wl + W_UP_OFF), CHUNK, NUP, DM};
                    pg8::StaticOrder S; S.init(g.M, g.N, G, bx);
                    EpiGlu E{ACT, HB, cwl, cbl};
                    for (int rep = 0; rep < REP_UP; ++rep) pg8::gemm_phase<EpiGlu, pg8::StaticOrder, PG8_ALIGN, PG8_SP2>(ring, g, S, E);
#endif
                } else {
#if !defined(ONLY) || ONLY==8
                    pg8::Gemm g; bf16_t* O;
                    if (q == 3) { g = pg8::Gemm{XH, (const bf16_t*)((const unsigned char*)Wl + W_OUT_OFF), MTOK, DM, DM}; O = Z; }
                    else { g = pg8::Gemm{ACT, (const bf16_t*)((const unsigned char*)Wl + W_DOWN_OFF), CHUNK, DM, DFF}; O = XH + (size_t)c * CHUNK * DM; }
                    pg8::StaticOrder S; S.init(g.M, g.N, G, bx);
                    pg8::EpiBf16<0> E{O, DM, nullptr, 0, 0, 1.f};
                    for (int rep = 0; rep < REP_PLAIN; ++rep) pg8::gemm_phase<pg8::EpiBf16<0>, pg8::StaticOrder, PG8_ALIGN, PG8_SP2>(ring, g, S, E);
#endif
                }
            }
        }
        if (ph + 1 < p.ph_hi) { for (int rep = 0; rep < REP_SYNC; ++rep) { if (MK_MULTI == 0 && ph != 0) xcd_barrier(xbar); else grid.sync(); } }
    }
}

extern "C" void kernel_launch(void* const* d_in, const int* in_sizes, int n_in, void* d_out, int out_size, void* d_ws, size_t ws_size, hipStream_t stream) {
    static int grid = 0;
    if (grid == 0) {
        if (n_in != 17 || out_size != MTOK * DM || ws_size < WS_END) { fprintf(stderr, "kernel_launch: unexpected shapes: n_in %d out %d ws %zu (need %zu)\n", n_in, out_size, ws_size, (size_t)WS_END); grid = -1; return; }
        int dev = 0, cus = 0, per_cu = 0;
        if (hipGetDevice(&dev) != hipSuccess || hipDeviceGetAttribute(&cus, hipDeviceAttributeMultiprocessorCount, dev) != hipSuccess) { grid = -1; return; }
        if (hipFuncSetAttribute((const void*)mega_fwd, hipFuncAttributeMaxDynamicSharedMemorySize, LDS_BYTES) != hipSuccess) { fprintf(stderr, "kernel_launch: hipFuncSetAttribute failed\n"); grid = -1; return; }
        if (hipOccupancyMaxActiveBlocksPerMultiprocessor(&per_cu, (const void*)mega_fwd, 512, LDS_BYTES) != hipSuccess || per_cu < 1) { fprintf(stderr, "kernel_launch: occupancy query says %d\n", per_cu); per_cu = 1; }
        (void)hipGetLastError();
        grid = cus * 1;
    }
    if (grid < 0) return;
    if (hipMemsetAsync((char*)d_ws + WS_BAR, 0, BAR_BYTES, stream) != hipSuccess) { fprintf(stderr, "kernel_launch: memset failed\n"); return; }
    Params p{};
    for (int i = 0; i < 17; ++i) p.in[i] = (const float*)d_in[i];
    p.out = (float*)d_out; p.ws = (unsigned char*)d_ws;
#if MK_MULTI
    for (int ph = 0; ph < NPHASE; ++ph) { p.ph_lo = ph; p.ph_hi = ph + 1; hipLaunchKernelGGL(mega_fwd, dim3(grid), dim3(512), LDS_BYTES, stream, p); }
#else
    p.ph_lo = 0; p.ph_hi = NPHASE;
    void* args[] = {&p};
    hipError_t e = hipLaunchCooperativeKernel((const void*)mega_fwd, dim3(grid), dim3(512), args, LDS_BYTES, stream);
    if (e != hipSuccess) fprintf(stderr, "cooperative launch failed: %s (grid %d)\n", hipGetErrorString(e), grid);
#endif
}
```

```cpp
#include <hip/hip_runtime.h>
#include <hip/hip_bf16.h>
#include <hip/hip_cooperative_groups.h>
#include <cstdio>
#include <cstdint>
#ifndef MK_MULTI
#define MK_MULTI 0
#endif
__device__ __forceinline__ int ltid() { int t = threadIdx.x; asm volatile("" : "+v"(t)); return t; }
#ifndef REP_UP
#define REP_UP 1
#endif
#ifndef REP_ATTN
#define REP_ATTN 1
#endif
#ifndef REP_PLAIN
#define REP_PLAIN 1
#endif
#ifndef REP_WIN
#define REP_WIN 1
#endif
#ifndef REP_P0
#define REP_P0 1
#endif
#ifndef REP_LIGHT
#define REP_LIGHT 1
#endif
#ifndef REP_SYNC
#define REP_SYNC 1
#endif
#ifndef REP_ROPE
#define REP_ROPE 1
#endif
#ifndef REP_RES
#define REP_RES 1
#endif
#ifndef REP_POOL
#define REP_POOL 1
#endif
#ifndef REP_BAR
#define REP_BAR 0
#endif
namespace pg8 {
#define PG8_LAS __attribute__((address_space(3)))
typedef unsigned short bf16_t;
typedef short bf16x8 __attribute__((ext_vector_type(8)));
typedef float f32x4 __attribute__((ext_vector_type(4)));
typedef unsigned u32x4 __attribute__((ext_vector_type(4)));
constexpr int BM = 256, BK = 64, HALF = 128, HTB = HALF * BK * 2  , STAGE_BYTES = 8 * HTB, NXCD = 8, WGM = 4;

__host__ __device__ __forceinline__ int lds_byte(int r, int c) { const int st = (r >> 4) * 2 + (c >> 5), rr = r & 15, cc = c & 31, ob = rr * 64 + cc * 2; return st * 1024 + (ob ^ (((ob >> 9) & 1) << 5)); }
__host__ __device__ __forceinline__ void stage_rc(int b, int& R, int& C) { const int st = b / 1024, sb = b % 1024, swz = sb ^ (((sb >> 9) & 1) << 5); R = (st >> 1) * 16 + swz / 64; C = (st & 1) * 32 + (swz % 64) / 2; }
__host__ __device__ __forceinline__ int perm32(int rho) { const int n = rho >> 4, i = rho & 15; return 8 * (i >> 2) + 4 * n + (i & 3); }

struct Unit { int pm, pn; };
struct Gemm { const bf16_t* A; const bf16_t* Bt; int M, N, K; };

struct StaticOrder {
    int nM, nN, nwg, G, c;
    __host__ __device__ void init(int M, int N, int G_, int c_) { nM = M / BM; nN = N / BM; nwg = nM * nN; G = G_; c = c_; }
    __host__ __device__ bool next(int i, Unit& u) const {
        const long L = (long)i * G + c; if (L >= nwg) return false;
        int wgid = (int)L; { const int q = nwg / NXCD, r = nwg % NXCD, xcd = wgid % NXCD, off = wgid / NXCD; wgid = (xcd < r ? xcd * (q + 1) : r * (q + 1) + (xcd - r) * q) + off; }
        const int nig = WGM * nN, gid = wgid / nig, fm = gid * WGM, gsz = (nM - fm) < WGM ? (nM - fm) : WGM;
        u.pm = fm + ((wgid % nig) % gsz); u.pn = (wgid % nig) / gsz; return true;
    }
    __device__ __forceinline__ void a_ready(const Unit&) const {}
    __device__ __forceinline__ void done(const Unit&) const {}
};

__device__ __forceinline__ unsigned cvt_pk_bf16(float lo, float hi) { unsigned r; asm volatile("v_cvt_pk_bf16_f32 %0, %1, %2" : "=v"(r) : "v"(lo), "v"(hi)); return r; }
typedef float f32x2 __attribute__((ext_vector_type(2)));
__device__ __forceinline__ f32x2 gelu_pk(f32x2 v) {
    const f32x2 av = __builtin_elementwise_abs(v), d = av * 0.2316418882f + 1.0f;
    f32x2 t; t.x = __builtin_amdgcn_rcpf(d.x); t.y = __builtin_amdgcn_rcpf(d.y);
    f32x2 q = t * 0.5307027145f + (-0.7265760135f); q = q * t + 0.7107068705f; q = q * t + (-0.142248368f); q = q * t + 0.127414796f; q = q * t;
    const f32x2 s = (v * v) * (-0.72134752044f);
    f32x2 e; e.x = __builtin_amdgcn_exp2f(s.x); e.y = __builtin_amdgcn_exp2f(s.y);
    const f32x2 m = v * (q * e), r = v - m;
    f32x2 o; o.x = v.x < 0.f ? m.x : r.x; o.y = v.y < 0.f ? m.y : r.y; return o;
}

template <int ACT  > struct EpiBf16 {
    static constexpr bool PERM = true, AFTER_DRAIN = false; static_assert(ACT == 0 || ACT == 1, "EpiBf16: ACT is 0 (none) or 1 (gelu_pk)");
    bf16_t* O; int ldc; const float* bias; int split_cols; size_t split_stride; float scale0;
    __device__ __forceinline__ void operator()(const f32x4 (&acc)[2][2][4][2], const Unit& u, int wr, int wc, int fr, int fq) const {
        const int row0 = u.pm * BM + wr * 64 + fr; int colt = u.pn * BM; bf16_t* base = O;
        float sc = 1.f; if (split_cols) { const int t = colt / split_cols; base += (size_t)t * split_stride; colt -= t * split_cols; if (t == 0) sc = scale0; }
        const int col0 = colt + wc * 32 + 8 * fq, bcol0 = u.pn * BM + wc * 32 + 8 * fq;
        f32x4 bv[2][2];
#pragma unroll
        for (int bj = 0; bj < 2; ++bj)
#pragma unroll
            for (int n = 0; n < 2; ++n) bv[bj][n] = bias ? *(const f32x4*)(bias + bcol0 + bj * HALF + 4 * n) : (f32x4){0.f, 0.f, 0.f, 0.f};
#pragma unroll
        for (int ai = 0; ai < 2; ++ai)
#pragma unroll
            for (int m = 0; m < 4; ++m) { bf16_t* rowp = base + (size_t)(row0 + ai * HALF + m * 16) * ldc + col0;
#pragma unroll
                for (int bj = 0; bj < 2; ++bj) { f32x4 v0 = acc[ai][bj][m][0] + bv[bj][0], v1 = acc[ai][bj][m][1] + bv[bj][1];
                    if (ACT == 1) { f32x2 a = gelu_pk((f32x2){v0[0], v0[1]}), b = gelu_pk((f32x2){v0[2], v0[3]}), c = gelu_pk((f32x2){v1[0], v1[1]}), d = gelu_pk((f32x2){v1[2], v1[3]});
                        v0 = (f32x4){a.x, a.y, b.x, b.y}; v1 = (f32x4){c.x, c.y, d.x, d.y}; }
                    v0 = v0 * sc; v1 = v1 * sc; u32x4 w; w.x = cvt_pk_bf16(v0[0], v0[1]); w.y = cvt_pk_bf16(v0[2], v0[3]); w.z = cvt_pk_bf16(v1[0], v1[1]); w.w = cvt_pk_bf16(v1[2], v1[3]);
                    *(u32x4*)(rowp + bj * HALF) = w; } }
    }
};
template <class Epi, class Sched, bool ALIGN_EPI = false, bool SP2 = false>
__device__ __forceinline__ void gemm_phase(PG8_LAS unsigned char* lds, const Gemm g, const Sched& S, const Epi& E) {
    const int tid = ltid(), wid = __builtin_amdgcn_readfirstlane(tid >> 6), lane = tid & 63, wr = wid >> 2, wc = wid & 3, fr = lane & 15, fq = lane >> 4;
    const int K = g.K, nt = K / BK;
    unsigned voffA[2], voffB[2];
#pragma unroll
    for (int i = 0; i < 2; ++i) { int R, C; stage_rc(tid * 16 + i * 8192, R, C); const int Rb = Epi::PERM ? ((R & ~31) + perm32(R & 31)) : R;
        voffA[i] = (unsigned)(R * K + C) * 2u; voffB[i] = (unsigned)(Rb * K + C) * 2u; }
    const size_t kstep = (size_t)(BK * 2);
    const size_t hstep = (size_t)HALF * K * 2;
    const size_t tstep = 2 * hstep;
    const unsigned ldsw = (unsigned)wid * 1024u;
    const int aoff = lds_byte(wr * 64 + fr, fq * 8), boff = lds_byte(wc * 32 + fr, fq * 8);
#define PG8_SA(b, h) (((b) * 2 + (h)) * HTB)
#define PG8_SB(b, h) ((4 + (b) * 2 + (h)) * HTB)
#define PG8_STAGE(bufoff, gbase, voff) do { _Pragma("unroll") for (int _i = 0; _i < 2; ++_i) \
        __builtin_amdgcn_global_load_lds((const unsigned*)((const char*)(gbase) + (voff)[_i]), (PG8_LAS unsigned*)(lds + (bufoff) + ldsw + _i * 8192), 16, 0, 0); } while (0)
#define PG8_LDA(dst, b, h) do { _Pragma("unroll") for (int m = 0; m < 4; ++m) _Pragma("unroll") for (int k = 0; k < 2; ++k) dst[m][k] = *(const PG8_LAS bf16x8*)(lds + PG8_SA(b, h) + aoff + m * 2048 + k * 1024); } while (0)
#define PG8_LDB(dst, b, h) do { _Pragma("unroll") for (int n = 0; n < 2; ++n) _Pragma("unroll") for (int k = 0; k < 2; ++k) dst[n][k] = *(const PG8_LAS bf16x8*)(lds + PG8_SB(b, h) + boff + n * 2048 + k * 1024); } while (0)
#define PG8_MMA(ai, bj, At, Bt) do { __builtin_amdgcn_s_setprio(1); _Pragma("unroll") for (int m = 0; m < 4; ++m) _Pragma("unroll") for (int n = 0; n < 2; ++n) _Pragma("unroll") for (int k = 0; k < 2; ++k) \
        acc[ai][bj][m][n] = __builtin_amdgcn_mfma_f32_16x16x32_bf16(Bt[n][k], At[m][k], acc[ai][bj][m][n], 0, 0, 0); __builtin_amdgcn_s_setprio(0); } while (0)
#define PG8_WAIT_V(n) asm volatile("s_waitcnt vmcnt(" #n ")" ::: "memory")
#define PG8_WAIT_L(n) asm volatile("s_waitcnt lgkmcnt(" #n ")" ::: "memory")
#define PG8_BAR __builtin_amdgcn_s_barrier()
#define PG8_SCHED __builtin_amdgcn_sched_barrier(0)
    Unit cur, nxt; int ui = 0;
    if (!S.next(0, cur)) return;
    f32x4 acc[2][2][4][2];
#pragma unroll
    for (int a = 0; a < 2; ++a)
#pragma unroll
        for (int b = 0; b < 2; ++b)
#pragma unroll
            for (int m = 0; m < 4; ++m)
#pragma unroll
                for (int n = 0; n < 2; ++n) acc[a][b][m][n] = (f32x4){0.f, 0.f, 0.f, 0.f};
    bf16x8 At[4][2], B0[2][2], B1[2][2];
    const char* cA = (const char*)g.A + (size_t)cur.pm * tstep; const char* cB = (const char*)g.Bt + (size_t)cur.pn * tstep;
    S.a_ready(cur);
    if constexpr (SP2) {
        PG8_STAGE(PG8_SB(0, 0), cB, voffB); PG8_STAGE(PG8_SB(0, 1), cB + hstep, voffB); PG8_STAGE(PG8_SA(0, 0), cA, voffA); PG8_STAGE(PG8_SA(0, 1), cA + hstep, voffA);
        if (wr == 1) PG8_BAR;
        PG8_WAIT_V(2); PG8_BAR;
        PG8_STAGE(PG8_SB(1, 0), cB + kstep, voffB); PG8_STAGE(PG8_SA(1, 0), cA + kstep, voffA); PG8_STAGE(PG8_SB(1, 1), cB + hstep + kstep, voffB);
        PG8_WAIT_V(6); PG8_BAR;
    } else {
        PG8_STAGE(PG8_SB(0, 0), cB, voffB); PG8_STAGE(PG8_SA(0, 0), cA, voffA); PG8_STAGE(PG8_SB(0, 1), cB + hstep, voffB); PG8_STAGE(PG8_SA(0, 1), cA + hstep, voffA);
        if (wr == 1) PG8_BAR;
        PG8_WAIT_V(4); PG8_BAR;
        PG8_STAGE(PG8_SB(1, 0), cB + kstep, voffB); PG8_STAGE(PG8_SA(1, 0), cA + kstep, voffA); PG8_STAGE(PG8_SB(1, 1), cB + hstep + kstep, voffB);
        PG8_WAIT_V(6); PG8_BAR;
    }
    for (;;) {
        const bool has_next = S.next(ui + 1, nxt);
        const char* nA = has_next ? (const char*)g.A + (size_t)nxt.pm * tstep : cA; const char* nB = has_next ? (const char*)g.Bt + (size_t)nxt.pn * tstep : cB;
        for (int t = 0; t < nt; t += 2) {
            const bool last = (t == nt - 2);
            const char* a1 = cA + (size_t)(t + 1) * kstep;
            const char* a2 = last ? nA : cA + (size_t)(t + 2) * kstep; const char* b2 = last ? nB : cB + (size_t)(t + 2) * kstep;
            const char* a3 = a2 + kstep; const char* b3 = b2 + kstep;
            if (last && has_next) S.a_ready(nxt);
            if constexpr (SP2) {
            PG8_LDB(B0, 0, 0); PG8_LDB(B1, 0, 1); PG8_SCHED; PG8_LDA(At, 0, 0); PG8_STAGE(PG8_SA(1, 1), a1 + hstep, voffA);
            PG8_WAIT_V(8); PG8_WAIT_L(0); PG8_BAR; PG8_MMA(0, 0, At, B0); PG8_MMA(0, 1, At, B1); PG8_BAR; PG8_SCHED;
            PG8_LDA(At, 0, 1); PG8_STAGE(PG8_SB(0, 0), b2, voffB); PG8_STAGE(PG8_SB(0, 1), b2 + hstep, voffB); PG8_STAGE(PG8_SA(0, 0), a2, voffA);
            PG8_WAIT_V(8); PG8_WAIT_L(0); PG8_BAR; PG8_MMA(1, 0, At, B0); PG8_MMA(1, 1, At, B1); PG8_BAR; PG8_SCHED;
            PG8_LDB(B0, 1, 0); PG8_LDB(B1, 1, 1); PG8_SCHED; PG8_LDA(At, 1, 0); PG8_STAGE(PG8_SA(0, 1), a2 + hstep, voffA);
            PG8_WAIT_V(8); PG8_WAIT_L(0); PG8_BAR; PG8_MMA(0, 0, At, B0); PG8_MMA(0, 1, At, B1); PG8_BAR; PG8_SCHED;
            PG8_LDA(At, 1, 1); PG8_STAGE(PG8_SB(1, 0), b3, voffB); PG8_STAGE(PG8_SB(1, 1), b3 + hstep, voffB); PG8_STAGE(PG8_SA(1, 0), a3, voffA);
            PG8_WAIT_V(8); PG8_WAIT_L(0); PG8_BAR; PG8_MMA(1, 0, At, B0); PG8_MMA(1, 1, At, B1); PG8_BAR; PG8_SCHED;
            } else {
            PG8_LDB(B0, 0, 0); PG8_SCHED; PG8_LDA(At, 0, 0); PG8_STAGE(PG8_SA(1, 1), a1 + hstep, voffA);
            PG8_WAIT_L(8); PG8_BAR; PG8_WAIT_L(0); PG8_MMA(0, 0, At, B0); PG8_BAR; PG8_SCHED;
            PG8_LDB(B1, 0, 1); PG8_STAGE(PG8_SB(0, 0), b2, voffB);
            PG8_BAR; PG8_WAIT_L(0); PG8_MMA(0, 1, At, B1); PG8_BAR;
            PG8_LDA(At, 0, 1); PG8_STAGE(PG8_SA(0, 0), a2, voffA);
            PG8_BAR; PG8_WAIT_L(0); PG8_MMA(1, 0, At, B0); PG8_BAR; PG8_SCHED;
            PG8_STAGE(PG8_SB(0, 1), b2 + hstep, voffB);
            PG8_WAIT_V(6); PG8_BAR; PG8_MMA(1, 1, At, B1); PG8_BAR;
            PG8_LDB(B0, 1, 0); PG8_SCHED; PG8_LDA(At, 1, 0); PG8_STAGE(PG8_SA(0, 1), a2 + hstep, voffA);
            PG8_WAIT_L(8); PG8_BAR; PG8_WAIT_L(0); PG8_MMA(0, 0, At, B0); PG8_BAR; PG8_SCHED;
            PG8_LDB(B1, 1, 1); PG8_STAGE(PG8_SB(1, 0), b3, voffB);
            PG8_BAR; PG8_WAIT_L(0); PG8_MMA(0, 1, At, B1); PG8_BAR;
            PG8_LDA(At, 1, 1); PG8_STAGE(PG8_SA(1, 0), a3, voffA);
            PG8_BAR; PG8_WAIT_L(0); PG8_MMA(1, 0, At, B0); PG8_BAR; PG8_SCHED;
            PG8_STAGE(PG8_SB(1, 1), b3 + hstep, voffB);
            PG8_WAIT_V(6); PG8_BAR; PG8_MMA(1, 1, At, B1); PG8_BAR;
            }
        }
        if constexpr (ALIGN_EPI) { if (wr == 0) PG8_BAR; }
        if constexpr (!Epi::AFTER_DRAIN) { E(acc, cur, wr, wc, fr, fq); S.done(cur); }
        if (!has_next) break;
#pragma unroll
        for (int a = 0; a < 2; ++a)
#pragma unroll
            for (int b = 0; b < 2; ++b)
#pragma unroll
                for (int m = 0; m < 4; ++m)
#pragma unroll
                    for (int n = 0; n < 2; ++n) acc[a][b][m][n] = (f32x4){0.f, 0.f, 0.f, 0.f};
        cur = nxt; cA = nA; cB = nB; ++ui;
        if constexpr (ALIGN_EPI) { if (wr == 1) PG8_BAR; }
    }
    PG8_WAIT_V(0);
    if constexpr (!ALIGN_EPI) { if (wr == 0) PG8_BAR; }
    PG8_BAR;
    if constexpr (Epi::AFTER_DRAIN) { E.fused(acc, cur, wr, wc, fr, fq, lds, wid, lane); S.done(cur); }
#undef PG8_SA
#undef PG8_SB
#undef PG8_STAGE
#undef PG8_LDA
#undef PG8_LDB
#undef PG8_MMA
#undef PG8_WAIT_V
#undef PG8_WAIT_L
#undef PG8_BAR
#undef PG8_SCHED
}
}
#define PG8_SP2 true
#define PG8_ALIGN true
namespace att {
using bf16 = __hip_bfloat16;
constexpr int   D = 128, NW = 8, QBLK = 32, KVBLK = 64;
constexpr float SCALE = 0.088388347648318440f;
constexpr float THR = 8.f;
constexpr int SDEPTH = 2;
constexpr bool STATIC_MAX = true;
constexpr int LDQ = 2048, LDK = 2048, LDO = 2048;
constexpr size_t SHM_V = KVBLK * D * 2, SHM_K = KVBLK * D * 2, SHM_ATTN = 2 * SHM_V + 2 * SHM_K + NW * 64 * 4;
using bf16x8 = __attribute__((ext_vector_type(8))) short;
using s16x4  = __attribute__((ext_vector_type(4))) short;
using f32x16 = __attribute__((ext_vector_type(16))) float;
using f32x8  = __attribute__((ext_vector_type(8))) float;
using u32x4  = __attribute__((ext_vector_type(4))) unsigned;
#define KSWZ(row, colB) ((row) * 256 + ((colB) ^ (((row) & 7) << 4)))
#define SBAR() __builtin_amdgcn_sched_barrier(0)
__device__ __forceinline__ int crow(int r, int hi) { return (r & 3) + 8 * (r >> 2) + 4 * hi; }
__device__ __forceinline__ unsigned cvtpk(float lo, float hi) {
  unsigned r; asm volatile("v_cvt_pk_bf16_f32 %0, %1, %2" : "=v"(r) : "v"(lo), "v"(hi)); return r;
}
template <typename TIn> struct Stage;
template <> struct Stage<bf16>  { using T = bf16x8;
  __device__ static __forceinline__ T ld8(const bf16* p) { return *reinterpret_cast<const bf16x8*>(p); }
  __device__ static __forceinline__ bf16x8 tobf(T x) { return x; } };
template <> struct Stage<float> { using T = f32x8;
  __device__ static __forceinline__ T ld8(const float* p) { return *reinterpret_cast<const f32x8*>(p); }
  __device__ static __forceinline__ bf16x8 tobf(T x) {
    u32x4 w = {cvtpk(x[0], x[1]), cvtpk(x[2], x[3]), cvtpk(x[4], x[5]), cvtpk(x[6], x[7])}; return *reinterpret_cast<bf16x8*>(&w); } };

template <bool SHIFT> __device__ __forceinline__ void partialSM(f32x16& p0, f32x16& p1, float& m_reg, float& mn, float& alpha) {
  constexpr float C = SCALE * 1.4426950408889634f;
  if constexpr (STATIC_MAX) { mn = m_reg; alpha = 1.f; }
  else {
  float pmax = p0[0]; for (int r = 1; r < 16; ++r) pmax = fmaxf(pmax, p0[r]); for (int r = 0; r < 16; ++r) pmax = fmaxf(pmax, p1[r]);
  { auto rr = __builtin_amdgcn_permlane32_swap(__float_as_uint(pmax), __float_as_uint(pmax), false, false);
    pmax = fmaxf(__uint_as_float(rr[0]), __uint_as_float(rr[1])); }
  if (__builtin_expect(__all(pmax - m_reg <= THR / SCALE), 1)) { mn = m_reg; alpha = 1.f; }
  else { mn = fmaxf(m_reg, pmax); alpha = __builtin_amdgcn_exp2f((m_reg - mn) * C); m_reg = mn; }
  }
  if constexpr (!STATIC_MAX) { float mnC = -mn * C;
  for (int r = 0; r < 16; ++r) p0[r] = fmaf(p0[r], C, mnC); for (int r = 0; r < 16; ++r) p1[r] = fmaf(p1[r], C, mnC); }
  if constexpr (STATIC_MAX && SHIFT) { for (int r = 0; r < 16; ++r) p0[r] += m_reg; for (int r = 0; r < 16; ++r) p1[r] += m_reg; }
  for (int r = 0; r < 16; ++r) p0[r] = __builtin_amdgcn_exp2f(p0[r]);
}
__device__ __forceinline__ void finishSM(f32x16& p0, f32x16& p1, float alpha, float& l_reg, bf16x8& pa0, bf16x8& pa1, bf16x8& pa2, bf16x8& pa3) {
  for (int r = 0; r < 16; ++r) p1[r] = __builtin_amdgcn_exp2f(p1[r]);
  float ps = 0; for (int r = 0; r < 16; ++r) ps += p0[r]; for (int r = 0; r < 16; ++r) ps += p1[r];
  { auto rr = __builtin_amdgcn_permlane32_swap(__float_as_uint(ps), __float_as_uint(ps), false, false);
    ps = __uint_as_float(rr[0]) + __uint_as_float(rr[1]); }
  l_reg = l_reg * alpha + ps;
#define PK4(P, BASE, OUT) do { unsigned a0 = cvtpk(P[BASE + 0], P[BASE + 1]), a1 = cvtpk(P[BASE + 2], P[BASE + 3]);   \
    unsigned b0 = cvtpk(P[BASE + 4], P[BASE + 5]), b1 = cvtpk(P[BASE + 6], P[BASE + 7]);                              \
    auto r0 = __builtin_amdgcn_permlane32_swap(a0, b0, false, false); auto r1 = __builtin_amdgcn_permlane32_swap(a1, b1, false, false); \
    u32x4 w = {r0[0], r1[0], r0[1], r1[1]}; OUT = *reinterpret_cast<bf16x8*>(&w); } while (0)
  PK4(p0, 0, pa0); PK4(p0, 8, pa1); PK4(p1, 0, pa2); PK4(p1, 8, pa3);
#undef PK4
}
__device__ __forceinline__ void qkt(f32x16& p0, f32x16& p1, const bf16* Ks, const bf16x8* qr, int r32, int hi) {
#pragma unroll
  for (int d0 = 0; d0 < 8; ++d0) { int cb = (d0 * 16 + hi * 8) * 2;
    bf16x8 b0 = *reinterpret_cast<const bf16x8*>((const char*)Ks + KSWZ(r32, cb));
    bf16x8 b1 = *reinterpret_cast<const bf16x8*>((const char*)Ks + KSWZ(32 + r32, cb));
    p0 = __builtin_amdgcn_mfma_f32_32x32x16_bf16(b0, qr[d0], d0 == 0 ? f32x16{} : p0, 0, 0, 0);
    p1 = __builtin_amdgcn_mfma_f32_32x32x16_bf16(b1, qr[d0], d0 == 0 ? f32x16{} : p1, 0, 0, 0); }
}
__device__ __forceinline__ int v_st(int k, int c) { const int kk = (k & ~0xC) | ((k & 4) << 1) | ((k & 8) >> 1); return ((kk >> 3) * 4 + (c >> 5)) * 512 + ((kk & 7) * 32 + (c & 31)) * 2; }
__device__ __forceinline__ int v_rd_base(int lane) { return ((lane & 3) << 3) | (((lane >> 2) & 3) << 6) | (((lane >> 4) & 1) << 5) | (((lane >> 5) & 1) << 8); }
constexpr int v_rd_off(int d0, int ks, int half) { return d0 * 512 + ks * 4096 + half * 2048; }
template <int OFF> __device__ __forceinline__ s16x4 tr_read(int vb) {
  s16x4 r; asm volatile("ds_read_b64_tr_b16 %0, %1 offset:%2" : "=&v"(r) : "v"(vb), "i"(OFF) : "memory"); return r;
}
template <int D0> __device__ __forceinline__ void pv_one(f32x16& od, int vb, bf16x8 pa0, bf16x8 pa1, bf16x8 pa2, bf16x8 pa3) {
  const s16x4 l0 = tr_read<v_rd_off(D0, 0, 0)>(vb), h0 = tr_read<v_rd_off(D0, 0, 1)>(vb), l1 = tr_read<v_rd_off(D0, 1, 0)>(vb), h1 = tr_read<v_rd_off(D0, 1, 1)>(vb);
  const s16x4 l2 = tr_read<v_rd_off(D0, 2, 0)>(vb), h2 = tr_read<v_rd_off(D0, 2, 1)>(vb), l3 = tr_read<v_rd_off(D0, 3, 0)>(vb), h3 = tr_read<v_rd_off(D0, 3, 1)>(vb);
  asm volatile("s_waitcnt lgkmcnt(0)" ::: "memory"); SBAR();
#define PK(L, H) (bf16x8){L[0], L[1], L[2], L[3], H[0], H[1], H[2], H[3]}
  od = __builtin_amdgcn_mfma_f32_32x32x16_bf16(pa0, PK(l0, h0), od, 0, 0, 0);
  od = __builtin_amdgcn_mfma_f32_32x32x16_bf16(pa1, PK(l1, h1), od, 0, 0, 0);
  od = __builtin_amdgcn_mfma_f32_32x32x16_bf16(pa2, PK(l2, h2), od, 0, 0, 0);
  od = __builtin_amdgcn_mfma_f32_32x32x16_bf16(pa3, PK(l3, h3), od, 0, 0, 0);
#undef PK
}
__device__ __forceinline__ void pv_d0(f32x16* o, int vb, bf16x8 pa0, bf16x8 pa1, bf16x8 pa2, bf16x8 pa3) {
  pv_one<0>(o[0], vb, pa0, pa1, pa2, pa3); pv_one<1>(o[1], vb, pa0, pa1, pa2, pa3); pv_one<2>(o[2], vb, pa0, pa1, pa2, pa3); pv_one<3>(o[3], vb, pa0, pa1, pa2, pa3);
}
template <typename TQ, bool SHIFT>
__device__ __forceinline__ void attn_dense_body(const TQ* __restrict__ Qb, const bf16* __restrict__ Kh, const bf16* __restrict__ Vh,
                                                bf16* __restrict__ Ob, int seq, char* lds, float bound) {
  using St = Stage<bf16>; using SQ = Stage<TQ>;
  const int tid = ltid(), wid = tid >> 6, lane = tid & 63, r32 = lane & 31, hi = lane >> 5;
  bf16* V_lds = (bf16*)lds; bf16* K_lds = (bf16*)(lds + 2 * SHM_V);
  float* ws = (float*)(lds + 2 * SHM_V + 2 * SHM_K) + wid * 64; float* li_l = ws; float* al_l = ws + 32;
  float m_reg = STATIC_MAX ? -bound * (SCALE * 1.4426950408889634f) : -1e30f, l_reg = 0; f32x16 o[4] = {}; bf16x8 qr[8];
  const TQ* Qw = Qb + (long)(wid * QBLK + r32) * LDQ + hi * 8;
#pragma unroll
  for (int d0 = 0; d0 < 8; ++d0) qr[d0] = SQ::tobf(SQ::ld8(Qw + d0 * 16));
  const int sr = tid >> 4, sc = (tid & 15) * 8, vst0 = v_st(sr, sc), vst1 = v_st(32 + sr, sc);
  const int vb0 = (int)(uintptr_t)V_lds + v_rd_base(lane);
  struct { typename St::T vs0, vs1, ks0, ks1; } sr_[SDEPTH];
#define SLOAD(i, k0) do { sr_[i].vs0 = St::ld8(&Vh[(long)((k0) + sr) * LDK + sc]); sr_[i].vs1 = St::ld8(&Vh[(long)((k0) + 32 + sr) * LDK + sc]); \
    sr_[i].ks0 = St::ld8(&Kh[(long)((k0) + sr) * LDK + sc]); sr_[i].ks1 = St::ld8(&Kh[(long)((k0) + 32 + sr) * LDK + sc]); } while (0)
#define SWRITE(b, i) do { *(bf16x8*)((char*)V_lds + (b) * SHM_V + vst0) = St::tobf(sr_[i].vs0);          \
    *(bf16x8*)((char*)V_lds + (b) * SHM_V + vst1) = St::tobf(sr_[i].vs1); int kc = sc * 2;               \
    *(bf16x8*)((char*)K_lds + (b) * SHM_K + KSWZ(sr, kc)) = St::tobf(sr_[i].ks0);                       \
    *(bf16x8*)((char*)K_lds + (b) * SHM_K + KSWZ(32 + sr, kc)) = St::tobf(sr_[i].ks1); } while (0)
#define SWAIT() do { if constexpr (SDEPTH == 2) asm volatile("s_waitcnt vmcnt(4)" ::: "memory"); else asm volatile("s_waitcnt vmcnt(0)" ::: "memory"); } while (0)
#define RESC(a) do { if (!STATIC_MAX && __any((a) < 1.f)) { if (hi == 0) al_l[r32] = (a); asm volatile("s_waitcnt lgkmcnt(0)" ::: "memory"); \
    for (int d = 0; d < 4; ++d) for (int r = 0; r < 16; ++r) o[d][r] *= al_l[crow(r, hi)]; } } while (0)
  f32x16 pA0, pA1, pB0, pB1; float mnA, mnB, alA, alB; bf16x8 pa0, pa1, pa2, pa3; const int NT = seq / KVBLK;
  constexpr int SE = 0, SO = SDEPTH - 1;
  SLOAD(SE, 0); asm volatile("s_waitcnt vmcnt(0)" ::: "memory"); SWRITE(0, SE); __syncthreads();
  qkt(pA0, pA1, K_lds, qr, r32, hi); partialSM<SHIFT>(pA0, pA1, m_reg, mnA, alA);
  SLOAD(SO, KVBLK); if constexpr (SDEPTH == 2) { if (2 < NT) SLOAD(SE, 2 * KVBLK); }
  SWAIT(); SWRITE(1, SO); __syncthreads();
  for (int j = 1; j + 1 < NT; j += 2) {
    SBAR(); qkt(pB0, pB1, (bf16*)((char*)K_lds + SHM_K), qr, r32, hi);
    finishSM(pA0, pA1, alA, l_reg, pa0, pa1, pa2, pa3); SBAR();
    SLOAD(SO, (j + SDEPTH) * KVBLK); SBAR();
    pv_d0(o, vb0, pa0, pa1, pa2, pa3); partialSM<SHIFT>(pB0, pB1, m_reg, mnB, alB);
    __syncthreads(); SWAIT(); SWRITE(0, SE);
    RESC(alB); __syncthreads();
    SBAR(); qkt(pA0, pA1, K_lds, qr, r32, hi);
    finishSM(pB0, pB1, alB, l_reg, pa0, pa1, pa2, pa3); SBAR();
    if (SDEPTH == 1 || j + 3 < NT) SLOAD(SE, (j + 1 + SDEPTH) * KVBLK); SBAR();
    pv_d0(o, vb0 + (int)SHM_V, pa0, pa1, pa2, pa3); partialSM<SHIFT>(pA0, pA1, m_reg, mnA, alA);
    __syncthreads(); SWAIT(); SWRITE(1, SO);
    RESC(alA); __syncthreads();
  }
  SBAR(); qkt(pB0, pB1, (bf16*)((char*)K_lds + SHM_K), qr, r32, hi);
  finishSM(pA0, pA1, alA, l_reg, pa0, pa1, pa2, pa3); SBAR();
  pv_d0(o, vb0, pa0, pa1, pa2, pa3); partialSM<SHIFT>(pB0, pB1, m_reg, mnB, alB);
  __syncthreads(); RESC(alB);
  finishSM(pB0, pB1, alB, l_reg, pa0, pa1, pa2, pa3); SBAR();
  pv_d0(o, vb0 + (int)SHM_V, pa0, pa1, pa2, pa3);
  if (hi == 0) li_l[r32] = l_reg; asm volatile("s_waitcnt lgkmcnt(0)" ::: "memory");
  float rli[16];
#pragma unroll
  for (int r = 0; r < 16; ++r) rli[r] = __builtin_amdgcn_rcpf(li_l[crow(r, hi)]);
  bf16* Ow = Ob + (long)(wid * QBLK) * LDO;
#pragma unroll
  for (int r = 0; r < 16; ++r) { int orow = crow(r, hi);
    for (int d0 = 0; d0 < 4; ++d0) Ow[(long)orow * LDO + d0 * 32 + r32] = __float2bfloat16(o[d0][r] * rli[r]); }
#undef SLOAD
#undef SWRITE
#undef SWAIT
#undef RESC
}

template <int NC> __device__ __forceinline__ void pv_n(f32x16* o, int vb, bf16x8 pa0, bf16x8 pa1, bf16x8 pa2, bf16x8 pa3) {
  pv_one<0>(o[0], vb, pa0, pa1, pa2, pa3);
  if constexpr (NC > 1) pv_one<1>(o[1], vb, pa0, pa1, pa2, pa3);
  if constexpr (NC > 2) { pv_one<2>(o[2], vb, pa0, pa1, pa2, pa3); pv_one<3>(o[3], vb, pa0, pa1, pa2, pa3); }
}
template <int MB, int NKT, class BR, class ST>
__device__ __forceinline__ void dft_unit(const bf16* __restrict__ A, int lda, const BR& br, const ST& st, char* lds) {
  constexpr int NBW = 8 / MB, NC = 4 / NBW;
  const int tid = ltid(), wid = tid >> 6, lane = tid & 63, r32 = lane & 31, hi = lane >> 5;
  const int mb = wid % MB, cgp = wid / MB;
  const int sr = tid >> 4, sc = (tid & 15) * 8, vst0 = v_st(sr, sc), vst1 = v_st(32 + sr, sc);
  bf16x8 bq[NKT][2], af[NKT][4];
#pragma unroll
  for (int kt = 0; kt < NKT; ++kt) {
    bq[kt][0] = *reinterpret_cast<const bf16x8*>(br.row(kt * 64 + sr) + sc);
    bq[kt][1] = *reinterpret_cast<const bf16x8*>(br.row(kt * 64 + 32 + sr) + sc);
  }
  const bf16* Aw = A + (long)(mb * 32 + r32) * lda + hi * 8;
#pragma unroll
  for (int kt = 0; kt < NKT; ++kt)
#pragma unroll
    for (int ks = 0; ks < 4; ++ks) af[kt][ks] = *reinterpret_cast<const bf16x8*>(Aw + kt * 64 + ks * 16);
  __syncthreads();
#pragma unroll
  for (int kt = 0; kt < NKT; ++kt) {
    *(bf16x8*)(lds + kt * 16384 + vst0) = bq[kt][0];
    *(bf16x8*)(lds + kt * 16384 + vst1) = bq[kt][1];
  }
  __syncthreads();
  f32x16 o[NC];
#pragma unroll
  for (int d = 0; d < NC; ++d) o[d] = f32x16{};
  const int vb = (int)(uintptr_t)lds + v_rd_base(lane) + cgp * NC * 512;
#pragma unroll
  for (int kt = 0; kt < NKT; ++kt) pv_n<NC>(o, vb + kt * 16384, af[kt][0], af[kt][1], af[kt][2], af[kt][3]);
  bf16* stg = (bf16*)(lds + 65536) + wid * 4096;
  const float sc_ = st.scale;
#pragma unroll
  for (int r = 0; r < 16; ++r) {
#pragma unroll
    for (int d = 0; d < NC; ++d) stg[crow(r, hi) * (NC * 32) + d * 32 + r32] = __float2bfloat16(o[d][r] * sc_);
  }
  asm volatile("s_waitcnt lgkmcnt(0)" ::: "memory");
#pragma unroll
  for (int i = 0; i < NC * 2; ++i) { const int idx = i * 64 + lane, row = idx / (NC * 4), cc = idx % (NC * 4);
    const u32x4 v = *(const u32x4*)(stg + row * (NC * 32) + cc * 8);
    st.store16(mb * 32 + row, cgp * NC * 32 + cc * 8, v); }
  asm volatile("s_waitcnt lgkmcnt(0)" ::: "memory");
}
#undef SBAR
#undef KSWZ
}

namespace cg = cooperative_groups;
#define LAS __attribute__((address_space(3)))
typedef unsigned short bf16_t;
typedef unsigned v4u __attribute__((ext_vector_type(4)));
typedef unsigned v2u __attribute__((ext_vector_type(2)));
typedef float f4 __attribute__((ext_vector_type(4)));

#define XB_TMO      128
#define XB_XCNT(j)  (256  + 64 * (j))
#define XB_XSUB(j)  (1280 + 64 * (j))
#define XB_XGEN(j)  (2304 + 64 * (j))
#define XB_TOP      3328
#define XB_TOPGEN   3392
#define XCD_BAR_WORDS 3456
#define XB_SPIN_CAP (1u << 18)

__device__ __forceinline__ unsigned xb_ld(unsigned* p)              { return __hip_atomic_load(p, __ATOMIC_RELAXED, __HIP_MEMORY_SCOPE_AGENT); }
__device__ __forceinline__ unsigned xb_add(unsigned* p, unsigned v) { return __hip_atomic_fetch_add(p, v, __ATOMIC_RELAXED, __HIP_MEMORY_SCOPE_AGENT); }
__device__ __forceinline__ unsigned xb_xcc_id() { return (unsigned)__builtin_amdgcn_s_getreg((3 << 11) | 20) & 0xFu; }
#define XB_SPIN(cond, bar) do { unsigned _sp = 0; while (cond) { __builtin_amdgcn_s_sleep(1); \
    if ((++_sp & 255u) == 0u) { if (xb_ld(&(bar)[XB_TMO])) break; if (_sp > XB_SPIN_CAP) { atomicAdd(&(bar)[XB_TMO], 1u); break; } } } } while (0)

struct XcdBarrier {
    unsigned* bar; unsigned x;
    volatile LAS unsigned* st;
};

__device__ __forceinline__ XcdBarrier xcd_barrier_post(unsigned* bar, volatile LAS unsigned* st) {
    XcdBarrier b; b.bar = bar; b.x = xb_xcc_id(); b.st = st;
    if (threadIdx.x == 0) (void)xb_add(&bar[XB_XCNT(b.x)], 1u);
    return b;
}
__device__ __forceinline__ void xcd_barrier_complete(unsigned* bar, unsigned x, unsigned& nloc, unsigned& nx) {
    const unsigned G = gridDim.x * gridDim.y * gridDim.z;
    unsigned sum, cnt, mine, sp = 0u;
    for (;;) {
        sum = 0u; cnt = 0u; mine = 0u;
#pragma unroll
        for (unsigned j = 0; j < 16; ++j) { const unsigned c = xb_ld(&bar[XB_XCNT(j)]); sum += c; cnt += (c > 0u) ? 1u : 0u; mine = (j == x) ? c : mine; }
        if (sum == G) break;
        __builtin_amdgcn_s_sleep(1);
        if ((++sp & 255u) == 0u) { if (xb_ld(&bar[XB_TMO])) break; if (sp > XB_SPIN_CAP) { atomicAdd(&bar[XB_TMO], 1u); break; } }
    }
    nloc = mine > 0u ? mine : 1u; nx = cnt > 0u ? cnt : 1u;
}

__device__ __forceinline__ void xcd_barrier(const XcdBarrier& b) {
    asm volatile("s_waitcnt vmcnt(0)" ::: "memory");
    __syncthreads();
    if (threadIdx.x == 0) {
        unsigned* bar = b.bar;
        __builtin_amdgcn_s_waitcnt(0);
        unsigned nloc = b.st[0], nx = b.st[1];
        if (nloc == 0u) { xcd_barrier_complete(bar, b.x, nloc, nx); b.st[0] = nloc; b.st[1] = nx; }
        const unsigned old = xb_add(&bar[XB_XSUB(b.x)], 1u);
        const unsigned gen = old / nloc;
        if (old + 1u == (gen + 1u) * nloc) {
            __builtin_amdgcn_fence(__ATOMIC_RELEASE, "agent");
            asm volatile("s_waitcnt vmcnt(0)" ::: "memory");
            const unsigned og = xb_add(&bar[XB_TOP], 1u);
            const unsigned tg = og / nx;
            if (og + 1u == (tg + 1u) * nx) xb_add(&bar[XB_TOPGEN], 1u);
            else XB_SPIN(xb_ld(&bar[XB_TOPGEN]) == tg, bar);
            __builtin_amdgcn_fence(__ATOMIC_ACQUIRE, "agent");
            xb_add(&bar[XB_XGEN(b.x)], 1u);
            asm volatile("s_waitcnt vmcnt(0)" ::: "memory");
        } else {
            XB_SPIN(xb_ld(&bar[XB_XGEN(b.x)]) == gen, bar);
            __builtin_amdgcn_fence(__ATOMIC_ACQUIRE, "agent");
            asm volatile("s_waitcnt vmcnt(0)" ::: "memory");
        }
    }
    __syncthreads();
}

constexpr int DM = 2048, MTOK = 65536, NIN = 3072, DFF = 5632, NUP = 11264, WINW = 2560;
constexpr int NPROMPT = 32768;
constexpr int CHUNK = 65536, NCHUNK = 1;
constexpr float EPS = 1e-6f;
constexpr size_t MiB = (size_t)1 << 20;
constexpr size_t WS_M2F = 0;
constexpr size_t WS_COS = 1 * MiB, WS_SIN = 5 * MiB;
constexpr size_t WS_A1P = 9 * MiB, WS_A1S = 9 * MiB + 128 * 1024;
constexpr size_t WS_A3P = 10 * MiB, WS_A3S = 18 * MiB;
constexpr size_t WS_BAR = 19 * MiB, BAR_BYTES = 16384;
constexpr size_t WS_W = 20 * MiB;
constexpr size_t W_LAYER = 86 * MiB, W_OUT_OFF = 12 * MiB, W_UP_OFF = 20 * MiB, W_DOWN_OFF = 64 * MiB;
constexpr size_t WS_XH = 192 * MiB;
constexpr size_t WS_Z = 448 * MiB;
constexpr size_t WS_G = 704 * MiB;
constexpr size_t WS_Y = 832 * MiB;
constexpr size_t WS_ACT = 448 * MiB;
constexpr size_t WS_HB = 1152 * MiB;
constexpr size_t WS_XB = 1240 * MiB;
constexpr size_t WS_END = 1496 * MiB;
constexpr int LDS_BYTES = 135168;

__device__ __forceinline__ float bf2f(unsigned short b) { return __uint_as_float((unsigned)b << 16); }
__device__ __forceinline__ float bflo(unsigned w) { return __uint_as_float(w << 16); }
__device__ __forceinline__ float bfhi(unsigned w) { return __uint_as_float(w & 0xffff0000u); }
__device__ __forceinline__ unsigned pk2(float lo, float hi) { return pg8::cvt_pk_bf16(lo, hi); }
__device__ __forceinline__ float wave_sum(float v) {
#pragma unroll
    for (int o = 1; o < 64; o <<= 1) v += __shfl_xor(v, o);
    return v;
}

struct EpiWin {
    static constexpr bool PERM = true, AFTER_DRAIN = false;
    bf16_t* Z; bf16_t* Gp;
    __device__ __forceinline__ void operator()(const pg8::f32x4 (&acc)[2][2][4][2], const pg8::Unit& u, int wr, int wc, int fr, int fq) const {
        const int row0 = u.pm * pg8::BM + wr * 64 + fr;
        bf16_t* base; size_t rstride, bjstride;
        if (u.pn < 8) { base = Z + (size_t)row0 * 2048 + u.pn * 256 + wc * 32 + 8 * fq; rstride = 2048; bjstride = 128; }
        else {
            const int g = u.pn - 8, r0 = u.pm * pg8::BM; size_t sb; int L, t0;
            if (r0 < NPROMPT) { const int s = r0 >> 14; sb = (size_t)s * (2u * 16384u * 512u); L = 16384; t0 = row0 - s * 16384; }
            else { const int s = (r0 - NPROMPT) >> 12; sb = (size_t)NPROMPT * 1024 + (size_t)s * (2u * 4096u * 512u); L = 4096; t0 = row0 - NPROMPT - s * 4096; }
            base = Gp + sb + (size_t)t0 * 512 + g * 128 + wc * 32 + 8 * fq; rstride = 512; bjstride = (size_t)L * 512;
        }
#pragma unroll
        for (int ai = 0; ai < 2; ++ai)
#pragma unroll
            for (int m = 0; m < 4; ++m) { bf16_t* rowp = base + (size_t)(ai * pg8::HALF + m * 16) * rstride;
#pragma unroll
                for (int bj = 0; bj < 2; ++bj) { const pg8::f32x4 v0 = acc[ai][bj][m][0], v1 = acc[ai][bj][m][1];
                    pg8::u32x4 w; w.x = pk2(v0[0], v0[1]); w.y = pk2(v0[2], v0[3]); w.z = pk2(v1[0], v1[1]); w.w = pk2(v1[2], v1[3]);
                    *(pg8::u32x4*)(rowp + bj * bjstride) = w; } }
    }
};

__device__ __forceinline__ void p0a_tables(const float* fourier_w, unsigned char* ws, LAS float* tab, int gtid, int NT) {
    float* M2F = (float*)(ws + WS_M2F);
    { const int t = ltid(); if (t < 128) { float sn, cs; sincospif((float)t * (2.f / 128.f), &sn, &cs); tab[t] = cs; tab[128 + t] = -sn; } }
    __syncthreads();
    for (int i = gtid; i < 2 * 4 * 128 * 256; i += NT) {
        const int lg = i >> 15, c = (i >> 8) & 127, n = i & 255, part = n >> 7, e2 = n & 127;
        const float* fw = fourier_w + (size_t)lg * 16384 + e2;
        float acc = 0.f;
#pragma unroll 8
        for (int e = 0; e < 128; ++e) { const int r = (c * e) & 127; acc += tab[part * 128 + r] * fw[e * 128]; }
        M2F[i] = acc;
    }
    __syncthreads();
    float* COS = (float*)(ws + WS_COS); float* SIN = (float*)(ws + WS_SIN);
    for (int i = gtid; i < 16384 * 64; i += NT) {
        const int t = i >> 6, j = i & 63; const float pos = (float)(j < 32 ? (t >> 6) : (t & 63));
        const float inv = 1.0f / powf(10000.0f, (float)(j & 31) / 32.0f); const float ang = pos * inv;
        COS[i] = cosf(ang); SIN[i] = sinf(ang);
    }
    bf16_t* A1P = (bf16_t*)(ws + WS_A1P);
    for (int i = gtid; i < 256 * 256; i += NT) { const int m = i >> 8, k = i & 255, pm = m >> 7, k1 = m & 127, pk = k >> 7, t1 = k & 127; const int r = (t1 * k1) & 127;
        float sn, cs; sincospif((float)r * (2.f / 128.f), &sn, &cs); const float v = (pm == pk) ? cs : (pm == 0 ? sn : -sn); A1P[i] = (bf16_t)(pk2(v, 0.f) & 0xffff); }
    bf16_t* A1S = (bf16_t*)(ws + WS_A1S);
    for (int i = gtid; i < 128 * 128; i += NT) { const int m = i >> 7, k = i & 127, pm = m >> 6, k1 = m & 63, pk = k >> 6, t1 = k & 63; const int r = (t1 * k1) & 63;
        float sn, cs; sincospif((float)r * (2.f / 64.f), &sn, &cs); const float v = (pm == pk) ? cs : (pm == 0 ? sn : -sn); A1S[i] = (bf16_t)(pk2(v, 0.f) & 0xffff); }
    bf16_t* A3P = (bf16_t*)(ws + WS_A3P);
    for (int i = gtid; i < 128 * 128 * 256; i += NT) { const int k1 = i >> 15, k2 = (i >> 8) & 127, kk = i & 255, part = kk >> 7, t2 = kk & 127; const int k = k1 + 128 * k2; const int r = (t2 * k) & 16383;
        float sn, cs; sincospif((float)r * (1.f / 8192.f), &sn, &cs); A3P[i] = (bf16_t)(pk2(part ? sn : cs, 0.f) & 0xffff); }
    bf16_t* A3S = (bf16_t*)(ws + WS_A3S);
    for (int i = gtid; i < 64 * 64 * 128; i += NT) { const int k1 = i >> 13, k2 = (i >> 7) & 63, kk = i & 127, part = kk >> 6, t2 = kk & 63; const int k = k1 + 64 * k2; const int r = (t2 * k) & 4095;
        float sn, cs; sincospif((float)r * (1.f / 2048.f), &sn, &cs); A3S[i] = (bf16_t)(pk2(part ? sn : cs, 0.f) & 0xffff); }
}

struct ValUp { const float* W; __device__ __forceinline__ const float* ptr(int k, int n) const { const int src = ((n >> 7) & 1) * DFF + (n >> 8) * 128 + (n & 127); return W + (size_t)k * NUP + src; }
    __device__ __forceinline__ float operator()(int k, int n) const { return *ptr(k, n); } };
struct ValDirect { const float* W; int ldw; __device__ __forceinline__ const float* ptr(int k, int n) const { return W + (size_t)k * ldw + n; }
    __device__ __forceinline__ float operator()(int k, int n) const { return W[(size_t)k * ldw + n]; } };
struct ValWin { const float* win; const float* poolw; const float* pscale; const float* m2f;
    __device__ __forceinline__ const float* ptr(int k, int n) const { return win + (size_t)k * WINW + n; }
    __device__ __forceinline__ float operator()(int k, int n) const {
        if (n >= 512 && n < 2048) return win[(size_t)k * WINW + n];
        if (n < 512) { const int g = n >> 7, e = n & 127; const float* wr = win + (size_t)k * WINW + g * 128; const float* pw = poolw + g * 16384 + e; float acc = 0.f;
            for (int c = 0; c < 128; ++c) acc += wr[c] * pw[c * 128]; return acc * pscale[n]; }
        const int n2 = n - 2048, g = n2 >> 8, np = n2 & 255; const float* wr = win + (size_t)k * WINW + 2048 + g * 128; const float* mf = m2f + g * 32768 + np; float acc = 0.f;
        for (int c = 0; c < 128; ++c) acc += wr[c] * mf[c * 256]; return acc; } };
template <class F> __device__ __forceinline__ void transpose_item(const F& val, int K, bf16_t* WT, int k0, int n0, LAS float* scr, int lane) {
    for (int i = 0; i < 32; ++i) { const int kk = 2 * i + (lane >> 5); scr[kk * 33 + (lane & 31)] = val(k0 + kk, n0 + (lane & 31)); }
    asm volatile("s_waitcnt lgkmcnt(0)" ::: "memory");
    const int c = lane & 7;
#pragma unroll
    for (int j = 0; j < 4; ++j) { const int n = (lane >> 3) + 8 * j; const LAS float* s = scr + (8 * c) * 33 + n;
        v4u o; o.x = pk2(s[0 * 33], s[1 * 33]); o.y = pk2(s[2 * 33], s[3 * 33]); o.z = pk2(s[4 * 33], s[5 * 33]); o.w = pk2(s[6 * 33], s[7 * 33]);
        *(v4u*)(WT + (size_t)(n0 + n) * K + k0 + 8 * c) = o; }
    asm volatile("s_waitcnt lgkmcnt(0)" ::: "memory");
}
template <class F> __device__ __forceinline__ void tr_load(const F& f, int k0, int n0, int lane, f4 (&v)[8]) {
#pragma unroll
    for (int i = 0; i < 8; ++i) v[i] = __builtin_nontemporal_load((const f4*)f.ptr(k0 + 8 * i + (lane >> 3), n0 + 4 * (lane & 7)));
}
__device__ __forceinline__ void tr_store(const f4 (&v)[8], int K, bf16_t* WT, int k0, int n0, LAS float* scr, int lane) {
#pragma unroll
    for (int i = 0; i < 8; ++i) { LAS float* d = scr + (8 * i + (lane >> 3)) * 33 + 4 * (lane & 7); d[0] = v[i].x; d[1] = v[i].y; d[2] = v[i].z; d[3] = v[i].w; }
    asm volatile("s_waitcnt lgkmcnt(0)" ::: "memory");
    const int c = lane & 7;
#pragma unroll
    for (int j = 0; j < 4; ++j) { const int n = (lane >> 3) + 8 * j; const LAS float* s = scr + (8 * c) * 33 + n;
        v4u o; o.x = pk2(s[0 * 33], s[1 * 33]); o.y = pk2(s[2 * 33], s[3 * 33]); o.z = pk2(s[4 * 33], s[5 * 33]); o.w = pk2(s[6 * 33], s[7 * 33]);
        *(v4u*)(WT + (size_t)(n0 + n) * K + k0 + 8 * c) = o; }
    asm volatile("s_waitcnt lgkmcnt(0)" ::: "memory");
}
template <class F> __device__ __forceinline__ void transpose_matrix(const F& val, int K, int N, bf16_t* WT, LAS float* scr, int gw, int NGW, int lane, int nlo, int nhi) {
    const int nblk = (nhi - nlo) / 32, nitems = (K / 64) * nblk;
    int it = gw; if (it >= nitems) return;
    f4 cur[8], nxt[8];
    tr_load(val, 64 * (it / nblk), nlo + 32 * (it % nblk), lane, cur);
    for (; it < nitems; it += NGW) {
        const int k0 = 64 * (it / nblk), n0 = nlo + 32 * (it % nblk); const int it2 = it + NGW; const bool more = it2 < nitems;
        if (more) tr_load(val, 64 * (it2 / nblk), nlo + 32 * (it2 % nblk), lane, nxt);
        tr_store(cur, K, WT, k0, n0, scr, lane);
        if (more) {
#pragma unroll
            for (int i = 0; i < 8; ++i) cur[i] = nxt[i]; }
    }
}

typedef float __attribute__((address_space(4))) cf32;
__device__ __forceinline__ void fold_items(const float* win, const float* poolw, const float* pscale, const float* m2f, bf16_t* WT, int gw, int NGW, int lane) {
    for (int it = gw; it < 64 * 24; it += NGW) {
        const int kb = it / 24, nb = it - kb * 24, k0 = 32 * kb;
        float m2[128]; int base, nout;
        if (nb < 8) { const int n = nb * 64 + lane, g = nb >> 1, e = n & 127; base = g * 128; nout = n; const float sc = pscale[n]; const float* pw = poolw + g * 16384 + e;
#pragma unroll
            for (int c = 0; c < 128; ++c) m2[c] = pw[c * 128] * sc;
        } else { const int n2 = (nb - 8) * 64 + lane, g = (nb - 8) >> 2, np = n2 & 255; base = 2048 + g * 128; nout = 2048 + n2; const float* mf = m2f + g * 32768 + np;
#pragma unroll
            for (int c = 0; c < 128; ++c) m2[c] = mf[c * 256];
        }
        bf16_t* wrow = WT + (size_t)nout * DM + k0;
        for (int kg = 0; kg < 4; ++kg) {
            float acc[8];
#pragma unroll
            for (int kk = 0; kk < 8; ++kk) { const cf32* wr = (const cf32*)(unsigned long long)(win + (size_t)(k0 + 8 * kg + kk) * WINW + base); float a = 0.f;
#pragma unroll
                for (int c = 0; c < 128; ++c) a += wr[c] * m2[c];
                acc[kk] = a; }
            v4u o; o.x = pk2(acc[0], acc[1]); o.y = pk2(acc[2], acc[3]); o.z = pk2(acc[4], acc[5]); o.w = pk2(acc[6], acc[7]);
            *(v4u*)(wrow + 8 * kg) = o;
        }
    }
}

__device__ __forceinline__ const float* xrow_ptr(const float* xa, const float* xb, int row) { return (row < NPROMPT) ? xa + (size_t)row * DM : xb + (size_t)(row - NPROMPT) * DM; }
template <bool XBF, bool OBF, int RR>
__device__ __forceinline__ void resid_rows(const float* xa, const float* xb, const bf16_t* xbf, const bf16_t* m, const float* g1, float* xout, bf16_t* xbout, bf16_t* xh, const float* g2, int gw, int NGW, int lane) {
    constexpr bool W = XBF;
#define EO(k) (W ? (8 * lane + 512 * ((k) >> 1) + 4 * ((k) & 1)) : (4 * lane + 256 * (k)))
    for (int row0 = gw; row0 < MTOK; row0 += RR * NGW) {
        f4 xf[XBF ? 1 : RR][8]; v2u xp[XBF ? RR : 1][8]; v2u mw[RR][8];
#pragma unroll
        for (int u = 0; u < RR; ++u) { const int row = row0 + u * NGW;
            if constexpr (XBF) { const bf16_t* xr = xbf + (size_t)row * DM;
#pragma unroll
                for (int j = 0; j < 4; ++j) { const v4u t = __builtin_nontemporal_load((const v4u*)(xr + 8 * lane + 512 * j)); xp[u][2 * j] = (v2u){t.x, t.y}; xp[u][2 * j + 1] = (v2u){t.z, t.w}; }
            } else { const float* xr = xrow_ptr(xa, xb, row);
#pragma unroll
                for (int k = 0; k < 8; ++k) xf[u][k] = __builtin_nontemporal_load((const f4*)(xr + EO(k))); } }
        if (m) {
#pragma unroll
            for (int u = 0; u < RR; ++u) { const bf16_t* mr = m + (size_t)(row0 + u * NGW) * DM;
                if constexpr (W) {
#pragma unroll
                    for (int j = 0; j < 4; ++j) { const v4u t = __builtin_nontemporal_load((const v4u*)(mr + 8 * lane + 512 * j)); mw[u][2 * j] = (v2u){t.x, t.y}; mw[u][2 * j + 1] = (v2u){t.z, t.w}; }
                } else {
#pragma unroll
                    for (int k = 0; k < 8; ++k) mw[u][k] = __builtin_nontemporal_load((const v2u*)(mr + EO(k))); } }
        }
#pragma unroll
        for (int u = 0; u < RR; ++u) { const int row = row0 + u * NGW;
            f4 xv[8];
#pragma unroll
            for (int k = 0; k < 8; ++k) { if constexpr (XBF) { const v2u w = xp[u][k]; xv[k] = (f4){bflo(w.x), bfhi(w.x), bflo(w.y), bfhi(w.y)}; } else xv[k] = xf[u][k]; }
            if (m) { float ss = 0.f;
#pragma unroll
                for (int k = 0; k < 8; ++k) { const v2u w = mw[u][k]; const f4 mv = (f4){bflo(w.x), bfhi(w.x), bflo(w.y), bfhi(w.y)}; ss += (mv.x * mv.x + mv.y * mv.y) + (mv.z * mv.z + mv.w * mv.w); }
                const float r = 1.0f / sqrtf(wave_sum(ss) * (1.f / DM) + EPS);
#pragma unroll
                for (int k = 0; k < 8; ++k) { const v2u w = mw[u][k]; const f4 mv = (f4){bflo(w.x), bfhi(w.x), bflo(w.y), bfhi(w.y)}; const f4 gv = *(const f4*)(g1 + EO(k)); xv[k] += mv * r * gv; } }
            if constexpr (OBF) { if (xbout) {
                if constexpr (W) {
#pragma unroll
                    for (int j = 0; j < 4; ++j) { v4u w; w.x = pk2(xv[2 * j].x, xv[2 * j].y); w.y = pk2(xv[2 * j].z, xv[2 * j].w); w.z = pk2(xv[2 * j + 1].x, xv[2 * j + 1].y); w.w = pk2(xv[2 * j + 1].z, xv[2 * j + 1].w);
                        __builtin_nontemporal_store(w, (v4u*)(xbout + (size_t)row * DM + 8 * lane + 512 * j)); }
                } else {
#pragma unroll
                    for (int k = 0; k < 8; ++k) { v2u w; w.x = pk2(xv[k].x, xv[k].y); w.y = pk2(xv[k].z, xv[k].w); __builtin_nontemporal_store(w, (v2u*)(xbout + (size_t)row * DM + EO(k))); } } }
            } else { if (xout) {
#pragma unroll
                for (int k = 0; k < 8; ++k) __builtin_nontemporal_store(xv[k], (f4*)(xout + (size_t)row * DM + EO(k))); } }
            if (xh) { float ss = 0.f;
#pragma unroll
                for (int k = 0; k < 8; ++k) ss += (xv[k].x * xv[k].x + xv[k].y * xv[k].y) + (xv[k].z * xv[k].z + xv[k].w * xv[k].w);
                const float r = 1.0f / sqrtf(wave_sum(ss) * (1.f / DM) + EPS);
                if constexpr (W) {
#pragma unroll
                    for (int j = 0; j < 4; ++j) { const f4 ga = *(const f4*)(g2 + EO(2 * j)), gb = *(const f4*)(g2 + EO(2 * j + 1)); const f4 ya = xv[2 * j] * r * ga, yb = xv[2 * j + 1] * r * gb;
                        v4u w; w.x = pk2(ya.x, ya.y); w.y = pk2(ya.z, ya.w); w.z = pk2(yb.x, yb.y); w.w = pk2(yb.z, yb.w); *(v4u*)(xh + (size_t)row * DM + 8 * lane + 512 * j) = w; }
                } else {
#pragma unroll
                    for (int k = 0; k < 8; ++k) { const f4 gv = *(const f4*)(g2 + EO(k)); const f4 y = xv[k] * r * gv;
                        v2u w; w.x = pk2(y.x, y.y); w.y = pk2(y.z, y.w); *(v2u*)(xh + (size_t)row * DM + EO(k)) = w; } } }
        }
    }
#undef EO
}

__device__ __forceinline__ void rope_pass(bf16_t* Z, bf16_t* Zout, const float* qn, const float* kn, const float* COS, const float* SIN, int gtid, int NT) {
    const int qw = gtid >> 4, NQW = NT >> 4, j = gtid & 15;
    constexpr float QC = 0.088388347648318440f * 1.4426950408889634f;
    const f4 qa = *(const f4*)(qn + 4 * j) * QC, qb = *(const f4*)(qn + 64 + 4 * j) * QC, ka = *(const f4*)(kn + 4 * j), kb = *(const f4*)(kn + 64 + 4 * j);
    for (int row = qw; row < MTOK; row += NQW) {
        const int t = row < NPROMPT ? (row & 16383) : (row & 4095);
        const bf16_t* p = Z + (size_t)row * DM + 512 + 4 * j;
        v2u a[10], b[10];
#pragma unroll
        for (int hh = 0; hh < 10; ++hh) { a[hh] = *(const v2u*)(p + hh * 128); b[hh] = *(const v2u*)(p + hh * 128 + 64); }
        const f4 c = *(const f4*)(COS + t * 64 + 4 * j), sn = *(const f4*)(SIN + t * 64 + 4 * j);
        bf16_t* po = Zout + (size_t)row * DM + 512 + 4 * j;
#pragma unroll
        for (int hh = 0; hh < 10; ++hh) {
            f4 x = (f4){bflo(a[hh].x), bfhi(a[hh].x), bflo(a[hh].y), bfhi(a[hh].y)}, y = (f4){bflo(b[hh].x), bfhi(b[hh].x), bflo(b[hh].y), bfhi(b[hh].y)};
            float ss = ((x.x * x.x + x.y * x.y) + (x.z * x.z + x.w * x.w)) + ((y.x * y.x + y.y * y.y) + (y.z * y.z + y.w * y.w));
#pragma unroll
            for (int o = 1; o < 16; o <<= 1) ss += __shfl_xor(ss, o);
            const float r = 1.0f / sqrtf(ss * (1.f / 128.f) + EPS);
            x = x * r * (hh < 8 ? qa : ka); y = y * r * (hh < 8 ? qb : kb);
            const f4 ox = x * c - y * sn, oy = y * c + x * sn;
            v2u wx, wy; wx.x = pk2(ox.x, ox.y); wx.y = pk2(ox.z, ox.w); wy.x = pk2(oy.x, oy.y); wy.y = pk2(oy.z, oy.w);
            *(v2u*)(po + hh * 128) = wx; *(v2u*)(po + hh * 128 + 64) = wy;
        }
    }
}

__device__ __forceinline__ void acc8(float* s, const bf16_t* p, float sg) { const v4u v = *(const v4u*)p;
    s[0] += sg * bflo(v.x); s[1] += sg * bfhi(v.x); s[2] += sg * bflo(v.y); s[3] += sg * bfhi(v.y); s[4] += sg * bflo(v.z); s[5] += sg * bfhi(v.z); s[6] += sg * bflo(v.w); s[7] += sg * bfhi(v.w); }
__device__ __forceinline__ void pool_pass(const bf16_t* Z, bf16_t* H, int gtid, int NT) {
    constexpr int RL = 32;
    for (int it = gtid; it < (MTOK / RL) * 64; it += NT) {
        const int ch = it & 63, run = it >> 6, c0 = ch * 8, g = ch >> 4, w = 2 << g, a = w >> 1, b = w - 1 - a;
        const int row0 = run * RL; int t0, L; if (row0 < NPROMPT) { t0 = row0 & 16383; L = 16384; } else { t0 = row0 & 4095; L = 4096; }
        const bf16_t* zb = Z + (size_t)(row0 - t0) * DM + c0;
        float s[8] = {0.f, 0.f, 0.f, 0.f, 0.f, 0.f, 0.f, 0.f};
        { const int lo = t0 - a < 0 ? 0 : t0 - a, hi = t0 + b > L - 1 ? L - 1 : t0 + b;
          for (int tt = lo; tt <= hi; ++tt) acc8(s, zb + (size_t)tt * DM, 1.f); }
#pragma unroll 4
        for (int r = 0; r < RL; ++r) {
            const int t = t0 + r; const int lo = t - a < 0 ? 0 : t - a, hi = t + b > L - 1 ? L - 1 : t + b;
            const float ic = 1.0f / (float)(hi - lo + 1);
            const v4u v = *(const v4u*)(zb + (size_t)t * DM);
            v4u o; o.x = pk2(s[0] * ic - bflo(v.x), s[1] * ic - bfhi(v.x)); o.y = pk2(s[2] * ic - bflo(v.y), s[3] * ic - bfhi(v.y));
            o.z = pk2(s[4] * ic - bflo(v.z), s[5] * ic - bfhi(v.z)); o.w = pk2(s[6] * ic - bflo(v.w), s[7] * ic - bfhi(v.w));
            *(v4u*)(H + (size_t)(row0 + r) * DM + c0) = o;
            if (t + 1 + b <= L - 1) acc8(s, zb + (size_t)(t + 1 + b) * DM, 1.f);
            if (t - a >= 0) acc8(s, zb + (size_t)(t - a) * DM, -1.f);
        }
    }
}

__device__ __forceinline__ float gelu_tanh(float x) { const float y = 0.7978845608028654f * (x + 0.044715f * x * x * x); return x * __builtin_amdgcn_rcpf(1.0f + __expf(-2.0f * y)); }
__device__ __forceinline__ void ld8f(const bf16_t* p, float* o) { const v4u v = *(const v4u*)p; o[0] = bflo(v.x); o[1] = bfhi(v.x); o[2] = bflo(v.y); o[3] = bfhi(v.y); o[4] = bflo(v.z); o[5] = bfhi(v.z); o[6] = bflo(v.w); o[7] = bfhi(v.w); }
__device__ __forceinline__ float dpp_ror1(float v) { return __int_as_float(__builtin_amdgcn_update_dpp(0, __float_as_int(v), 0x121, 0xf, 0xf, false)); }
__device__ __forceinline__ float dpp_ror15(float v) { return __int_as_float(__builtin_amdgcn_update_dpp(0, __float_as_int(v), 0x12F, 0xf, 0xf, false)); }
struct EpiGlu {
    static constexpr bool PERM = true, AFTER_DRAIN = false;
    bf16_t* ACT; bf16_t* HB; const float* cw; const float* cb;
    __device__ __forceinline__ void operator()(const pg8::f32x4 (&acc)[2][2][4][2], const pg8::Unit& u, int wr, int wc, int fr, int fq) const {
        const int jc = u.pn * 128 + wc * 32 + 8 * fq;
        const bool first = (fr == 0), last = (fr == 15);
        v2u stash[2][4];
#pragma unroll
        for (int n = 0; n < 2; ++n) {
            const f4 w0g = *(const f4*)(cw + jc + 4 * n), w1g = *(const f4*)(cw + NUP + jc + 4 * n), w2g = *(const f4*)(cw + 2 * NUP + jc + 4 * n), bg = *(const f4*)(cb + jc + 4 * n);
            const f4 w0v = *(const f4*)(cw + DFF + jc + 4 * n), w1v = *(const f4*)(cw + NUP + DFF + jc + 4 * n), w2v = *(const f4*)(cw + 2 * NUP + DFF + jc + 4 * n), bv = *(const f4*)(cb + DFF + jc + 4 * n);
#pragma unroll
            for (int ai = 0; ai < 2; ++ai) {
                float g1p[4], v1p[4], g15c[4], v15c[4];
#pragma unroll
                for (int i = 0; i < 4; ++i) { g1p[i] = 0.f; v1p[i] = 0.f; g15c[i] = dpp_ror15(acc[ai][0][0][n][i]); v15c[i] = dpp_ror15(acc[ai][1][0][n][i]); }
#pragma unroll
                for (int m = 0; m < 4; ++m) {
                    const int mn = m < 3 ? m + 1 : 3;
                    float o[4];
#pragma unroll
                    for (int i = 0; i < 4; ++i) {
                        const float g = acc[ai][0][m][n][i], v = acc[ai][1][m][n][i];
                        const float g1c = dpp_ror1(g), v1c = dpp_ror1(v), g15n = dpp_ror15(acc[ai][0][mn][n][i]), v15n = dpp_ror15(acc[ai][1][mn][n][i]);
                        const float gp = first ? g1p[i] : g1c, gn = last ? g15n : g15c[i], vp = first ? v1p[i] : v1c, vn = last ? v15n : v15c[i];
                        g1p[i] = g1c; v1p[i] = v1c; g15c[i] = g15n; v15c[i] = v15n;
                        const float a = gp * w0g[i] + g * w1g[i] + gn * w2g[i] + bg[i];
                        const float b = vp * w0v[i] + v * w1v[i] + vn * w2v[i] + bv[i];
                        const float e = __builtin_amdgcn_exp2f(a * (-2.3022082f + -0.10294324f * (a * a)));
                        o[i] = a * __builtin_amdgcn_rcpf(1.0f + e) * b;
                    }
                    const int row = u.pm * pg8::BM + ai * pg8::HALF + wr * 64 + m * 16 + fr;
                    v2u w; w.x = pk2(o[0], o[1]); w.y = pk2(o[2], o[3]);
                    if (n == 0) stash[ai][m] = w;
                    else { v4u ww; ww.x = stash[ai][m].x; ww.y = stash[ai][m].y; ww.z = w.x; ww.w = w.y; *(v4u*)(ACT + (size_t)row * DFF + jc) = ww; }
                }
            }
        }
#pragma unroll
        for (int ai = 0; ai < 2; ++ai) {
            const int grp = u.pm * 4 + ai * 2 + wr;
            if (fr < 2 || fr >= 14) {
                const int m = fr < 2 ? 0 : 3, slot = fr < 2 ? fr : fr - 12;
                bf16_t* hp = HB + ((size_t)grp * 4 + slot) * NUP + u.pn * 256 + wc * 32 + 8 * fq;
#pragma unroll
                for (int bj = 0; bj < 2; ++bj) {
                    const pg8::f32x4 v0 = fr < 2 ? acc[ai][bj][0][0] : acc[ai][bj][3][0], v1 = fr < 2 ? acc[ai][bj][0][1] : acc[ai][bj][3][1];
                    v4u w; w.x = pk2(v0[0], v0[1]); w.y = pk2(v0[2], v0[3]); w.z = pk2(v1[0], v1[1]); w.w = pk2(v1[2], v1[3]);
                    *(v4u*)(hp + bj * 128) = w;
                }
                (void)m;
            }
        }
    }
};
__device__ __forceinline__ void glu_fix(const bf16_t* HB, bf16_t* ACT, const float* cw, const float* cb, int gtid, int NT) {
    constexpr int NCC = DFF / 8, NG = CHUNK / 64;
    for (int it = gtid; it < NG * 2 * NCC; it += NT) {
        const int cc = it % NCC, rest = it / NCC, which = rest & 1, g = rest >> 1, j0 = cc * 8, colp = (j0 >> 7) * 256 + (j0 & 127);
        const int row = g * 64 + (which ? 63 : 0); const int Lc = row < NPROMPT ? 16384 : 4096;
        const bf16_t *P, *C, *N;
        if (!which) { C = HB + ((size_t)g * 4 + 0) * NUP; N = HB + ((size_t)g * 4 + 1) * NUP; P = ((row & (Lc - 1)) == 0) ? nullptr : HB + ((size_t)(g - 1) * 4 + 3) * NUP; }
        else { P = HB + ((size_t)g * 4 + 2) * NUP; C = HB + ((size_t)g * 4 + 3) * NUP; N = (((row + 1) & (Lc - 1)) == 0) ? nullptr : HB + ((size_t)(g + 1) * 4 + 0) * NUP; }
        float pg[8], pv[8], cg_[8], cv[8], ng[8], nv[8];
        if (P) { ld8f(P + colp, pg); ld8f(P + colp + 128, pv); } else {
#pragma unroll
            for (int i = 0; i < 8; ++i) { pg[i] = 0.f; pv[i] = 0.f; } }
        if (N) { ld8f(N + colp, ng); ld8f(N + colp + 128, nv); } else {
#pragma unroll
            for (int i = 0; i < 8; ++i) { ng[i] = 0.f; nv[i] = 0.f; } }
        ld8f(C + colp, cg_); ld8f(C + colp + 128, cv);
        float o[8];
#pragma unroll
        for (int h = 0; h < 2; ++h) {
            const f4 w0g = *(const f4*)(cw + j0 + 4 * h), w1g = *(const f4*)(cw + NUP + j0 + 4 * h), w2g = *(const f4*)(cw + 2 * NUP + j0 + 4 * h), bg = *(const f4*)(cb + j0 + 4 * h);
            const f4 w0v = *(const f4*)(cw + DFF + j0 + 4 * h), w1v = *(const f4*)(cw + NUP + DFF + j0 + 4 * h), w2v = *(const f4*)(cw + 2 * NUP + DFF + j0 + 4 * h), bv = *(const f4*)(cb + DFF + j0 + 4 * h);
#pragma unroll
            for (int q = 0; q < 4; ++q) { const int i = 4 * h + q;
                const float a = pg[i] * w0g[q] + cg_[i] * w1g[q] + ng[i] * w2g[q] + bg[q];
                const float b = pv[i] * w0v[q] + cv[i] * w1v[q] + nv[i] * w2v[q] + bv[q];
                o[i] = gelu_tanh(a) * b; } }
        v4u w; w.x = pk2(o[0], o[1]); w.y = pk2(o[2], o[3]); w.z = pk2(o[4], o[5]); w.w = pk2(o[6], o[7]);
        *(v4u*)(ACT + (size_t)row * DFF + j0) = w;
    }
}

struct BRow1 { const att::bf16* base; size_t ldb; __device__ __forceinline__ const att::bf16* row(int kk) const { return base + (size_t)kk * ldb; } };
struct St1 { att::bf16* base; size_t ldb; float scale; __device__ __forceinline__ void store16(int m, int c, att::u32x4 v) const { *(att::u32x4*)(base + (size_t)m * ldb + c) = v; } };
struct BRow3 { const att::bf16* base; int R, lgR, k1; __device__ __forceinline__ const att::bf16* row(int kk) const { const int part = kk >> lgR, t2 = kk & (R - 1); return base + (size_t)(((part << lgR) + k1) * R + t2) * 512; } };
struct St3 { att::bf16* base; int R; float scale; __device__ __forceinline__ void store16(int m, int c, att::u32x4 v) const { *(att::u32x4*)(base + (size_t)(m * R) * DM + c) = v; } };

__device__ __forceinline__ void dft_stage1(const bf16_t* Gp, bf16_t* Yp, const unsigned char* ws, char* lds, int vcu, int G) {
    for (int it = 0;; ++it) { const int uid = it * G + vcu; if (uid >= 3072) break;
        if (uid < 1024) { const int s = uid >> 9, nt = uid & 511; const size_t off = (size_t)s * (2u * 16384u * 512u) + (size_t)nt * 128;
            BRow1 br{(const att::bf16*)Gp + off, 65536}; St1 st{(att::bf16*)Yp + off, 65536, 1.f};
            att::dft_unit<8, 4>((const att::bf16*)(ws + WS_A1P), 256, br, st, lds);
        } else { const int u2 = uid - 1024, s = u2 >> 8, nt = u2 & 255; const size_t off = (size_t)NPROMPT * 1024 + (size_t)s * (2u * 4096u * 512u) + (size_t)nt * 128;
            BRow1 br{(const att::bf16*)Gp + off, 32768}; St1 st{(att::bf16*)Yp + off, 32768, 1.f};
            att::dft_unit<4, 2>((const att::bf16*)(ws + WS_A1S), 128, br, st, lds);
        }
    }
}
__device__ __forceinline__ void dft_stage3(const bf16_t* Yp, bf16_t* H, const unsigned char* ws, char* lds, int vcu, int G) {
    for (int it = 0;; ++it) { const int uid = it * G + vcu; if (uid >= 3072) break;
        if (uid < 1024) { const int s = uid >> 9, k1 = (uid >> 2) & 127, nt = uid & 3;
            BRow3 br{(const att::bf16*)Yp + (size_t)s * (2u * 16384u * 512u) + nt * 128, 128, 7, k1};
            St3 st{(att::bf16*)H + (size_t)(s * 16384 + k1) * DM + 1536 + nt * 128, 128, 1.0f / sqrtf(16384.f * 128.f)};
            att::dft_unit<4, 4>((const att::bf16*)(ws + WS_A3P) + (size_t)k1 * (128 * 256), 256, br, st, lds);
        } else { const int u2 = uid - 1024, s = u2 >> 8, k1 = (u2 >> 2) & 63, nt = u2 & 3;
            BRow3 br{(const att::bf16*)Yp + (size_t)NPROMPT * 1024 + (size_t)s * (2u * 4096u * 512u) + nt * 128, 64, 6, k1};
            St3 st{(att::bf16*)H + (size_t)(NPROMPT + s * 4096 + k1) * DM + 1536 + nt * 128, 64, 1.0f / sqrtf(4096.f * 128.f)};
            att::dft_unit<2, 2>((const att::bf16*)(ws + WS_A3S) + (size_t)k1 * (64 * 128), 128, br, st, lds);
        }
    }
}

template <bool SHIFT> __device__ __forceinline__ void attn_units(const bf16_t* Z, bf16_t* H, float bound, char* lds, int vcu, int G) {
    for (int it = 0;; ++it) { const int uid = it * G + vcu; if (uid >= 2048) break;
        int rowbase, h, qb, seq;
        if (uid < 1024) { const int s = uid >> 9; h = (uid >> 6) & 7; qb = uid & 63; rowbase = s * 16384; seq = 16384; }
        else { const int u2 = uid - 1024, s = u2 >> 7; h = (u2 >> 4) & 7; qb = u2 & 15; rowbase = NPROMPT + s * 4096; seq = 4096; }
        const att::bf16* Q = (const att::bf16*)Z + (size_t)(rowbase + qb * 256) * DM + 512 + h * 128;
        const att::bf16* K = (const att::bf16*)Z + (size_t)rowbase * DM + 1536 + (h >> 2) * 128;
        att::bf16* O = (att::bf16*)H + (size_t)(rowbase + qb * 256) * DM + 512 + h * 128;
        att::attn_dense_body<att::bf16, SHIFT>(Q, K, K + 256, O, seq, lds, bound);
        __syncthreads();
    }
}
__device__ __forceinline__ void attn_phase(const bf16_t* Z, bf16_t* H, const float* qn, const float* kn, char* lds, int vcu, int G) {
    float mq = 0.f, mk = 0.f;
    for (int i = 0; i < 128; ++i) { mq = fmaxf(mq, fabsf(qn[i])); mk = fmaxf(mk, fabsf(kn[i])); }
    const float bound = 128.f * mq * mk * 1.02f;
    const bool noshift = __builtin_amdgcn_readfirstlane((int)(bound * (att::SCALE * 1.4426950408889634f) < 60.f)) != 0;
    if (noshift) attn_units<false>(Z, H, bound, lds, vcu, G);
    else attn_units<true>(Z, H, bound, lds, vcu, G);
}

struct Params { const float* in[17]; float* out; unsigned char* ws; int ph_lo, ph_hi; };
constexpr int NPL = 9;
constexpr int NPHASE = 2 + 2 * NPL;

__global__ void __launch_bounds__(512, 2) mega_fwd(Params p) {
    extern __shared__ __attribute__((aligned(16))) unsigned char lds[];
    cg::grid_group grid = cg::this_grid();
    const int G = gridDim.x, bx = blockIdx.x;
    const int vcu = (G % 8 == 0) ? (bx % 8) * (G / 8) + bx / 8 : bx;
    const int NGW = G * 8, NT = G * 512;
    unsigned char* ws = p.ws;
    const float *x_prompt = p.in[0], *x_sample = p.in[1], *g_pre_mix = p.in[2], *g_post_mix = p.in[3], *w_in = p.in[4], *pool_w = p.in[5], *pool_scale = p.in[6],
                *q_norm = p.in[7], *k_norm = p.in[8], *fourier_w = p.in[9], *w_out = p.in[10], *g_pre_ffn = p.in[11], *g_post_ffn = p.in[12], *w_up = p.in[13],
                *conv_w = p.in[14], *conv_b = p.in[15], *w_down = p.in[16];
    bf16_t* XH = (bf16_t*)(ws + WS_XH); bf16_t* Z = (bf16_t*)(ws + WS_Z); bf16_t* Gp = (bf16_t*)(ws + WS_G); bf16_t* Yp = (bf16_t*)(ws + WS_Y);
    bf16_t* HB = (bf16_t*)(ws + WS_HB); bf16_t* ACT = (bf16_t*)(ws + WS_ACT); bf16_t* XB = (bf16_t*)(ws + WS_XB);
    LAS unsigned char* ring = (LAS unsigned char*)lds;
    volatile LAS unsigned* bst = (volatile LAS unsigned*)(ring + 131072 + 64);
    if (threadIdx.x < 2) bst[threadIdx.x] = 0u;
    __syncthreads();
    XcdBarrier xbar = xcd_barrier_post((unsigned*)(ws + WS_BAR), bst);

    for (int ph = p.ph_lo; ph < p.ph_hi; ++ph) {
        const int tid = ltid(), lane = tid & 63, wave = __builtin_amdgcn_readfirstlane(tid >> 6);
        const int gw = vcu * 8 + wave, gtid = bx * 512 + tid;
        if (ph == 0) {
#if !defined(ONLY) || ONLY==0
            for (int rep = 0; rep < REP_P0; ++rep) p0a_tables(fourier_w, ws, (LAS float*)ring, gtid, NT);
#endif
        } else if (ph == 1) {
#if !defined(ONLY) || ONLY==1
            LAS float* scr = (LAS float*)(ring + wave * 16384);
            for (int l = 0; l < 2 * REP_P0; ++l) {
                bf16_t* Wl = (bf16_t*)(ws + WS_W + (l & 1) * W_LAYER);
                ValWin vw{w_in + (size_t)(l & 1) * DM * WINW, pool_w + (size_t)(l & 1) * 4 * 16384, pool_scale + (l & 1) * 512, (const float*)(ws + WS_M2F) + (size_t)(l & 1) * 4 * 32768};
                transpose_matrix(vw, DM, NIN, Wl, scr, gw, NGW, lane, 512, 2048);
                fold_items(vw.win, vw.poolw, vw.pscale, vw.m2f, Wl, gw, NGW, lane);
                ValDirect vo{w_out + (size_t)(l & 1) * DM * DM, DM};
                transpose_matrix(vo, DM, DM, (bf16_t*)((unsigned char*)Wl + W_OUT_OFF), scr, gw, NGW, lane, 0, DM);
                ValUp vu{w_up + (size_t)(l & 1) * DM * NUP};
                transpose_matrix(vu, DM, NUP, (bf16_t*)((unsigned char*)Wl + W_UP_OFF), scr, gw, NGW, lane, 0, NUP);
                ValDirect vd{w_down + (size_t)(l & 1) * DFF * DM, DM};
                transpose_matrix(vd, DFF, DM, (bf16_t*)((unsigned char*)Wl + W_DOWN_OFF), scr, gw, NGW, lane, 0, DM);
            }
            for (int rep = 0; rep < REP_P0; ++rep) resid_rows<false, false, 2>(x_prompt, x_sample, nullptr, nullptr, nullptr, nullptr, nullptr, XH, g_pre_mix, gw, NGW, lane);
#endif
        } else {
            const int l = (ph - 2) / NPL, q = (ph - 2) % NPL;
            const bf16_t* Wl = (const bf16_t*)(ws + WS_W + l * W_LAYER);
            if (q == 0) {
#if !defined(ONLY) || ONLY==2
                pg8::Gemm g{XH, Wl, MTOK, NIN, DM}; pg8::StaticOrder S; S.init(MTOK, NIN, G, bx);
                EpiWin E{Z, Gp};
                for (int rep = 0; rep < REP_WIN; ++rep) pg8::gemm_phase<EpiWin, pg8::StaticOrder, PG8_ALIGN, PG8_SP2>(ring, g, S, E);
#endif
            } else if (q == 1) {
#if !defined(ONLY) || ONLY==3
                for (int rep = 1; rep < REP_ROPE; ++rep) rope_pass(Z, (bf16_t*)(ws + WS_END), q_norm + l * 128, k_norm + l * 128, (const float*)(ws + WS_COS), (const float*)(ws + WS_SIN), gtid, NT);
                rope_pass(Z, Z, q_norm + l * 128, k_norm + l * 128, (const float*)(ws + WS_COS), (const float*)(ws + WS_SIN), gtid, NT);
                for (int rep = 0; rep < REP_LIGHT * REP_POOL; ++rep) pool_pass(Z, XH, gtid, NT);
                for (int rep = 0; rep < REP_LIGHT; ++rep) dft_stage1(Gp, Yp, ws, (char*)lds, vcu, G);
#endif
            } else if (q == 2) {
#if !defined(ONLY) || ONLY==4
                for (int rep = 0; rep < REP_ATTN; ++rep) attn_phase(Z, XH, q_norm + l * 128, k_norm + l * 128, (char*)lds, vcu, G);
#endif
#if !defined(ONLY) || ONLY==5
                for (int rep = 0; rep < REP_LIGHT; ++rep) dft_stage3(Yp, XH, ws, (char*)lds, vcu, G);
#endif
            } else if (q == 4) {
#if !defined(ONLY) || ONLY==6
                for (int rep = 1; rep < REP_RES; ++rep) resid_rows<true, true, 4>(nullptr, nullptr, XB, Z, g_post_mix + DM, nullptr, nullptr, (bf16_t*)(ws + WS_END), g_pre_ffn + DM, gw, NGW, lane);
                if (l == 0) resid_rows<false, true, 2>(x_prompt, x_sample, nullptr, Z, g_post_mix, nullptr, XB, XH, g_pre_ffn, gw, NGW, lane);
                else resid_rows<true, true, 4>(nullptr, nullptr, XB, Z, g_post_mix + DM, nullptr, XB, XH, g_pre_ffn + DM, gw, NGW, lane);
#endif
            } else if (q == 8) {
#if !defined(ONLY) || ONLY==6
                if (l == 0) resid_rows<true, true, 4>(nullptr, nullptr, XB, XH, g_post_ffn, nullptr, XB, XH, g_pre_mix + DM, gw, NGW, lane);
                else resid_rows<true, false, 4>(nullptr, nullptr, XB, XH, g_post_ffn + DM, p.out, nullptr, nullptr, nullptr, gw, NGW, lane);
#endif
            } else {
                const int c = 0, step = (q >= 5) ? (q - 5) : -1;
                const float* cwl = conv_w + (size_t)l * 3 * NUP; const float* cbl = conv_b + (size_t)l * NUP;
                if (step == 1) {
#if !defined(ONLY) || ONLY==7
                    for (int rep = 0; rep < REP_LIGHT; ++rep) glu_fix(HB, ACT, cwl, cbl, gtid, NT);
#endif
                } else if (step == 0) {
#if !defined(ONLY) || ONLY==9
                    pg8::Gemm g{XH + (size_t)c * CHUNK * DM, (const bf16_t*)((const unsigned char*)Wl + W_UP_OFF), CHUNK, NUP, DM};
                    pg8::StaticOrder S; S.init(g.M, g.N, G, bx);
                    EpiGlu E{ACT, HB, cwl, cbl};
                    for (int rep = 0; rep < REP_UP; ++rep) pg8::gemm_phase<EpiGlu, pg8::StaticOrder, PG8_ALIGN, PG8_SP2>(ring, g, S, E);
#endif
                } else {
#if !defined(ONLY) || ONLY==8
                    pg8::Gemm g; bf16_t* O;
                    if (q == 3) { g = pg8::Gemm{XH, (const bf16_t*)((const unsigned char*)Wl + W_OUT_OFF), MTOK, DM, DM}; O = Z; }
                    else { g = pg8::Gemm{ACT, (const bf16_t*)((const unsigned char*)Wl + W_DOWN_OFF), CHUNK, DM, DFF}; O = XH + (size_t)c * CHUNK * DM; }
                    pg8::StaticOrder S; S.init(g.M, g.N, G, bx);
                    pg8::EpiBf16<0> E{O, DM, nullptr, 0, 0, 1.f};
                    for (int rep = 0; rep < REP_PLAIN; ++rep) pg8::gemm_phase<pg8::EpiBf16<0>, pg8::StaticOrder, PG8_ALIGN, PG8_SP2>(ring, g, S, E);
#endif
                }
            }
        }
        if (ph + 1 < p.ph_hi) { for (int rep = 0; rep < REP_SYNC; ++rep) { if (MK_MULTI == 0 && ph != 0) xcd_barrier(xbar); else grid.sync(); } }
    }
}

extern "C" void kernel_launch(void* const* d_in, const int* in_sizes, int n_in, void* d_out, int out_size, void* d_ws, size_t ws_size, hipStream_t stream) {
    static int grid = 0;
    if (grid == 0) {
        if (n_in != 17 || out_size != MTOK * DM || ws_size < WS_END) { fprintf(stderr, "kernel_launch: unexpected shapes: n_in %d out %d ws %zu (need %zu)\n", n_in, out_size, ws_size, (size_t)WS_END); grid = -1; return; }
        int dev = 0, cus = 0, per_cu = 0;
        if (hipGetDevice(&dev) != hipSuccess || hipDeviceGetAttribute(&cus, hipDeviceAttributeMultiprocessorCount, dev) != hipSuccess) { grid = -1; return; }
        if (hipFuncSetAttribute((const void*)mega_fwd, hipFuncAttributeMaxDynamicSharedMemorySize, LDS_BYTES) != hipSuccess) { fprintf(stderr, "kernel_launch: hipFuncSetAttribute failed\n"); grid = -1; return; }
        if (hipOccupancyMaxActiveBlocksPerMultiprocessor(&per_cu, (const void*)mega_fwd, 512, LDS_BYTES) != hipSuccess || per_cu < 1) { fprintf(stderr, "kernel_launch: occupancy query says %d\n", per_cu); per_cu = 1; }
        (void)hipGetLastError();
        grid = cus * 1;
    }
    if (grid < 0) return;
    if (hipMemsetAsync((char*)d_ws + WS_BAR, 0, BAR_BYTES, stream) != hipSuccess) { fprintf(stderr, "kernel_launch: memset failed\n"); return; }
    Params p{};
    for (int i = 0; i < 17; ++i) p.in[i] = (const float*)d_in[i];
    p.out = (float*)d_out; p.ws = (unsigned char*)d_ws;
#if MK_MULTI
    for (int ph = 0; ph < NPHASE; ++ph) { p.ph_lo = ph; p.ph_hi = ph + 1; hipLaunchKernelGGL(mega_fwd, dim3(grid), dim3(512), LDS_BYTES, stream, p); }
#else
    p.ph_lo = 0; p.ph_hi = NPHASE;
    void* args[] = {&p};
    hipError_t e = hipLaunchCooperativeKernel((const void*)mega_fwd, dim3(grid), dim3(512), args, LDS_BYTES, stream);
    if (e != hipSuccess) fprintf(stderr, "cooperative launch failed: %s (grid %d)\n", hipGetErrorString(e), grid);
#endif
}
```

```cpp
#include <hip/hip_runtime.h>
#include <hip/hip_bf16.h>
#include <hip/hip_cooperative_groups.h>
#include <cstdio>
#include <cstdint>
#ifndef MK_MULTI
#define MK_MULTI 0
#endif
__device__ __forceinline__ int ltid() { int t = threadIdx.x; asm volatile("" : "+v"(t)); return t; }
#ifndef REP_UP
#define REP_UP 1
#endif
#ifndef REP_ATTN
#define REP_ATTN 1
#endif
#ifndef REP_PLAIN
#define REP_PLAIN 1
#endif
#ifndef REP_WIN
#define REP_WIN 1
#endif
#ifndef REP_P0
#define REP_P0 1
#endif
#ifndef REP_LIGHT
#define REP_LIGHT 1
#endif
#ifndef REP_SYNC
#define REP_SYNC 1
#endif
#ifndef REP_ROPE
#define REP_ROPE 1
#endif
#ifndef REP_RES
#define REP_RES 1
#endif
#ifndef REP_POOL
#define REP_POOL 1
#endif
#ifndef REP_BAR
#define REP_BAR 0
#endif
namespace pg8 {
#define PG8_LAS __attribute__((address_space(3)))
typedef unsigned short bf16_t;
typedef short bf16x8 __attribute__((ext_vector_type(8)));
typedef float f32x4 __attribute__((ext_vector_type(4)));
typedef unsigned u32x4 __attribute__((ext_vector_type(4)));
constexpr int BM = 256, BK = 64, HALF = 128, HTB = HALF * BK * 2  , STAGE_BYTES = 8 * HTB, NXCD = 8, WGM = 4;

__host__ __device__ __forceinline__ int lds_byte(int r, int c) { const int st = (r >> 4) * 2 + (c >> 5), rr = r & 15, cc = c & 31, ob = rr * 64 + cc * 2; return st * 1024 + (ob ^ (((ob >> 9) & 1) << 5)); }
__host__ __device__ __forceinline__ void stage_rc(int b, int& R, int& C) { const int st = b / 1024, sb = b % 1024, swz = sb ^ (((sb >> 9) & 1) << 5); R = (st >> 1) * 16 + swz / 64; C = (st & 1) * 32 + (swz % 64) / 2; }
__host__ __device__ __forceinline__ int perm32(int rho) { const int n = rho >> 4, i = rho & 15; return 8 * (i >> 2) + 4 * n + (i & 3); }

struct Unit { int pm, pn; };
struct Gemm { const bf16_t* A; const bf16_t* Bt; int M, N, K; };

struct StaticOrder {
    int nM, nN, nwg, G, c;
    __host__ __device__ void init(int M, int N, int G_, int c_) { nM = M / BM; nN = N / BM; nwg = nM * nN; G = G_; c = c_; }
    __host__ __device__ bool next(int i, Unit& u) const {
        const long L = (long)i * G + c; if (L >= nwg) return false;
        int wgid = (int)L; { const int q = nwg / NXCD, r = nwg % NXCD, xcd = wgid % NXCD, off = wgid / NXCD; wgid = (xcd < r ? xcd * (q + 1) : r * (q + 1) + (xcd - r) * q) + off; }
        const int nig = WGM * nN, gid = wgid / nig, fm = gid * WGM, gsz = (nM - fm) < WGM ? (nM - fm) : WGM;
        u.pm = fm + ((wgid % nig) % gsz); u.pn = (wgid % nig) / gsz; return true;
    }
    __device__ __forceinline__ void a_ready(const Unit&) const {}
    __device__ __forceinline__ void done(const Unit&) const {}
};

__device__ __forceinline__ unsigned cvt_pk_bf16(float lo, float hi) { unsigned r; asm volatile("v_cvt_pk_bf16_f32 %0, %1, %2" : "=v"(r) : "v"(lo), "v"(hi)); return r; }
typedef float f32x2 __attribute__((ext_vector_type(2)));
__device__ __forceinline__ f32x2 gelu_pk(f32x2 v) {
    const f32x2 av = __builtin_elementwise_abs(v), d = av * 0.2316418882f + 1.0f;
    f32x2 t; t.x = __builtin_amdgcn_rcpf(d.x); t.y = __builtin_amdgcn_rcpf(d.y);
    f32x2 q = t * 0.5307027145f + (-0.7265760135f); q = q * t + 0.7107068705f; q = q * t + (-0.142248368f); q = q * t + 0.127414796f; q = q * t;
    const f32x2 s = (v * v) * (-0.72134752044f);
    f32x2 e; e.x = __builtin_amdgcn_exp2f(s.x); e.y = __builtin_amdgcn_exp2f(s.y);
    const f32x2 m = v * (q * e), r = v - m;
    f32x2 o; o.x = v.x < 0.f ? m.x : r.x; o.y = v.y < 0.f ? m.y : r.y; return o;
}

template <int ACT  > struct EpiBf16 {
    static constexpr bool PERM = true, AFTER_DRAIN = false; static_assert(ACT == 0 || ACT == 1, "EpiBf16: ACT is 0 (none) or 1 (gelu_pk)");
    bf16_t* O; int ldc; const float* bias; int split_cols; size_t split_stride; float scale0;
    __device__ __forceinline__ void operator()(const f32x4 (&acc)[2][2][4][2], const Unit& u, int wr, int wc, int fr, int fq) const {
        const int row0 = u.pm * BM + wr * 64 + fr; int colt = u.pn * BM; bf16_t* base = O;
        float sc = 1.f; if (split_cols) { const int t = colt / split_cols; base += (size_t)t * split_stride; colt -= t * split_cols; if (t == 0) sc = scale0; }
        const int col0 = colt + wc * 32 + 8 * fq, bcol0 = u.pn * BM + wc * 32 + 8 * fq;
        f32x4 bv[2][2];
#pragma unroll
        for (int bj = 0; bj < 2; ++bj)
#pragma unroll
            for (int n = 0; n < 2; ++n) bv[bj][n] = bias ? *(const f32x4*)(bias + bcol0 + bj * HALF + 4 * n) : (f32x4){0.f, 0.f, 0.f, 0.f};
#pragma unroll
        for (int ai = 0; ai < 2; ++ai)
#pragma unroll
            for (int m = 0; m < 4; ++m) { bf16_t* rowp = base + (size_t)(row0 + ai * HALF + m * 16) * ldc + col0;
#pragma unroll
                for (int bj = 0; bj < 2; ++bj) { f32x4 v0 = acc[ai][bj][m][0] + bv[bj][0], v1 = acc[ai][bj][m][1] + bv[bj][1];
                    if (ACT == 1) { f32x2 a = gelu_pk((f32x2){v0[0], v0[1]}), b = gelu_pk((f32x2){v0[2], v0[3]}), c = gelu_pk((f32x2){v1[0], v1[1]}), d = gelu_pk((f32x2){v1[2], v1[3]});
                        v0 = (f32x4){a.x, a.y, b.x, b.y}; v1 = (f32x4){c.x, c.y, d.x, d.y}; }
                    v0 = v0 * sc; v1 = v1 * sc; u32x4 w; w.x = cvt_pk_bf16(v0[0], v0[1]); w.y = cvt_pk_bf16(v0[2], v0[3]); w.z = cvt_pk_bf16(v1[0], v1[1]); w.w = cvt_pk_bf16(v1[2], v1[3]);
                    *(u32x4*)(rowp + bj * HALF) = w; } }
    }
};
template <class Epi, class Sched, bool ALIGN_EPI = false, bool SP2 = false>
__device__ __forceinline__ void gemm_phase(PG8_LAS unsigned char* lds, const Gemm g, const Sched& S, const Epi& E) {
    const int tid = ltid(), wid = __builtin_amdgcn_readfirstlane(tid >> 6), lane = tid & 63, wr = wid >> 2, wc = wid & 3, fr = lane & 15, fq = lane >> 4;
    const int K = g.K, nt = K / BK;
    unsigned voffA[2], voffB[2];
#pragma unroll
    for (int i = 0; i < 2; ++i) { int R, C; stage_rc(tid * 16 + i * 8192, R, C); const int Rb = Epi::PERM ? ((R & ~31) + perm32(R & 31)) : R;
        voffA[i] = (unsigned)(R * K + C) * 2u; voffB[i] = (unsigned)(Rb * K + C) * 2u; }
    const size_t kstep = (size_t)(BK * 2);
    const size_t hstep = (size_t)HALF * K * 2;
    const size_t tstep = 2 * hstep;
    const unsigned ldsw = (unsigned)wid * 1024u;
    const int aoff = lds_byte(wr * 64 + fr, fq * 8), boff = lds_byte(wc * 32 + fr, fq * 8);
#define PG8_SA(b, h) (((b) * 2 + (h)) * HTB)
#define PG8_SB(b, h) ((4 + (b) * 2 + (h)) * HTB)
#define PG8_STAGE(bufoff, gbase, voff) do { _Pragma("unroll") for (int _i = 0; _i < 2; ++_i) \
        __builtin_amdgcn_global_load_lds((const unsigned*)((const char*)(gbase) + (voff)[_i]), (PG8_LAS unsigned*)(lds + (bufoff) + ldsw + _i * 8192), 16, 0, 0); } while (0)
#define PG8_LDA(dst, b, h) do { _Pragma("unroll") for (int m = 0; m < 4; ++m) _Pragma("unroll") for (int k = 0; k < 2; ++k) dst[m][k] = *(const PG8_LAS bf16x8*)(lds + PG8_SA(b, h) + aoff + m * 2048 + k * 1024); } while (0)
#define PG8_LDB(dst, b, h) do { _Pragma("unroll") for (int n = 0; n < 2; ++n) _Pragma("unroll") for (int k = 0; k < 2; ++k) dst[n][k] = *(const PG8_LAS bf16x8*)(lds + PG8_SB(b, h) + boff + n * 2048 + k * 1024); } while (0)
#define PG8_MMA(ai, bj, At, Bt) do { __builtin_amdgcn_s_setprio(1); _Pragma("unroll") for (int m = 0; m < 4; ++m) _Pragma("unroll") for (int n = 0; n < 2; ++n) _Pragma("unroll") for (int k = 0; k < 2; ++k) \
        acc[ai][bj][m][n] = __builtin_amdgcn_mfma_f32_16x16x32_bf16(Bt[n][k], At[m][k], acc[ai][bj][m][n], 0, 0, 0); __builtin_amdgcn_s_setprio(0); } while (0)
#define PG8_WAIT_V(n) asm volatile("s_waitcnt vmcnt(" #n ")" ::: "memory")
#define PG8_WAIT_L(n) asm volatile("s_waitcnt lgkmcnt(" #n ")" ::: "memory")
#define PG8_BAR __builtin_amdgcn_s_barrier()
#define PG8_SCHED __builtin_amdgcn_sched_barrier(0)
    Unit cur, nxt; int ui = 0;
    if (!S.next(0, cur)) return;
    f32x4 acc[2][2][4][2];
#pragma unroll
    for (int a = 0; a < 2; ++a)
#pragma unroll
        for (int b = 0; b < 2; ++b)
#pragma unroll
            for (int m = 0; m < 4; ++m)
#pragma unroll
                for (int n = 0; n < 2; ++n) acc[a][b][m][n] = (f32x4){0.f, 0.f, 0.f, 0.f};
    bf16x8 At[4][2], B0[2][2], B1[2][2];
    const char* cA = (const char*)g.A + (size_t)cur.pm * tstep; const char* cB = (const char*)g.Bt + (size_t)cur.pn * tstep;
    S.a_ready(cur);
    if constexpr (SP2) {
        PG8_STAGE(PG8_SB(0, 0), cB, voffB); PG8_STAGE(PG8_SB(0, 1), cB + hstep, voffB); PG8_STAGE(PG8_SA(0, 0), cA, voffA); PG8_STAGE(PG8_SA(0, 1), cA + hstep, voffA);
        if (wr == 1) PG8_BAR;
        PG8_WAIT_V(2); PG8_BAR;
        PG8_STAGE(PG8_SB(1, 0), cB + kstep, voffB); PG8_STAGE(PG8_SA(1, 0), cA + kstep, voffA); PG8_STAGE(PG8_SB(1, 1), cB + hstep + kstep, voffB);
        PG8_WAIT_V(6); PG8_BAR;
    } else {
        PG8_STAGE(PG8_SB(0, 0), cB, voffB); PG8_STAGE(PG8_SA(0, 0), cA, voffA); PG8_STAGE(PG8_SB(0, 1), cB + hstep, voffB); PG8_STAGE(PG8_SA(0, 1), cA + hstep, voffA);
        if (wr == 1) PG8_BAR;
        PG8_WAIT_V(4); PG8_BAR;
        PG8_STAGE(PG8_SB(1, 0), cB + kstep, voffB); PG8_STAGE(PG8_SA(1, 0), cA + kstep, voffA); PG8_STAGE(PG8_SB(1, 1), cB + hstep + kstep, voffB);
        PG8_WAIT_V(6); PG8_BAR;
    }
    for (;;) {
        const bool has_next = S.next(ui + 1, nxt);
        const char* nA = has_next ? (const char*)g.A + (size_t)nxt.pm * tstep : cA; const char* nB = has_next ? (const char*)g.Bt + (size_t)nxt.pn * tstep : cB;
        for (int t = 0; t < nt; t += 2) {
            const bool last = (t == nt - 2);
            const char* a1 = cA + (size_t)(t + 1) * kstep;
            const char* a2 = last ? nA : cA + (size_t)(t + 2) * kstep; const char* b2 = last ? nB : cB + (size_t)(t + 2) * kstep;
            const char* a3 = a2 + kstep; const char* b3 = b2 + kstep;
            if (last && has_next) S.a_ready(nxt);
            if constexpr (SP2) {
            PG8_LDB(B0, 0, 0); PG8_LDB(B1, 0, 1); PG8_SCHED; PG8_LDA(At, 0, 0); PG8_STAGE(PG8_SA(1, 1), a1 + hstep, voffA);
            PG8_WAIT_V(8); PG8_WAIT_L(0); PG8_BAR; PG8_MMA(0, 0, At, B0); PG8_MMA(0, 1, At, B1); PG8_BAR; PG8_SCHED;
            PG8_LDA(At, 0, 1); PG8_STAGE(PG8_SB(0, 0), b2, voffB); PG8_STAGE(PG8_SB(0, 1), b2 + hstep, voffB); PG8_STAGE(PG8_SA(0, 0), a2, voffA);
            PG8_WAIT_V(8); PG8_WAIT_L(0); PG8_BAR; PG8_MMA(1, 0, At, B0); PG8_MMA(1, 1, At, B1); PG8_BAR; PG8_SCHED;
            PG8_LDB(B0, 1, 0); PG8_LDB(B1, 1, 1); PG8_SCHED; PG8_LDA(At, 1, 0); PG8_STAGE(PG8_SA(0, 1), a2 + hstep, voffA);
            PG8_WAIT_V(8); PG8_WAIT_L(0); PG8_BAR; PG8_MMA(0, 0, At, B0); PG8_MMA(0, 1, At, B1); PG8_BAR; PG8_SCHED;
            PG8_LDA(At, 1, 1); PG8_STAGE(PG8_SB(1, 0), b3, voffB); PG8_STAGE(PG8_SB(1, 1), b3 + hstep, voffB); PG8_STAGE(PG8_SA(1, 0), a3, voffA);
            PG8_WAIT_V(8); PG8_WAIT_L(0); PG8_BAR; PG8_MMA(1, 0, At, B0); PG8_MMA(1, 1, At, B1); PG8_BAR; PG8_SCHED;
            } else {
            PG8_LDB(B0, 0, 0); PG8_SCHED; PG8_LDA(At, 0, 0); PG8_STAGE(PG8_SA(1, 1), a1 + hstep, voffA);
            PG8_WAIT_L(8); PG8_BAR; PG8_WAIT_L(0); PG8_MMA(0, 0, At, B0); PG8_BAR; PG8_SCHED;
            PG8_LDB(B1, 0, 1); PG8_STAGE(PG8_SB(0, 0), b2, voffB);
            PG8_BAR; PG8_WAIT_L(0); PG8_MMA(0, 1, At, B1); PG8_BAR;
            PG8_LDA(At, 0, 1); PG8_STAGE(PG8_SA(0, 0), a2, voffA);
            PG8_BAR; PG8_WAIT_L(0); PG8_MMA(1, 0, At, B0); PG8_BAR; PG8_SCHED;
            PG8_STAGE(PG8_SB(0, 1), b2 + hstep, voffB);
            PG8_WAIT_V(6); PG8_BAR; PG8_MMA(1, 1, At, B1); PG8_BAR;
            PG8_LDB(B0, 1, 0); PG8_SCHED; PG8_LDA(At, 1, 0); PG8_STAGE(PG8_SA(0, 1), a2 + hstep, voffA);
            PG8_WAIT_L(8); PG8_BAR; PG8_WAIT_L(0); PG8_MMA(0, 0, At, B0); PG8_BAR; PG8_SCHED;
            PG8_LDB(B1, 1, 1); PG8_STAGE(PG8_SB(1, 0), b3, voffB);
            PG8_BAR; PG8_WAIT_L(0); PG8_MMA(0, 1, At, B1); PG8_BAR;
            PG8_LDA(At, 1, 1); PG8_STAGE(PG8_SA(1, 0), a3, voffA);
            PG8_BAR; PG8_WAIT_L(0); PG8_MMA(1, 0, At, B0); PG8_BAR; PG8_SCHED;
            PG8_STAGE(PG8_SB(1, 1), b3 + hstep, voffB);
            PG8_WAIT_V(6); PG8_BAR; PG8_MMA(1, 1, At, B1); PG8_BAR;
            }
        }
        if constexpr (ALIGN_EPI) { if (wr == 0) PG8_BAR; }
        if constexpr (!Epi::AFTER_DRAIN) { E(acc, cur, wr, wc, fr, fq); S.done(cur); }
        if (!has_next) break;
#pragma unroll
        for (int a = 0; a < 2; ++a)
#pragma unroll
            for (int b = 0; b < 2; ++b)
#pragma unroll
                for (int m = 0; m < 4; ++m)
#pragma unroll
                    for (int n = 0; n < 2; ++n) acc[a][b][m][n] = (f32x4){0.f, 0.f, 0.f, 0.f};
        cur = nxt; cA = nA; cB = nB; ++ui;
        if constexpr (ALIGN_EPI) { if (wr == 1) PG8_BAR; }
    }
    PG8_WAIT_V(0);
    if constexpr (!ALIGN_EPI) { if (wr == 0) PG8_BAR; }
    PG8_BAR;
    if constexpr (Epi::AFTER_DRAIN) { E.fused(acc, cur, wr, wc, fr, fq, lds, wid, lane); S.done(cur); }
#undef PG8_SA
#undef PG8_SB
#undef PG8_STAGE
#undef PG8_LDA
#undef PG8_LDB
#undef PG8_MMA
#undef PG8_WAIT_V
#undef PG8_WAIT_L
#undef PG8_BAR
#undef PG8_SCHED
}
}
#define PG8_SP2 true
#define PG8_ALIGN true
namespace att {
using bf16 = __hip_bfloat16;
constexpr int   D = 128, NW = 8, QBLK = 32, KVBLK = 64;
constexpr float SCALE = 0.088388347648318440f;
constexpr float THR = 8.f;
constexpr int SDEPTH = 2;
constexpr bool STATIC_MAX = true;
constexpr int LDQ = 2048, LDK = 2048, LDO = 2048;
constexpr size_t SHM_V = KVBLK * D * 2, SHM_K = KVBLK * D * 2, SHM_ATTN = 2 * SHM_V + 2 * SHM_K + NW * 64 * 4;
using bf16x8 = __attribute__((ext_vector_type(8))) short;
using s16x4  = __attribute__((ext_vector_type(4))) short;
using f32x16 = __attribute__((ext_vector_type(16))) float;
using f32x8  = __attribute__((ext_vector_type(8))) float;
using u32x4  = __attribute__((ext_vector_type(4))) unsigned;
#define KSWZ(row, colB) ((row) * 256 + ((colB) ^ (((row) & 7) << 4)))
#define SBAR() __builtin_amdgcn_sched_barrier(0)
__device__ __forceinline__ int crow(int r, int hi) { return (r & 3) + 8 * (r >> 2) + 4 * hi; }
__device__ __forceinline__ unsigned cvtpk(float lo, float hi) {
  unsigned r; asm volatile("v_cvt_pk_bf16_f32 %0, %1, %2" : "=v"(r) : "v"(lo), "v"(hi)); return r;
}
template <typename TIn> struct Stage;
template <> struct Stage<bf16>  { using T = bf16x8;
  __device__ static __forceinline__ T ld8(const bf16* p) { return *reinterpret_cast<const bf16x8*>(p); }
  __device__ static __forceinline__ bf16x8 tobf(T x) { return x; } };
template <> struct Stage<float> { using T = f32x8;
  __device__ static __forceinline__ T ld8(const float* p) { return *reinterpret_cast<const f32x8*>(p); }
  __device__ static __forceinline__ bf16x8 tobf(T x) {
    u32x4 w = {cvtpk(x[0], x[1]), cvtpk(x[2], x[3]), cvtpk(x[4], x[5]), cvtpk(x[6], x[7])}; return *reinterpret_cast<bf16x8*>(&w); } };

template <bool SHIFT> __device__ __forceinline__ void partialSM(f32x16& p0, f32x16& p1, float& m_reg, float& mn, float& alpha) {
  constexpr float C = SCALE * 1.4426950408889634f;
  if constexpr (STATIC_MAX) { mn = m_reg; alpha = 1.f; }
  else {
  float pmax = p0[0]; for (int r = 1; r < 16; ++r) pmax = fmaxf(pmax, p0[r]); for (int r = 0; r < 16; ++r) pmax = fmaxf(pmax, p1[r]);
  { auto rr = __builtin_amdgcn_permlane32_swap(__float_as_uint(pmax), __float_as_uint(pmax), false, false);
    pmax = fmaxf(__uint_as_float(rr[0]), __uint_as_float(rr[1])); }
  if (__builtin_expect(__all(pmax - m_reg <= THR / SCALE), 1)) { mn = m_reg; alpha = 1.f; }
  else { mn = fmaxf(m_reg, pmax); alpha = __builtin_amdgcn_exp2f((m_reg - mn) * C); m_reg = mn; }
  }
  if constexpr (!STATIC_MAX) { float mnC = -mn * C;
  for (int r = 0; r < 16; ++r) p0[r] = fmaf(p0[r], C, mnC); for (int r = 0; r < 16; ++r) p1[r] = fmaf(p1[r], C, mnC); }
  if constexpr (STATIC_MAX && SHIFT) { for (int r = 0; r < 16; ++r) p0[r] += m_reg; for (int r = 0; r < 16; ++r) p1[r] += m_reg; }
  for (int r = 0; r < 16; ++r) p0[r] = __builtin_amdgcn_exp2f(p0[r]);
}
__device__ __forceinline__ void finishSM(f32x16& p0, f32x16& p1, float alpha, float& l_reg, bf16x8& pa0, bf16x8& pa1, bf16x8& pa2, bf16x8& pa3) {
  for (int r = 0; r < 16; ++r) p1[r] = __builtin_amdgcn_exp2f(p1[r]);
  float ps = 0; for (int r = 0; r < 16; ++r) ps += p0[r]; for (int r = 0; r < 16; ++r) ps += p1[r];
  { auto rr = __builtin_amdgcn_permlane32_swap(__float_as_uint(ps), __float_as_uint(ps), false, false);
    ps = __uint_as_float(rr[0]) + __uint_as_float(rr[1]); }
  l_reg = l_reg * alpha + ps;
#define PK4(P, BASE, OUT) do { unsigned a0 = cvtpk(P[BASE + 0], P[BASE + 1]), a1 = cvtpk(P[BASE + 2], P[BASE + 3]);   \
    unsigned b0 = cvtpk(P[BASE + 4], P[BASE + 5]), b1 = cvtpk(P[BASE + 6], P[BASE + 7]);                              \
    auto r0 = __builtin_amdgcn_permlane32_swap(a0, b0, false, false); auto r1 = __builtin_amdgcn_permlane32_swap(a1, b1, false, false); \
    u32x4 w = {r0[0], r1[0], r0[1], r1[1]}; OUT = *reinterpret_cast<bf16x8*>(&w); } while (0)
  PK4(p0, 0, pa0); PK4(p0, 8, pa1); PK4(p1, 0, pa2); PK4(p1, 8, pa3);
#undef PK4
}
__device__ __forceinline__ void qkt(f32x16& p0, f32x16& p1, const bf16* Ks, const bf16x8* qr, int r32, int hi) {
#pragma unroll
  for (int d0 = 0; d0 < 8; ++d0) { int cb = (d0 * 16 + hi * 8) * 2;
    bf16x8 b0 = *reinterpret_cast<const bf16x8*>((const char*)Ks + KSWZ(r32, cb));
    bf16x8 b1 = *reinterpret_cast<const bf16x8*>((const char*)Ks + KSWZ(32 + r32, cb));
    p0 = __builtin_amdgcn_mfma_f32_32x32x16_bf16(b0, qr[d0], d0 == 0 ? f32x16{} : p0, 0, 0, 0);
    p1 = __builtin_amdgcn_mfma_f32_32x32x16_bf16(b1, qr[d0], d0 == 0 ? f32x16{} : p1, 0, 0, 0); }
}
__device__ __forceinline__ int v_st(int k, int c) { const int kk = (k & ~0xC) | ((k & 4) << 1) | ((k & 8) >> 1); return ((kk >> 3) * 4 + (c >> 5)) * 512 + ((kk & 7) * 32 + (c & 31)) * 2; }
__device__ __forceinline__ int v_rd_base(int lane) { return ((lane & 3) << 3) | (((lane >> 2) & 3) << 6) | (((lane >> 4) & 1) << 5) | (((lane >> 5) & 1) << 8); }
constexpr int v_rd_off(int d0, int ks, int half) { return d0 * 512 + ks * 4096 + half * 2048; }
template <int OFF> __device__ __forceinline__ s16x4 tr_read(int vb) {
  s16x4 r; asm volatile("ds_read_b64_tr_b16 %0, %1 offset:%2" : "=&v"(r) : "v"(vb), "i"(OFF) : "memory"); return r;
}
template <int D0> __device__ __forceinline__ void pv_one(f32x16& od, int vb, bf16x8 pa0, bf16x8 pa1, bf16x8 pa2, bf16x8 pa3) {
  const s16x4 l0 = tr_read<v_rd_off(D0, 0, 0)>(vb), h0 = tr_read<v_rd_off(D0, 0, 1)>(vb), l1 = tr_read<v_rd_off(D0, 1, 0)>(vb), h1 = tr_read<v_rd_off(D0, 1, 1)>(vb);
  const s16x4 l2 = tr_read<v_rd_off(D0, 2, 0)>(vb), h2 = tr_read<v_rd_off(D0, 2, 1)>(vb), l3 = tr_read<v_rd_off(D0, 3, 0)>(vb), h3 = tr_read<v_rd_off(D0, 3, 1)>(vb);
  asm volatile("s_waitcnt lgkmcnt(0)" ::: "memory"); SBAR();
#define PK(L, H) (bf16x8){L[0], L[1], L[2], L[3], H[0], H[1], H[2], H[3]}
  od = __builtin_amdgcn_mfma_f32_32x32x16_bf16(pa0, PK(l0, h0), od, 0, 0, 0);
  od = __builtin_amdgcn_mfma_f32_32x32x16_bf16(pa1, PK(l1, h1), od, 0, 0, 0);
  od = __builtin_amdgcn_mfma_f32_32x32x16_bf16(pa2, PK(l2, h2), od, 0, 0, 0);
  od = __builtin_amdgcn_mfma_f32_32x32x16_bf16(pa3, PK(l3, h3), od, 0, 0, 0);
#undef PK
}
__device__ __forceinline__ void pv_d0(f32x16* o, int vb, bf16x8 pa0, bf16x8 pa1, bf16x8 pa2, bf16x8 pa3) {
  pv_one<0>(o[0], vb, pa0, pa1, pa2, pa3); pv_one<1>(o[1], vb, pa0, pa1, pa2, pa3); pv_one<2>(o[2], vb, pa0, pa1, pa2, pa3); pv_one<3>(o[3], vb, pa0, pa1, pa2, pa3);
}
template <typename TQ, bool SHIFT>
__device__ __forceinline__ void attn_dense_body(const TQ* __restrict__ Qb, const bf16* __restrict__ Kh, const bf16* __restrict__ Vh,
                                                bf16* __restrict__ Ob, int seq, char* lds, float bound) {
  using St = Stage<bf16>; using SQ = Stage<TQ>;
  const int tid = ltid(), wid = tid >> 6, lane = tid & 63, r32 = lane & 31, hi = lane >> 5;
  bf16* V_lds = (bf16*)lds; bf16* K_lds = (bf16*)(lds + 2 * SHM_V);
  float* ws = (float*)(lds + 2 * SHM_V + 2 * SHM_K) + wid * 64; float* li_l = ws; float* al_l = ws + 32;
  float m_reg = STATIC_MAX ? -bound * (SCALE * 1.4426950408889634f) : -1e30f, l_reg = 0; f32x16 o[4] = {}; bf16x8 qr[8];
  const TQ* Qw = Qb + (long)(wid * QBLK + r32) * LDQ + hi * 8;
#pragma unroll
  for (int d0 = 0; d0 < 8; ++d0) qr[d0] = SQ::tobf(SQ::ld8(Qw + d0 * 16));
  const int sr = tid >> 4, sc = (tid & 15) * 8, vst0 = v_st(sr, sc), vst1 = v_st(32 + sr, sc);
  const int vb0 = (int)(uintptr_t)V_lds + v_rd_base(lane);
  struct { typename St::T vs0, vs1, ks0, ks1; } sr_[SDEPTH];
#define SLOAD(i, k0) do { sr_[i].vs0 = St::ld8(&Vh[(long)((k0) + sr) * LDK + sc]); sr_[i].vs1 = St::ld8(&Vh[(long)((k0) + 32 + sr) * LDK + sc]); \
    sr_[i].ks0 = St::ld8(&Kh[(long)((k0) + sr) * LDK + sc]); sr_[i].ks1 = St::ld8(&Kh[(long)((k0) + 32 + sr) * LDK + sc]); } while (0)
#define SWRITE(b, i) do { *(bf16x8*)((char*)V_lds + (b) * SHM_V + vst0) = St::tobf(sr_[i].vs0);          \
    *(bf16x8*)((char*)V_lds + (b) * SHM_V + vst1) = St::tobf(sr_[i].vs1); int kc = sc * 2;               \
    *(bf16x8*)((char*)K_lds + (b) * SHM_K + KSWZ(sr, kc)) = St::tobf(sr_[i].ks0);                       \
    *(bf16x8*)((char*)K_lds + (b) * SHM_K + KSWZ(32 + sr, kc)) = St::tobf(sr_[i].ks1); } while (0)
#define SWAIT() do { if constexpr (SDEPTH == 2) asm volatile("s_waitcnt vmcnt(4)" ::: "memory"); else asm volatile("s_waitcnt vmcnt(0)" ::: "memory"); } while (0)
#define RESC(a) do { if (!STATIC_MAX && __any((a) < 1.f)) { if (hi == 0) al_l[r32] = (a); asm volatile("s_waitcnt lgkmcnt(0)" ::: "memory"); \
    for (int d = 0; d < 4; ++d) for (int r = 0; r < 16; ++r) o[d][r] *= al_l[crow(r, hi)]; } } while (0)
  f32x16 pA0, pA1, pB0, pB1; float mnA, mnB, alA, alB; bf16x8 pa0, pa1, pa2, pa3; const int NT = seq / KVBLK;
  constexpr int SE = 0, SO = SDEPTH - 1;
  SLOAD(SE, 0); asm volatile("s_waitcnt vmcnt(0)" ::: "memory"); SWRITE(0, SE); __syncthreads();
  qkt(pA0, pA1, K_lds, qr, r32, hi); partialSM<SHIFT>(pA0, pA1, m_reg, mnA, alA);
  SLOAD(SO, KVBLK); if constexpr (SDEPTH == 2) { if (2 < NT) SLOAD(SE, 2 * KVBLK); }
  SWAIT(); SWRITE(1, SO); __syncthreads();
  for (int j = 1; j + 1 < NT; j += 2) {
    SBAR(); qkt(pB0, pB1, (bf16*)((char*)K_lds + SHM_K), qr, r32, hi);
    finishSM(pA0, pA1, alA, l_reg, pa0, pa1, pa2, pa3); SBAR();
    SLOAD(SO, (j + SDEPTH) * KVBLK); SBAR();
    pv_d0(o, vb0, pa0, pa1, pa2, pa3); partialSM<SHIFT>(pB0, pB1, m_reg, mnB, alB);
    __syncthreads(); SWAIT(); SWRITE(0, SE);
    RESC(alB); __syncthreads();
    SBAR(); qkt(pA0, pA1, K_lds, qr, r32, hi);
    finishSM(pB0, pB1, alB, l_reg, pa0, pa1, pa2, pa3); SBAR();
    if (SDEPTH == 1 || j + 3 < NT) SLOAD(SE, (j + 1 + SDEPTH) * KVBLK); SBAR();
    pv_d0(o, vb0 + (int)SHM_V, pa0, pa1, pa2, pa3); partialSM<SHIFT>(pA0, pA1, m_reg, mnA, alA);
    __syncthreads(); SWAIT(); SWRITE(1, SO);
    RESC(alA); __syncthreads();
  }
  SBAR(); qkt(pB0, pB1, (bf16*)((char*)K_lds + SHM_K), qr, r32, hi);
  finishSM(pA0, pA1, alA, l_reg, pa0, pa1, pa2, pa3); SBAR();
  pv_d0(o, vb0, pa0, pa1, pa2, pa3); partialSM<SHIFT>(pB0, pB1, m_reg, mnB, alB);
  __syncthreads(); RESC(alB);
  finishSM(pB0, pB1, alB, l_reg, pa0, pa1, pa2, pa3); SBAR();
  pv_d0(o, vb0 + (int)SHM_V, pa0, pa1, pa2, pa3);
  if (hi == 0) li_l[r32] = l_reg; asm volatile("s_waitcnt lgkmcnt(0)" ::: "memory");
  float rli[16];
#pragma unroll
  for (int r = 0; r < 16; ++r) rli[r] = __builtin_amdgcn_rcpf(li_l[crow(r, hi)]);
  bf16* Ow = Ob + (long)(wid * QBLK) * LDO;
#pragma unroll
  for (int r = 0; r < 16; ++r) { int orow = crow(r, hi);
    for (int d0 = 0; d0 < 4; ++d0) Ow[(long)orow * LDO + d0 * 32 + r32] = __float2bfloat16(o[d0][r] * rli[r]); }
#undef SLOAD
#undef SWRITE
#undef SWAIT
#undef RESC
}

template <int NC> __device__ __forceinline__ void pv_n(f32x16* o, int vb, bf16x8 pa0, bf16x8 pa1, bf16x8 pa2, bf16x8 pa3) {
  pv_one<0>(o[0], vb, pa0, pa1, pa2, pa3);
  if constexpr (NC > 1) pv_one<1>(o[1], vb, pa0, pa1, pa2, pa3);
  if constexpr (NC > 2) { pv_one<2>(o[2], vb, pa0, pa1, pa2, pa3); pv_one<3>(o[3], vb, pa0, pa1, pa2, pa3); }
}
template <int MB, int NKT, class BR, class ST>
__device__ __forceinline__ void dft_unit(const bf16* __restrict__ A, int lda, const BR& br, const ST& st, char* lds) {
  constexpr int NBW = 8 / MB, NC = 4 / NBW;
  const int tid = ltid(), wid = tid >> 6, lane = tid & 63, r32 = lane & 31, hi = lane >> 5;
  const int mb = wid % MB, cgp = wid / MB;
  const int sr = tid >> 4, sc = (tid & 15) * 8, vst0 = v_st(sr, sc), vst1 = v_st(32 + sr, sc);
  bf16x8 bq[NKT][2], af[NKT][4];
#pragma unroll
  for (int kt = 0; kt < NKT; ++kt) {
    bq[kt][0] = __builtin_nontemporal_load(reinterpret_cast<const bf16x8*>(br.row(kt * 64 + sr) + sc));
    bq[kt][1] = __builtin_nontemporal_load(reinterpret_cast<const bf16x8*>(br.row(kt * 64 + 32 + sr) + sc));
  }
  const bf16* Aw = A + (long)(mb * 32 + r32) * lda + hi * 8;
#pragma unroll
  for (int kt = 0; kt < NKT; ++kt)
#pragma unroll
    for (int ks = 0; ks < 4; ++ks) af[kt][ks] = *reinterpret_cast<const bf16x8*>(Aw + kt * 64 + ks * 16);
  __syncthreads();
#pragma unroll
  for (int kt = 0; kt < NKT; ++kt) {
    *(bf16x8*)(lds + kt * 16384 + vst0) = bq[kt][0];
    *(bf16x8*)(lds + kt * 16384 + vst1) = bq[kt][1];
  }
  __syncthreads();
  f32x16 o[NC];
#pragma unroll
  for (int d = 0; d < NC; ++d) o[d] = f32x16{};
  const int vb = (int)(uintptr_t)lds + v_rd_base(lane) + cgp * NC * 512;
#pragma unroll
  for (int kt = 0; kt < NKT; ++kt) pv_n<NC>(o, vb + kt * 16384, af[kt][0], af[kt][1], af[kt][2], af[kt][3]);
  bf16* stg = (bf16*)(lds + 65536) + wid * 4096;
  const float sc_ = st.scale;
#pragma unroll
  for (int r = 0; r < 16; ++r) {
#pragma unroll
    for (int d = 0; d < NC; ++d) stg[crow(r, hi) * (NC * 32) + d * 32 + r32] = __float2bfloat16(o[d][r] * sc_);
  }
  asm volatile("s_waitcnt lgkmcnt(0)" ::: "memory");
#pragma unroll
  for (int i = 0; i < NC * 2; ++i) { const int idx = i * 64 + lane, row = idx / (NC * 4), cc = idx % (NC * 4);
    const u32x4 v = *(const u32x4*)(stg + row * (NC * 32) + cc * 8);
    st.store16(mb * 32 + row, cgp * NC * 32 + cc * 8, v); }
  asm volatile("s_waitcnt lgkmcnt(0)" ::: "memory");
}
#undef SBAR
#undef KSWZ
}

namespace cg = cooperative_groups;
#define LAS __attribute__((address_space(3)))
typedef unsigned short bf16_t;
typedef unsigned v4u __attribute__((ext_vector_type(4)));
typedef unsigned v2u __attribute__((ext_vector_type(2)));
typedef float f4 __attribute__((ext_vector_type(4)));

#define XB_TMO      128
#define XB_XCNT(j)  (256  + 64 * (j))
#define XB_XSUB(j)  (1280 + 64 * (j))
#define XB_XGEN(j)  (2304 + 64 * (j))
#define XB_TOP      3328
#define XB_TOPGEN   3392
#define XCD_BAR_WORDS 3456
#define XB_SPIN_CAP (1u << 18)

__device__ __forceinline__ unsigned xb_ld(unsigned* p)              { return __hip_atomic_load(p, __ATOMIC_RELAXED, __HIP_MEMORY_SCOPE_AGENT); }
__device__ __forceinline__ unsigned xb_add(unsigned* p, unsigned v) { return __hip_atomic_fetch_add(p, v, __ATOMIC_RELAXED, __HIP_MEMORY_SCOPE_AGENT); }
__device__ __forceinline__ unsigned xb_xcc_id() { return (unsigned)__builtin_amdgcn_s_getreg((3 << 11) | 20) & 0xFu; }
#define XB_SPIN(cond, bar) do { unsigned _sp = 0; while (cond) { __builtin_amdgcn_s_sleep(1); \
    if ((++_sp & 255u) == 0u) { if (xb_ld(&(bar)[XB_TMO])) break; if (_sp > XB_SPIN_CAP) { atomicAdd(&(bar)[XB_TMO], 1u); break; } } } } while (0)

struct XcdBarrier {
    unsigned* bar; unsigned x;
    volatile LAS unsigned* st;
};

__device__ __forceinline__ XcdBarrier xcd_barrier_post(unsigned* bar, volatile LAS unsigned* st) {
    XcdBarrier b; b.bar = bar; b.x = xb_xcc_id(); b.st = st;
    if (threadIdx.x == 0) (void)xb_add(&bar[XB_XCNT(b.x)], 1u);
    return b;
}
__device__ __forceinline__ void xcd_barrier_complete(unsigned* bar, unsigned x, unsigned& nloc, unsigned& nx) {
    const unsigned G = gridDim.x * gridDim.y * gridDim.z;
    unsigned sum, cnt, mine, sp = 0u;
    for (;;) {
        sum = 0u; cnt = 0u; mine = 0u;
#pragma unroll
        for (unsigned j = 0; j < 16; ++j) { const unsigned c = xb_ld(&bar[XB_XCNT(j)]); sum += c; cnt += (c > 0u) ? 1u : 0u; mine = (j == x) ? c : mine; }
        if (sum == G) break;
        __builtin_amdgcn_s_sleep(1);
        if ((++sp & 255u) == 0u) { if (xb_ld(&bar[XB_TMO])) break; if (sp > XB_SPIN_CAP) { atomicAdd(&bar[XB_TMO], 1u); break; } }
    }
    nloc = mine > 0u ? mine : 1u; nx = cnt > 0u ? cnt : 1u;
}

__device__ __forceinline__ void xcd_barrier(const XcdBarrier& b) {
    asm volatile("s_waitcnt vmcnt(0)" ::: "memory");
    __syncthreads();
    if (threadIdx.x == 0) {
        unsigned* bar = b.bar;
        __builtin_amdgcn_s_waitcnt(0);
        unsigned nloc = b.st[0], nx = b.st[1];
        if (nloc == 0u) { xcd_barrier_complete(bar, b.x, nloc, nx); b.st[0] = nloc; b.st[1] = nx; }
        const unsigned old = xb_add(&bar[XB_XSUB(b.x)], 1u);
        const unsigned gen = old / nloc;
        if (old + 1u == (gen + 1u) * nloc) {
            __builtin_amdgcn_fence(__ATOMIC_RELEASE, "agent");
            asm volatile("s_waitcnt vmcnt(0)" ::: "memory");
            const unsigned og = xb_add(&bar[XB_TOP], 1u);
            const unsigned tg = og / nx;
            if (og + 1u == (tg + 1u) * nx) xb_add(&bar[XB_TOPGEN], 1u);
            else XB_SPIN(xb_ld(&bar[XB_TOPGEN]) == tg, bar);
            __builtin_amdgcn_fence(__ATOMIC_ACQUIRE, "agent");
            xb_add(&bar[XB_XGEN(b.x)], 1u);
            asm volatile("s_waitcnt vmcnt(0)" ::: "memory");
        } else {
            XB_SPIN(xb_ld(&bar[XB_XGEN(b.x)]) == gen, bar);
            __builtin_amdgcn_fence(__ATOMIC_ACQUIRE, "agent");
            asm volatile("s_waitcnt vmcnt(0)" ::: "memory");
        }
    }
    __syncthreads();
}

constexpr int DM = 2048, MTOK = 65536, NIN = 3072, DFF = 5632, NUP = 11264, WINW = 2560;
constexpr int NPROMPT = 32768;
constexpr int CHUNK = 65536, NCHUNK = 1;
constexpr float EPS = 1e-6f;
constexpr size_t MiB = (size_t)1 << 20;
constexpr size_t WS_M2F = 0;
constexpr size_t WS_COS = 1 * MiB, WS_SIN = 5 * MiB;
constexpr size_t WS_A1P = 9 * MiB, WS_A1S = 9 * MiB + 128 * 1024;
constexpr size_t WS_A3P = 10 * MiB, WS_A3S = 18 * MiB;
constexpr size_t WS_BAR = 19 * MiB, BAR_BYTES = 16384;
constexpr size_t WS_W = 20 * MiB;
constexpr size_t W_LAYER = 86 * MiB, W_OUT_OFF = 12 * MiB, W_UP_OFF = 20 * MiB, W_DOWN_OFF = 64 * MiB;
constexpr size_t WS_XH = 192 * MiB;
constexpr size_t WS_Z = 448 * MiB;
constexpr size_t WS_G = 704 * MiB;
constexpr size_t WS_Y = 832 * MiB;
constexpr size_t WS_ACT = 448 * MiB;
constexpr size_t WS_HB = 1152 * MiB;
constexpr size_t WS_XB = 1240 * MiB;
constexpr size_t WS_END = 1496 * MiB;
constexpr int LDS_BYTES = 135168;

__device__ __forceinline__ float bf2f(unsigned short b) { return __uint_as_float((unsigned)b << 16); }
__device__ __forceinline__ float bflo(unsigned w) { return __uint_as_float(w << 16); }
__device__ __forceinline__ float bfhi(unsigned w) { return __uint_as_float(w & 0xffff0000u); }
__device__ __forceinline__ unsigned pk2(float lo, float hi) { return pg8::cvt_pk_bf16(lo, hi); }
__device__ __forceinline__ float wave_sum(float v) {
#pragma unroll
    for (int o = 1; o < 64; o <<= 1) v += __shfl_xor(v, o);
    return v;
}

struct EpiWin {
    static constexpr bool PERM = true, AFTER_DRAIN = false;
    bf16_t* Z; bf16_t* Gp;
    __device__ __forceinline__ void operator()(const pg8::f32x4 (&acc)[2][2][4][2], const pg8::Unit& u, int wr, int wc, int fr, int fq) const {
        const int row0 = u.pm * pg8::BM + wr * 64 + fr;
        bf16_t* base; size_t rstride, bjstride;
        if (u.pn < 8) { base = Z + (size_t)row0 * 2048 + u.pn * 256 + wc * 32 + 8 * fq; rstride = 2048; bjstride = 128; }
        else {
            const int g = u.pn - 8, r0 = u.pm * pg8::BM; size_t sb; int L, t0;
            if (r0 < NPROMPT) { const int s = r0 >> 14; sb = (size_t)s * (2u * 16384u * 512u); L = 16384; t0 = row0 - s * 16384; }
            else { const int s = (r0 - NPROMPT) >> 12; sb = (size_t)NPROMPT * 1024 + (size_t)s * (2u * 4096u * 512u); L = 4096; t0 = row0 - NPROMPT - s * 4096; }
            base = Gp + sb + (size_t)t0 * 512 + g * 128 + wc * 32 + 8 * fq; rstride = 512; bjstride = (size_t)L * 512;
        }
#pragma unroll
        for (int ai = 0; ai < 2; ++ai)
#pragma unroll
            for (int m = 0; m < 4; ++m) { bf16_t* rowp = base + (size_t)(ai * pg8::HALF + m * 16) * rstride;
#pragma unroll
                for (int bj = 0; bj < 2; ++bj) { const pg8::f32x4 v0 = acc[ai][bj][m][0], v1 = acc[ai][bj][m][1];
                    pg8::u32x4 w; w.x = pk2(v0[0], v0[1]); w.y = pk2(v0[2], v0[3]); w.z = pk2(v1[0], v1[1]); w.w = pk2(v1[2], v1[3]);
                    *(pg8::u32x4*)(rowp + bj * bjstride) = w; } }
    }
};

__device__ __forceinline__ void p0a_tables(const float* fourier_w, unsigned char* ws, LAS float* tab, int gtid, int NT) {
    float* M2F = (float*)(ws + WS_M2F);
    { const int t = ltid(); if (t < 128) { float sn, cs; sincospif((float)t * (2.f / 128.f), &sn, &cs); tab[t] = cs; tab[128 + t] = -sn; } }
    __syncthreads();
    for (int i = gtid; i < 2 * 4 * 128 * 256; i += NT) {
        const int lg = i >> 15, c = (i >> 8) & 127, n = i & 255, part = n >> 7, e2 = n & 127;
        const float* fw = fourier_w + (size_t)lg * 16384 + e2;
        float acc = 0.f;
#pragma unroll 8
        for (int e = 0; e < 128; ++e) { const int r = (c * e) & 127; acc += tab[part * 128 + r] * fw[e * 128]; }
        M2F[i] = acc;
    }
    __syncthreads();
    float* COS = (float*)(ws + WS_COS); float* SIN = (float*)(ws + WS_SIN);
    for (int i = gtid; i < 16384 * 64; i += NT) {
        const int t = i >> 6, j = i & 63; const float pos = (float)(j < 32 ? (t >> 6) : (t & 63));
        const float inv = 1.0f / powf(10000.0f, (float)(j & 31) / 32.0f); const float ang = pos * inv;
        COS[i] = cosf(ang); SIN[i] = sinf(ang);
    }
    bf16_t* A1P = (bf16_t*)(ws + WS_A1P);
    for (int i = gtid; i < 256 * 256; i += NT) { const int m = i >> 8, k = i & 255, pm = m >> 7, k1 = m & 127, pk = k >> 7, t1 = k & 127; const int r = (t1 * k1) & 127;
        float sn, cs; sincospif((float)r * (2.f / 128.f), &sn, &cs); const float v = (pm == pk) ? cs : (pm == 0 ? sn : -sn); A1P[i] = (bf16_t)(pk2(v, 0.f) & 0xffff); }
    bf16_t* A1S = (bf16_t*)(ws + WS_A1S);
    for (int i = gtid; i < 128 * 128; i += NT) { const int m = i >> 7, k = i & 127, pm = m >> 6, k1 = m & 63, pk = k >> 6, t1 = k & 63; const int r = (t1 * k1) & 63;
        float sn, cs; sincospif((float)r * (2.f / 64.f), &sn, &cs); const float v = (pm == pk) ? cs : (pm == 0 ? sn : -sn); A1S[i] = (bf16_t)(pk2(v, 0.f) & 0xffff); }
    bf16_t* A3P = (bf16_t*)(ws + WS_A3P);
    for (int i = gtid; i < 128 * 128 * 256; i += NT) { const int k1 = i >> 15, k2 = (i >> 8) & 127, kk = i & 255, part = kk >> 7, t2 = kk & 127; const int k = k1 + 128 * k2; const int r = (t2 * k) & 16383;
        float sn, cs; sincospif((float)r * (1.f / 8192.f), &sn, &cs); A3P[i] = (bf16_t)(pk2(part ? sn : cs, 0.f) & 0xffff); }
    bf16_t* A3S = (bf16_t*)(ws + WS_A3S);
    for (int i = gtid; i < 64 * 64 * 128; i += NT) { const int k1 = i >> 13, k2 = (i >> 7) & 63, kk = i & 127, part = kk >> 6, t2 = kk & 63; const int k = k1 + 64 * k2; const int r = (t2 * k) & 4095;
        float sn, cs; sincospif((float)r * (1.f / 2048.f), &sn, &cs); A3S[i] = (bf16_t)(pk2(part ? sn : cs, 0.f) & 0xffff); }
}

struct ValUp { const float* W; __device__ __forceinline__ const float* ptr(int k, int n) const { const int src = ((n >> 7) & 1) * DFF + (n >> 8) * 128 + (n & 127); return W + (size_t)k * NUP + src; }
    __device__ __forceinline__ float operator()(int k, int n) const { return *ptr(k, n); } };
struct ValDirect { const float* W; int ldw; __device__ __forceinline__ const float* ptr(int k, int n) const { return W + (size_t)k * ldw + n; }
    __device__ __forceinline__ float operator()(int k, int n) const { return W[(size_t)k * ldw + n]; } };
struct ValWin { const float* win; const float* poolw; const float* pscale; const float* m2f;
    __device__ __forceinline__ const float* ptr(int k, int n) const { return win + (size_t)k * WINW + n; }
    __device__ __forceinline__ float operator()(int k, int n) const {
        if (n >= 512 && n < 2048) return win[(size_t)k * WINW + n];
        if (n < 512) { const int g = n >> 7, e = n & 127; const float* wr = win + (size_t)k * WINW + g * 128; const float* pw = poolw + g * 16384 + e; float acc = 0.f;
            for (int c = 0; c < 128; ++c) acc += wr[c] * pw[c * 128]; return acc * pscale[n]; }
        const int n2 = n - 2048, g = n2 >> 8, np = n2 & 255; const float* wr = win + (size_t)k * WINW + 2048 + g * 128; const float* mf = m2f + g * 32768 + np; float acc = 0.f;
        for (int c = 0; c < 128; ++c) acc += wr[c] * mf[c * 256]; return acc; } };
template <class F> __device__ __forceinline__ void transpose_item(const F& val, int K, bf16_t* WT, int k0, int n0, LAS float* scr, int lane) {
    for (int i = 0; i < 32; ++i) { const int kk = 2 * i + (lane >> 5); scr[kk * 33 + (lane & 31)] = val(k0 + kk, n0 + (lane & 31)); }
    asm volatile("s_waitcnt lgkmcnt(0)" ::: "memory");
    const int c = lane & 7;
#pragma unroll
    for (int j = 0; j < 4; ++j) { const int n = (lane >> 3) + 8 * j; const LAS float* s = scr + (8 * c) * 33 + n;
        v4u o; o.x = pk2(s[0 * 33], s[1 * 33]); o.y = pk2(s[2 * 33], s[3 * 33]); o.z = pk2(s[4 * 33], s[5 * 33]); o.w = pk2(s[6 * 33], s[7 * 33]);
        *(v4u*)(WT + (size_t)(n0 + n) * K + k0 + 8 * c) = o; }
    asm volatile("s_waitcnt lgkmcnt(0)" ::: "memory");
}
template <class F> __device__ __forceinline__ void tr_load(const F& f, int k0, int n0, int lane, f4 (&v)[8]) {
#pragma unroll
    for (int i = 0; i < 8; ++i) v[i] = __builtin_nontemporal_load((const f4*)f.ptr(k0 + 8 * i + (lane >> 3), n0 + 4 * (lane & 7)));
}
__device__ __forceinline__ void tr_store(const f4 (&v)[8], int K, bf16_t* WT, int k0, int n0, LAS float* scr, int lane) {
#pragma unroll
    for (int i = 0; i < 8; ++i) { LAS float* d = scr + (8 * i + (lane >> 3)) * 33 + 4 * (lane & 7); d[0] = v[i].x; d[1] = v[i].y; d[2] = v[i].z; d[3] = v[i].w; }
    asm volatile("s_waitcnt lgkmcnt(0)" ::: "memory");
    const int c = lane & 7;
#pragma unroll
    for (int j = 0; j < 4; ++j) { const int n = (lane >> 3) + 8 * j; const LAS float* s = scr + (8 * c) * 33 + n;
        v4u o; o.x = pk2(s[0 * 33], s[1 * 33]); o.y = pk2(s[2 * 33], s[3 * 33]); o.z = pk2(s[4 * 33], s[5 * 33]); o.w = pk2(s[6 * 33], s[7 * 33]);
        *(v4u*)(WT + (size_t)(n0 + n) * K + k0 + 8 * c) = o; }
    asm volatile("s_waitcnt lgkmcnt(0)" ::: "memory");
}
template <class F> __device__ __forceinline__ void transpose_matrix(const F& val, int K, int N, bf16_t* WT, LAS float* scr, int gw, int NGW, int lane, int nlo, int nhi) {
    const int nblk = (nhi - nlo) / 32, nitems = (K / 64) * nblk;
    int it = gw; if (it >= nitems) return;
    f4 cur[8], nxt[8];
    tr_load(val, 64 * (it / nblk), nlo + 32 * (it % nblk), lane, cur);
    for (; it < nitems; it += NGW) {
        const int k0 = 64 * (it / nblk), n0 = nlo + 32 * (it % nblk); const int it2 = it + NGW; const bool more = it2 < nitems;
        if (more) tr_load(val, 64 * (it2 / nblk), nlo + 32 * (it2 % nblk), lane, nxt);
        tr_store(cur, K, WT, k0, n0, scr, lane);
        if (more) {
#pragma unroll
            for (int i = 0; i < 8; ++i) cur[i] = nxt[i]; }
    }
}

typedef float __attribute__((address_space(4))) cf32;
__device__ __forceinline__ void fold_items(const float* win, const float* poolw, const float* pscale, const float* m2f, bf16_t* WT, int gw, int NGW, int lane) {
    for (int it = gw; it < 64 * 24; it += NGW) {
        const int kb = it / 24, nb = it - kb * 24, k0 = 32 * kb;
        float m2[128]; int base, nout;
        if (nb < 8) { const int n = nb * 64 + lane, g = nb >> 1, e = n & 127; base = g * 128; nout = n; const float sc = pscale[n]; const float* pw = poolw + g * 16384 + e;
#pragma unroll
            for (int c = 0; c < 128; ++c) m2[c] = pw[c * 128] * sc;
        } else { const int n2 = (nb - 8) * 64 + lane, g = (nb - 8) >> 2, np = n2 & 255; base = 2048 + g * 128; nout = 2048 + n2; const float* mf = m2f + g * 32768 + np;
#pragma unroll
            for (int c = 0; c < 128; ++c) m2[c] = mf[c * 256];
        }
        bf16_t* wrow = WT + (size_t)nout * DM + k0;
        for (int kg = 0; kg < 4; ++kg) {
            float acc[8];
#pragma unroll
            for (int kk = 0; kk < 8; ++kk) { const cf32* wr = (const cf32*)(unsigned long long)(win + (size_t)(k0 + 8 * kg + kk) * WINW + base); float a = 0.f;
#pragma unroll
                for (int c = 0; c < 128; ++c) a += wr[c] * m2[c];
                acc[kk] = a; }
            v4u o; o.x = pk2(acc[0], acc[1]); o.y = pk2(acc[2], acc[3]); o.z = pk2(acc[4], acc[5]); o.w = pk2(acc[6], acc[7]);
            *(v4u*)(wrow + 8 * kg) = o;
        }
    }
}

__device__ __forceinline__ const float* xrow_ptr(const float* xa, const float* xb, int row) { return (row < NPROMPT) ? xa + (size_t)row * DM : xb + (size_t)(row - NPROMPT) * DM; }
template <bool XBF, bool OBF, int RR>
__device__ __forceinline__ void resid_rows(const float* xa, const float* xb, const bf16_t* xbf, const bf16_t* m, const float* g1, float* xout, bf16_t* xbout, bf16_t* xh, const float* g2, int gw, int NGW, int lane) {
    constexpr bool W = XBF;
#define EO(k) (W ? (8 * lane + 512 * ((k) >> 1) + 4 * ((k) & 1)) : (4 * lane + 256 * (k)))
    for (int row0 = gw; row0 < MTOK; row0 += RR * NGW) {
        f4 xf[XBF ? 1 : RR][8]; v2u xp[XBF ? RR : 1][8]; v2u mw[RR][8];
#pragma unroll
        for (int u = 0; u < RR; ++u) { const int row = row0 + u * NGW;
            if constexpr (XBF) { const bf16_t* xr = xbf + (size_t)row * DM;
#pragma unroll
                for (int j = 0; j < 4; ++j) { const v4u t = __builtin_nontemporal_load((const v4u*)(xr + 8 * lane + 512 * j)); xp[u][2 * j] = (v2u){t.x, t.y}; xp[u][2 * j + 1] = (v2u){t.z, t.w}; }
            } else { const float* xr = xrow_ptr(xa, xb, row);
#pragma unroll
                for (int k = 0; k < 8; ++k) xf[u][k] = __builtin_nontemporal_load((const f4*)(xr + EO(k))); } }
        if (m) {
#pragma unroll
            for (int u = 0; u < RR; ++u) { const bf16_t* mr = m + (size_t)(row0 + u * NGW) * DM;
                if constexpr (W) {
#pragma unroll
                    for (int j = 0; j < 4; ++j) { const v4u t = __builtin_nontemporal_load((const v4u*)(mr + 8 * lane + 512 * j)); mw[u][2 * j] = (v2u){t.x, t.y}; mw[u][2 * j + 1] = (v2u){t.z, t.w}; }
                } else {
#pragma unroll
                    for (int k = 0; k < 8; ++k) mw[u][k] = __builtin_nontemporal_load((const v2u*)(mr + EO(k))); } }
        }
#pragma unroll
        for (int u = 0; u < RR; ++u) { const int row = row0 + u * NGW;
            f4 xv[8];
#pragma unroll
            for (int k = 0; k < 8; ++k) { if constexpr (XBF) { const v2u w = xp[u][k]; xv[k] = (f4){bflo(w.x), bfhi(w.x), bflo(w.y), bfhi(w.y)}; } else xv[k] = xf[u][k]; }
            if (m) { float ss = 0.f;
#pragma unroll
                for (int k = 0; k < 8; ++k) { const v2u w = mw[u][k]; const f4 mv = (f4){bflo(w.x), bfhi(w.x), bflo(w.y), bfhi(w.y)}; ss += (mv.x * mv.x + mv.y * mv.y) + (mv.z * mv.z + mv.w * mv.w); }
                const float r = 1.0f / sqrtf(wave_sum(ss) * (1.f / DM) + EPS);
#pragma unroll
                for (int k = 0; k < 8; ++k) { const v2u w = mw[u][k]; const f4 mv = (f4){bflo(w.x), bfhi(w.x), bflo(w.y), bfhi(w.y)}; const f4 gv = *(const f4*)(g1 + EO(k)); xv[k] += mv * r * gv; } }
            if constexpr (OBF) { if (xbout) {
                if constexpr (W) {
#pragma unroll
                    for (int j = 0; j < 4; ++j) { v4u w; w.x = pk2(xv[2 * j].x, xv[2 * j].y); w.y = pk2(xv[2 * j].z, xv[2 * j].w); w.z = pk2(xv[2 * j + 1].x, xv[2 * j + 1].y); w.w = pk2(xv[2 * j + 1].z, xv[2 * j + 1].w);
                        __builtin_nontemporal_store(w, (v4u*)(xbout + (size_t)row * DM + 8 * lane + 512 * j)); }
                } else {
#pragma unroll
                    for (int k = 0; k < 8; ++k) { v2u w; w.x = pk2(xv[k].x, xv[k].y); w.y = pk2(xv[k].z, xv[k].w); __builtin_nontemporal_store(w, (v2u*)(xbout + (size_t)row * DM + EO(k))); } } }
            } else { if (xout) {
#pragma unroll
                for (int k = 0; k < 8; ++k) __builtin_nontemporal_store(xv[k], (f4*)(xout + (size_t)row * DM + EO(k))); } }
            if (xh) { float ss = 0.f;
#pragma unroll
                for (int k = 0; k < 8; ++k) ss += (xv[k].x * xv[k].x + xv[k].y * xv[k].y) + (xv[k].z * xv[k].z + xv[k].w * xv[k].w);
                const float r = 1.0f / sqrtf(wave_sum(ss) * (1.f / DM) + EPS);
                if constexpr (W) {
#pragma unroll
                    for (int j = 0; j < 4; ++j) { const f4 ga = *(const f4*)(g2 + EO(2 * j)), gb = *(const f4*)(g2 + EO(2 * j + 1)); const f4 ya = xv[2 * j] * r * ga, yb = xv[2 * j + 1] * r * gb;
                        v4u w; w.x = pk2(ya.x, ya.y); w.y = pk2(ya.z, ya.w); w.z = pk2(yb.x, yb.y); w.w = pk2(yb.z, yb.w); *(v4u*)(xh + (size_t)row * DM + 8 * lane + 512 * j) = w; }
                } else {
#pragma unroll
                    for (int k = 0; k < 8; ++k) { const f4 gv = *(const f4*)(g2 + EO(k)); const f4 y = xv[k] * r * gv;
                        v2u w; w.x = pk2(y.x, y.y); w.y = pk2(y.z, y.w); *(v2u*)(xh + (size_t)row * DM + EO(k)) = w; } } }
        }
    }
#undef EO
}

__device__ __forceinline__ void rope_pass(bf16_t* Z, bf16_t* Zout, const float* qn, const float* kn, const float* COS, const float* SIN, int gtid, int NT) {
    const int qw = gtid >> 4, NQW = NT >> 4, j = gtid & 15;
    constexpr float QC = 0.088388347648318440f * 1.4426950408889634f;
    const f4 qa = *(const f4*)(qn + 4 * j) * QC, qb = *(const f4*)(qn + 64 + 4 * j) * QC, ka = *(const f4*)(kn + 4 * j), kb = *(const f4*)(kn + 64 + 4 * j);
    for (int row = qw; row < MTOK; row += NQW) {
        const int t = row < NPROMPT ? (row & 16383) : (row & 4095);
        const bf16_t* p = Z + (size_t)row * DM + 512 + 4 * j;
        v2u a[10], b[10];
#pragma unroll
        for (int hh = 0; hh < 10; ++hh) { a[hh] = *(const v2u*)(p + hh * 128); b[hh] = *(const v2u*)(p + hh * 128 + 64); }
        const f4 c = *(const f4*)(COS + t * 64 + 4 * j), sn = *(const f4*)(SIN + t * 64 + 4 * j);
        bf16_t* po = Zout + (size_t)row * DM + 512 + 4 * j;
#pragma unroll
        for (int hh = 0; hh < 10; ++hh) {
            f4 x = (f4){bflo(a[hh].x), bfhi(a[hh].x), bflo(a[hh].y), bfhi(a[hh].y)}, y = (f4){bflo(b[hh].x), bfhi(b[hh].x), bflo(b[hh].y), bfhi(b[hh].y)};
            float ss = ((x.x * x.x + x.y * x.y) + (x.z * x.z + x.w * x.w)) + ((y.x * y.x + y.y * y.y) + (y.z * y.z + y.w * y.w));
#pragma unroll
            for (int o = 1; o < 16; o <<= 1) ss += __shfl_xor(ss, o);
            const float r = 1.0f / sqrtf(ss * (1.f / 128.f) + EPS);
            x = x * r * (hh < 8 ? qa : ka); y = y * r * (hh < 8 ? qb : kb);
            const f4 ox = x * c - y * sn, oy = y * c + x * sn;
            v2u wx, wy; wx.x = pk2(ox.x, ox.y); wx.y = pk2(ox.z, ox.w); wy.x = pk2(oy.x, oy.y); wy.y = pk2(oy.z, oy.w);
            *(v2u*)(po + hh * 128) = wx; *(v2u*)(po + hh * 128 + 64) = wy;
        }
    }
}

__device__ __forceinline__ void acc8(float* s, const bf16_t* p, float sg) { const v4u v = *(const v4u*)p;
    s[0] += sg * bflo(v.x); s[1] += sg * bfhi(v.x); s[2] += sg * bflo(v.y); s[3] += sg * bfhi(v.y); s[4] += sg * bflo(v.z); s[5] += sg * bfhi(v.z); s[6] += sg * bflo(v.w); s[7] += sg * bfhi(v.w); }
__device__ __forceinline__ void pool_pass(const bf16_t* Z, bf16_t* H, int gtid, int NT) {
    constexpr int RL = 32;
    for (int it = gtid; it < (MTOK / RL) * 64; it += NT) {
        const int ch = it & 63, run = it >> 6, c0 = ch * 8, g = ch >> 4, w = 2 << g, a = w >> 1, b = w - 1 - a;
        const int row0 = run * RL; int t0, L; if (row0 < NPROMPT) { t0 = row0 & 16383; L = 16384; } else { t0 = row0 & 4095; L = 4096; }
        const bf16_t* zb = Z + (size_t)(row0 - t0) * DM + c0;
        float s[8] = {0.f, 0.f, 0.f, 0.f, 0.f, 0.f, 0.f, 0.f};
        { const int lo = t0 - a < 0 ? 0 : t0 - a, hi = t0 + b > L - 1 ? L - 1 : t0 + b;
          for (int tt = lo; tt <= hi; ++tt) acc8(s, zb + (size_t)tt * DM, 1.f); }
#pragma unroll 4
        for (int r = 0; r < RL; ++r) {
            const int t = t0 + r; const int lo = t - a < 0 ? 0 : t - a, hi = t + b > L - 1 ? L - 1 : t + b;
            const float ic = 1.0f / (float)(hi - lo + 1);
            const v4u v = *(const v4u*)(zb + (size_t)t * DM);
            v4u o; o.x = pk2(s[0] * ic - bflo(v.x), s[1] * ic - bfhi(v.x)); o.y = pk2(s[2] * ic - bflo(v.y), s[3] * ic - bfhi(v.y));
            o.z = pk2(s[4] * ic - bflo(v.z), s[5] * ic - bfhi(v.z)); o.w = pk2(s[6] * ic - bflo(v.w), s[7] * ic - bfhi(v.w));
            *(v4u*)(H + (size_t)(row0 + r) * DM + c0) = o;
            if (t + 1 + b <= L - 1) acc8(s, zb + (size_t)(t + 1 + b) * DM, 1.f);
            if (t - a >= 0) acc8(s, zb + (size_t)(t - a) * DM, -1.f);
        }
    }
}

__device__ __forceinline__ float gelu_tanh(float x) { const float y = 0.7978845608028654f * (x + 0.044715f * x * x * x); return x * __builtin_amdgcn_rcpf(1.0f + __expf(-2.0f * y)); }
__device__ __forceinline__ void ld8f(const bf16_t* p, float* o) { const v4u v = __builtin_nontemporal_load((const v4u*)p); o[0] = bflo(v.x); o[1] = bfhi(v.x); o[2] = bflo(v.y); o[3] = bfhi(v.y); o[4] = bflo(v.z); o[5] = bfhi(v.z); o[6] = bflo(v.w); o[7] = bfhi(v.w); }
__device__ __forceinline__ float dpp_ror1(float v) { return __int_as_float(__builtin_amdgcn_update_dpp(0, __float_as_int(v), 0x121, 0xf, 0xf, false)); }
__device__ __forceinline__ float dpp_ror15(float v) { return __int_as_float(__builtin_amdgcn_update_dpp(0, __float_as_int(v), 0x12F, 0xf, 0xf, false)); }
struct EpiGlu {
    static constexpr bool PERM = true, AFTER_DRAIN = false;
    bf16_t* ACT; bf16_t* HB; const float* cw; const float* cb;
    __device__ __forceinline__ void operator()(const pg8::f32x4 (&acc)[2][2][4][2], const pg8::Unit& u, int wr, int wc, int fr, int fq) const {
        const int jc = u.pn * 128 + wc * 32 + 8 * fq;
        const bool first = (fr == 0), last = (fr == 15);
        v2u stash[2][4];
#pragma unroll
        for (int n = 0; n < 2; ++n) {
            const f4 w0g = *(const f4*)(cw + jc + 4 * n), w1g = *(const f4*)(cw + NUP + jc + 4 * n), w2g = *(const f4*)(cw + 2 * NUP + jc + 4 * n), bg = *(const f4*)(cb + jc + 4 * n);
            const f4 w0v = *(const f4*)(cw + DFF + jc + 4 * n), w1v = *(const f4*)(cw + NUP + DFF + jc + 4 * n), w2v = *(const f4*)(cw + 2 * NUP + DFF + jc + 4 * n), bv = *(const f4*)(cb + DFF + jc + 4 * n);
#pragma unroll
            for (int ai = 0; ai < 2; ++ai) {
                float g1p[4], v1p[4], g15c[4], v15c[4];
#pragma unroll
                for (int i = 0; i < 4; ++i) { g1p[i] = 0.f; v1p[i] = 0.f; g15c[i] = dpp_ror15(acc[ai][0][0][n][i]); v15c[i] = dpp_ror15(acc[ai][1][0][n][i]); }
#pragma unroll
                for (int m = 0; m < 4; ++m) {
                    const int mn = m < 3 ? m + 1 : 3;
                    float o[4];
#pragma unroll
                    for (int i = 0; i < 4; ++i) {
                        const float g = acc[ai][0][m][n][i], v = acc[ai][1][m][n][i];
                        const float g1c = dpp_ror1(g), v1c = dpp_ror1(v), g15n = dpp_ror15(acc[ai][0][mn][n][i]), v15n = dpp_ror15(acc[ai][1][mn][n][i]);
                        const float gp = first ? g1p[i] : g1c, gn = last ? g15n : g15c[i], vp = first ? v1p[i] : v1c, vn = last ? v15n : v15c[i];
                        g1p[i] = g1c; v1p[i] = v1c; g15c[i] = g15n; v15c[i] = v15n;
                        const float a = gp * w0g[i] + g * w1g[i] + gn * w2g[i] + bg[i];
                        const float b = vp * w0v[i] + v * w1v[i] + vn * w2v[i] + bv[i];
                        const float e = __builtin_amdgcn_exp2f(a * (-2.3022082f + -0.10294324f * (a * a)));
                        o[i] = a * __builtin_amdgcn_rcpf(1.0f + e) * b;
                    }
                    const int row = u.pm * pg8::BM + ai * pg8::HALF + wr * 64 + m * 16 + fr;
                    v2u w; w.x = pk2(o[0], o[1]); w.y = pk2(o[2], o[3]);
                    if (n == 0) stash[ai][m] = w;
                    else { v4u ww; ww.x = stash[ai][m].x; ww.y = stash[ai][m].y; ww.z = w.x; ww.w = w.y; *(v4u*)(ACT + (size_t)row * DFF + jc) = ww; }
                }
            }
        }
#pragma unroll
        for (int ai = 0; ai < 2; ++ai) {
            const int grp = u.pm * 4 + ai * 2 + wr;
            if (fr < 2 || fr >= 14) {
                const int m = fr < 2 ? 0 : 3, slot = fr < 2 ? fr : fr - 12;
                bf16_t* hp = HB + ((size_t)grp * 4 + slot) * NUP + u.pn * 256 + wc * 32 + 8 * fq;
#pragma unroll
                for (int bj = 0; bj < 2; ++bj) {
                    const pg8::f32x4 v0 = fr < 2 ? acc[ai][bj][0][0] : acc[ai][bj][3][0], v1 = fr < 2 ? acc[ai][bj][0][1] : acc[ai][bj][3][1];
                    v4u w; w.x = pk2(v0[0], v0[1]); w.y = pk2(v0[2], v0[3]); w.z = pk2(v1[0], v1[1]); w.w = pk2(v1[2], v1[3]);
                    *(v4u*)(hp + bj * 128) = w;
                }
                (void)m;
            }
        }
    }
};
__device__ __forceinline__ void glu_fix(const bf16_t* HB, bf16_t* ACT, const float* cw, const float* cb, int gtid, int NT) {
    constexpr int NCC = DFF / 8, NG = CHUNK / 64;
    for (int it = gtid; it < NG * 2 * NCC; it += NT) {
        const int cc = it % NCC, rest = it / NCC, which = rest & 1, g = rest >> 1, j0 = cc * 8, colp = (j0 >> 7) * 256 + (j0 & 127);
        const int row = g * 64 + (which ? 63 : 0); const int Lc = row < NPROMPT ? 16384 : 4096;
        const bf16_t *P, *C, *N;
        if (!which) { C = HB + ((size_t)g * 4 + 0) * NUP; N = HB + ((size_t)g * 4 + 1) * NUP; P = ((row & (Lc - 1)) == 0) ? nullptr : HB + ((size_t)(g - 1) * 4 + 3) * NUP; }
        else { P = HB + ((size_t)g * 4 + 2) * NUP; C = HB + ((size_t)g * 4 + 3) * NUP; N = (((row + 1) & (Lc - 1)) == 0) ? nullptr : HB + ((size_t)(g + 1) * 4 + 0) * NUP; }
        float pg[8], pv[8], cg_[8], cv[8], ng[8], nv[8];
        if (P) { ld8f(P + colp, pg); ld8f(P + colp + 128, pv); } else {
#pragma unroll
            for (int i = 0; i < 8; ++i) { pg[i] = 0.f; pv[i] = 0.f; } }
        if (N) { ld8f(N + colp, ng); ld8f(N + colp + 128, nv); } else {
#pragma unroll
            for (int i = 0; i < 8; ++i) { ng[i] = 0.f; nv[i] = 0.f; } }
        ld8f(C + colp, cg_); ld8f(C + colp + 128, cv);
        float o[8];
#pragma unroll
        for (int h = 0; h < 2; ++h) {
            const f4 w0g = *(const f4*)(cw + j0 + 4 * h), w1g = *(const f4*)(cw + NUP + j0 + 4 * h), w2g = *(const f4*)(cw + 2 * NUP + j0 + 4 * h), bg = *(const f4*)(cb + j0 + 4 * h);
            const f4 w0v = *(const f4*)(cw + DFF + j0 + 4 * h), w1v = *(const f4*)(cw + NUP + DFF + j0 + 4 * h), w2v = *(const f4*)(cw + 2 * NUP + DFF + j0 + 4 * h), bv = *(const f4*)(cb + DFF + j0 + 4 * h);
#pragma unroll
            for (int q = 0; q < 4; ++q) { const int i = 4 * h + q;
                const float a = pg[i] * w0g[q] + cg_[i] * w1g[q] + ng[i] * w2g[q] + bg[q];
                const float b = pv[i] * w0v[q] + cv[i] * w1v[q] + nv[i] * w2v[q] + bv[q];
                o[i] = gelu_tanh(a) * b; } }
        v4u w; w.x = pk2(o[0], o[1]); w.y = pk2(o[2], o[3]); w.z = pk2(o[4], o[5]); w.w = pk2(o[6], o[7]);
        *(v4u*)(ACT + (size_t)row * DFF + j0) = w;
    }
}

struct BRow1 { const att::bf16* base; size_t ldb; __device__ __forceinline__ const att::bf16* row(int kk) const { return base + (size_t)kk * ldb; } };
struct St1 { att::bf16* base; size_t ldb; float scale; __device__ __forceinline__ void store16(int m, int c, att::u32x4 v) const { *(att::u32x4*)(base + (size_t)m * ldb + c) = v; } };
struct BRow3 { const att::bf16* base; int R, lgR, k1; __device__ __forceinline__ const att::bf16* row(int kk) const { const int part = kk >> lgR, t2 = kk & (R - 1); return base + (size_t)(((part << lgR) + k1) * R + t2) * 512; } };
struct St3 { att::bf16* base; int R; float scale; __device__ __forceinline__ void store16(int m, int c, att::u32x4 v) const { *(att::u32x4*)(base + (size_t)(m * R) * DM + c) = v; } };

__device__ __forceinline__ void dft_stage1(const bf16_t* Gp, bf16_t* Yp, const unsigned char* ws, char* lds, int vcu, int G) {
    for (int it = 0;; ++it) { const int uid = it * G + vcu; if (uid >= 3072) break;
        if (uid < 1024) { const int s = uid >> 9, nt = uid & 511; const size_t off = (size_t)s * (2u * 16384u * 512u) + (size_t)nt * 128;
            BRow1 br{(const att::bf16*)Gp + off, 65536}; St1 st{(att::bf16*)Yp + off, 65536, 1.f};
            att::dft_unit<8, 4>((const att::bf16*)(ws + WS_A1P), 256, br, st, lds);
        } else { const int u2 = uid - 1024, s = u2 >> 8, nt = u2 & 255; const size_t off = (size_t)NPROMPT * 1024 + (size_t)s * (2u * 4096u * 512u) + (size_t)nt * 128;
            BRow1 br{(const att::bf16*)Gp + off, 32768}; St1 st{(att::bf16*)Yp + off, 32768, 1.f};
            att::dft_unit<4, 2>((const att::bf16*)(ws + WS_A1S), 128, br, st, lds);
        }
    }
}
__device__ __forceinline__ void dft_stage3(const bf16_t* Yp, bf16_t* H, const unsigned char* ws, char* lds, int vcu, int G) {
    for (int it = 0;; ++it) { const int uid = it * G + vcu; if (uid >= 3072) break;
        if (uid < 1024) { const int s = uid >> 9, k1 = (uid >> 2) & 127, nt = uid & 3;
            BRow3 br{(const att::bf16*)Yp + (size_t)s * (2u * 16384u * 512u) + nt * 128, 128, 7, k1};
            St3 st{(att::bf16*)H + (size_t)(s * 16384 + k1) * DM + 1536 + nt * 128, 128, 1.0f / sqrtf(16384.f * 128.f)};
            att::dft_unit<4, 4>((const att::bf16*)(ws + WS_A3P) + (size_t)k1 * (128 * 256), 256, br, st, lds);
        } else { const int u2 = uid - 1024, s = u2 >> 8, k1 = (u2 >> 2) & 63, nt = u2 & 3;
            BRow3 br{(const att::bf16*)Yp + (size_t)NPROMPT * 1024 + (size_t)s * (2u * 4096u * 512u) + nt * 128, 64, 6, k1};
            St3 st{(att::bf16*)H + (size_t)(NPROMPT + s * 4096 + k1) * DM + 1536 + nt * 128, 64, 1.0f / sqrtf(4096.f * 128.f)};
            att::dft_unit<2, 2>((const att::bf16*)(ws + WS_A3S) + (size_t)k1 * (64 * 128), 128, br, st, lds);
        }
    }
}

template <bool SHIFT> __device__ __forceinline__ void attn_units(const bf16_t* Z, bf16_t* H, float bound, char* lds, int vcu, int G) {
    for (int it = 0;; ++it) { const int uid = it * G + vcu; if (uid >= 2048) break;
        int rowbase, h, qb, seq;
        if (uid < 1024) { const int s = uid >> 9; h = (uid >> 6) & 7; qb = uid & 63; rowbase = s * 16384; seq = 16384; }
        else { const int u2 = uid - 1024, s = u2 >> 7; h = (u2 >> 4) & 7; qb = u2 & 15; rowbase = NPROMPT + s * 4096; seq = 4096; }
        const att::bf16* Q = (const att::bf16*)Z + (size_t)(rowbase + qb * 256) * DM + 512 + h * 128;
        const att::bf16* K = (const att::bf16*)Z + (size_t)rowbase * DM + 1536 + (h >> 2) * 128;
        att::bf16* O = (att::bf16*)H + (size_t)(rowbase + qb * 256) * DM + 512 + h * 128;
        att::attn_dense_body<att::bf16, SHIFT>(Q, K, K + 256, O, seq, lds, bound);
        __syncthreads();
    }
}
__device__ __forceinline__ void attn_phase(const bf16_t* Z, bf16_t* H, const float* qn, const float* kn, char* lds, int vcu, int G) {
    float mq = 0.f, mk = 0.f;
    for (int i = 0; i < 128; ++i) { mq = fmaxf(mq, fabsf(qn[i])); mk = fmaxf(mk, fabsf(kn[i])); }
    const float bound = 128.f * mq * mk * 1.02f;
    const bool noshift = __builtin_amdgcn_readfirstlane((int)(bound * (att::SCALE * 1.4426950408889634f) < 60.f)) != 0;
    if (noshift) attn_units<false>(Z, H, bound, lds, vcu, G);
    else attn_units<true>(Z, H, bound, lds, vcu, G);
}

struct Params { const float* in[17]; float* out; unsigned char* ws; int ph_lo, ph_hi; };
constexpr int NPL = 9;
constexpr int NPHASE = 2 + 2 * NPL;

__global__ void __launch_bounds__(512, 2) mega_fwd(Params p) {
    extern __shared__ __attribute__((aligned(16))) unsigned char lds[];
    cg::grid_group grid = cg::this_grid();
    const int G = gridDim.x, bx = blockIdx.x;
    const int vcu = (G % 8 == 0) ? (bx % 8) * (G / 8) + bx / 8 : bx;
    const int NGW = G * 8, NT = G * 512;
    unsigned char* ws = p.ws;
    const float *x_prompt = p.in[0], *x_sample = p.in[1], *g_pre_mix = p.in[2], *g_post_mix = p.in[3], *w_in = p.in[4], *pool_w = p.in[5], *pool_scale = p.in[6],
                *q_norm = p.in[7], *k_norm = p.in[8], *fourier_w = p.in[9], *w_out = p.in[10], *g_pre_ffn = p.in[11], *g_post_ffn = p.in[12], *w_up = p.in[13],
                *conv_w = p.in[14], *conv_b = p.in[15], *w_down = p.in[16];
    bf16_t* XH = (bf16_t*)(ws + WS_XH); bf16_t* Z = (bf16_t*)(ws + WS_Z); bf16_t* Gp = (bf16_t*)(ws + WS_G); bf16_t* Yp = (bf16_t*)(ws + WS_Y);
    bf16_t* HB = (bf16_t*)(ws + WS_HB); bf16_t* ACT = (bf16_t*)(ws + WS_ACT); bf16_t* XB = (bf16_t*)(ws + WS_XB);
    LAS unsigned char* ring = (LAS unsigned char*)lds;
    volatile LAS unsigned* bst = (volatile LAS unsigned*)(ring + 131072 + 64);
    if (threadIdx.x < 2) bst[threadIdx.x] = 0u;
    __syncthreads();
    XcdBarrier xbar = xcd_barrier_post((unsigned*)(ws + WS_BAR), bst);

    for (int ph = p.ph_lo; ph < p.ph_hi; ++ph) {
        const int tid = ltid(), lane = tid & 63, wave = __builtin_amdgcn_readfirstlane(tid >> 6);
        const int gw = vcu * 8 + wave, gtid = bx * 512 + tid;
        if (ph == 0) {
#if !defined(ONLY) || ONLY==0
            for (int rep = 0; rep < REP_P0; ++rep) p0a_tables(fourier_w, ws, (LAS float*)ring, gtid, NT);
#endif
        } else if (ph == 1) {
#if !defined(ONLY) || ONLY==1
            LAS float* scr = (LAS float*)(ring + wave * 16384);
            for (int l = 0; l < 2 * REP_P0; ++l) {
                bf16_t* Wl = (bf16_t*)(ws + WS_W + (l & 1) * W_LAYER);
                ValWin vw{w_in + (size_t)(l & 1) * DM * WINW, pool_w + (size_t)(l & 1) * 4 * 16384, pool_scale + (l & 1) * 512, (const float*)(ws + WS_M2F) + (size_t)(l & 1) * 4 * 32768};
                transpose_matrix(vw, DM, NIN, Wl, scr, gw, NGW, lane, 512, 2048);
                fold_items(vw.win, vw.poolw, vw.pscale, vw.m2f, Wl, gw, NGW, lane);
                ValDirect vo{w_out + (size_t)(l & 1) * DM * DM, DM};
                transpose_matrix(vo, DM, DM, (bf16_t*)((unsigned char*)Wl + W_OUT_OFF), scr, gw, NGW, lane, 0, DM);
                ValUp vu{w_up + (size_t)(l & 1) * DM * NUP};
                transpose_matrix(vu, DM, NUP, (bf16_t*)((unsigned char*)Wl + W_UP_OFF), scr, gw, NGW, lane, 0, NUP);
                ValDirect vd{w_down + (size_t)(l & 1) * DFF * DM, DM};
                transpose_matrix(vd, DFF, DM, (bf16_t*)((unsigned char*)Wl + W_DOWN_OFF), scr, gw, NGW, lane, 0, DM);
            }
            for (int rep = 0; rep < REP_P0; ++rep) resid_rows<false, false, 2>(x_prompt, x_sample, nullptr, nullptr, nullptr, nullptr, nullptr, XH, g_pre_mix, gw, NGW, lane);
#endif
        } else {
            const int l = (ph - 2) / NPL, q = (ph - 2) % NPL;
            const bf16_t* Wl = (const bf16_t*)(ws + WS_W + l * W_LAYER);
            if (q == 0) {
#if !defined(ONLY) || ONLY==2
                pg8::Gemm g{XH, Wl, MTOK, NIN, DM}; pg8::StaticOrder S; S.init(MTOK, NIN, G, bx);
                EpiWin E{Z, Gp};
                for (int rep = 0; rep < REP_WIN; ++rep) pg8::gemm_phase<EpiWin, pg8::StaticOrder, PG8_ALIGN, PG8_SP2>(ring, g, S, E);
#endif
            } else if (q == 1) {
#if !defined(ONLY) || ONLY==3
                for (int rep = 1; rep < REP_ROPE; ++rep) rope_pass(Z, (bf16_t*)(ws + WS_END), q_norm + l * 128, k_norm + l * 128, (const float*)(ws + WS_COS), (const float*)(ws + WS_SIN), gtid, NT);
                rope_pass(Z, Z, q_norm + l * 128, k_norm + l * 128, (const float*)(ws + WS_COS), (const float*)(ws + WS_SIN), gtid, NT);
                for (int rep = 0; rep < REP_LIGHT * REP_POOL; ++rep) pool_pass(Z, XH, gtid, NT);
                for (int rep = 0; rep < REP_LIGHT; ++rep) dft_stage1(Gp, Yp, ws, (char*)lds, vcu, G);
#endif
            } else if (q == 2) {
#if !defined(ONLY) || ONLY==4
                for (int rep = 0; rep < REP_ATTN; ++rep) attn_phase(Z, XH, q_norm + l * 128, k_norm + l * 128, (char*)lds, vcu, G);
#endif
#if !defined(ONLY) || ONLY==5
                for (int rep = 0; rep < REP_LIGHT; ++rep) dft_stage3(Yp, XH, ws, (char*)lds, vcu, G);
#endif
            } else if (q == 4) {
#if !defined(ONLY) || ONLY==6
                for (int rep = 1; rep < REP_RES; ++rep) resid_rows<true, true, 4>(nullptr, nullptr, XB, Z, g_post_mix + DM, nullptr, nullptr, (bf16_t*)(ws + WS_END), g_pre_ffn + DM, gw, NGW, lane);
                if (l == 0) resid_rows<false, true, 2>(x_prompt, x_sample, nullptr, Z, g_post_mix, nullptr, XB, XH, g_pre_ffn, gw, NGW, lane);
                else resid_rows<true, true, 4>(nullptr, nullptr, XB, Z, g_post_mix + DM, nullptr, XB, XH, g_pre_ffn + DM, gw, NGW, lane);
#endif
            } else if (q == 8) {
#if !defined(ONLY) || ONLY==6
                if (l == 0) resid_rows<true, true, 4>(nullptr, nullptr, XB, XH, g_post_ffn, nullptr, XB, XH, g_pre_mix + DM, gw, NGW, lane);
                else resid_rows<true, false, 4>(nullptr, nullptr, XB, XH, g_post_ffn + DM, p.out, nullptr, nullptr, nullptr, gw, NGW, lane);
#endif
            } else {
                const int c = 0, step = (q >= 5) ? (q - 5) : -1;
                const float* cwl = conv_w + (size_t)l * 3 * NUP; const float* cbl = conv_b + (size_t)l * NUP;
                if (step == 1) {
#if !defined(ONLY) || ONLY==7
                    for (int rep = 0; rep < REP_LIGHT; ++rep) glu_fix(HB, ACT, cwl, cbl, gtid, NT);
#endif
                } else if (step == 0) {
#if !defined(ONLY) || ONLY==9
                    pg8::Gemm g{XH + (size_t)c * CHUNK * DM, (const bf16_t*)((const unsigned char*)Wl + W_UP_OFF), CHUNK, NUP, DM};
                    pg8::StaticOrder S; S.init(g.M, g.N, G, bx);
                    EpiGlu E{ACT, HB, cwl, cbl};
                    for (int rep = 0; rep < REP_UP; ++rep) pg8::gemm_phase<EpiGlu, pg8::StaticOrder, PG8_ALIGN, PG8_SP2>(ring, g, S, E);
#endif
                } else {
#if !defined(ONLY) || ONLY==8
                    pg8::Gemm g; bf16_t* O;
                    if (q == 3) { g = pg8::Gemm{XH, (const bf16_t*)((const unsigned char*)Wl + W_OUT_OFF), MTOK, DM, DM}; O = Z; }
                    else { g = pg8::Gemm{ACT, (const bf16_t*)((const unsigned char*)Wl + W_DOWN_OFF), CHUNK, DM, DFF}; O = XH + (size_t)c * CHUNK * DM; }
                    pg8::StaticOrder S; S.init(g.M, g.N, G, bx);
                    pg8::EpiBf16<0> E{O, DM, nullptr, 0, 0, 1.f};
                    for (int rep = 0; rep < REP_PLAIN; ++rep) pg8::gemm_phase<pg8::EpiBf16<0>, pg8::StaticOrder, PG8_ALIGN, PG8_SP2>(ring, g, S, E);
#endif
                }
            }
        }
        if (ph + 1 < p.ph_hi) { for (int rep = 0; rep < REP_SYNC; ++rep) { if (MK_MULTI == 0 && ph != 0) xcd_barrier(xbar); else grid.sync(); } }
    }
}

extern "C" void kernel_launch(void* const* d_in, const int* in_sizes, int n_in, void* d_out, int out_size, void* d_ws, size_t ws_size, hipStream_t stream) {
    static int grid = 0;
    if (grid == 0) {
        if (n_in != 17 || out_size != MTOK * DM || ws_size < WS_END) { fprintf(stderr, "kernel_launch: unexpected shapes: n_in %d out %d ws %zu (need %zu)\n", n_in, out_size, ws_size, (size_t)WS_END); grid = -1; return; }
        int dev = 0, cus = 0, per_cu = 0;
        if (hipGetDevice(&dev) != hipSuccess || hipDeviceGetAttribute(&cus, hipDeviceAttributeMultiprocessorCount, dev) != hipSuccess) { grid = -1; return; }
        if (hipFuncSetAttribute((const void*)mega_fwd, hipFuncAttributeMaxDynamicSharedMemorySize, LDS_BYTES) != hipSuccess) { fprintf(stderr, "kernel_launch: hipFuncSetAttribute failed\n"); grid = -1; return; }
        if (hipOccupancyMaxActiveBlocksPerMultiprocessor(&per_cu, (const void*)mega_fwd, 512, LDS_BYTES) != hipSuccess || per_cu < 1) { fprintf(stderr, "kernel_launch: occupancy query says %d\n", per_cu); per_cu = 1; }
        (void)hipGetLastError();
        grid = cus * 1;
    }
    if (grid < 0) return;
    if (hipMemsetAsync((char*)d_ws + WS_BAR, 0, BAR_BYTES, stream) != hipSuccess) { fprintf(stderr, "kernel_launch: memset failed\n"); return; }
    Params p{};
    for (int i = 0; i < 17; ++i) p.in[i] = (const float*)d_in[i];
    p.out = (float*)d_out; p.ws = (unsigned char*)d_ws;
#if MK_MULTI
    for (int ph = 0; ph < NPHASE; ++ph) { p.ph_lo = ph; p.ph_hi = ph + 1; hipLaunchKernelGGL(mega_fwd, dim3(grid), dim3(512), LDS_BYTES, stream, p); }
#else
    p.ph_lo = 0; p.ph_hi = NPHASE;
    void* args[] = {&p};
    hipError_t e = hipLaunchCooperativeKernel((const void*)mega_fwd, dim3(grid), dim3(512), args, LDS_BYTES, stream);
    if (e != hipSuccess) fprintf(stderr, "cooperative launch failed: %s (grid %d)\n", hipGetErrorString(e), grid);
#endif
}
```
